# Optimizing an MI355X kernel written in HIP

```python
import math
import jax, jax.numpy as jnp
from jax import lax
import numpy as np

D_MODEL = 2048
BATCH = 2
SEQ = 4096
DEPTH = 1

GRID_W = 64
HEAD_DIM = 128
NA_HEADS = 8
NA_WIDTH = NA_HEADS * HEAD_DIM
NA_WIN_ROWS_MAX = 8
NA_WIN_COLS = 16
DA_HEADS = 4
DA_VDIM = 2 * HEAD_DIM
DA_WIDTH = DA_HEADS * DA_VDIM
DA_QK = DA_HEADS * HEAD_DIM
DA_Q_BLOCK = 128
DA_LAYER_LAMBDA_BASE = 0.8
MIX_WIDTH = NA_WIDTH + DA_WIDTH
IN_COLS = 3 * NA_WIDTH + 4 * DA_QK + DA_WIDTH
N_EXPERTS = 16
EC_CAPACITY_FACTOR = 2
EXPERT_FF = 2816
RMS_EPS = 1e-6

kernel_name = "hybrid_natten_diffattn_ec_moe"


def rms_norm(x, g):
    xf = x.astype(jnp.float32)
    y = xf * lax.rsqrt(jnp.mean(xf * xf, axis=-1, keepdims=True) + RMS_EPS)
    return (y * g.astype(jnp.float32)).astype(x.dtype)


def lambda_init(layer_idx):
    return DA_LAYER_LAMBDA_BASE - 0.6 * math.exp(-0.3 * layer_idx)


def neighborhood_attention(q, k, v, rpb):
    B, S, H, d = q.shape
    rows = S // GRID_W
    kh = min(NA_WIN_ROWS_MAX, rows)
    kw = NA_WIN_COLS
    qg = q.reshape(B, rows, GRID_W, H, d)
    kg = k.reshape(B, rows, GRID_W, H, d)
    vg = v.reshape(B, rows, GRID_W, H, d)
    r = jnp.arange(rows)
    rs = jnp.clip(r - kh // 2, 0, rows - kh)
    row_idx = rs[:, None] + jnp.arange(kh)[None, :]
    k_rows = kg[:, row_idx]
    v_rows = vg[:, row_idx]
    c = jnp.arange(GRID_W)
    cs = jnp.clip(c - kw // 2, 0, GRID_W - kw)
    col_valid = (c[None, :] >= cs[:, None]) & (c[None, :] < cs[:, None] + kw)
    row_off = row_idx - r[:, None] + (NA_WIN_ROWS_MAX - 1)
    col_off = jnp.clip(c[None, :] - c[:, None], -(kw - 1), kw - 1) + (kw - 1)
    bias = rpb[:, row_off[:, None, :, None], col_off[None, :, None, :]]
    s = jnp.einsum('brqhd,brkchd->bhrqkc', qg, k_rows).astype(jnp.float32) * (d ** -0.5)
    s = s + bias.astype(jnp.float32)[None]
    s = jnp.where(col_valid[:, None, :], s, -jnp.inf)
    p = jax.nn.softmax(s.reshape(B, H, rows, GRID_W, kh * GRID_W), axis=-1)
    p = p.reshape(s.shape).astype(v.dtype)
    o = jnp.einsum('bhrqkc,brkchd->brqhd', p, v_rows)
    return o.reshape(B, S, H * d)


def differential_attention(q1, q2, k1, k2, v, lam, slopes):
    B, S, H, d = q1.shape
    nb = S // DA_Q_BLOCK
    scale = d ** -0.5
    pos = jnp.arange(S, dtype=jnp.float32)

    def to_blocks(t):
        return t.reshape(B, nb, DA_Q_BLOCK, H, d).transpose(1, 0, 2, 3, 4)

    def block(args):
        q1b, q2b, tb = args
        dist = jnp.abs(tb[:, None] - pos[None, :])
        alibi = -slopes[:, None, None] * dist[None]
        s1 = jnp.einsum('bqhd,bkhd->bhqk', q1b, k1).astype(jnp.float32) * scale + alibi
        s2 = jnp.einsum('bqhd,bkhd->bhqk', q2b, k2).astype(jnp.float32) * scale + alibi
        w = jax.nn.softmax(s1, axis=-1) - lam * jax.nn.softmax(s2, axis=-1)
        return jnp.einsum('bhqk,bkhe->bqhe', w.astype(v.dtype), v)

    o = lax.map(block, (to_blocks(q1), to_blocks(q2), pos.reshape(nb, DA_Q_BLOCK)))
    return o.transpose(1, 0, 2, 3, 4).reshape(B, S, H, v.shape[-1])


def expert_choice_ffn(h, w_router, w_gate, w_up, w_down):
    B, S, D = h.shape
    n_exp = w_router.shape[-1]
    cap = EC_CAPACITY_FACTOR * S // n_exp
    aff = jax.nn.softmax((h @ w_router).astype(jnp.float32), axis=-1)
    gate, idx = lax.top_k(aff.transpose(0, 2, 1), cap)
    bidx = jnp.arange(B)[:, None, None]
    xs = h[bidx, idx]
    g = jnp.einsum('becd,edf->becf', xs, w_gate)
    u = jnp.einsum('becd,edf->becf', xs, w_up)
    y = jnp.einsum('becf,efd->becd', jax.nn.silu(g) * u, w_down)
    y = y * gate[..., None].astype(h.dtype)
    return jnp.zeros_like(h).at[bidx, idx].add(y)


def setup_inputs(seed: int = 0) -> dict:
    key = jax.random.key(seed)
    ks = jax.random.split(key, 20)
    f32 = jnp.float32
    L = DEPTH

    def nrm(k, shape, scale):
        return jax.random.normal(k, shape, f32) * scale

    def gain(k, shape):
        return 1.0 + 0.02 * jax.random.normal(k, shape, f32)

    return {
        "x": jax.random.normal(ks[0], (BATCH, SEQ, D_MODEL), f32),
        "ln1_g": gain(ks[1], (L, D_MODEL)),
        "w_in": nrm(ks[2], (L, D_MODEL, IN_COLS), D_MODEL ** -0.5),
        "qn_a": gain(ks[3], (L, HEAD_DIM)),
        "kn_a": gain(ks[4], (L, HEAD_DIM)),
        "rpb_a": nrm(ks[5], (L, NA_HEADS, 2 * NA_WIN_ROWS_MAX - 1, 2 * NA_WIN_COLS - 1), 0.5),
        "on_a": gain(ks[6], (L, NA_WIDTH)),
        "qn_b": gain(ks[7], (L, HEAD_DIM)),
        "kn_b": gain(ks[8], (L, HEAD_DIM)),
        "lam_q1": nrm(ks[9], (L, HEAD_DIM), 0.1),
        "lam_k1": nrm(ks[10], (L, HEAD_DIM), 0.1),
        "lam_q2": nrm(ks[11], (L, HEAD_DIM), 0.1),
        "lam_k2": nrm(ks[12], (L, HEAD_DIM), 0.1),
        "subln_b": gain(ks[13], (L, DA_VDIM)),
        "w_out": nrm(ks[14], (L, MIX_WIDTH, D_MODEL), MIX_WIDTH ** -0.5),
        "ln2_g": gain(ks[15], (L, D_MODEL)),
        "w_router": nrm(ks[16], (L, D_MODEL, N_EXPERTS), D_MODEL ** -0.5),
        "w_gate": nrm(ks[17], (L, N_EXPERTS, D_MODEL, EXPERT_FF), D_MODEL ** -0.5),
        "w_up": nrm(ks[18], (L, N_EXPERTS, D_MODEL, EXPERT_FF), D_MODEL ** -0.5),
        "w_down": nrm(ks[19], (L, N_EXPERTS, EXPERT_FF, D_MODEL), EXPERT_FF ** -0.5),
    }


def reference(x, ln1_g, w_in, qn_a, kn_a, rpb_a, on_a, qn_b, kn_b, lam_q1, lam_k1,
              lam_q2, lam_k2, subln_b, w_out, ln2_g, w_router, w_gate, w_up, w_down):
    B, S, _ = x.shape
    splits = [NA_WIDTH, 2 * NA_WIDTH, 3 * NA_WIDTH,
              3 * NA_WIDTH + DA_QK, 3 * NA_WIDTH + 2 * DA_QK,
              3 * NA_WIDTH + 3 * DA_QK, 3 * NA_WIDTH + 4 * DA_QK]
    slopes = 2.0 ** (-8.0 * jnp.arange(1, DA_HEADS + 1, dtype=jnp.float32) / DA_HEADS)
    for l in range(DEPTH):
        h = rms_norm(x, ln1_g[l])
        proj = h @ w_in[l]
        qa, ka, va, q1, q2, k1, k2, vb = jnp.split(proj, splits, axis=-1)
        qa = rms_norm(qa.reshape(B, S, NA_HEADS, HEAD_DIM), qn_a[l])
        ka = rms_norm(ka.reshape(B, S, NA_HEADS, HEAD_DIM), kn_a[l])
        va = va.reshape(B, S, NA_HEADS, HEAD_DIM)
        oa = rms_norm(neighborhood_attention(qa, ka, va, rpb_a[l]), on_a[l])
        lam_i = lambda_init(l)
        lam = (jnp.exp(jnp.sum(lam_q1[l].astype(jnp.float32) * lam_k1[l].astype(jnp.float32)))
               - jnp.exp(jnp.sum(lam_q2[l].astype(jnp.float32) * lam_k2[l].astype(jnp.float32)))
               + lam_i)
        q1 = rms_norm(q1.reshape(B, S, DA_HEADS, HEAD_DIM), qn_b[l])
        q2 = rms_norm(q2.reshape(B, S, DA_HEADS, HEAD_DIM), qn_b[l])
        k1 = rms_norm(k1.reshape(B, S, DA_HEADS, HEAD_DIM), kn_b[l])
        k2 = rms_norm(k2.reshape(B, S, DA_HEADS, HEAD_DIM), kn_b[l])
        vb = vb.reshape(B, S, DA_HEADS, DA_VDIM)
        ob = differential_attention(q1, q2, k1, k2, vb, lam, slopes)
        ob = (rms_norm(ob, subln_b[l]) * (1.0 - lam_i)).reshape(B, S, DA_WIDTH)
        x = x + jnp.concatenate([oa, ob], axis=-1) @ w_out[l]
        h2 = rms_norm(x, ln2_g[l])
        x = x + expert_choice_ffn(h2, w_router[l], w_gate[l], w_up[l], w_down[l])
    return x
```

```cpp
#include <hip/hip_runtime.h>
#include <stdint.h>
#include <stdio.h>

#ifndef MK_N_LAUNCHES
#define MK_N_LAUNCHES 1
#endif

#define LAS __attribute__((address_space(3)))
typedef unsigned short bf16_t;
typedef short bf16x8 __attribute__((ext_vector_type(8)));
typedef short s16x4 __attribute__((ext_vector_type(4)));
typedef float f32x4 __attribute__((ext_vector_type(4)));
typedef float f32x2 __attribute__((ext_vector_type(2)));
typedef float f32x16 __attribute__((ext_vector_type(16)));
typedef unsigned u32x4 __attribute__((ext_vector_type(4)));
typedef unsigned u32x2 __attribute__((ext_vector_type(2)));
typedef int i32x8 __attribute__((ext_vector_type(8)));
typedef int i32x4 __attribute__((ext_vector_type(4)));

constexpr int NB = 2, SEQ = 4096, DM = 2048, MTOK = NB * SEQ;
constexpr int INC = 6144;
constexpr int NEXP = 16, CAP = 512, FF = 2816, EROWS = NB * CAP;
constexpr float RMS_EPS = 1e-6f;
constexpr float LOG2E = 1.4426950408889634f;
constexpr float QSCALE = 0.088388347648318440f * LOG2E;
constexpr int NTHR = 512;

constexpr size_t al256(size_t x) { return (x + 255) / 256 * 256; }
constexpr size_t WS_CTL = 0, CTL_BYTES = 65536;
constexpr size_t WS_WIN = WS_CTL + CTL_BYTES;
constexpr size_t WS_WOUT = WS_WIN + (size_t)INC * DM * 2;
constexpr size_t WS_WGU = WS_WOUT + (size_t)DM * DM * 2;
constexpr size_t WS_WD = WS_WGU + (size_t)NEXP * 2 * FF * DM * 2;
constexpr size_t WS_H = WS_WD + (size_t)NEXP * DM * FF * 2;
constexpr size_t WS_PROJ = WS_H + (size_t)MTOK * DM * 2;
constexpr size_t WS_NASSQ = WS_PROJ + (size_t)MTOK * INC * 2;
constexpr size_t WS_MIX = WS_NASSQ + (size_t)MTOK * 1024 * 2;
constexpr size_t WS_OPART = WS_MIX + (size_t)MTOK * DM * 2;
constexpr size_t WS_ROWSS = WS_OPART + (size_t)MTOK * DM * 4;
constexpr size_t WS_AFF = WS_ROWSS + (size_t)MTOK * 32 * 4;
constexpr size_t WS_SELIDX = WS_AFF + (size_t)NB * NEXP * SEQ * 4;
constexpr size_t WS_SELGATE = WS_SELIDX + (size_t)NEXP * EROWS * 4;
constexpr size_t WS_SLOT = WS_SELGATE + (size_t)NEXP * EROWS * 4;
constexpr size_t WS_H2 = WS_SLOT + (size_t)NB * NEXP * SEQ * 4;
constexpr size_t WS_ACT = WS_H2 + (size_t)MTOK * DM * 2;
constexpr size_t WS_Y = WS_ACT + (size_t)NEXP * EROWS * FF * 2;
constexpr size_t WS_WRT = WS_Y + (size_t)NEXP * EROWS * DM * 2;
constexpr size_t WS_END = WS_WRT + (size_t)NEXP * DM * 4;

constexpr int STAGE_BYTES = 131072;
constexpr int SCR_OFF = STAGE_BYTES;
constexpr int SCR_BYTES = 16384;
constexpr int MISC_OFF = SCR_OFF + SCR_BYTES - 64;
constexpr int LDS_BYTES = SCR_OFF + SCR_BYTES;

__device__ __forceinline__ unsigned cvtpk(float lo, float hi) { unsigned r; asm volatile("v_cvt_pk_bf16_f32 %0, %1, %2" : "=v"(r) : "v"(lo), "v"(hi)); return r; }
__device__ __forceinline__ float wave_sum(float v) {
#pragma unroll
    for (int o = 32; o >= 1; o >>= 1) v += __shfl_xor(v, o);
    return v;
}
__device__ __forceinline__ unsigned cvt4_fp8(float a, float b, float c, float d) { int w = 0; w = __builtin_amdgcn_cvt_pk_fp8_f32(a, b, w, false); w = __builtin_amdgcn_cvt_pk_fp8_f32(c, d, w, true); return (unsigned)w; }
constexpr float WSC8 = 128.0f, HSC8 = 4.0f, ASC8 = 8.0f;
__device__ __forceinline__ float bf2f(bf16_t b) { return __uint_as_float(((unsigned)b) << 16); }

#define XB_TMO      128
#define XB_XCNT(j)  (256  + 64 * (j))
#define XB_XSUB(j)  (1280 + 64 * (j))
#define XB_XGEN(j)  (2304 + 64 * (j))
#define XB_TOP      3328
#define XB_TOPGEN   3392
#define XCD_BAR_WORDS 3456
#define XB_SPIN_CAP (1u << 18)

__device__ __forceinline__ unsigned xb_ld(unsigned* p)              { return __hip_atomic_load(p, __ATOMIC_RELAXED, __HIP_MEMORY_SCOPE_AGENT); }
__device__ __forceinline__ unsigned xb_add(unsigned* p, unsigned v) { return __hip_atomic_fetch_add(p, v, __ATOMIC_RELAXED, __HIP_MEMORY_SCOPE_AGENT); }
__device__ __forceinline__ unsigned xb_xcc_id() { return (unsigned)__builtin_amdgcn_s_getreg((3 << 11) | 20) & 0xFu; }
#define XB_SPIN(cond, bar) do { unsigned _sp = 0; while (cond) { __builtin_amdgcn_s_sleep(1); \
    if ((++_sp & 255u) == 0u) { if (xb_ld(&(bar)[XB_TMO])) break; if (_sp > XB_SPIN_CAP) { atomicAdd(&(bar)[XB_TMO], 1u); break; } } } } while (0)

struct XcdBarrier { unsigned* bar; unsigned x; volatile LAS unsigned* st; };

__device__ __forceinline__ XcdBarrier xcd_barrier_post(unsigned* bar, volatile LAS unsigned* st) {
    XcdBarrier b; b.bar = bar; b.x = xb_xcc_id(); b.st = st;
    if (threadIdx.x == 0) (void)xb_add(&bar[XB_XCNT(b.x)], 1u);
    return b;
}
__device__ __forceinline__ void xcd_barrier_complete(unsigned* bar, unsigned x, unsigned& nloc, unsigned& nx) {
    const unsigned G = gridDim.x * gridDim.y * gridDim.z;
    unsigned sum, cnt, mine, sp = 0u;
    for (;;) {
        sum = 0u; cnt = 0u; mine = 0u;
#pragma unroll
        for (unsigned j = 0; j < 16; ++j) { const unsigned c = xb_ld(&bar[XB_XCNT(j)]); sum += c; cnt += (c > 0u) ? 1u : 0u; mine = (j == x) ? c : mine; }
        if (sum == G) break;
        __builtin_amdgcn_s_sleep(1);
        if ((++sp & 255u) == 0u) { if (xb_ld(&bar[XB_TMO])) break; if (sp > XB_SPIN_CAP) { atomicAdd(&bar[XB_TMO], 1u); break; } }
    }
    nloc = mine > 0u ? mine : 1u; nx = cnt > 0u ? cnt : 1u;
}
__device__ __forceinline__ void xcd_barrier(const XcdBarrier& b) {
    asm volatile("s_waitcnt vmcnt(0)" ::: "memory");
    __syncthreads();
    if (threadIdx.x == 0) {
        unsigned* bar = b.bar;
        __builtin_amdgcn_s_waitcnt(0);
        unsigned nloc = b.st[0], nx = b.st[1];
        if (nloc == 0u) { xcd_barrier_complete(bar, b.x, nloc, nx); b.st[0] = nloc; b.st[1] = nx; }
        const unsigned old = xb_add(&bar[XB_XSUB(b.x)], 1u);
        const unsigned gen = old / nloc;
        if (old + 1u == (gen + 1u) * nloc) {
            __builtin_amdgcn_fence(__ATOMIC_RELEASE, "agent");
            asm volatile("s_waitcnt vmcnt(0)" ::: "memory");
            const unsigned og = xb_add(&bar[XB_TOP], 1u);
            const unsigned tg = og / nx;
            if (og + 1u == (tg + 1u) * nx) xb_add(&bar[XB_TOPGEN], 1u);
            else XB_SPIN(xb_ld(&bar[XB_TOPGEN]) == tg, bar);
            __builtin_amdgcn_fence(__ATOMIC_ACQUIRE, "agent");
            xb_add(&bar[XB_XGEN(b.x)], 1u);
            asm volatile("s_waitcnt vmcnt(0)" ::: "memory");
        } else {
            XB_SPIN(xb_ld(&bar[XB_XGEN(b.x)]) == gen, bar);
            __builtin_amdgcn_fence(__ATOMIC_ACQUIRE, "agent");
            asm volatile("s_waitcnt vmcnt(0)" ::: "memory");
        }
    }
    __syncthreads();
}

struct Params {
    const float* x; const float* ln1_g; const float* w_in; const float* qn_a; const float* kn_a; const float* rpb_a; const float* on_a;
    const float* qn_b; const float* kn_b; const float* lam_q1; const float* lam_k1; const float* lam_q2; const float* lam_k2; const float* subln_b;
    const float* w_out; const float* ln2_g; const float* w_router; const float* w_gate; const float* w_up; const float* w_down;
    float* out; unsigned char* ws; int ph_lo, ph_hi;
};

__device__ __forceinline__ void cvt_load(const float* __restrict__ src, int N, int k0, int n0, int tid, f32x4 (&v)[8], const float* kscale) {
    const int ln = tid & 63, kq = tid >> 6;
    const float* p = src + (size_t)(k0 + kq * 8) * N + n0 + ln * 4;
#pragma unroll
    for (int i = 0; i < 8; ++i) v[i] = __builtin_nontemporal_load((const f32x4*)(p + (size_t)i * N));
    if (kscale) {
#pragma unroll
        for (int i = 0; i < 8; ++i) v[i] = v[i] * kscale[k0 + kq * 8 + i];
    }
}
__device__ __forceinline__ void cvt_to_lds(LAS unsigned char* buf, int tid, const f32x4 (&v)[8]) {
    const int ln = tid & 63, kq = tid >> 6;
#pragma unroll
    for (int j = 0; j < 4; ++j) {
        u32x4 w; w.x = cvtpk(v[0][j], v[1][j]); w.y = cvtpk(v[2][j], v[3][j]); w.z = cvtpk(v[4][j], v[5][j]); w.w = cvtpk(v[6][j], v[7][j]);
        *(LAS u32x4*)(buf + (ln * 4 + j) * 144 + kq * 16) = w;
    }
}
__device__ __forceinline__ void cvt_store(const LAS unsigned char* buf, bf16_t* __restrict__ dst, int K, int k0, int n0, int blk, int off, int tid) {
#pragma unroll
    for (int q = 0; q < 4; ++q) {
        const int p = tid + q * 512, n = p >> 3, kp = p & 7, ng = n0 + n;
        const u32x4 w = *(const LAS u32x4*)(buf + n * 144 + kp * 16);
        const size_t drow = (size_t)(ng >> 7) * blk + off + (ng & 127);
        *(u32x4*)(dst + drow * K + k0 + kp * 8) = w;
    }
}
__device__ __forceinline__ void cvt_to_lds8(LAS unsigned char* buf, int tid, const f32x4 (&v)[8]) {
    const int ln = tid & 63, kq = tid >> 6, slot = (kq ^ (ln & 7)) * 8;
    f32x4 u[8];
#pragma unroll
    for (int i = 0; i < 8; ++i) u[i] = v[i] * WSC8;
#pragma unroll
    for (int j = 0; j < 4; ++j) {
        u32x2 w; w.x = cvt4_fp8(u[0][j], u[1][j], u[2][j], u[3][j]); w.y = cvt4_fp8(u[4][j], u[5][j], u[6][j], u[7][j]);
        *(LAS u32x2*)(buf + (ln * 4 + j) * 64 + slot) = w;
    }
}
__device__ __forceinline__ void cvt_store8(const LAS unsigned char* buf, unsigned char* __restrict__ dst, int Kb, int k0, int n0, int blk, int off, int tid) {
#pragma unroll
    for (int q = 0; q < 2; ++q) {
        const int p = tid + q * 512, n = p >> 2, kp = p & 3, ng = n0 + n, sw = (n >> 2) & 7;
        const u32x2 lo = *(const LAS u32x2*)(buf + n * 64 + ((2 * kp) ^ sw) * 8), hi = *(const LAS u32x2*)(buf + n * 64 + ((2 * kp + 1) ^ sw) * 8);
        const u32x4 w = {lo.x, lo.y, hi.x, hi.y};
        const size_t drow = (size_t)(ng >> 7) * blk + off + (ng & 127);
        __builtin_nontemporal_store(w, (u32x4*)(dst + drow * Kb + k0 + kp * 16));
    }
}
struct CvtTile { const float* src; bf16_t* dst; int K, N, k0, n0, blk, off; const float* kscale; int fp8; };
__device__ __forceinline__ void cvt_to_lds_any(LAS unsigned char* buf, int tid, const f32x4 (&v)[8], int fp8) { if (fp8) cvt_to_lds8(buf, tid, v); else cvt_to_lds(buf, tid, v); }
__device__ __forceinline__ void cvt_store_any(const LAS unsigned char* buf, const CvtTile& t, int tid) {
    if (t.fp8) cvt_store8(buf, (unsigned char*)t.dst, t.K, t.k0, t.n0, t.blk, t.off, tid); else cvt_store(buf, t.dst, t.K, t.k0, t.n0, t.blk, t.off, tid); }
template <int KIND> __device__ __forceinline__ constexpr int cvt_count() { return KIND == 0 ? 768 : KIND == 1 ? 256 : 16 * 352; }
template <int KIND> __device__ __forceinline__ CvtTile cvt_decode(const Params& P, int r) {
    CvtTile t; t.kscale = nullptr; t.fp8 = 0;
    if (KIND == 0) { t.src = P.w_in; t.dst = (bf16_t*)(P.ws + WS_WIN); t.K = DM; t.N = INC; t.k0 = (r / 24) * 64; t.n0 = (r % 24) * 256; t.blk = 128; t.off = 0; }
    else if (KIND == 1) { t.src = P.w_out; t.dst = (bf16_t*)(P.ws + WS_WOUT); t.K = DM; t.N = DM; t.k0 = (r / 8) * 64; t.n0 = (r % 8) * 256; t.blk = 128; t.off = 0; t.kscale = (t.k0 < 1024) ? P.on_a : nullptr; }
    else if (KIND == 2 || KIND == 3) { const int e = r / 352, q = r % 352;
        t.src = (KIND == 3 ? P.w_up : P.w_gate) + (size_t)e * DM * FF; t.dst = (bf16_t*)(P.ws + WS_WGU + (size_t)e * 2 * FF * DM);
        t.K = DM; t.N = FF; t.k0 = (q / 11) * 64; t.n0 = (q % 11) * 256; t.blk = 256; t.off = (KIND == 3) ? 128 : 0; t.fp8 = 1; }
    else { const int e = r / 352, q = r % 352;
        t.src = P.w_down + (size_t)e * FF * DM; t.dst = (bf16_t*)(P.ws + WS_WD + (size_t)e * DM * FF);
        t.K = FF; t.N = DM; t.k0 = (q / 8) * 64; t.n0 = (q % 8) * 256; t.blk = 128; t.off = 0; t.fp8 = 1; }
    return t;
}
constexpr int CW_QG = 4096, CW_QU = 4160, CW_QD = 4224;

template <int KIND> __device__ __forceinline__ void cvt_static(const Params& P, LAS unsigned char* lds) {
    const int tid = threadIdx.x, G = gridDim.x; constexpr int NT = cvt_count<KIND>();
    int idA = blockIdx.x, idB = blockIdx.x + G;
    f32x4 vA[8], vB[8];
    CvtTile tA = cvt_decode<KIND>(P, idA < NT ? idA : 0), tB = cvt_decode<KIND>(P, idB < NT ? idB : 0);
    if (idA < NT) cvt_load(tA.src, tA.N, tA.k0, tA.n0, tid, vA, tA.kscale);
    if (idB < NT) cvt_load(tB.src, tB.N, tB.k0, tB.n0, tid, vB, tB.kscale);
    for (;;) {
        if (idA >= NT) break;
        cvt_to_lds_any(lds, tid, vA, tA.fp8);
        { const int nid = idA + 2 * G; CvtTile tn = cvt_decode<KIND>(P, nid < NT ? nid : 0);
          if (nid < NT) cvt_load(tn.src, tn.N, tn.k0, tn.n0, tid, vA, tn.kscale);
          asm volatile("s_waitcnt lgkmcnt(0)" ::: "memory"); __builtin_amdgcn_s_barrier(); asm volatile("" ::: "memory");
          cvt_store_any(lds, tA, tid);
          tA = tn; idA = nid; }
        if (idB >= NT) break;
        cvt_to_lds_any(lds + 36864, tid, vB, tB.fp8);
        { const int nid = idB + 2 * G; CvtTile tn = cvt_decode<KIND>(P, nid < NT ? nid : 0);
          if (nid < NT) cvt_load(tn.src, tn.N, tn.k0, tn.n0, tid, vB, tn.kscale);
          asm volatile("s_waitcnt lgkmcnt(0)" ::: "memory"); __builtin_amdgcn_s_barrier(); asm volatile("" ::: "memory");
          cvt_store_any(lds + 36864, tB, tid);
          tB = tn; idB = nid; }
    }
}
__device__ __forceinline__ void p0_prologue(const Params& P, LAS unsigned char* lds) {
    int tid = threadIdx.x; asm volatile("" : "+v"(tid)); const int lane = tid & 63, wid = tid >> 6;
    {
        bf16_t* H = (bf16_t*)(P.ws + WS_H);
        for (int row = blockIdx.x * 8 + wid; row < MTOK; row += gridDim.x * 8) {
            const f32x4* xp = (const f32x4*)(P.x + (size_t)row * DM);
            f32x4 v[8]; float ss = 0.f;
#pragma unroll
            for (int i = 0; i < 8; ++i) { v[i] = xp[i * 64 + lane]; ss += v[i][0] * v[i][0] + v[i][1] * v[i][1] + v[i][2] * v[i][2] + v[i][3] * v[i][3]; }
            ss = wave_sum(ss);
            const float rstd = rsqrtf(ss * (1.0f / DM) + RMS_EPS);
#pragma unroll
            for (int i = 0; i < 8; ++i) {
                const f32x4 g = ((const f32x4*)P.ln1_g)[i * 64 + lane];
                u32x2 w; w.x = cvtpk(v[i][0] * rstd * g[0], v[i][1] * rstd * g[1]); w.y = cvtpk(v[i][2] * rstd * g[2], v[i][3] * rstd * g[3]);
                *(u32x2*)(H + (size_t)row * DM + (i * 64 + lane) * 4) = w;
            }
        }
    }
    cvt_static<0>(P, lds); __syncthreads(); cvt_static<1>(P, lds);
    { float* wrt = (float*)(P.ws + WS_WRT);
      for (int i = blockIdx.x * NTHR + tid; i < NEXP * DM; i += gridDim.x * NTHR) { const int e = i >> 11, c = i & 2047; wrt[i] = P.w_router[c * 16 + e]; } }
}
__device__ __forceinline__ void cvt_load_asm(const float* __restrict__ src, int N, int k0, int n0, int tid, f32x4 (&v)[8]) {
    const int ln = tid & 63, kq = tid >> 6;
    const float* p = src + (size_t)(k0 + kq * 8) * N + n0 + ln * 4;
#pragma unroll
    for (int i = 0; i < 8; ++i) { const float* q = p + (size_t)i * N; asm volatile("global_load_dwordx4 %0, %1, off nt" : "=v"(v[i]) : "v"(q) : "memory"); }
}
__device__ __forceinline__ void cvt_load_asm_s(const float* tile  , int N, unsigned voff, f32x4 (&v)[8]) {
#pragma unroll
    for (int i = 0; i < 8; ++i) { const float* q = tile + (size_t)i * N; asm volatile("global_load_dwordx4 %0, %1, %2 nt" : "=v"(v[i]) : "v"(voff), "s"(q) : "memory"); }
}
#define CVT_WAIT_SET(v, N) asm volatile("s_waitcnt vmcnt(" #N ")" : "+v"(v[0]), "+v"(v[1]), "+v"(v[2]), "+v"(v[3]), "+v"(v[4]), "+v"(v[5]), "+v"(v[6]), "+v"(v[7]) :: "memory")
template <int KIND> __device__ __forceinline__ void cvt_queue(const Params& P, LAS unsigned char* lds, unsigned* qhead) {
    const int tid = threadIdx.x; constexpr unsigned n = (unsigned)cvt_count<KIND>(); constexpr unsigned CH = 8;
    LAS unsigned* slot = (LAS unsigned*)(lds + 73728);
#define QCLAIM() __hip_atomic_fetch_add(qhead, CH, __ATOMIC_RELAXED, __HIP_MEMORY_SCOPE_AGENT)
    __syncthreads();
    if (tid == 0) { const unsigned s0 = QCLAIM(), s1 = QCLAIM(); slot[0] = s0; slot[1] = s1; }
    __syncthreads();
    unsigned cbase = slot[0], pos = 0, par = 1;
#define QGEN(dst) do { dst = cbase + pos; if (++pos == CH) { pos = 0; cbase = slot[par]; \
        if (tid == 0) { const unsigned nb_ = (cbase < n) ? QCLAIM() : 0xffffff00u; slot[par ^ 1] = nb_; } par ^= 1; } } while (0)
    unsigned id[4]; f32x4 v[4][8]; CvtTile t[4];
    const unsigned lvoff = (unsigned)(((tid >> 6) * 8 * cvt_decode<KIND>(P, 0).N + (tid & 63) * 4) * 4);
#pragma unroll
    for (int i = 0; i < 4; ++i) { unsigned g; QGEN(g); id[i] = __builtin_amdgcn_readfirstlane(g); t[i] = cvt_decode<KIND>(P, id[i] < n ? (int)id[i] : 0);
        cvt_load_asm_s(t[i].src + (size_t)t[i].k0 * t[i].N + t[i].n0, t[i].N, lvoff, v[i]); }
    CVT_WAIT_SET(v[0], 0); CVT_WAIT_SET(v[1], 0); CVT_WAIT_SET(v[2], 0); CVT_WAIT_SET(v[3], 0);
    bool more = true;
    while (more) {
#pragma unroll
        for (int i = 0; i < 4; ++i) {
            if (id[i] >= n) { more = false; break; }
            CVT_WAIT_SET(v[i], 32);
            LAS unsigned char* buf = lds + (i & 1) * 36864;
            cvt_to_lds_any(buf, tid, v[i], t[i].fp8);
            unsigned g; QGEN(g);
            asm volatile("s_waitcnt lgkmcnt(0)" ::: "memory"); __builtin_amdgcn_s_barrier(); asm volatile("" ::: "memory");
            const unsigned nx = __builtin_amdgcn_readfirstlane(g);
            CvtTile tn = cvt_decode<KIND>(P, nx < n ? (int)nx : 0);
            cvt_load_asm_s(tn.src + (size_t)tn.k0 * tn.N + tn.n0, tn.N, lvoff, v[i]);
            cvt_store_any(buf, t[i], tid);
            t[i] = tn; id[i] = nx;
        }
    }
    asm volatile("s_waitcnt vmcnt(0)" ::: "memory");
#undef QCLAIM
#undef QGEN
    __syncthreads();
}

namespace pg8 {
constexpr int BM = 256, BK = 64, HALF = 128, HTB = HALF * BK * 2, NXCD = 8, WGM = 8;
__device__ __forceinline__ int lds_byte(int r, int c) { const int st = (r >> 4) * 2 + (c >> 5), rr = r & 15, cc = c & 31, ob = rr * 64 + cc * 2; return st * 1024 + (ob ^ (((ob >> 9) & 1) << 5)); }
__device__ __forceinline__ void stage_rc(int b, int& R, int& C) { const int st = b / 1024, sb = b % 1024, swz = sb ^ (((sb >> 9) & 1) << 5); R = (st >> 1) * 16 + swz / 64; C = (st & 1) * 32 + (swz % 64) / 2; }
__device__ __forceinline__ int perm32(int rho) { const int n = rho >> 4, i = rho & 15; return 8 * (i >> 2) + 4 * n + (i & 3); }

struct Unit { int pm, pn, e; };

template <bool GATHER, bool HOOK, bool FP8, class Epi, class Sched>
__device__ __forceinline__ void gemm_phase(LAS unsigned char* lds, const int K, const Sched& S, const Epi& E, const LAS unsigned* gtab) {
    int tid = threadIdx.x; asm volatile("" : "+v"(tid));
    const int wid = __builtin_amdgcn_readfirstlane(tid >> 6), lane = tid & 63, wr = wid >> 2, wc = wid & 3, fr = lane & 15, fq = lane >> 4;
    const int nt = K / BK;
    unsigned voffA[2], voffB[2]; int RA[2], CA2[2];
#pragma unroll
    for (int i = 0; i < 2; ++i) { int R, C; stage_rc(tid * 16 + i * 8192, R, C); const int Rb = (R & ~31) + perm32(R & 31);
        voffA[i] = (unsigned)(R * K + C) * 2u; voffB[i] = (unsigned)(Rb * K + C) * 2u; RA[i] = R; CA2[i] = C * 2; }
    const size_t kstep = (size_t)(BK * 2);
    const size_t hstep = (size_t)HALF * K * 2;
    const unsigned ldsw = (unsigned)wid * 1024u;
    const int aoff = lds_byte(wr * 64 + fr, fq * 8), boff = lds_byte(wc * 32 + fr, fq * 8);
#define PG8_SA(b, h) (((b) * 2 + (h)) * HTB)
#define PG8_SB(b, h) ((4 + (b) * 2 + (h)) * HTB)
#define PG8_STAGE(bufoff, gbase, voff) do { _Pragma("unroll") for (int _i = 0; _i < 2; ++_i) \
        __builtin_amdgcn_global_load_lds((const unsigned*)((const char*)(gbase) + (voff)[_i]), (LAS unsigned*)(lds + (bufoff) + ldsw + _i * 8192), 16, 0, 0); } while (0)
#define PG8_STAGE_A(bufoff, ubase, kbytes, h, gv) do { if (GATHER) { PG8_STAGE(bufoff, (ubase) + (kbytes), (gv)[h]); } else { PG8_STAGE(bufoff, (ubase) + (kbytes) + (h) * hstep, voffA); } } while (0)
#define PG8_LD2(addr) __builtin_shufflevector(*(const LAS i32x4*)(addr), *(const LAS i32x4*)((addr) + 1024), 0, 1, 2, 3, 4, 5, 6, 7)
#define PG8_LDA(dst, b, h) do { if (FP8) { _Pragma("unroll") for (int m = 0; m < 4; ++m) dst##_f8[m] = PG8_LD2(lds + PG8_SA(b, h) + aoff + m * 2048); } \
        else { _Pragma("unroll") for (int m = 0; m < 4; ++m) _Pragma("unroll") for (int k = 0; k < 2; ++k) dst##_bf[m][k] = *(const LAS bf16x8*)(lds + PG8_SA(b, h) + aoff + m * 2048 + k * 1024); } } while (0)
#define PG8_LDB(dst, b, h) do { if (FP8) { _Pragma("unroll") for (int n = 0; n < 2; ++n) dst##_f8[n] = PG8_LD2(lds + PG8_SB(b, h) + boff + n * 2048); } \
        else { _Pragma("unroll") for (int n = 0; n < 2; ++n) _Pragma("unroll") for (int k = 0; k < 2; ++k) dst##_bf[n][k] = *(const LAS bf16x8*)(lds + PG8_SB(b, h) + boff + n * 2048 + k * 1024); } } while (0)
#define PG8_MMA(ai, bj, At, Bt) do { __builtin_amdgcn_s_setprio(1); \
        if (FP8) { _Pragma("unroll") for (int m = 0; m < 4; ++m) _Pragma("unroll") for (int n = 0; n < 2; ++n) \
            asm volatile("v_mfma_scale_f32_16x16x128_f8f6f4 %0, %1, %2, %0, %3, %3 op_sel_hi:[0,0,0]" : "+v"(acc[ai][bj][m][n]) : "v"(Bt##_f8[n]), "v"(At##_f8[m]), "v"(sc1)); } \
        else { _Pragma("unroll") for (int m = 0; m < 4; ++m) _Pragma("unroll") for (int n = 0; n < 2; ++n) _Pragma("unroll") for (int k = 0; k < 2; ++k) \
            acc[ai][bj][m][n] = __builtin_amdgcn_mfma_f32_16x16x32_bf16(Bt##_bf[n][k], At##_bf[m][k], acc[ai][bj][m][n], 0, 0, 0); } \
        __builtin_amdgcn_s_setprio(0); } while (0)
#define PG8_WAIT_V(n) asm volatile("s_waitcnt vmcnt(" #n ")" ::: "memory")
#define PG8_WAIT_L(n) asm volatile("s_waitcnt lgkmcnt(" #n ")" ::: "memory")
#define PG8_BAR __builtin_amdgcn_s_barrier()
#define PG8_SCHED __builtin_amdgcn_sched_barrier(0)
#define PG8_GLOAD(gv, i) do { if (GATHER) { _Pragma("unroll") for (int _h = 0; _h < 2; ++_h) _Pragma("unroll") for (int _i = 0; _i < 2; ++_i) (gv)[_h][_i] = gtab[(i) * 256 + _h * 128 + RA[_i]] + (unsigned)CA2[_i]; } } while (0)
    Unit cur, nxt; int ui = 0;
    if (!S.next(0, cur)) return;
    f32x4 acc[2][2][4][2];
    if constexpr (Epi::INIT) E.init(acc, cur, wr, wc, fr, fq, gtab);
    else {
#pragma unroll
    for (int a = 0; a < 2; ++a)
#pragma unroll
        for (int b = 0; b < 2; ++b)
#pragma unroll
            for (int m = 0; m < 4; ++m)
#pragma unroll
                for (int n = 0; n < 2; ++n) acc[a][b][m][n] = (f32x4){0.f, 0.f, 0.f, 0.f};
    }
    i32x8 At_f8[4], B0_f8[2], B1_f8[2]; bf16x8 At_bf[4][2], B0_bf[2][2], B1_bf[2][2];
    int sc1 = 0x7F7F7F7F; asm volatile("" : "+v"(sc1));
    unsigned gc[2][2] = {{0u, 0u}, {0u, 0u}}, gn[2][2] = {{0u, 0u}, {0u, 0u}};
    PG8_GLOAD(gc, 0);
    const char* cA = S.abase(cur); const char* cB = S.bbase(cur);
    PG8_STAGE(PG8_SB(0, 0), cB, voffB); PG8_STAGE_A(PG8_SA(0, 0), cA, 0, 0, gc); PG8_STAGE(PG8_SB(0, 1), cB + hstep, voffB); PG8_STAGE_A(PG8_SA(0, 1), cA, 0, 1, gc);
    if (wr == 1) PG8_BAR;
    PG8_WAIT_V(4); PG8_BAR;
    PG8_STAGE(PG8_SB(1, 0), cB + kstep, voffB); PG8_STAGE_A(PG8_SA(1, 0), cA, kstep, 0, gc); PG8_STAGE(PG8_SB(1, 1), cB + hstep + kstep, voffB);
    PG8_WAIT_V(6); PG8_BAR;
    for (;;) {
        const bool has_next = S.next(ui + 1, nxt);
        const char* nA = has_next ? S.abase(nxt) : cA; const char* nB = has_next ? S.bbase(nxt) : cB;
        if (GATHER) { if (has_next) { PG8_GLOAD(gn, ui + 1); } else {
#pragma unroll
            for (int _h = 0; _h < 2; ++_h)
#pragma unroll
                for (int _i = 0; _i < 2; ++_i) gn[_h][_i] = gc[_h][_i]; } }
        for (int t = 0; t < nt; t += 2) {
            const bool last = (t == nt - 2);
            const size_t k1 = (size_t)(t + 1) * kstep;
            const char* a2 = last ? nA : cA + (size_t)(t + 2) * kstep; const char* b2 = last ? nB : cB + (size_t)(t + 2) * kstep;
            const char* a3 = a2 + kstep; const char* b3 = b2 + kstep;
            unsigned g2[2][2];
#pragma unroll
            for (int _h = 0; _h < 2; ++_h)
#pragma unroll
                for (int _i = 0; _i < 2; ++_i) g2[_h][_i] = last ? gn[_h][_i] : gc[_h][_i];
            if (HOOK && t == 16) {
                const LAS float* ht = (const LAS float*)gtab;
#pragma unroll
                for (int a = 0; a < 2; ++a)
#pragma unroll
                    for (int m = 0; m < 4; ++m) { const float sc = ht[a * 128 + wr * 64 + m * 16 + fr];
#pragma unroll
                        for (int b = 0; b < 2; ++b)
#pragma unroll
                            for (int n = 0; n < 2; ++n) acc[a][b][m][n] = acc[a][b][m][n] * sc; }
            }
            PG8_LDB(B0, 0, 0); PG8_SCHED; PG8_LDA(At, 0, 0); PG8_STAGE_A(PG8_SA(1, 1), cA, k1, 1, gc);
            PG8_WAIT_L(8); PG8_BAR; PG8_WAIT_L(0); PG8_MMA(0, 0, At, B0); PG8_BAR; PG8_SCHED;
            PG8_LDB(B1, 0, 1); PG8_STAGE(PG8_SB(0, 0), b2, voffB);
            PG8_BAR; PG8_WAIT_L(0); PG8_MMA(0, 1, At, B1); PG8_BAR;
            PG8_LDA(At, 0, 1); PG8_STAGE_A(PG8_SA(0, 0), a2, 0, 0, g2);
            PG8_BAR; PG8_WAIT_L(0); PG8_MMA(1, 0, At, B0); PG8_BAR; PG8_SCHED;
            PG8_STAGE(PG8_SB(0, 1), b2 + hstep, voffB);
            PG8_WAIT_V(6); PG8_BAR; PG8_MMA(1, 1, At, B1); PG8_BAR;
            PG8_LDB(B0, 1, 0); PG8_SCHED; PG8_LDA(At, 1, 0); PG8_STAGE_A(PG8_SA(0, 1), a2, 0, 1, g2);
            PG8_WAIT_L(8); PG8_BAR; PG8_WAIT_L(0); PG8_MMA(0, 0, At, B0); PG8_BAR; PG8_SCHED;
            PG8_LDB(B1, 1, 1); PG8_STAGE(PG8_SB(1, 0), b3, voffB);
            PG8_BAR; PG8_WAIT_L(0); PG8_MMA(0, 1, At, B1); PG8_BAR;
            PG8_LDA(At, 1, 1); PG8_STAGE_A(PG8_SA(1, 0), a3, 0, 0, g2);
            PG8_BAR; PG8_WAIT_L(0); PG8_MMA(1, 0, At, B0); PG8_BAR; PG8_SCHED;
            PG8_STAGE(PG8_SB(1, 1), b3 + hstep, voffB);
            PG8_WAIT_V(6); PG8_BAR; PG8_MMA(1, 1, At, B1); PG8_BAR;
        }
        E(acc, cur, wr, wc, fr, fq, lds);
        if (!has_next) break;
#pragma unroll
        for (int a = 0; a < 2; ++a)
#pragma unroll
            for (int b = 0; b < 2; ++b)
#pragma unroll
                for (int m = 0; m < 4; ++m)
#pragma unroll
                    for (int n = 0; n < 2; ++n) acc[a][b][m][n] = (f32x4){0.f, 0.f, 0.f, 0.f};
        cur = nxt; cA = nA; cB = nB; ++ui;
#pragma unroll
        for (int _h = 0; _h < 2; ++_h)
#pragma unroll
            for (int _i = 0; _i < 2; ++_i) gc[_h][_i] = gn[_h][_i];
    }
    PG8_WAIT_V(0);
    if (wr == 0) PG8_BAR;
    PG8_BAR;
#undef PG8_SA
#undef PG8_SB
#undef PG8_STAGE
#undef PG8_STAGE_A
#undef PG8_LDA
#undef PG8_LDB
#undef PG8_MMA
#undef PG8_LD2
#undef PG8_WAIT_V
#undef PG8_WAIT_L
#undef PG8_BAR
#undef PG8_SCHED
#undef PG8_GLOAD
}

struct OrderMN {
    int nM, nN, nwg, G, c; const char* A; const char* Bt; size_t tstep;
    __device__ __forceinline__ void init(const void* A_, const void* Bt_, int M, int N, int K, int G_, int c_) { nM = M / BM; nN = N / BM; nwg = nM * nN; G = G_; c = c_; A = (const char*)A_; Bt = (const char*)Bt_; tstep = (size_t)BM * K * 2; }
    __device__ __forceinline__ bool next(int i, Unit& u) const {
        if (c >= G) return false;
        const long L = (long)i * G + c; if (L >= nwg) return false;
        int wgid = (int)L; { const int q = nwg / NXCD, r = nwg % NXCD, xcd = wgid % NXCD, off = wgid / NXCD; wgid = (xcd < r ? xcd * (q + 1) : r * (q + 1) + (xcd - r) * q) + off; }
        const int nig = WGM * nN, gid = wgid / nig, fm = gid * WGM, gsz = (nM - fm) < WGM ? (nM - fm) : WGM;
        u.pm = fm + ((wgid % nig) % gsz); u.pn = (wgid % nig) / gsz; u.e = 0; return true;
    }
    __device__ __forceinline__ const char* abase(const Unit& u) const { return A + (size_t)u.pm * tstep; }
    __device__ __forceinline__ const char* bbase(const Unit& u) const { return Bt + (size_t)u.pn * tstep; }
};
struct OrderExpert {
    int nN, ntile, G, c, per; const char* A; const char* Bt; size_t a_estride, b_estride, tstepA, tstepB; bool gather;
    __device__ __forceinline__ void init(const void* A_, const void* Bt_, int N, int K, size_t a_es, size_t b_es, bool gather_, int G_, int c_, int per_) {
        nN = N / BM; ntile = NEXP * nN; G = G_; c = c_; per = per_; A = (const char*)A_; Bt = (const char*)Bt_; a_estride = a_es; b_estride = b_es; tstepA = (size_t)BM * K * 2; tstepB = tstepA; gather = gather_; }
    __device__ __forceinline__ bool next(int i, Unit& u) const {
        int T, pm;
        if ((G & 7) == 0) {
            const int x = c & 7, j = c >> 3; if (j >= per) return false;
            const int q = i * per + j, U = 4 * nN; if (q >= 2 * U) return false;
            const int el = q >= U ? 1 : 0, r = q - el * U, chunk = r >> 5, w = r & 31;
            pm = w & 3; const int pn = chunk * 8 + (w >> 2);
            T = (2 * x + el) * nN + pn;
            if (pn >= nN) return false;
        }
        else { const int q = i * G + c; T = q >> 2; pm = q & 3; }
        if (T >= ntile) return false;
        u.e = T / nN; u.pn = T % nN; u.pm = pm; return true;
    }
    __device__ __forceinline__ const char* abase(const Unit& u) const { return gather ? A : A + (size_t)u.e * a_estride + (size_t)u.pm * tstepA; }
    __device__ __forceinline__ const char* bbase(const Unit& u) const { return Bt + (size_t)u.e * b_estride + (size_t)u.pn * tstepB; }
};
}

struct EpiInProj {
    static constexpr bool INIT = false;
    bf16_t* proj;
    __device__ __forceinline__ void operator()(const f32x4 (&acc)[2][2][4][2], const pg8::Unit& u, int wr, int wc, int fr, int fq, LAS unsigned char* lds) const {
        const int pn = u.pn, grp = pn >> 2;
        const int row0 = u.pm * 256 + wr * 64 + fr;
        if (grp == 5 || grp == 2) {
#pragma unroll
            for (int ai = 0; ai < 2; ++ai)
#pragma unroll
                for (int m = 0; m < 4; ++m) {
                    bf16_t* rowp = proj + (size_t)(row0 + ai * 128 + m * 16) * INC + pn * 256 + wc * 32 + 8 * fq;
#pragma unroll
                    for (int bj = 0; bj < 2; ++bj) { const f32x4 v0 = acc[ai][bj][m][0], v1 = acc[ai][bj][m][1];
                        u32x4 w; w.x = cvtpk(v0[0], v0[1]); w.y = cvtpk(v0[2], v0[3]); w.z = cvtpk(v1[0], v1[1]); w.w = cvtpk(v1[2], v1[3]);
                        *(u32x4*)(rowp + bj * 128) = w; }
                }
            return;
        }
        const int gsel = (grp == 0) ? 0 : (grp == 1) ? 1 : (grp == 3) ? 2 : 3;
        const LAS float* gain = (const LAS float*)(lds + SCR_OFF + 8192) + gsel * 128;
        const float osc = (grp == 0 || grp == 3) ? QSCALE : 1.0f;
        LAS float* Pt = (LAS float*)(lds + SCR_OFF);
#pragma unroll
        for (int ai = 0; ai < 2; ++ai)
#pragma unroll
            for (int m = 0; m < 4; ++m)
#pragma unroll
                for (int bj = 0; bj < 2; ++bj) {
                    const f32x4 v0 = acc[ai][bj][m][0], v1 = acc[ai][bj][m][1];
                    float s = (v0[0] * v0[0] + v0[1] * v0[1]) + (v0[2] * v0[2] + v0[3] * v0[3]) + (v1[0] * v1[0] + v1[1] * v1[1]) + (v1[2] * v1[2] + v1[3] * v1[3]);
                    s += __shfl_xor(s, 16); s += __shfl_xor(s, 32);
                    if (fq == 0) Pt[((ai * 128 + wr * 64 + m * 16 + fr) * 2 + bj) * 4 + wc] = s;
                }
        asm volatile("s_waitcnt lgkmcnt(0)" ::: "memory"); __builtin_amdgcn_s_barrier(); asm volatile("" ::: "memory");
        const f32x4 g0 = *(const LAS f32x4*)(gain + wc * 32 + 8 * fq), g1 = *(const LAS f32x4*)(gain + wc * 32 + 8 * fq + 4);
#pragma unroll
        for (int ai = 0; ai < 2; ++ai)
#pragma unroll
            for (int m = 0; m < 4; ++m) {
                bf16_t* rowp = proj + (size_t)(row0 + ai * 128 + m * 16) * INC + pn * 256 + wc * 32 + 8 * fq;
#pragma unroll
                for (int bj = 0; bj < 2; ++bj) {
                    const f32x4 ps = *(const LAS f32x4*)(Pt + ((ai * 128 + wr * 64 + m * 16 + fr) * 2 + bj) * 4);
                    const float rstd = rsqrtf(((ps[0] + ps[1]) + (ps[2] + ps[3])) * (1.0f / 128.0f) + RMS_EPS) * osc;
                    const f32x4 v0 = acc[ai][bj][m][0] * rstd * g0, v1 = acc[ai][bj][m][1] * rstd * g1;
                    u32x4 w; w.x = cvtpk(v0[0], v0[1]); w.y = cvtpk(v0[2], v0[3]); w.z = cvtpk(v1[0], v1[1]); w.w = cvtpk(v1[2], v1[3]);
                    *(u32x4*)(rowp + bj * 128) = w;
                }
            }
    }
};
struct EpiOutProj {
    static constexpr bool INIT = true;
    const float* x; float* out; float* rowss;
    __device__ __forceinline__ void init(f32x4 (&acc)[2][2][4][2], const pg8::Unit& u, int wr, int wc, int fr, int fq, const LAS unsigned* gtab) const {
        const LAS float* ht = (const LAS float*)gtab;
        const int row0 = u.pm * 256 + wr * 64 + fr, col0 = u.pn * 256 + wc * 32 + 8 * fq;
#pragma unroll
        for (int ai = 0; ai < 2; ++ai)
#pragma unroll
            for (int m = 0; m < 4; ++m) {
                const float isc = __builtin_amdgcn_rcpf(ht[ai * 128 + wr * 64 + m * 16 + fr]);
                const float* xp = x + (size_t)(row0 + ai * 128 + m * 16) * DM + col0;
#pragma unroll
                for (int bj = 0; bj < 2; ++bj)
#pragma unroll
                    for (int n = 0; n < 2; ++n) acc[ai][bj][m][n] = *(const f32x4*)(xp + bj * 128 + 4 * n) * isc;
            }
    }
    __device__ __forceinline__ void operator()(const f32x4 (&acc)[2][2][4][2], const pg8::Unit& u, int wr, int wc, int fr, int fq, LAS unsigned char* lds) const {
        const int row0 = u.pm * 256 + wr * 64 + fr, col0 = u.pn * 256 + wc * 32 + 8 * fq;
#pragma unroll
        for (int ai = 0; ai < 2; ++ai)
#pragma unroll
            for (int m = 0; m < 4; ++m) {
                const int row = row0 + ai * 128 + m * 16;
                float* op = out + (size_t)row * DM + col0;
                float s = 0.f;
#pragma unroll
                for (int bj = 0; bj < 2; ++bj)
#pragma unroll
                    for (int n = 0; n < 2; ++n) {
                        const f32x4 v = acc[ai][bj][m][n];
                        *(f32x4*)(op + bj * 128 + 4 * n) = v;
                        s += (v[0] * v[0] + v[1] * v[1]) + (v[2] * v[2] + v[3] * v[3]);
                    }
                s += __shfl_xor(s, 16); s += __shfl_xor(s, 32);
                if (fq == 0) rowss[(size_t)row * 32 + u.pn * 4 + wc] = s;
            }
    }
};
struct EpiGateUp {
    static constexpr bool INIT = false;
    unsigned char* act;
    __device__ __forceinline__ void operator()(const f32x4 (&acc)[2][2][4][2], const pg8::Unit& u, int wr, int wc, int fr, int fq, LAS unsigned char* lds) const {
        const int row0 = u.pm * 256 + wr * 64 + fr;
        unsigned char* base = act + (size_t)u.e * EROWS * FF + u.pn * 128 + wc * 32 + 8 * fq;
        constexpr float DS = 1.0f / (WSC8 * HSC8);
#pragma unroll
        for (int ai = 0; ai < 2; ++ai)
#pragma unroll
            for (int m = 0; m < 4; ++m) {
                float r[8];
#pragma unroll
                for (int n = 0; n < 2; ++n)
#pragma unroll
                    for (int j = 0; j < 4; ++j) { const float g = acc[ai][0][m][n][j] * DS, uu = acc[ai][1][m][n][j] * DS;
                        const float a = g * __builtin_amdgcn_rcpf(1.0f + __builtin_amdgcn_exp2f(-g * LOG2E)) * uu * ASC8;
                        r[n * 4 + j] = fminf(fmaxf(a, -448.0f), 448.0f); }
                u32x2 w; w.x = cvt4_fp8(r[0], r[1], r[2], r[3]); w.y = cvt4_fp8(r[4], r[5], r[6], r[7]);
                *(u32x2*)(base + (size_t)(row0 + ai * 128 + m * 16) * FF) = w;
            }
    }
};
struct EpiDown {
    static constexpr bool INIT = false;
    bf16_t* y; const float* selgate;
    __device__ __forceinline__ void operator()(const f32x4 (&acc)[2][2][4][2], const pg8::Unit& u, int wr, int wc, int fr, int fq, LAS unsigned char* lds) const {
        const int row0 = u.pm * 256 + wr * 64 + fr;
        bf16_t* base = y + (size_t)u.e * EROWS * DM + u.pn * 256 + wc * 32 + 8 * fq;
#pragma unroll
        for (int ai = 0; ai < 2; ++ai)
#pragma unroll
            for (int m = 0; m < 4; ++m) {
                const int row = row0 + ai * 128 + m * 16;
                const float gt = selgate[u.e * EROWS + row] * (1.0f / (WSC8 * ASC8));
#pragma unroll
                for (int bj = 0; bj < 2; ++bj) { const f32x4 v0 = acc[ai][bj][m][0] * gt, v1 = acc[ai][bj][m][1] * gt;
                    u32x4 w; w.x = cvtpk(v0[0], v0[1]); w.y = cvtpk(v0[2], v0[3]); w.z = cvtpk(v1[0], v1[1]); w.w = cvtpk(v1[2], v1[3]);
                    *(u32x4*)(base + (size_t)row * DM + bj * 128) = w; }
            }
    }
};

#define KSWZ(row, colB) ((row) * 256 + ((colB) ^ (((row) & 7) << 4)))
#define SBAR() __builtin_amdgcn_sched_barrier(0)
__device__ __forceinline__ int crow(int r, int hi) { return (r & 3) + 8 * (r >> 2) + 4 * hi; }
#define PK4(P, BASE, OUT) do { unsigned a0 = cvtpk(P[BASE + 0], P[BASE + 1]), a1 = cvtpk(P[BASE + 2], P[BASE + 3]);   \
    unsigned b0 = cvtpk(P[BASE + 4], P[BASE + 5]), b1 = cvtpk(P[BASE + 6], P[BASE + 7]);                              \
    auto r0 = __builtin_amdgcn_permlane32_swap(a0, b0, false, false); auto r1 = __builtin_amdgcn_permlane32_swap(a1, b1, false, false); \
    u32x4 w = {r0[0], r1[0], r0[1], r1[1]}; OUT = *reinterpret_cast<bf16x8*>(&w); } while (0)
__device__ __forceinline__ float swap_add(float v) { auto rr = __builtin_amdgcn_permlane32_swap(__float_as_uint(v), __float_as_uint(v), false, false); return __uint_as_float(rr[0]) + __uint_as_float(rr[1]); }

namespace da {
constexpr int D = 128, NW = 8, QBLK = 32, KVBLK = 64;
constexpr int SHM_V = KVBLK * D * 2, SHM_K = KVBLK * D * 2, SHM_ATTN = 2 * SHM_V + 2 * SHM_K + NW * 64 * 4;
constexpr int LDP = INC;

__device__ __forceinline__ void qkt(f32x16& p0, f32x16& p1, const LAS unsigned char* Ks, const bf16x8* qr, int r32, int hi) {
    p0 = f32x16{}; p1 = f32x16{};
#pragma unroll
    for (int d0 = 0; d0 < 8; ++d0) { const int cb = (d0 * 16 + hi * 8) * 2;
        const bf16x8 b0 = *(const LAS bf16x8*)(Ks + KSWZ(r32, cb));
        const bf16x8 b1 = *(const LAS bf16x8*)(Ks + KSWZ(32 + r32, cb));
        p0 = __builtin_amdgcn_mfma_f32_32x32x16_bf16(b0, qr[d0], p0, 0, 0, 0);
        p1 = __builtin_amdgcn_mfma_f32_32x32x16_bf16(b1, qr[d0], p1, 0, 0, 0); }
}
__device__ __forceinline__ int v_st(int k, int c) { const int kk = (k & ~0xC) | ((k & 4) << 1) | ((k & 8) >> 1); return ((kk >> 3) * 4 + (c >> 5)) * 512 + ((kk & 7) * 32 + (c & 31)) * 2; }
__device__ __forceinline__ int v_rd_base(int lane) { return ((lane & 3) << 3) | (((lane >> 2) & 3) << 6) | (((lane >> 4) & 1) << 5) | (((lane >> 5) & 1) << 8); }
constexpr int v_rd_off(int d0, int ks, int half) { return d0 * 512 + ks * 4096 + half * 2048; }
template <int OFF> __device__ __forceinline__ s16x4 tr_read(int vb) {
    s16x4 r; asm volatile("ds_read_b64_tr_b16 %0, %1 offset:%2" : "=&v"(r) : "v"(vb), "i"(OFF) : "memory"); return r;
}
template <int D0> __device__ __forceinline__ void pv_one(f32x16& od, int vb, bf16x8 pa0, bf16x8 pa1, bf16x8 pa2, bf16x8 pa3) {
    const s16x4 l0 = tr_read<v_rd_off(D0, 0, 0)>(vb), h0 = tr_read<v_rd_off(D0, 0, 1)>(vb), l1 = tr_read<v_rd_off(D0, 1, 0)>(vb), h1 = tr_read<v_rd_off(D0, 1, 1)>(vb);
    const s16x4 l2 = tr_read<v_rd_off(D0, 2, 0)>(vb), h2 = tr_read<v_rd_off(D0, 2, 1)>(vb), l3 = tr_read<v_rd_off(D0, 3, 0)>(vb), h3 = tr_read<v_rd_off(D0, 3, 1)>(vb);
    asm volatile("s_waitcnt lgkmcnt(0)" ::: "memory"); SBAR();
#define PKV(L, H) (bf16x8){L[0], L[1], L[2], L[3], H[0], H[1], H[2], H[3]}
    od = __builtin_amdgcn_mfma_f32_32x32x16_bf16(pa0, PKV(l0, h0), od, 0, 0, 0);
    od = __builtin_amdgcn_mfma_f32_32x32x16_bf16(pa1, PKV(l1, h1), od, 0, 0, 0);
    od = __builtin_amdgcn_mfma_f32_32x32x16_bf16(pa2, PKV(l2, h2), od, 0, 0, 0);
    od = __builtin_amdgcn_mfma_f32_32x32x16_bf16(pa3, PKV(l3, h3), od, 0, 0, 0);
#undef PKV
}
__device__ __forceinline__ void pv_d0(f32x16* o, int vb, bf16x8 pa0, bf16x8 pa1, bf16x8 pa2, bf16x8 pa3) {
    pv_one<0>(o[0], vb, pa0, pa1, pa2, pa3); pv_one<1>(o[1], vb, pa0, pa1, pa2, pa3); pv_one<2>(o[2], vb, pa0, pa1, pa2, pa3); pv_one<3>(o[3], vb, pa0, pa1, pa2, pa3);
}
__device__ __forceinline__ void sm_a(f32x16& p0, f32x16& p1, float dq, float slope2) {
#pragma unroll
    for (int r = 0; r < 16; ++r) { const float c = (float)((r & 3) + 8 * (r >> 2)); p0[r] = __builtin_amdgcn_exp2f(p0[r] - slope2 * fabsf(dq - c)); }
#pragma unroll
    for (int r = 0; r < 16; ++r) { const float c = (float)((r & 3) + 8 * (r >> 2) + 32); p1[r] = p1[r] - slope2 * fabsf(dq - c); }
}
__device__ __forceinline__ void sm_b(f32x16& p0, f32x16& p1, float& l_reg, bf16x8& pa0, bf16x8& pa1, bf16x8& pa2, bf16x8& pa3) {
#pragma unroll
    for (int r = 0; r < 16; ++r) p1[r] = __builtin_amdgcn_exp2f(p1[r]);
    float ps = 0;
#pragma unroll
    for (int r = 0; r < 16; ++r) ps += p0[r];
#pragma unroll
    for (int r = 0; r < 16; ++r) ps += p1[r];
    l_reg += swap_add(ps);
    PK4(p0, 0, pa0); PK4(p0, 8, pa1); PK4(p1, 0, pa2); PK4(p1, 8, pa3);
}
__device__ __forceinline__ void attn_body(const bf16_t* __restrict__ Qb, const bf16_t* __restrict__ Kh, const bf16_t* __restrict__ Vh, float* __restrict__ Ob, int q0, float slope2, LAS unsigned char* lds) {
    const int tid = threadIdx.x, wid = tid >> 6, lane = tid & 63, r32 = lane & 31, hi = lane >> 5;
    LAS unsigned char* V_lds = lds; LAS unsigned char* K_lds = lds + 2 * SHM_V;
    LAS float* li_l = (LAS float*)(lds + 2 * SHM_V + 2 * SHM_K) + wid * 64;
    float l_reg = 0; f32x16 o[4] = {}; bf16x8 qr[8];
    const bf16_t* Qw = Qb + (size_t)(wid * QBLK + r32) * LDP + hi * 8;
#pragma unroll
    for (int d0 = 0; d0 < 8; ++d0) qr[d0] = *(const bf16x8*)(Qw + d0 * 16);
    const int sr = tid >> 4, sc = (tid & 15) * 8, vst0 = v_st(sr, sc), vst1 = v_st(32 + sr, sc);
    const int vb0 = (int)(uintptr_t)V_lds + v_rd_base(lane);
    const float dqbase = (float)(q0 + wid * QBLK + r32 - 4 * hi);
    struct { bf16x8 vs0, vs1, ks0, ks1; } sr_[1];
    const unsigned so0 = (unsigned)(sr * LDP + sc) * 2u, so1 = (unsigned)((32 + sr) * LDP + sc) * 2u;
#define SLOAD(i, k0) do { const char* vb_ = (const char*)Vh + (size_t)(k0) * (LDP * 2); const char* kb_ = (const char*)Kh + (size_t)(k0) * (LDP * 2); \
    sr_[i].vs0 = *(const bf16x8*)(vb_ + so0); sr_[i].vs1 = *(const bf16x8*)(vb_ + so1); \
    sr_[i].ks0 = *(const bf16x8*)(kb_ + so0); sr_[i].ks1 = *(const bf16x8*)(kb_ + so1); } while (0)
#define SWRITE(b, i) do { *(LAS bf16x8*)(V_lds + (b) * SHM_V + vst0) = sr_[i].vs0;          \
    *(LAS bf16x8*)(V_lds + (b) * SHM_V + vst1) = sr_[i].vs1; const int kc = sc * 2;               \
    *(LAS bf16x8*)(K_lds + (b) * SHM_K + KSWZ(sr, kc)) = sr_[i].ks0;                       \
    *(LAS bf16x8*)(K_lds + (b) * SHM_K + KSWZ(32 + sr, kc)) = sr_[i].ks1; } while (0)
#define SWAIT() asm volatile("s_waitcnt vmcnt(0)" ::: "memory")
    f32x16 pA0, pA1, pB0, pB1; bf16x8 pa0, pa1, pa2, pa3; constexpr int NT = SEQ / KVBLK;
    SLOAD(0, 0); SWAIT(); SWRITE(0, 0); __syncthreads();
    qkt(pA0, pA1, K_lds, qr, r32, hi); sm_a(pA0, pA1, dqbase, slope2);
    SLOAD(0, KVBLK);
    SWAIT(); SWRITE(1, 0); __syncthreads();
    for (int j = 1; j + 1 < NT; j += 2) {
        SBAR(); qkt(pB0, pB1, K_lds + SHM_K, qr, r32, hi);
        sm_b(pA0, pA1, l_reg, pa0, pa1, pa2, pa3); SBAR();
        SLOAD(0, (j + 1) * KVBLK); SBAR();
        pv_d0(o, vb0, pa0, pa1, pa2, pa3); sm_a(pB0, pB1, dqbase - (float)(j * KVBLK), slope2);
        __syncthreads(); SWAIT(); SWRITE(0, 0);
        __syncthreads();
        SBAR(); qkt(pA0, pA1, K_lds, qr, r32, hi);
        sm_b(pB0, pB1, l_reg, pa0, pa1, pa2, pa3); SBAR();
        SLOAD(0, (j + 2) * KVBLK); SBAR();
        pv_d0(o, vb0 + SHM_V, pa0, pa1, pa2, pa3); sm_a(pA0, pA1, dqbase - (float)((j + 1) * KVBLK), slope2);
        __syncthreads(); SWAIT(); SWRITE(1, 0);
        __syncthreads();
    }
    SBAR(); qkt(pB0, pB1, K_lds + SHM_K, qr, r32, hi);
    sm_b(pA0, pA1, l_reg, pa0, pa1, pa2, pa3); SBAR();
    pv_d0(o, vb0, pa0, pa1, pa2, pa3); sm_a(pB0, pB1, dqbase - (float)((NT - 1) * KVBLK), slope2);
    __syncthreads();
    sm_b(pB0, pB1, l_reg, pa0, pa1, pa2, pa3); SBAR();
    pv_d0(o, vb0 + SHM_V, pa0, pa1, pa2, pa3);
    if (hi == 0) li_l[r32] = l_reg; asm volatile("s_waitcnt lgkmcnt(0)" ::: "memory");
    float rli[16];
#pragma unroll
    for (int r = 0; r < 16; ++r) rli[r] = __builtin_amdgcn_rcpf(li_l[crow(r, hi)]);
    float* Ow = Ob + (size_t)(wid * QBLK) * DM;
#pragma unroll
    for (int r = 0; r < 16; ++r) { const int orow = crow(r, hi);
#pragma unroll
        for (int d0 = 0; d0 < 4; ++d0) Ow[(size_t)orow * DM + d0 * 32 + r32] = o[d0][r] * rli[r]; }
    __syncthreads();
#undef SLOAD
#undef SWRITE
#undef SWAIT
}
}

namespace da2 {
constexpr int BUFB = 65536, KB = 16384;
__device__ __forceinline__ int v_rd_base(int lane) { return ((lane & 3) << 3) | (((lane >> 2) & 3) << 6) | (((lane >> 4) & 1) << 5) | (((lane >> 5) & 1) << 8); }
template <int OFF> __device__ __forceinline__ s16x4 tr_read(int vb) {
    s16x4 r; asm volatile("ds_read_b64_tr_b16 %0, %1 offset:%2" : "=&v"(r) : "v"(vb), "i"(OFF) : "memory"); return r;
}
template <int NCB, int CB> __device__ __forceinline__ void pv_one(f32x16& od, int vb, bf16x8 pa0, bf16x8 pa1, bf16x8 pa2, bf16x8 pa3) {
    constexpr int S = NCB * 512;
    const s16x4 l0 = tr_read<CB * 512 + 0 * S>(vb), h0 = tr_read<CB * 512 + 1 * S>(vb), l1 = tr_read<CB * 512 + 2 * S>(vb), h1 = tr_read<CB * 512 + 3 * S>(vb);
    const s16x4 l2 = tr_read<CB * 512 + 4 * S>(vb), h2 = tr_read<CB * 512 + 5 * S>(vb), l3 = tr_read<CB * 512 + 6 * S>(vb), h3 = tr_read<CB * 512 + 7 * S>(vb);
    asm volatile("s_waitcnt lgkmcnt(0)" ::: "memory"); SBAR();
#define PKV(L, H) (bf16x8){L[0], L[1], L[2], L[3], H[0], H[1], H[2], H[3]}
    od = __builtin_amdgcn_mfma_f32_32x32x16_bf16(pa0, PKV(l0, h0), od, 0, 0, 0);
    od = __builtin_amdgcn_mfma_f32_32x32x16_bf16(pa1, PKV(l1, h1), od, 0, 0, 0);
    od = __builtin_amdgcn_mfma_f32_32x32x16_bf16(pa2, PKV(l2, h2), od, 0, 0, 0);
    od = __builtin_amdgcn_mfma_f32_32x32x16_bf16(pa3, PKV(l3, h3), od, 0, 0, 0);
#undef PKV
}
__device__ __forceinline__ void qkt(f32x16& p0, f32x16& p1, const LAS unsigned char* Ks, const bf16x8* qr, int r32, int hi) {
    p0 = f32x16{}; p1 = f32x16{};
#pragma unroll
    for (int d0 = 0; d0 < 8; ++d0) { const int cb = (d0 * 16 + hi * 8) * 2;
        const bf16x8 b0 = *(const LAS bf16x8*)(Ks + KSWZ(r32, cb));
        const bf16x8 b1 = *(const LAS bf16x8*)(Ks + KSWZ(32 + r32, cb));
        p0 = __builtin_amdgcn_mfma_f32_32x32x16_bf16(b0, qr[d0], p0, 0, 0, 0);
        p1 = __builtin_amdgcn_mfma_f32_32x32x16_bf16(b1, qr[d0], p1, 0, 0, 0); }
}
__device__ __forceinline__ int unswap23(int kk) { return (kk & ~0xC) | ((kk & 4) << 1) | ((kk & 8) >> 1); }

__device__ __forceinline__ void epilogue(const Params& P, LAS unsigned char* lds, f32x16 (&o)[8], float l_reg, int tz, int it) {
    const int wid = __builtin_amdgcn_readfirstlane(tz >> 6), lane = tz & 63, r32 = lane & 31, hi = lane >> 5;
    float lam;
    { float a = P.lam_q1[lane] * P.lam_k1[lane] + P.lam_q1[lane + 64] * P.lam_k1[lane + 64];
      float c = P.lam_q2[lane] * P.lam_k2[lane] + P.lam_q2[lane + 64] * P.lam_k2[lane + 64];
      a = wave_sum(a); c = wave_sum(c); lam = expf(a) - expf(c) + 0.2f; }
    const int br = wid >> 2, w4 = wid & 3;
    const int b = it >> 7, h = (it >> 5) & 3, qt = it & 31;
    const size_t row0 = (size_t)b * SEQ; const int q0 = qt * 128;
    LAS float* li_l = (LAS float*)(lds + SCR_OFF) + wid * 32;
    if (hi == 0) li_l[r32] = l_reg;
    asm volatile("s_waitcnt lgkmcnt(0)" ::: "memory");
    __syncthreads();
    LAS float* X = (LAS float*)lds + w4 * 8192;
    if (br == 1) {
#pragma unroll
        for (int r = 0; r < 16; ++r) { const float rl = __builtin_amdgcn_rcpf(li_l[crow(r, hi)]);
#pragma unroll
            for (int d = 0; d < 8; ++d) X[(r * 8 + d) * 64 + lane] = o[d][r] * rl; }
    }
    __syncthreads();
    if (br == 0) {
        LAS unsigned char* T = (LAS unsigned char*)X;
        float g[8];
#pragma unroll
        for (int d = 0; d < 8; ++d) g[d] = P.subln_b[d * 32 + r32];
#pragma unroll
        for (int r = 0; r < 16; ++r) {
            const float rl = __builtin_amdgcn_rcpf(li_l[crow(r, hi)]);
            float v[8], sq = 0.f;
#pragma unroll
            for (int d = 0; d < 8; ++d) { v[d] = o[d][r] * rl - lam * X[(r * 8 + d) * 64 + lane]; sq += v[d] * v[d]; }
#pragma unroll
            for (int sh = 16; sh >= 1; sh >>= 1) sq += __shfl_xor(sq, sh);
            const float rstd = rsqrtf(sq * (1.0f / 256.0f) + RMS_EPS) * 0.8f;
#pragma unroll
            for (int d = 0; d < 8; ++d) { const unsigned w = cvtpk(v[d] * rstd * g[d], 0.f); *(LAS bf16_t*)(T + (2 * r + hi) * 512 + (d * 32 + r32) * 2) = (bf16_t)(w & 0xffffu); }
        }
        asm volatile("s_waitcnt lgkmcnt(0)" ::: "memory");
        char* mixb = (char*)((bf16_t*)(P.ws + WS_MIX) + (row0 + q0 + w4 * 32) * DM + 1024 + h * 256);
        const unsigned loff = (unsigned)(hi * 4 * DM * 2 + r32 * 16);
#pragma unroll
        for (int i = 0; i < 16; ++i) {
            const u32x4 w = *(const LAS u32x4*)(T + (2 * i + hi) * 512 + r32 * 16);
            *(u32x4*)(mixb + (size_t)((i & 3) + 8 * (i >> 2)) * (DM * 2) + loff) = w;
        }
    }
    __syncthreads();
}
__device__ __forceinline__ void item(const Params& P, int it, LAS unsigned char* lds) {
    int tid = threadIdx.x; asm volatile("" : "+v"(tid));
    const int wid = __builtin_amdgcn_readfirstlane(tid >> 6), lane = tid & 63, r32 = lane & 31, hi = lane >> 5;
    const int br = wid >> 2, w4 = wid & 3;
    const int b = it >> 7, h = (it >> 5) & 3, qt = it & 31;
    const bf16_t* proj = (const bf16_t*)(P.ws + WS_PROJ);
    const size_t row0 = (size_t)b * SEQ; const int q0 = qt * 128;
    bf16x8 qr[8];
    { const bf16_t* Qw = proj + (row0 + q0 + w4 * 32 + r32) * INC + 3072 + br * 512 + h * 128 + hi * 8;
#pragma unroll
      for (int d0 = 0; d0 < 8; ++d0) qr[d0] = *(const bf16x8*)(Qw + d0 * 16); }
    const char* kbase = (const char*)(proj + row0 * INC + 4096 + h * 128);
    const char* vbase = (const char*)(proj + row0 * INC + 5120 + h * 256);
    const int krow = wid * 8 + (lane >> 4);
    const unsigned voffK0 = (unsigned)(krow * INC * 2 + (((lane & 15) ^ (lane >> 4)) << 4));
    const unsigned voffK1 = (unsigned)((krow + 4) * INC * 2 + (((lane & 15) ^ (4 + (lane >> 4))) << 4));
    const unsigned voffV = (unsigned)(unswap23(wid * 8 + ((lane & 31) >> 2)) * INC * 2 + (lane >> 5) * 64 + (lane & 3) * 16);
#define DA2_ISSUE(t, bufi) do { const char* kb_ = kbase + (size_t)(t) * (64 * INC * 2); const char* vb_ = vbase + (size_t)(t) * (64 * INC * 2); \
        LAS unsigned char* lb_ = lds + (bufi) * BUFB; \
        __builtin_amdgcn_global_load_lds((const unsigned*)(kb_ + voffK0), (LAS unsigned*)(lb_ + wid * 2048), 16, 0, 0); \
        __builtin_amdgcn_global_load_lds((const unsigned*)(kb_ + voffK1), (LAS unsigned*)(lb_ + wid * 2048 + 1024), 16, 0, 0); \
        __builtin_amdgcn_global_load_lds((const unsigned*)(kb_ + 1024 + voffK0), (LAS unsigned*)(lb_ + KB + wid * 2048), 16, 0, 0); \
        __builtin_amdgcn_global_load_lds((const unsigned*)(kb_ + 1024 + voffK1), (LAS unsigned*)(lb_ + KB + wid * 2048 + 1024), 16, 0, 0); \
        _Pragma("unroll") for (int i_ = 0; i_ < 4; ++i_) \
            __builtin_amdgcn_global_load_lds((const unsigned*)(vb_ + i_ * 128 + voffV), (LAS unsigned*)(lb_ + 2 * KB + wid * 4096 + i_ * 1024), 16, 0, 0); } while (0)
    const float slope2 = exp2f(-2.0f * (float)(h + 1)) * LOG2E;
    float dq = (float)(q0 + w4 * 32 + r32 - 4 * hi);
    f32x16 o[8];
#pragma unroll
    for (int d = 0; d < 8; ++d) o[d] = f32x16{};
    float l_reg = 0.f;
    const int vb0 = (int)(uintptr_t)(lds + 2 * KB) + v_rd_base(lane);
    DA2_ISSUE(0, 0);
#pragma unroll 1
    for (int j = 0; j < SEQ / 64; ++j) {
        asm volatile("s_waitcnt vmcnt(0)" ::: "memory");
        __builtin_amdgcn_s_barrier();
        asm volatile("" ::: "memory");
        if (j + 1 < SEQ / 64) DA2_ISSUE(j + 1, (j + 1) & 1);
        const LAS unsigned char* Kb = lds + (j & 1) * BUFB + br * KB;
        f32x16 p0, p1;
        qkt(p0, p1, Kb, qr, r32, hi);
        float ps = 0.f;
#pragma unroll
        for (int r = 0; r < 16; ++r) { const float c = (float)((r & 3) + 8 * (r >> 2)); p0[r] = __builtin_amdgcn_exp2f(p0[r] - slope2 * fabsf(dq - c)); ps += p0[r]; }
#pragma unroll
        for (int r = 0; r < 16; ++r) { const float c = (float)((r & 3) + 8 * (r >> 2) + 32); p1[r] = __builtin_amdgcn_exp2f(p1[r] - slope2 * fabsf(dq - c)); ps += p1[r]; }
        l_reg += swap_add(ps);
        bf16x8 pa0, pa1, pa2, pa3;
        PK4(p0, 0, pa0); PK4(p0, 8, pa1); PK4(p1, 0, pa2); PK4(p1, 8, pa3);
        const int vb = vb0 + (j & 1) * BUFB;
        pv_one<8, 0>(o[0], vb, pa0, pa1, pa2, pa3); pv_one<8, 1>(o[1], vb, pa0, pa1, pa2, pa3); pv_one<8, 2>(o[2], vb, pa0, pa1, pa2, pa3); pv_one<8, 3>(o[3], vb, pa0, pa1, pa2, pa3);
        pv_one<8, 4>(o[4], vb, pa0, pa1, pa2, pa3); pv_one<8, 5>(o[5], vb, pa0, pa1, pa2, pa3); pv_one<8, 6>(o[6], vb, pa0, pa1, pa2, pa3); pv_one<8, 7>(o[7], vb, pa0, pa1, pa2, pa3);
        dq -= 64.0f;
    }
#undef DA2_ISSUE
    int tz = threadIdx.x; asm volatile("" : "+v"(tz));
    epilogue(P, lds, o, l_reg, tz, it);
}
}

namespace da3 {
constexpr int BUFB = 65536, KB = 16384;
__device__ __forceinline__ void qk_softmax(const LAS unsigned char* Kb, const bf16x8* qr, int r32, int hi, float dq, float slope2, int rel  ,
                                           float& l_reg, bf16x8& pa0, bf16x8& pa1, bf16x8& pa2, bf16x8& pa3) {
    f32x16 p0, p1;
    if (rel != 0) {
        const float ss = rel < 0 ? slope2 : -slope2, A = -ss * dq;
#pragma unroll
        for (int r = 0; r < 16; ++r) { const float c = (float)((r & 3) + 8 * (r >> 2)); p0[r] = fmaf(ss, c, A); p1[r] = fmaf(ss, c + 32.0f, A); }
    } else {
#pragma unroll
        for (int r = 0; r < 16; ++r) { const float c = (float)((r & 3) + 8 * (r >> 2)); p0[r] = -slope2 * fabsf(dq - c); p1[r] = -slope2 * fabsf(dq - c - 32.0f); }
    }
#pragma unroll
    for (int d0 = 0; d0 < 8; ++d0) { const int cb = (d0 * 16 + hi * 8) * 2;
        const bf16x8 b0 = *(const LAS bf16x8*)(Kb + KSWZ(r32, cb));
        const bf16x8 b1 = *(const LAS bf16x8*)(Kb + KSWZ(32 + r32, cb));
        p0 = __builtin_amdgcn_mfma_f32_32x32x16_bf16(b0, qr[d0], p0, 0, 0, 0);
        p1 = __builtin_amdgcn_mfma_f32_32x32x16_bf16(b1, qr[d0], p1, 0, 0, 0); }
    f32x2 s2 = {0.f, 0.f};
#pragma unroll
    for (int r = 0; r < 16; r += 2) { p0[r] = __builtin_amdgcn_exp2f(p0[r]); p0[r + 1] = __builtin_amdgcn_exp2f(p0[r + 1]); s2 += (f32x2){p0[r], p0[r + 1]}; }
#pragma unroll
    for (int r = 0; r < 16; r += 2) { p1[r] = __builtin_amdgcn_exp2f(p1[r]); p1[r + 1] = __builtin_amdgcn_exp2f(p1[r + 1]); s2 += (f32x2){p1[r], p1[r + 1]}; }
    l_reg += swap_add(s2[0] + s2[1]);
    PK4(p0, 0, pa0); PK4(p0, 8, pa1); PK4(p1, 0, pa2); PK4(p1, 8, pa3);
}
struct VFrag { s16x4 l0, h0, l1, h1, l2, h2, l3, h3; };
template <int CB> __device__ __forceinline__ void vread(VFrag& f, int vb) {
    constexpr int S = 8 * 512;
    f.l0 = da2::tr_read<CB * 512 + 0 * S>(vb); f.h0 = da2::tr_read<CB * 512 + 1 * S>(vb); f.l1 = da2::tr_read<CB * 512 + 2 * S>(vb); f.h1 = da2::tr_read<CB * 512 + 3 * S>(vb);
    f.l2 = da2::tr_read<CB * 512 + 4 * S>(vb); f.h2 = da2::tr_read<CB * 512 + 5 * S>(vb); f.l3 = da2::tr_read<CB * 512 + 6 * S>(vb); f.h3 = da2::tr_read<CB * 512 + 7 * S>(vb);
}
__device__ __forceinline__ void vmma(f32x16& od, const VFrag& f, bf16x8 pa0, bf16x8 pa1, bf16x8 pa2, bf16x8 pa3) {
#define PKV(L, H) (bf16x8){L[0], L[1], L[2], L[3], H[0], H[1], H[2], H[3]}
    od = __builtin_amdgcn_mfma_f32_32x32x16_bf16(pa0, PKV(f.l0, f.h0), od, 0, 0, 0);
    od = __builtin_amdgcn_mfma_f32_32x32x16_bf16(pa1, PKV(f.l1, f.h1), od, 0, 0, 0);
    od = __builtin_amdgcn_mfma_f32_32x32x16_bf16(pa2, PKV(f.l2, f.h2), od, 0, 0, 0);
    od = __builtin_amdgcn_mfma_f32_32x32x16_bf16(pa3, PKV(f.l3, f.h3), od, 0, 0, 0);
#undef PKV
}
#define DA3_LW(n) do { asm volatile("s_waitcnt lgkmcnt(" #n ")" ::: "memory"); SBAR(); } while (0)
__device__ __forceinline__ void pv8(f32x16 (&o)[8], int vb, bf16x8 pa0, bf16x8 pa1, bf16x8 pa2, bf16x8 pa3) {
    VFrag fa, fb;
    vread<0>(fa, vb);
    vread<1>(fb, vb); DA3_LW(8); vmma(o[0], fa, pa0, pa1, pa2, pa3);
    vread<2>(fa, vb); DA3_LW(8); vmma(o[1], fb, pa0, pa1, pa2, pa3);
    vread<3>(fb, vb); DA3_LW(8); vmma(o[2], fa, pa0, pa1, pa2, pa3);
    vread<4>(fa, vb); DA3_LW(8); vmma(o[3], fb, pa0, pa1, pa2, pa3);
    vread<5>(fb, vb); DA3_LW(8); vmma(o[4], fa, pa0, pa1, pa2, pa3);
    vread<6>(fa, vb); DA3_LW(8); vmma(o[5], fb, pa0, pa1, pa2, pa3);
    vread<7>(fb, vb); DA3_LW(8); vmma(o[6], fa, pa0, pa1, pa2, pa3);
    DA3_LW(0); vmma(o[7], fb, pa0, pa1, pa2, pa3);
}
__device__ __forceinline__ void item(const Params& P, int it, LAS unsigned char* lds) {
    int tid = threadIdx.x; asm volatile("" : "+v"(tid));
    const int wid = __builtin_amdgcn_readfirstlane(tid >> 6), lane = tid & 63, r32 = lane & 31, hi = lane >> 5;
    const int br = wid >> 2, w4 = wid & 3;
    const int b = it >> 7, h = (it >> 5) & 3, qt = it & 31;
    const bf16_t* proj = (const bf16_t*)(P.ws + WS_PROJ);
    const size_t row0 = (size_t)b * SEQ; const int q0 = qt * 128;
    bf16x8 qr[8];
    { const bf16_t* Qw = proj + (row0 + q0 + w4 * 32 + r32) * INC + 3072 + br * 512 + h * 128 + hi * 8;
#pragma unroll
      for (int d0 = 0; d0 < 8; ++d0) qr[d0] = *(const bf16x8*)(Qw + d0 * 16); }
    const char* kbase = (const char*)(proj + row0 * INC + 4096 + br * 512 + h * 128);
    const char* vbase = (const char*)(proj + row0 * INC + 5120 + h * 256);
#define DA3_LANE() int lz_ = lane; asm volatile("" : "+v"(lz_)); const int krow_ = w4 * 16 + (lz_ >> 4)
#define DA3_ISSUE_K(t, bufi) do { DA3_LANE(); \
        const unsigned voffK0 = (unsigned)(krow_ * INC * 2 + (((lz_ & 15) ^ (lz_ >> 4)) << 4)); \
        const unsigned voffK1 = (unsigned)((krow_ + 4) * INC * 2 + (((lz_ & 15) ^ (4 + (lz_ >> 4))) << 4)); \
        const char* kb_ = kbase + (size_t)(t) * (64 * INC * 2); LAS unsigned char* lb_ = lds + (bufi) * BUFB + br * KB + w4 * 4096; \
        __builtin_amdgcn_global_load_lds((const unsigned*)(kb_ + voffK0), (LAS unsigned*)(lb_), 16, 0, 0); \
        __builtin_amdgcn_global_load_lds((const unsigned*)(kb_ + voffK1), (LAS unsigned*)(lb_ + 1024), 16, 0, 0); \
        __builtin_amdgcn_global_load_lds((const unsigned*)(kb_ + 8 * INC * 2 + voffK0), (LAS unsigned*)(lb_ + 2048), 16, 0, 0); \
        __builtin_amdgcn_global_load_lds((const unsigned*)(kb_ + 8 * INC * 2 + voffK1), (LAS unsigned*)(lb_ + 3072), 16, 0, 0); } while (0)
#define DA3_ISSUE_V(t, bufi) do { DA3_LANE(); (void)krow_; \
        const unsigned voffV = (unsigned)(da2::unswap23(wid * 8 + ((lz_ & 31) >> 2)) * INC * 2 + (lz_ >> 5) * 64 + (lz_ & 3) * 16); \
        const char* vb_ = vbase + (size_t)(t) * (64 * INC * 2); LAS unsigned char* lb_ = lds + (bufi) * BUFB + 2 * KB + wid * 4096; \
        _Pragma("unroll") for (int i_ = 0; i_ < 4; ++i_) \
            __builtin_amdgcn_global_load_lds((const unsigned*)(vb_ + i_ * 128 + voffV), (LAS unsigned*)(lb_ + i_ * 1024), 16, 0, 0); } while (0)
#define DA3_BAR() do { asm volatile("" ::: "memory"); __builtin_amdgcn_s_barrier(); asm volatile("" ::: "memory"); } while (0)
    const float slope2 = exp2f(-2.0f * (float)(h + 1)) * LOG2E;
    const int qlo = q0 + w4 * 32, jd = qlo >> 6;
    int jlo = 0, jhi = SEQ / 64 - 1;
    { float gq = fmaxf(fabsf(P.qn_b[lane]), fabsf(P.qn_b[lane + 64])), gk = fmaxf(fabsf(P.kn_b[lane]), fabsf(P.kn_b[lane + 64]));
#pragma unroll
      for (int o_ = 32; o_ >= 1; o_ >>= 1) { gq = fmaxf(gq, __shfl_xor(gq, o_)); gk = fmaxf(gk, __shfl_xor(gk, o_)); }
      const float smax = 128.0f * QSCALE * gq * gk, dmax = (160.0f + smax) / slope2;
      const int di = dmax < 8192.0f ? (int)dmax + 1 : 8192;
      const int klo = q0 - di, khi = q0 + 127 + di;
      jlo = __builtin_amdgcn_readfirstlane(klo <= 0 ? 0 : (klo >> 6)); jhi = __builtin_amdgcn_readfirstlane(khi >= SEQ - 1 ? SEQ / 64 - 1 : (khi >> 6)); }
    float dq = (float)(qlo + r32 - 4 * hi - 64 * jlo);
    f32x16 o[8];
#pragma unroll
    for (int d = 0; d < 8; ++d) o[d] = f32x16{};
    float l_reg = 0.f;
    const int vb0 = (int)(uintptr_t)(lds + 2 * KB) + da2::v_rd_base(lane);
    bf16x8 pa0, pa1, pa2, pa3;
    DA3_ISSUE_K(jlo, 0); DA3_ISSUE_V(jlo, 0);
    if (br == 0) {
        asm volatile("s_waitcnt vmcnt(4)" ::: "memory");
#pragma unroll 1
        for (int j = jlo; j <= jhi; ++j) {
            const int jn = (j + 1 <= jhi) ? j + 1 : jhi, bc = (j - jlo) & 1, bn = bc ^ 1;
            DA3_BAR();
            DA3_ISSUE_K(jn, bn);
            qk_softmax(lds + bc * BUFB, qr, r32, hi, dq, slope2, j - jd, l_reg, pa0, pa1, pa2, pa3);
            asm volatile("s_waitcnt vmcnt(4)" ::: "memory");
            DA3_BAR();
            DA3_ISSUE_V(jn, bn);
            pv8(o, vb0 + bc * BUFB, pa0, pa1, pa2, pa3);
            asm volatile("s_waitcnt vmcnt(4)" ::: "memory");
            dq -= 64.0f;
        }
        DA3_BAR();
    } else {
        DA3_BAR();
        asm volatile("s_waitcnt vmcnt(0)" ::: "memory");
#pragma unroll 1
        for (int j = jlo; j <= jhi; ++j) {
            const int jn = (j + 1 <= jhi) ? j + 1 : jhi, bc = (j - jlo) & 1, bn = bc ^ 1;
            DA3_BAR();
            DA3_ISSUE_K(jn, bn); DA3_ISSUE_V(jn, bn);
            qk_softmax(lds + bc * BUFB + KB, qr, r32, hi, dq, slope2, j - jd, l_reg, pa0, pa1, pa2, pa3);
            DA3_BAR();
            pv8(o, vb0 + bc * BUFB, pa0, pa1, pa2, pa3);
            asm volatile("s_waitcnt vmcnt(0)" ::: "memory");
            dq -= 64.0f;
        }
    }
#undef DA3_ISSUE_K
#undef DA3_LANE
#undef DA3_ISSUE_V
#undef DA3_BAR
    asm volatile("s_waitcnt vmcnt(0)" ::: "memory");
    int tz = threadIdx.x; asm volatile("" : "+v"(tz));
    da2::epilogue(P, lds, o, l_reg, tz, it);
}
}

namespace da5 {
constexpr int BUFB = 65536, KB = 16384;
typedef float f32x4v __attribute__((ext_vector_type(4)));
template <int OFF> __device__ __forceinline__ s16x4 trr(int a) { s16x4 r; asm volatile("ds_read_b64_tr_b16 %0, %1 offset:%2" : "=&v"(r) : "v"(a), "i"(OFF) : "memory"); return r; }
#define D5_LW(n) do { asm volatile("s_waitcnt lgkmcnt(" #n ")" ::: "memory"); SBAR(); } while (0)

__device__ __forceinline__ void qk_softmax(const LAS unsigned char* Kb, const bf16x8 (&qr)[4][2], int lane_, float dqb, float slope2, int rel, float (&l)[2], bf16x8 (&pa)[2][2]) {
    asm volatile("" : "+v"(lane_));
    const int l16 = lane_ & 15, g = lane_ >> 4;
    f32x4v S[4][2];
    if (rel != 0) {
        const float ss = rel < 0 ? slope2 : -slope2, A = -ss * dqb;
#pragma unroll
        for (int kg = 0; kg < 4; ++kg)
#pragma unroll
            for (int qg = 0; qg < 2; ++qg)
#pragma unroll
                for (int r = 0; r < 4; ++r) S[kg][qg][r] = fmaf(ss, (float)(16 * kg + r - 16 * qg), A);
    } else {
#pragma unroll
        for (int kg = 0; kg < 4; ++kg)
#pragma unroll
            for (int qg = 0; qg < 2; ++qg)
#pragma unroll
                for (int r = 0; r < 4; ++r) S[kg][qg][r] = -slope2 * fabsf(dqb - (float)(16 * kg + r - 16 * qg));
    }
    const int krow = l16 * 256, kx = (l16 & 7) << 4;
#pragma unroll
    for (int s = 0; s < 4; ++s) {
        const int ka = krow + ((64 * s + 16 * g) ^ kx);
        const bf16x8 k0 = *(const LAS bf16x8*)(Kb + ka), k1 = *(const LAS bf16x8*)(Kb + ka + 4096), k2 = *(const LAS bf16x8*)(Kb + ka + 8192), k3 = *(const LAS bf16x8*)(Kb + ka + 12288);
#pragma unroll
        for (int qg = 0; qg < 2; ++qg) {
            S[0][qg] = __builtin_amdgcn_mfma_f32_16x16x32_bf16(k0, qr[s][qg], S[0][qg], 0, 0, 0);
            S[1][qg] = __builtin_amdgcn_mfma_f32_16x16x32_bf16(k1, qr[s][qg], S[1][qg], 0, 0, 0);
            S[2][qg] = __builtin_amdgcn_mfma_f32_16x16x32_bf16(k2, qr[s][qg], S[2][qg], 0, 0, 0);
            S[3][qg] = __builtin_amdgcn_mfma_f32_16x16x32_bf16(k3, qr[s][qg], S[3][qg], 0, 0, 0);
        }
    }
#pragma unroll
    for (int qg = 0; qg < 2; ++qg) {
        f32x2 s2 = {0.f, 0.f};
#pragma unroll
        for (int kg = 0; kg < 4; ++kg) {
#pragma unroll
            for (int r = 0; r < 4; ++r) S[kg][qg][r] = __builtin_amdgcn_exp2f(S[kg][qg][r]);
            s2 += (f32x2){S[kg][qg][0], S[kg][qg][1]}; s2 += (f32x2){S[kg][qg][2], S[kg][qg][3]};
        }
        float ps = s2[0] + s2[1];
        ps += __shfl_xor(ps, 16); ps += __shfl_xor(ps, 32);
        l[qg] += ps;
#pragma unroll
        for (int ks = 0; ks < 2; ++ks) {
            u32x4 w; w.x = cvtpk(S[2 * ks][qg][0], S[2 * ks][qg][1]); w.y = cvtpk(S[2 * ks][qg][2], S[2 * ks][qg][3]);
            w.z = cvtpk(S[2 * ks + 1][qg][0], S[2 * ks + 1][qg][1]); w.w = cvtpk(S[2 * ks + 1][qg][2], S[2 * ks + 1][qg][3]);
            pa[qg][ks] = *reinterpret_cast<bf16x8*>(&w);
        }
    }
}
struct VF { s16x4 a0, a1, b0, b1; };
template <int HI> __device__ __forceinline__ void vread(VF& f, int a) {
    f.a0 = trr<HI * 256 + 0>(a); f.a1 = trr<HI * 256 + 8192>(a); f.b0 = trr<HI * 256 + 16384>(a); f.b1 = trr<HI * 256 + 24576>(a);
}
__device__ __forceinline__ void vmma(f32x4v& o0, f32x4v& o1, const VF& f, const bf16x8 (&pa)[2][2]) {
#define PKV(L, H) (bf16x8){L[0], L[1], L[2], L[3], H[0], H[1], H[2], H[3]}
    const bf16x8 v0 = PKV(f.a0, f.a1), v1 = PKV(f.b0, f.b1);
    o0 = __builtin_amdgcn_mfma_f32_16x16x32_bf16(pa[0][0], v0, o0, 0, 0, 0);
    o1 = __builtin_amdgcn_mfma_f32_16x16x32_bf16(pa[1][0], v0, o1, 0, 0, 0);
    o0 = __builtin_amdgcn_mfma_f32_16x16x32_bf16(pa[0][1], v1, o0, 0, 0, 0);
    o1 = __builtin_amdgcn_mfma_f32_16x16x32_bf16(pa[1][1], v1, o1, 0, 0, 0);
#undef PKV
}
__device__ __forceinline__ void pv16(f32x4v (&o)[2][16], int vbuf, int lane_, const bf16x8 (&pa)[2][2]) {
    asm volatile("" : "+v"(lane_));
    const int l16 = lane_ & 15, g = lane_ >> 4, q4 = l16 >> 2, p = l16 & 3;
    const int lb = (4 * g + q4) * 512 + ((4 * (g & 1) + q4) << 5) + 8 * p;
    VF fa, fb;
#define VA(vt) (vbuf + (lb ^ (((vt) & 7) << 5)))
    vread<0>(fa, VA(0));
    vread<0>(fb, VA(1)); D5_LW(4); vmma(o[0][0], o[1][0], fa, pa);
    vread<0>(fa, VA(2)); D5_LW(4); vmma(o[0][1], o[1][1], fb, pa);
    vread<0>(fb, VA(3)); D5_LW(4); vmma(o[0][2], o[1][2], fa, pa);
    vread<0>(fa, VA(4)); D5_LW(4); vmma(o[0][3], o[1][3], fb, pa);
    vread<0>(fb, VA(5)); D5_LW(4); vmma(o[0][4], o[1][4], fa, pa);
    vread<0>(fa, VA(6)); D5_LW(4); vmma(o[0][5], o[1][5], fb, pa);
    vread<0>(fb, VA(7)); D5_LW(4); vmma(o[0][6], o[1][6], fa, pa);
    vread<1>(fa, VA(8)); D5_LW(4); vmma(o[0][7], o[1][7], fb, pa);
    vread<1>(fb, VA(9)); D5_LW(4); vmma(o[0][8], o[1][8], fa, pa);
    vread<1>(fa, VA(10)); D5_LW(4); vmma(o[0][9], o[1][9], fb, pa);
    vread<1>(fb, VA(11)); D5_LW(4); vmma(o[0][10], o[1][10], fa, pa);
    vread<1>(fa, VA(12)); D5_LW(4); vmma(o[0][11], o[1][11], fb, pa);
    vread<1>(fb, VA(13)); D5_LW(4); vmma(o[0][12], o[1][12], fa, pa);
    vread<1>(fa, VA(14)); D5_LW(4); vmma(o[0][13], o[1][13], fb, pa);
    vread<1>(fb, VA(15)); D5_LW(4); vmma(o[0][14], o[1][14], fa, pa);
    D5_LW(0); vmma(o[0][15], o[1][15], fb, pa);
#undef VA
}
__device__ __forceinline__ void epilogue(const Params& P, LAS unsigned char* lds, f32x4v (&o)[2][16], const float (&l)[2], int tz, int it) {
    const int wid = __builtin_amdgcn_readfirstlane(tz >> 6), lane = tz & 63, l16 = lane & 15, g = lane >> 4;
    float lam;
    { float a = P.lam_q1[lane] * P.lam_k1[lane] + P.lam_q1[lane + 64] * P.lam_k1[lane + 64];
      float c = P.lam_q2[lane] * P.lam_k2[lane] + P.lam_q2[lane + 64] * P.lam_k2[lane + 64];
      a = wave_sum(a); c = wave_sum(c); lam = expf(a) - expf(c) + 0.2f; }
    const int br = wid >> 2, w4 = wid & 3;
    const int b = it >> 7, h = (it >> 5) & 3, qt = it & 31;
    const size_t row0 = (size_t)b * SEQ; const int q0 = qt * 128;
    LAS float* li_l = (LAS float*)(lds + SCR_OFF) + wid * 32;
    if (g == 0) { li_l[l16] = l[0]; li_l[16 + l16] = l[1]; }
    asm volatile("s_waitcnt lgkmcnt(0)" ::: "memory");
    __syncthreads();
    LAS float* X = (LAS float*)lds + w4 * 8192;
    if (br == 1) {
#pragma unroll
        for (int qg = 0; qg < 2; ++qg)
#pragma unroll
            for (int r = 0; r < 4; ++r) { const float rl = __builtin_amdgcn_rcpf(li_l[16 * qg + 4 * g + r]);
#pragma unroll
                for (int vt = 0; vt < 16; ++vt) X[((qg * 4 + r) * 16 + vt) * 64 + lane] = o[qg][vt][r] * rl; }
    }
    __syncthreads();
    if (br == 0) {
        LAS unsigned char* T = (LAS unsigned char*)X;
        float gw[16];
#pragma unroll
        for (int vt = 0; vt < 16; ++vt) gw[vt] = P.subln_b[16 * vt + l16];
#pragma unroll
        for (int qg = 0; qg < 2; ++qg)
#pragma unroll
            for (int r = 0; r < 4; ++r) {
                const int u = qg * 4 + r;
                const float rl = __builtin_amdgcn_rcpf(li_l[16 * qg + 4 * g + r]);
                float v[16], sq = 0.f;
#pragma unroll
                for (int vt = 0; vt < 16; ++vt) { v[vt] = o[qg][vt][r] * rl - lam * X[(u * 16 + vt) * 64 + lane]; sq += v[vt] * v[vt]; }
                sq += __shfl_xor(sq, 1); sq += __shfl_xor(sq, 2); sq += __shfl_xor(sq, 4); sq += __shfl_xor(sq, 8);
                const float rstd = rsqrtf(sq * (1.0f / 256.0f) + RMS_EPS) * 0.8f;
#pragma unroll
                for (int vt = 0; vt < 16; ++vt) { const unsigned w = cvtpk(v[vt] * rstd * gw[vt], 0.f); *(LAS bf16_t*)(T + (4 * u + g) * 512 + (16 * vt + l16) * 2) = (bf16_t)(w & 0xffffu); }
            }
        asm volatile("s_waitcnt lgkmcnt(0)" ::: "memory");
        char* mixb = (char*)((bf16_t*)(P.ws + WS_MIX) + (row0 + q0 + w4 * 32) * DM + 1024 + h * 256);
#pragma unroll
        for (int i = 0; i < 16; ++i) {
            const int ti = 2 * i + (lane >> 5), u = ti >> 2, gg = ti & 3, q = 16 * (u >> 2) + 4 * gg + (u & 3);
            const u32x4 w = *(const LAS u32x4*)(T + ti * 512 + (lane & 31) * 16);
            *(u32x4*)(mixb + (size_t)q * (DM * 2) + (lane & 31) * 16) = w;
        }
    }
    __syncthreads();
}
__device__ __forceinline__ void item(const Params& P, int it, LAS unsigned char* lds) {
    int tid = threadIdx.x; asm volatile("" : "+v"(tid));
    const int wid = __builtin_amdgcn_readfirstlane(tid >> 6), lane = tid & 63, l16 = lane & 15, g = lane >> 4;
    const int br = wid >> 2, w4 = wid & 3;
    const int b = it >> 7, h = (it >> 5) & 3, qt = it & 31;
    const bf16_t* proj = (const bf16_t*)(P.ws + WS_PROJ);
    const size_t row0 = (size_t)b * SEQ; const int q0 = qt * 128;
    bf16x8 qr[4][2];
    { const bf16_t* Qw = proj + (row0 + q0 + w4 * 32 + l16) * INC + 3072 + br * 512 + h * 128 + 8 * g;
#pragma unroll
      for (int s = 0; s < 4; ++s)
#pragma unroll
          for (int qg = 0; qg < 2; ++qg) qr[s][qg] = *(const bf16x8*)(Qw + (size_t)(16 * qg) * INC + 32 * s); }
    const char* kbase = (const char*)(proj + row0 * INC + 4096 + br * 512 + h * 128);
    const char* vbase = (const char*)(proj + row0 * INC + 5120 + h * 256);
#define D5_LANE() int lz_ = lane; asm volatile("" : "+v"(lz_))
#define D5_ISSUE_K(t, bufi) do { D5_LANE(); const int krow_ = w4 * 16 + (lz_ >> 4); \
        const unsigned voffK0 = (unsigned)(krow_ * INC * 2 + (((lz_ & 15) ^ (lz_ >> 4)) << 4)); \
        const unsigned voffK1 = (unsigned)((krow_ + 4) * INC * 2 + (((lz_ & 15) ^ (4 + (lz_ >> 4))) << 4)); \
        const char* kb_ = kbase + (size_t)(t) * (64 * INC * 2); LAS unsigned char* lb_ = lds + (bufi) * BUFB + br * KB + w4 * 4096; \
        __builtin_amdgcn_global_load_lds((const unsigned*)(kb_ + voffK0), (LAS unsigned*)(lb_), 16, 0, 0); \
        __builtin_amdgcn_global_load_lds((const unsigned*)(kb_ + voffK1), (LAS unsigned*)(lb_ + 1024), 16, 0, 0); \
        __builtin_amdgcn_global_load_lds((const unsigned*)(kb_ + 8 * INC * 2 + voffK0), (LAS unsigned*)(lb_ + 2048), 16, 0, 0); \
        __builtin_amdgcn_global_load_lds((const unsigned*)(kb_ + 8 * INC * 2 + voffK1), (LAS unsigned*)(lb_ + 3072), 16, 0, 0); } while (0)
#define D5_ISSUE_V(t, bufi) do { D5_LANE(); const char* vb_ = vbase + (size_t)(t) * (64 * INC * 2) + (size_t)(wid * 8) * (INC * 2); LAS unsigned char* lb_ = lds + (bufi) * BUFB + 2 * KB + wid * 4096; \
        _Pragma("unroll") for (int i_ = 0; i_ < 4; ++i_) { const int rr_ = 2 * i_ + (lz_ >> 5); \
            const unsigned vo_ = (unsigned)(rr_ * INC * 2 + (((lz_ & 31) ^ (rr_ << 1)) << 4)); \
            __builtin_amdgcn_global_load_lds((const unsigned*)(vb_ + vo_), (LAS unsigned*)(lb_ + i_ * 1024), 16, 0, 0); } } while (0)
#define D5_BAR() do { asm volatile("" ::: "memory"); __builtin_amdgcn_s_barrier(); asm volatile("" ::: "memory"); } while (0)
    const float slope2 = __int_as_float(__builtin_amdgcn_readfirstlane(__float_as_int(exp2f(-2.0f * (float)(h + 1)) * LOG2E)));
    const int qlo = q0 + w4 * 32, jd = qlo >> 6;
    int jlo = 0, jhi = SEQ / 64 - 1;
    { float gq = fmaxf(fabsf(P.qn_b[lane]), fabsf(P.qn_b[lane + 64])), gk = fmaxf(fabsf(P.kn_b[lane]), fabsf(P.kn_b[lane + 64]));
#pragma unroll
      for (int o_ = 32; o_ >= 1; o_ >>= 1) { gq = fmaxf(gq, __shfl_xor(gq, o_)); gk = fmaxf(gk, __shfl_xor(gk, o_)); }
      const float smax = 128.0f * QSCALE * gq * gk, dmax = (160.0f + smax) / slope2;
      const int di = dmax < 8192.0f ? (int)dmax + 1 : 8192;
      const int klo = q0 - di, khi = q0 + 127 + di;
      jlo = __builtin_amdgcn_readfirstlane(klo <= 0 ? 0 : (klo >> 6)); jhi = __builtin_amdgcn_readfirstlane(khi >= SEQ - 1 ? SEQ / 64 - 1 : (khi >> 6)); }
    float dqb = (float)(qlo + l16 - 4 * g - 64 * jlo);
    f32x4v o[2][16];
#pragma unroll
    for (int qg = 0; qg < 2; ++qg)
#pragma unroll
        for (int vt = 0; vt < 16; ++vt) o[qg][vt] = (f32x4v){0.f, 0.f, 0.f, 0.f};
    float l[2] = {0.f, 0.f};
    const int vbuf0 = (int)(uintptr_t)(lds + 2 * KB);
    bf16x8 pa[2][2];
    D5_ISSUE_K(jlo, 0); D5_ISSUE_V(jlo, 0);
    if (br == 0) {
        asm volatile("s_waitcnt vmcnt(4)" ::: "memory");
#pragma unroll 1
        for (int j = jlo; j <= jhi; ++j) {
            const int jn = (j + 1 <= jhi) ? j + 1 : jhi, bc = (j - jlo) & 1, bn = bc ^ 1;
            D5_BAR();
            D5_ISSUE_K(jn, bn);
            qk_softmax(lds + bc * BUFB, qr, lane, dqb, slope2, j - jd, l, pa);
            asm volatile("s_waitcnt vmcnt(4)" ::: "memory");
            D5_BAR();
            D5_ISSUE_V(jn, bn);
            pv16(o, vbuf0 + bc * BUFB, lane, pa);
            asm volatile("s_waitcnt vmcnt(4)" ::: "memory");
            dqb -= 64.0f;
        }
        D5_BAR();
    } else {
        D5_BAR();
        asm volatile("s_waitcnt vmcnt(0)" ::: "memory");
#pragma unroll 1
        for (int j = jlo; j <= jhi; ++j) {
            const int jn = (j + 1 <= jhi) ? j + 1 : jhi, bc = (j - jlo) & 1, bn = bc ^ 1;
            D5_BAR();
            D5_ISSUE_K(jn, bn); D5_ISSUE_V(jn, bn);
            qk_softmax(lds + bc * BUFB + KB, qr, lane, dqb, slope2, j - jd, l, pa);
            D5_BAR();
            pv16(o, vbuf0 + bc * BUFB, lane, pa);
            asm volatile("s_waitcnt vmcnt(0)" ::: "memory");
            dqb -= 64.0f;
        }
    }
#undef D5_ISSUE_K
#undef D5_ISSUE_V
#undef D5_BAR
#undef D5_LANE
    asm volatile("s_waitcnt vmcnt(0)" ::: "memory");
    int tz = threadIdx.x; asm volatile("" : "+v"(tz));
    epilogue(P, lds, o, l, tz, it);
}
#undef D5_LW
}

namespace na2 {
__device__ __forceinline__ void item(const Params& P, int it, LAS unsigned char* lds) {
    int tid = threadIdx.x; asm volatile("" : "+v"(tid));
    const int wid = __builtin_amdgcn_readfirstlane(tid >> 6), lane = tid & 63, r32 = lane & 31, hi = lane >> 5;
    const int b = it >> 7, h = (it >> 4) & 7, r0 = (it & 15) * 4;
    const int r = r0 + (wid >> 1), cq0 = (wid & 1) * 32;
    const bf16_t* proj = (const bf16_t*)(P.ws + WS_PROJ);
    LAS float* tab = (LAS float*)(lds + SCR_OFF);
    LAS float* li_l = (LAS float*)(lds + SCR_OFF + 2048) + wid * 32;
    for (int i = tid; i < 15 * 31; i += NTHR) tab[(i / 31) * 32 + (i % 31)] = P.rpb_a[h * 465 + i] * LOG2E;
    bf16x8 qr[8];
    { const bf16_t* Qw = proj + ((size_t)b * SEQ + r * 64 + cq0 + r32) * INC + h * 128 + hi * 8;
#pragma unroll
      for (int d0 = 0; d0 < 8; ++d0) qr[d0] = *(const bf16x8*)(Qw + d0 * 16); }
    int kr_lo = r0 - 4; kr_lo = kr_lo < 0 ? 0 : (kr_lo > 56 ? 56 : kr_lo);
    int kr_hi = r0 - 1; kr_hi = (kr_hi < 0 ? 0 : (kr_hi > 56 ? 56 : kr_hi)) + 7;
    int rs = r - 4; rs = rs < 0 ? 0 : (rs > 56 ? 56 : rs);
    const int cq = cq0 + r32; int cs = cq - 8; cs = cs < 0 ? 0 : (cs > 48 ? 48 : cs);
    const char* kbase = (const char*)(proj + (size_t)b * SEQ * INC + 1024 + h * 128);
    const char* vbase = (const char*)(proj + (size_t)b * SEQ * INC + 2048 + h * 128);
    const int krow = wid * 8 + (lane >> 4);
    const unsigned voffK0 = (unsigned)(krow * INC * 2 + (((lane & 15) ^ (lane >> 4)) << 4));
    const unsigned voffK1 = (unsigned)((krow + 4) * INC * 2 + (((lane & 15) ^ (4 + (lane >> 4))) << 4));
    const unsigned voffV = (unsigned)(da2::unswap23(wid * 8 + ((lane & 31) >> 2)) * INC * 2 + (lane >> 5) * 64 + (lane & 3) * 16);
#define NA2_ISSUE(kr, bufi) do { const char* kb_ = kbase + (size_t)(kr) * (64 * INC * 2); const char* vb_ = vbase + (size_t)(kr) * (64 * INC * 2); \
        LAS unsigned char* lb_ = lds + (bufi) * 32768; \
        __builtin_amdgcn_global_load_lds((const unsigned*)(kb_ + voffK0), (LAS unsigned*)(lb_ + wid * 2048), 16, 0, 0); \
        __builtin_amdgcn_global_load_lds((const unsigned*)(kb_ + voffK1), (LAS unsigned*)(lb_ + wid * 2048 + 1024), 16, 0, 0); \
        __builtin_amdgcn_global_load_lds((const unsigned*)(vb_ + voffV), (LAS unsigned*)(lb_ + 16384 + wid * 2048), 16, 0, 0); \
        __builtin_amdgcn_global_load_lds((const unsigned*)(vb_ + 128 + voffV), (LAS unsigned*)(lb_ + 16384 + wid * 2048 + 1024), 16, 0, 0); } while (0)
    f32x16 o[4];
#pragma unroll
    for (int d = 0; d < 4; ++d) o[d] = f32x16{};
    float l_reg = 0.f;
    const int vb0 = (int)(uintptr_t)(lds + 16384) + da2::v_rd_base(lane);
    NA2_ISSUE(kr_lo, 0);
#pragma unroll 1
    for (int kr = kr_lo; kr <= kr_hi; ++kr) {
        const int bi = (kr - kr_lo) & 1;
        asm volatile("s_waitcnt vmcnt(0) lgkmcnt(0)" ::: "memory");
        __builtin_amdgcn_s_barrier();
        asm volatile("" ::: "memory");
        if (kr < kr_hi) NA2_ISSUE(kr + 1, bi ^ 1);
        if (kr >= rs && kr < rs + 8) {
            f32x16 p0, p1;
            da2::qkt(p0, p1, lds + bi * 32768, qr, r32, hi);
            const LAS float* trow = tab + (kr - r + 7) * 32;
            float ps = 0.f;
#pragma unroll
            for (int rr = 0; rr < 16; ++rr) {
                const int ck = crow(rr, hi);
                { const int rel = ck - cq + 15; const bool valid = (ck >= cs) && (ck < cs + 16); const int idx = rel < 0 ? 0 : (rel > 30 ? 30 : rel);
                  const float v = valid ? __builtin_amdgcn_exp2f(p0[rr] + trow[idx]) : 0.f; p0[rr] = v; ps += v; }
                { const int ck1 = ck + 32; const int rel = ck1 - cq + 15; const bool valid = (ck1 >= cs) && (ck1 < cs + 16); const int idx = rel < 0 ? 0 : (rel > 30 ? 30 : rel);
                  const float v = valid ? __builtin_amdgcn_exp2f(p1[rr] + trow[idx]) : 0.f; p1[rr] = v; ps += v; }
            }
            l_reg += swap_add(ps);
            bf16x8 pa0, pa1, pa2, pa3;
            PK4(p0, 0, pa0); PK4(p0, 8, pa1); PK4(p1, 0, pa2); PK4(p1, 8, pa3);
            const int vb = vb0 + bi * 32768;
            da2::pv_one<4, 0>(o[0], vb, pa0, pa1, pa2, pa3); da2::pv_one<4, 1>(o[1], vb, pa0, pa1, pa2, pa3);
            da2::pv_one<4, 2>(o[2], vb, pa0, pa1, pa2, pa3); da2::pv_one<4, 3>(o[3], vb, pa0, pa1, pa2, pa3);
        }
    }
#undef NA2_ISSUE
    if (hi == 0) li_l[r32] = l_reg;
    asm volatile("s_waitcnt lgkmcnt(0)" ::: "memory");
    __syncthreads();
    LAS unsigned char* T = lds + wid * 8192;
    float* nassq = (float*)(P.ws + WS_NASSQ);
    const size_t t0 = (size_t)b * SEQ + r * 64 + cq0;
#pragma unroll
    for (int rr = 0; rr < 16; ++rr) {
        const float rl = __builtin_amdgcn_rcpf(li_l[crow(rr, hi)]);
        float sq = 0.f;
#pragma unroll
        for (int d = 0; d < 4; ++d) {
            const unsigned w = cvtpk(o[d][rr] * rl, 0.f); const float vq = __uint_as_float(w << 16);
            sq += vq * vq;
            *(LAS bf16_t*)(T + (2 * rr + hi) * 256 + (d * 32 + r32) * 2) = (bf16_t)(w & 0xffffu);
        }
#pragma unroll
        for (int sh = 16; sh >= 1; sh >>= 1) sq += __shfl_xor(sq, sh);
        if (r32 == 0) nassq[(t0 + crow(rr, hi)) * 8 + h] = sq;
    }
    asm volatile("s_waitcnt lgkmcnt(0)" ::: "memory");
    char* mixb = (char*)((bf16_t*)(P.ws + WS_MIX) + t0 * DM + h * 128);
#pragma unroll
    for (int i = 0; i < 8; ++i) {
        const int tr = i * 4 + (lane >> 4), rr2 = tr >> 1, h2 = tr & 1;
        const u32x4 w = *(const LAS u32x4*)(T + tr * 256 + (lane & 15) * 16);
        *(u32x4*)(mixb + (size_t)crow(rr2, h2) * (DM * 2) + (lane & 15) * 16) = w;
    }
    __syncthreads();
}
}

__device__ __forceinline__ void da_combine(const Params& P) {
    int tid = threadIdx.x; asm volatile("" : "+v"(tid)); const int wid = tid >> 6, lane = tid & 63;
    float a = P.lam_q1[lane] * P.lam_k1[lane] + P.lam_q1[lane + 64] * P.lam_k1[lane + 64];
    float c = P.lam_q2[lane] * P.lam_k2[lane] + P.lam_q2[lane + 64] * P.lam_k2[lane + 64];
    a = wave_sum(a); c = wave_sum(c);
    const float lam = expf(a) - expf(c) + 0.2f;
    const float* op = (const float*)(P.ws + WS_OPART);
    bf16_t* mix = (bf16_t*)(P.ws + WS_MIX);
    const f32x4 g = ((const f32x4*)P.subln_b)[lane];
    for (int it = blockIdx.x * 8 + wid; it < MTOK * 4; it += gridDim.x * 8) {
        const int tok = it >> 2, h = it & 3;
        const float* p = op + (size_t)tok * DM + h * 512;
        const f32x4 o1 = ((const f32x4*)p)[lane], o2 = ((const f32x4*)(p + 256))[lane];
        const f32x4 v = o1 - lam * o2;
        float ss = (v[0] * v[0] + v[1] * v[1]) + (v[2] * v[2] + v[3] * v[3]);
        ss = wave_sum(ss);
        const float rstd = rsqrtf(ss * (1.0f / 256.0f) + RMS_EPS) * 0.8f;
        u32x2 w; w.x = cvtpk(v[0] * rstd * g[0], v[1] * rstd * g[1]); w.y = cvtpk(v[2] * rstd * g[2], v[3] * rstd * g[3]);
        *(u32x2*)(mix + (size_t)tok * DM + 1024 + h * 256 + lane * 4) = w;
    }
}

__device__ __forceinline__ void router_phase(const Params& P, LAS unsigned char* lds) {
    int tid = threadIdx.x; asm volatile("" : "+v"(tid)); const int wid = tid >> 6, lane = tid & 63;
    { const f32x4* src = (const f32x4*)(P.ws + WS_WRT);
#pragma unroll
      for (int i = 0; i < 16; ++i) *(LAS f32x4*)(lds + (size_t)(i * NTHR + tid) * 16) = src[i * NTHR + tid];
      __syncthreads(); }
    const LAS float* wl = (const LAS float*)lds;
    const float* rowss = (const float*)(P.ws + WS_ROWSS);
    unsigned char* H2 = (unsigned char*)(P.ws + WS_H2);
    float* aff = (float*)(P.ws + WS_AFF);
    LAS float* red = (LAS float*)(lds + 131072) + wid * 64;
    for (int g4 = blockIdx.x * 8 + wid; g4 < MTOK / 4; g4 += gridDim.x * 8) {
        const int row0 = g4 * 4;
        f32x4 xa[4], xb[4];
#pragma unroll
        for (int t = 0; t < 4; ++t) { xa[t] = *(const f32x4*)(P.out + (size_t)(row0 + t) * DM + (0 * 64 + lane) * 4); xb[t] = *(const f32x4*)(P.out + (size_t)(row0 + t) * DM + (1 * 64 + lane) * 4); }
        float rstd[4];
#pragma unroll
        for (int t = 0; t < 4; ++t) { float s = (lane < 32) ? rowss[(size_t)(row0 + t) * 32 + lane] : 0.f; s = wave_sum(s); rstd[t] = rsqrtf(s * (1.0f / DM) + RMS_EPS); }
        float acc[64];
#pragma unroll
        for (int k = 0; k < 64; ++k) acc[k] = 0.f;
#pragma unroll
        for (int i = 0; i < 8; ++i) {
            const int c0 = (i * 64 + lane) * 4;
            const f32x4 g = *(const f32x4*)(P.ln2_g + c0);
            f32x4 hv[4];
#pragma unroll
            for (int t = 0; t < 4; ++t) {
                const f32x4 xc = (i & 1) ? xb[t] : xa[t];
                if (i + 2 < 8) { const f32x4 nx = *(const f32x4*)(P.out + (size_t)(row0 + t) * DM + ((i + 2) * 64 + lane) * 4); if (i & 1) xb[t] = nx; else xa[t] = nx; }
                hv[t] = xc * rstd[t] * g;
                *(unsigned*)(H2 + (size_t)(row0 + t) * DM + c0) = cvt4_fp8(hv[t][0] * HSC8, hv[t][1] * HSC8, hv[t][2] * HSC8, hv[t][3] * HSC8);
            }
#pragma unroll
            for (int e = 0; e < 16; ++e) {
                const f32x4 w = *(const LAS f32x4*)(wl + e * DM + c0);
#pragma unroll
                for (int t = 0; t < 4; ++t) acc[t * 16 + e] += (hv[t][0] * w[0] + hv[t][1] * w[1]) + (hv[t][2] * w[2] + hv[t][3] * w[3]);
            }
        }
#pragma unroll
        for (int step = 0; step < 6; ++step) {
            const int m = 32 >> step, half = 32 >> step;
            const bool up = (lane & m) != 0;
#pragma unroll
            for (int k = 0; k < half; ++k) {
                const float keep = up ? acc[k + half] : acc[k], send = up ? acc[k] : acc[k + half];
                acc[k] = keep + __shfl_xor(send, m);
            }
        }
        red[lane] = acc[0];
        asm volatile("s_waitcnt lgkmcnt(0)" ::: "memory");
        if (lane < 4) {
            const int t = lane; float lg[16], mx = -1e30f;
#pragma unroll
            for (int e = 0; e < 16; ++e) { lg[e] = red[t * 16 + e]; mx = fmaxf(mx, lg[e]); }
            float sum = 0.f;
#pragma unroll
            for (int e = 0; e < 16; ++e) { lg[e] = expf(lg[e] - mx); sum += lg[e]; }
            const float inv = 1.0f / sum;
            const int row = row0 + t, bb = row >> 12, sq = row & 4095;
#pragma unroll
            for (int e = 0; e < 16; ++e) aff[((size_t)bb * 16 + e) * SEQ + sq] = lg[e] * inv;
        }
    }
}

__device__ __forceinline__ void topk_phase(const Params& P, LAS unsigned char* lds) {
    int tid = threadIdx.x; asm volatile("" : "+v"(tid)); const int wid = tid >> 6, lane = tid & 63;
    const float* aff = (const float*)(P.ws + WS_AFF);
    int* selidx = (int*)(P.ws + WS_SELIDX); float* selgate = (float*)(P.ws + WS_SELGATE); int* slot = (int*)(P.ws + WS_SLOT);
    LAS unsigned* red = (LAS unsigned*)lds;
    for (int it = blockIdx.x; it < NB * NEXP; it += gridDim.x) {
        const int b = it >> 4, e = it & 15;
        const float* ap = aff + (size_t)it * SEQ + tid * 8;
        const f32x4 a0 = *(const f32x4*)ap, a1 = *(const f32x4*)(ap + 4);
        unsigned v[8];
#pragma unroll
        for (int j = 0; j < 4; ++j) { v[j] = __float_as_uint(a0[j]); v[4 + j] = __float_as_uint(a1[j]); }
        LAS unsigned* hist = red + 64;
        unsigned T = 0u, pmask = 0u, needk = (unsigned)CAP;
#pragma unroll 1
        for (int pass = 0; pass < 4; ++pass) {
            const int shift = 24 - 8 * pass;
            if (tid < 256) hist[tid] = 0u;
            __syncthreads();
#pragma unroll
            for (int j = 0; j < 8; ++j) if ((v[j] & pmask) == T) atomicAdd((unsigned*)(hist + ((v[j] >> shift) & 255u)), 1u);
            __syncthreads();
            unsigned hv = 0, incl = 0;
            if (tid < 256) { hv = hist[255 - tid]; incl = hv;
#pragma unroll
                for (int o = 1; o < 64; o <<= 1) { const unsigned up = __shfl_up(incl, o); if (lane >= o) incl += up; }
                if (lane == 63) hist[260 + wid] = incl; }
            __syncthreads();
            if (tid < 256) {
                for (int w = 0; w < wid; ++w) incl += hist[260 + w];
                const unsigned sfx = incl - hv;
                if (sfx < needk && incl >= needk) { hist[256] = (unsigned)(255 - tid); hist[257] = needk - sfx; }
            }
            __syncthreads();
            T |= hist[256] << shift; pmask |= 255u << shift; needk = hist[257];
            __syncthreads();
        }
        unsigned g[8], q[8], gsum = 0, qsum = 0;
#pragma unroll
        for (int j = 0; j < 8; ++j) { g[j] = v[j] > T ? 1u : 0u; q[j] = v[j] == T ? 1u : 0u; gsum += g[j]; qsum += q[j]; }
        unsigned gi = gsum, qi = qsum;
#pragma unroll
        for (int o = 1; o < 64; o <<= 1) { const unsigned tg = __shfl_up(gi, o), tq = __shfl_up(qi, o); if (lane >= o) { gi += tg; qi += tq; } }
        LAS unsigned* sc = red + 32;
        __syncthreads();
        if (lane == 63) { sc[wid] = gi; sc[8 + wid] = qi; }
        __syncthreads();
        unsigned gbase = 0, qbase = 0, gtot = 0;
#pragma unroll
        for (int w = 0; w < 8; ++w) { const unsigned a = sc[w], c2 = sc[8 + w]; if (w < wid) { gbase += a; qbase += c2; } gtot += a; }
        unsigned G = gbase + gi - gsum, Q = qbase + qi - qsum;
        const unsigned need = (unsigned)CAP - gtot;
#pragma unroll
        for (int j = 0; j < 8; ++j) {
            const int tok = tid * 8 + j;
            const bool sel = g[j] || (q[j] && Q < need);
            const unsigned sl = G + (Q < need ? Q : need);
            if (sel) { selidx[e * EROWS + b * CAP + sl] = b * SEQ + tok; selgate[e * EROWS + b * CAP + sl] = __uint_as_float(v[j]); }
            slot[(size_t)it * SEQ + tok] = sel ? (int)sl : -1;
            G += g[j]; Q += q[j];
        }
        __syncthreads();
    }
}

__device__ __forceinline__ void combine_phase(const Params& P, const float ysc) {
    int tid = threadIdx.x; asm volatile("" : "+v"(tid)); const int wid = tid >> 6, lane = tid & 63;
    const int* slot = (const int*)(P.ws + WS_SLOT);
    const bf16_t* Y = (const bf16_t*)(P.ws + WS_Y);
    for (int row = blockIdx.x * 8 + wid; row < MTOK; row += gridDim.x * 8) {
        const int b = row >> 12, s = row & 4095;
        const int sl = (lane < 16) ? slot[((size_t)b * 16 + lane) * SEQ + s] : -1;
        unsigned long long mask = __ballot(sl >= 0);
        float* op = P.out + (size_t)row * DM;
        f32x4 a[8];
#pragma unroll
        for (int i = 0; i < 4; ++i) { a[2 * i] = *(const f32x4*)(op + i * 512 + lane * 8); a[2 * i + 1] = *(const f32x4*)(op + i * 512 + lane * 8 + 4); }
        while (mask) {
            const int e = __builtin_ctzll(mask); mask &= mask - 1;
            const int se = __shfl(sl, e);
            const bf16_t* yp = Y + ((size_t)e * EROWS + b * CAP + se) * DM + lane * 8;
#pragma unroll
            for (int i = 0; i < 4; ++i) {
                const u32x4 w = *(const u32x4*)(yp + i * 512);
                a[2 * i][0] += ysc * __uint_as_float(w.x << 16); a[2 * i][1] += ysc * __uint_as_float(w.x & 0xffff0000u);
                a[2 * i][2] += ysc * __uint_as_float(w.y << 16); a[2 * i][3] += ysc * __uint_as_float(w.y & 0xffff0000u);
                a[2 * i + 1][0] += ysc * __uint_as_float(w.z << 16); a[2 * i + 1][1] += ysc * __uint_as_float(w.z & 0xffff0000u);
                a[2 * i + 1][2] += ysc * __uint_as_float(w.w << 16); a[2 * i + 1][3] += ysc * __uint_as_float(w.w & 0xffff0000u);
            }
        }
#pragma unroll
        for (int i = 0; i < 4; ++i) { *(f32x4*)(op + i * 512 + lane * 8) = a[2 * i]; *(f32x4*)(op + i * 512 + lane * 8 + 4) = a[2 * i + 1]; }
    }
}

#ifndef P1_COMPUTE_WGS
#define P1_COMPUTE_WGS 154
#endif
#ifndef P7_PER_XCD
#define P7_PER_XCD 30
#endif
constexpr int N_PHASES = 10;
__global__ void __launch_bounds__(NTHR, 2) fwd_kernel(Params P) {
    extern __shared__ __attribute__((aligned(16))) unsigned char lds_raw[];
    LAS unsigned char* lds = (LAS unsigned char*)lds_raw;
    const int tid = threadIdx.x;
    volatile LAS unsigned* MISC = (volatile LAS unsigned*)(lds + MISC_OFF);
    if (tid < 16) MISC[tid] = 0u;
    __syncthreads();
    XcdBarrier bar; bar.bar = (unsigned*)(P.ws + WS_CTL); bar.x = 0; bar.st = nullptr;
#if MK_N_LAUNCHES == 1
    bar = xcd_barrier_post((unsigned*)(P.ws + WS_CTL), MISC);
#define GRID_BAR() xcd_barrier(bar)
#else
#define GRID_BAR() do { } while (0)
#endif
    const int lo = P.ph_lo, hi = P.ph_hi;
#ifndef PH_MASK
#define PH_MASK 0x3ff
#endif
#define IN(k) (((PH_MASK >> (k)) & 1) && lo <= (k) && (k) < hi)
#define BOTH(k) (IN(k) && IN((k) + 1))

#ifndef PROBE_DUP
#define PROBE_DUP -1
#endif
#define DUP(k) for (int rep_ = 0; rep_ < ((PROBE_DUP) == (k) ? 2 : 1); ++rep_)
    if (IN(0)) { DUP(0) { p0_prologue(P, lds); __syncthreads(); } if (BOTH(0)) GRID_BAR(); }

    if (IN(1)) {
        { LAS float* gl = (LAS float*)(lds + SCR_OFF + 8192);
          if (tid < 128) { gl[tid] = P.qn_a[tid]; gl[128 + tid] = P.kn_a[tid]; gl[256 + tid] = P.qn_b[tid]; gl[384 + tid] = P.kn_b[tid]; }
          __syncthreads(); }
        DUP(1) {
        pg8::OrderMN S; S.init(P.ws + WS_H, P.ws + WS_WIN, MTOK, INC, DM, P1_COMPUTE_WGS, blockIdx.x);
        EpiInProj E{(bf16_t*)(P.ws + WS_PROJ)};
        pg8::gemm_phase<false, false, false>(lds, DM, S, E, nullptr);
        }
        cvt_queue<2>(P, lds, (unsigned*)(P.ws + WS_CTL) + CW_QG); cvt_queue<3>(P, lds, (unsigned*)(P.ws + WS_CTL) + CW_QU);
        if (BOTH(1)) GRID_BAR();
    }

    if (IN(2)) {
        const bf16_t* proj = (const bf16_t*)(P.ws + WS_PROJ);
        float* opart = (float*)(P.ws + WS_OPART);
        const int da_it = (blockIdx.x & 7) * 32 + (blockIdx.x >> 3);
        DUP(2) {
        if (blockIdx.x < 256) da5::item(P, da_it, lds);
        }
        DUP(12) {
        if (blockIdx.x < 256 && ((da_it >> 5) & 3) == 0) {
            const int r64 = (da_it >> 7) * 32 + (da_it & 31);
#pragma unroll 1
            for (int k = 0; k < 4; ++k) na2::item(P, r64 * 4 + k, lds);
        }
        }
        if (BOTH(2)) GRID_BAR();
    }


    if (IN(4)) {
        DUP(4) {
        pg8::OrderMN S; S.init(P.ws + WS_MIX, P.ws + WS_WOUT, MTOK, DM, DM, gridDim.x, blockIdx.x);
        LAS float* ht = (LAS float*)(lds + SCR_OFF);
        { pg8::Unit u; if (S.next(0, u) && tid < 256) { const float* q = (const float*)(P.ws + WS_NASSQ) + (size_t)(u.pm * 256 + tid) * 8;
            const f32x4 a = *(const f32x4*)q, c = *(const f32x4*)(q + 4);
            ht[tid] = rsqrtf(((a[0] + a[1]) + (a[2] + a[3]) + (c[0] + c[1]) + (c[2] + c[3])) * (1.0f / 1024.0f) + RMS_EPS); } }
        __syncthreads();
        EpiOutProj E{P.x, P.out, (float*)(P.ws + WS_ROWSS)};
        pg8::gemm_phase<false, true, false>(lds, DM, S, E, (const LAS unsigned*)ht);
        }
        if (BOTH(4)) GRID_BAR();
    }

    if (IN(5)) { DUP(5) { router_phase(P, lds); __syncthreads(); } if (BOTH(5)) GRID_BAR(); }

    if (IN(6)) { DUP(6) { topk_phase(P, lds); } if (BOTH(6)) GRID_BAR(); }

    if (IN(7)) {
        pg8::OrderExpert S; S.init(P.ws + WS_H2, P.ws + WS_WGU, 2 * FF, DM / 2, 0, (size_t)2 * FF * DM, true, gridDim.x, blockIdx.x, P7_PER_XCD);
        LAS unsigned* gtab = (LAS unsigned*)(lds + SCR_OFF);
        const int* selidx = (const int*)(P.ws + WS_SELIDX);
        { pg8::Unit u; for (int i = 0; i < 12 && S.next(i, u); ++i) { if (tid < 256) gtab[i * 256 + tid] = (unsigned)selidx[u.e * EROWS + u.pm * 256 + tid] * (unsigned)DM; } }
        __syncthreads();
        DUP(7) {
        EpiGateUp E{(unsigned char*)(P.ws + WS_ACT)};
        pg8::gemm_phase<true, false, true>(lds, DM / 2, S, E, gtab);
        }
        cvt_queue<4>(P, lds, (unsigned*)(P.ws + WS_CTL) + CW_QD);
        if (BOTH(7)) GRID_BAR();
    }

    if (IN(8)) {
        DUP(8) {
        pg8::OrderExpert S; S.init(P.ws + WS_ACT, P.ws + WS_WD, DM, FF / 2, (size_t)EROWS * FF, (size_t)DM * FF, false, gridDim.x, blockIdx.x, 32);
        EpiDown E{(bf16_t*)(P.ws + WS_Y), (const float*)(P.ws + WS_SELGATE)};
        pg8::gemm_phase<false, false, true>(lds, FF / 2, S, E, nullptr);
        }
        if (BOTH(8)) GRID_BAR();
    }

    if (IN(9)) { if (PROBE_DUP == 9) { combine_phase(P, 0.5f); __syncthreads(); combine_phase(P, 0.5f); } else combine_phase(P, 1.0f); }
#undef IN
#undef BOTH
}

extern "C" void kernel_launch(void* const* d_in, const int* in_sizes, int n_in, void* d_out, int out_size, void* d_ws, size_t ws_size, hipStream_t stream) {
    static int grid = 0;
    if (grid == 0) {
        if (n_in != 20 || out_size != MTOK * DM || ws_size < WS_END) { fprintf(stderr, "kernel_launch: unexpected shapes (n_in %d out %d ws %zu need %zu)\n", n_in, out_size, ws_size, (size_t)WS_END); grid = -1; return; }
        int dev = 0, cus = 0, per_cu = 0;
        if (hipGetDevice(&dev) != hipSuccess || hipDeviceGetAttribute(&cus, hipDeviceAttributeMultiprocessorCount, dev) != hipSuccess) { grid = -1; return; }
        if (hipFuncSetAttribute((const void*)fwd_kernel, hipFuncAttributeMaxDynamicSharedMemorySize, LDS_BYTES) != hipSuccess) { fprintf(stderr, "kernel_launch: hipFuncSetAttribute failed\n"); grid = -1; return; }
        if (hipOccupancyMaxActiveBlocksPerMultiprocessor(&per_cu, (const void*)fwd_kernel, NTHR, LDS_BYTES) != hipSuccess || per_cu < 1) fprintf(stderr, "kernel_launch: occupancy query reports %d\n", per_cu);
        (void)hipGetLastError();
        if (cus != 256) { fprintf(stderr, "kernel_launch: built for a 256-CU device, found %d\n", cus); grid = -1; return; }
        grid = cus;
    }
    if (grid < 0) return;
    hipMemsetAsync((char*)d_ws + WS_CTL, 0, CTL_BYTES, stream);
    Params p{};
    p.x = (const float*)d_in[0]; p.ln1_g = (const float*)d_in[1]; p.w_in = (const float*)d_in[2]; p.qn_a = (const float*)d_in[3]; p.kn_a = (const float*)d_in[4];
    p.rpb_a = (const float*)d_in[5]; p.on_a = (const float*)d_in[6]; p.qn_b = (const float*)d_in[7]; p.kn_b = (const float*)d_in[8];
    p.lam_q1 = (const float*)d_in[9]; p.lam_k1 = (const float*)d_in[10]; p.lam_q2 = (const float*)d_in[11]; p.lam_k2 = (const float*)d_in[12]; p.subln_b = (const float*)d_in[13];
    p.w_out = (const float*)d_in[14]; p.ln2_g = (const float*)d_in[15]; p.w_router = (const float*)d_in[16]; p.w_gate = (const float*)d_in[17]; p.w_up = (const float*)d_in[18]; p.w_down = (const float*)d_in[19];
    p.out = (float*)d_out; p.ws = (unsigned char*)d_ws;
#if MK_N_LAUNCHES == 1
    p.ph_lo = 0; p.ph_hi = N_PHASES;
    hipLaunchKernelGGL(fwd_kernel, dim3(grid), dim3(NTHR), LDS_BYTES, stream, p);
#else
#ifndef PROBE_LDUP
#define PROBE_LDUP -1
#endif
    for (int ph = 0; ph < N_PHASES; ++ph) { p.ph_lo = ph; p.ph_hi = ph + 1;
        for (int rep = 0; rep < ((ph == PROBE_LDUP && ph != 9) ? 2 : 1); ++rep) hipLaunchKernelGGL(fwd_kernel, dim3(grid), dim3(NTHR), LDS_BYTES, stream, p); }
#endif
    const hipError_t le = hipPeekAtLastError();
    if (le != hipSuccess) fprintf(stderr, "kernel_launch: launch failed: %s\n", hipGetErrorName(le));
}
```

```cpp
#include <hip/hip_runtime.h>
#include <stdint.h>
#include <stdio.h>

#ifndef MK_N_LAUNCHES
#define MK_N_LAUNCHES 1
#endif

#define LAS __attribute__((address_space(3)))
typedef unsigned short bf16_t;
typedef short bf16x8 __attribute__((ext_vector_type(8)));
typedef short s16x4 __attribute__((ext_vector_type(4)));
typedef float f32x4 __attribute__((ext_vector_type(4)));
typedef float f32x2 __attribute__((ext_vector_type(2)));
typedef float f32x16 __attribute__((ext_vector_type(16)));
typedef unsigned u32x4 __attribute__((ext_vector_type(4)));
typedef unsigned u32x2 __attribute__((ext_vector_type(2)));
typedef int i32x8 __attribute__((ext_vector_type(8)));
typedef int i32x4 __attribute__((ext_vector_type(4)));

constexpr int NB = 2, SEQ = 4096, DM = 2048, MTOK = NB * SEQ;
constexpr int INC = 6144;
constexpr int NEXP = 16, CAP = 512, FF = 2816, EROWS = NB * CAP;
constexpr float RMS_EPS = 1e-6f;
constexpr float LOG2E = 1.4426950408889634f;
constexpr float QSCALE = 0.088388347648318440f * LOG2E;
constexpr int NTHR = 512;

constexpr size_t al256(size_t x) { return (x + 255) / 256 * 256; }
constexpr size_t WS_CTL = 0, CTL_BYTES = 65536;
constexpr size_t WS_WIN = WS_CTL + CTL_BYTES;
constexpr size_t WS_WOUT = WS_WIN + (size_t)INC * DM * 2;
constexpr size_t WS_WGU = WS_WOUT + (size_t)DM * DM * 2;
constexpr size_t WS_WD = WS_WGU + (size_t)NEXP * 2 * FF * DM * 2;
constexpr size_t WS_H = WS_WD + (size_t)NEXP * DM * FF * 2;
constexpr size_t WS_PROJ = WS_H + (size_t)MTOK * DM * 2;
constexpr size_t WS_NASSQ = WS_PROJ + (size_t)MTOK * INC * 2;
constexpr size_t WS_MIX = WS_NASSQ + (size_t)MTOK * 1024 * 2;
constexpr size_t WS_OPART = WS_MIX + (size_t)MTOK * DM * 2;
constexpr size_t WS_ROWSS = WS_OPART + (size_t)MTOK * DM * 4;
constexpr size_t WS_AFF = WS_ROWSS + (size_t)MTOK * 32 * 4;
constexpr size_t WS_SELIDX = WS_AFF + (size_t)NB * NEXP * SEQ * 4;
constexpr size_t WS_SELGATE = WS_SELIDX + (size_t)NEXP * EROWS * 4;
constexpr size_t WS_SLOT = WS_SELGATE + (size_t)NEXP * EROWS * 4;
constexpr size_t WS_H2 = WS_SLOT + (size_t)NB * NEXP * SEQ * 4;
constexpr size_t WS_ACT = WS_H2 + (size_t)MTOK * DM * 2;
constexpr size_t WS_Y = WS_ACT + (size_t)NEXP * EROWS * FF * 2;
constexpr size_t WS_WRT = WS_Y + (size_t)NEXP * EROWS * DM * 2;
constexpr size_t WS_END = WS_WRT + (size_t)NEXP * DM * 4;

constexpr int STAGE_BYTES = 131072;
constexpr int SCR_OFF = STAGE_BYTES;
constexpr int SCR_BYTES = 16384;
constexpr int MISC_OFF = SCR_OFF + SCR_BYTES - 64;
constexpr int LDS_BYTES = SCR_OFF + SCR_BYTES;

__device__ __forceinline__ unsigned cvtpk(float lo, float hi) { unsigned r; asm volatile("v_cvt_pk_bf16_f32 %0, %1, %2" : "=v"(r) : "v"(lo), "v"(hi)); return r; }
__device__ __forceinline__ float wave_sum(float v) {
#pragma unroll
    for (int o = 32; o >= 1; o >>= 1) v += __shfl_xor(v, o);
    return v;
}
__device__ __forceinline__ unsigned cvt4_fp8(float a, float b, float c, float d) { int w = 0; w = __builtin_amdgcn_cvt_pk_fp8_f32(a, b, w, false); w = __builtin_amdgcn_cvt_pk_fp8_f32(c, d, w, true); return (unsigned)w; }
constexpr float WSC8 = 128.0f, HSC8 = 4.0f, ASC8 = 8.0f;
__device__ __forceinline__ float bf2f(bf16_t b) { return __uint_as_float(((unsigned)b) << 16); }

#define XB_TMO      128
#define XB_XCNT(j)  (256  + 64 * (j))
#define XB_XSUB(j)  (1280 + 64 * (j))
#define XB_XGEN(j)  (2304 + 64 * (j))
#define XB_TOP      3328
#define XB_TOPGEN   3392
#define XCD_BAR_WORDS 3456
#define XB_SPIN_CAP (1u << 18)

__device__ __forceinline__ unsigned xb_ld(unsigned* p)              { return __hip_atomic_load(p, __ATOMIC_RELAXED, __HIP_MEMORY_SCOPE_AGENT); }
__device__ __forceinline__ unsigned xb_add(unsigned* p, unsigned v) { return __hip_atomic_fetch_add(p, v, __ATOMIC_RELAXED, __HIP_MEMORY_SCOPE_AGENT); }
__device__ __forceinline__ unsigned xb_xcc_id() { return (unsigned)__builtin_amdgcn_s_getreg((3 << 11) | 20) & 0xFu; }
#define XB_SPIN(cond, bar) do { unsigned _sp = 0; while (cond) { __builtin_amdgcn_s_sleep(1); \
    if ((++_sp & 255u) == 0u) { if (xb_ld(&(bar)[XB_TMO])) break; if (_sp > XB_SPIN_CAP) { atomicAdd(&(bar)[XB_TMO], 1u); break; } } } } while (0)

struct XcdBarrier { unsigned* bar; unsigned x; volatile LAS unsigned* st; };

__device__ __forceinline__ XcdBarrier xcd_barrier_post(unsigned* bar, volatile LAS unsigned* st) {
    XcdBarrier b; b.bar = bar; b.x = xb_xcc_id(); b.st = st;
    if (threadIdx.x == 0) (void)xb_add(&bar[XB_XCNT(b.x)], 1u);
    return b;
}
__device__ __forceinline__ void xcd_barrier_complete(unsigned* bar, unsigned x, unsigned& nloc, unsigned& nx) {
    const unsigned G = gridDim.x * gridDim.y * gridDim.z;
    unsigned sum, cnt, mine, sp = 0u;
    for (;;) {
        sum = 0u; cnt = 0u; mine = 0u;
#pragma unroll
        for (unsigned j = 0; j < 16; ++j) { const unsigned c = xb_ld(&bar[XB_XCNT(j)]); sum += c; cnt += (c > 0u) ? 1u : 0u; mine = (j == x) ? c : mine; }
        if (sum == G) break;
        __builtin_amdgcn_s_sleep(1);
        if ((++sp & 255u) == 0u) { if (xb_ld(&bar[XB_TMO])) break; if (sp > XB_SPIN_CAP) { atomicAdd(&bar[XB_TMO], 1u); break; } }
    }
    nloc = mine > 0u ? mine : 1u; nx = cnt > 0u ? cnt : 1u;
}
__device__ __forceinline__ void xcd_barrier(const XcdBarrier& b) {
    asm volatile("s_waitcnt vmcnt(0)" ::: "memory");
    __syncthreads();
    if (threadIdx.x == 0) {
        unsigned* bar = b.bar;
        __builtin_amdgcn_s_waitcnt(0);
        unsigned nloc = b.st[0], nx = b.st[1];
        if (nloc == 0u) { xcd_barrier_complete(bar, b.x, nloc, nx); b.st[0] = nloc; b.st[1] = nx; }
        const unsigned old = xb_add(&bar[XB_XSUB(b.x)], 1u);
        const unsigned gen = old / nloc;
        if (old + 1u == (gen + 1u) * nloc) {
            __builtin_amdgcn_fence(__ATOMIC_RELEASE, "agent");
            asm volatile("s_waitcnt vmcnt(0)" ::: "memory");
            const unsigned og = xb_add(&bar[XB_TOP], 1u);
            const unsigned tg = og / nx;
            if (og + 1u == (tg + 1u) * nx) xb_add(&bar[XB_TOPGEN], 1u);
            else XB_SPIN(xb_ld(&bar[XB_TOPGEN]) == tg, bar);
            __builtin_amdgcn_fence(__ATOMIC_ACQUIRE, "agent");
            xb_add(&bar[XB_XGEN(b.x)], 1u);
            asm volatile("s_waitcnt vmcnt(0)" ::: "memory");
        } else {
            XB_SPIN(xb_ld(&bar[XB_XGEN(b.x)]) == gen, bar);
            __builtin_amdgcn_fence(__ATOMIC_ACQUIRE, "agent");
            asm volatile("s_waitcnt vmcnt(0)" ::: "memory");
        }
    }
    __syncthreads();
}

struct Params {
    const float* x; const float* ln1_g; const float* w_in; const float* qn_a; const float* kn_a; const float* rpb_a; const float* on_a;
    const float* qn_b; const float* kn_b; const float* lam_q1; const float* lam_k1; const float* lam_q2; const float* lam_k2; const float* subln_b;
    const float* w_out; const float* ln2_g; const float* w_router; const float* w_gate; const float* w_up; const float* w_down;
    float* out; unsigned char* ws; int ph_lo, ph_hi;
};

__device__ __forceinline__ void cvt_load(const float* __restrict__ src, int N, int k0, int n0, int tid, f32x4 (&v)[8], const float* kscale) {
    const int ln = tid & 63, kq = tid >> 6;
    const float* p = src + (size_t)(k0 + kq * 8) * N + n0 + ln * 4;
#pragma unroll
    for (int i = 0; i < 8; ++i) v[i] = __builtin_nontemporal_load((const f32x4*)(p + (size_t)i * N));
    if (kscale) {
#pragma unroll
        for (int i = 0; i < 8; ++i) v[i] = v[i] * kscale[k0 + kq * 8 + i];
    }
}
__device__ __forceinline__ void cvt_to_lds(LAS unsigned char* buf, int tid, const f32x4 (&v)[8]) {
    const int ln = tid & 63, kq = tid >> 6;
#pragma unroll
    for (int j = 0; j < 4; ++j) {
        u32x4 w; w.x = cvtpk(v[0][j], v[1][j]); w.y = cvtpk(v[2][j], v[3][j]); w.z = cvtpk(v[4][j], v[5][j]); w.w = cvtpk(v[6][j], v[7][j]);
        *(LAS u32x4*)(buf + (ln * 4 + j) * 144 + kq * 16) = w;
    }
}
__device__ __forceinline__ void cvt_store(const LAS unsigned char* buf, bf16_t* __restrict__ dst, int K, int k0, int n0, int blk, int off, int tid) {
#pragma unroll
    for (int q = 0; q < 4; ++q) {
        const int p = tid + q * 512, n = p >> 3, kp = p & 7, ng = n0 + n;
        const u32x4 w = *(const LAS u32x4*)(buf + n * 144 + kp * 16);
        const size_t drow = (size_t)(ng >> 7) * blk + off + (ng & 127);
        *(u32x4*)(dst + drow * K + k0 + kp * 8) = w;
    }
}
__device__ __forceinline__ void cvt_to_lds8(LAS unsigned char* buf, int tid, const f32x4 (&v)[8]) {
    const int ln = tid & 63, kq = tid >> 6, slot = (kq ^ (ln & 7)) * 8;
    f32x4 u[8];
#pragma unroll
    for (int i = 0; i < 8; ++i) u[i] = v[i] * WSC8;
#pragma unroll
    for (int j = 0; j < 4; ++j) {
        u32x2 w; w.x = cvt4_fp8(u[0][j], u[1][j], u[2][j], u[3][j]); w.y = cvt4_fp8(u[4][j], u[5][j], u[6][j], u[7][j]);
        *(LAS u32x2*)(buf + (ln * 4 + j) * 64 + slot) = w;
    }
}
__device__ __forceinline__ void cvt_store8(const LAS unsigned char* buf, unsigned char* __restrict__ dst, int Kb, int k0, int n0, int blk, int off, int tid) {
#pragma unroll
    for (int q = 0; q < 2; ++q) {
        const int p = tid + q * 512, n = p >> 2, kp = p & 3, ng = n0 + n, sw = (n >> 2) & 7;
        const u32x2 lo = *(const LAS u32x2*)(buf + n * 64 + ((2 * kp) ^ sw) * 8), hi = *(const LAS u32x2*)(buf + n * 64 + ((2 * kp + 1) ^ sw) * 8);
        const u32x4 w = {lo.x, lo.y, hi.x, hi.y};
        const size_t drow = (size_t)(ng >> 7) * blk + off + (ng & 127);
        __builtin_nontemporal_store(w, (u32x4*)(dst + drow * Kb + k0 + kp * 16));
    }
}
struct CvtTile { const float* src; bf16_t* dst; int K, N, k0, n0, blk, off; const float* kscale; int fp8; };
__device__ __forceinline__ void cvt_to_lds_any(LAS unsigned char* buf, int tid, const f32x4 (&v)[8], int fp8) { if (fp8) cvt_to_lds8(buf, tid, v); else cvt_to_lds(buf, tid, v); }
__device__ __forceinline__ void cvt_store_any(const LAS unsigned char* buf, const CvtTile& t, int tid) {
    if (t.fp8) cvt_store8(buf, (unsigned char*)t.dst, t.K, t.k0, t.n0, t.blk, t.off, tid); else cvt_store(buf, t.dst, t.K, t.k0, t.n0, t.blk, t.off, tid); }
template <int KIND> __device__ __forceinline__ constexpr int cvt_count() { return KIND == 0 ? 768 : KIND == 1 ? 256 : 16 * 352; }
template <int KIND> __device__ __forceinline__ CvtTile cvt_decode(const Params& P, int r) {
    CvtTile t; t.kscale = nullptr; t.fp8 = 0;
    if (KIND == 0) { t.src = P.w_in; t.dst = (bf16_t*)(P.ws + WS_WIN); t.K = DM; t.N = INC; t.k0 = (r / 24) * 64; t.n0 = (r % 24) * 256; t.blk = 128; t.off = 0; }
    else if (KIND == 1) { t.src = P.w_out; t.dst = (bf16_t*)(P.ws + WS_WOUT); t.K = DM; t.N = DM; t.k0 = (r / 8) * 64; t.n0 = (r % 8) * 256; t.blk = 128; t.off = 0; t.kscale = (t.k0 < 1024) ? P.on_a : nullptr; }
    else if (KIND == 2 || KIND == 3) { const int e = r / 352, q = r % 352;
        t.src = (KIND == 3 ? P.w_up : P.w_gate) + (size_t)e * DM * FF; t.dst = (bf16_t*)(P.ws + WS_WGU + (size_t)e * 2 * FF * DM);
        t.K = DM; t.N = FF; t.k0 = (q / 11) * 64; t.n0 = (q % 11) * 256; t.blk = 256; t.off = (KIND == 3) ? 128 : 0; t.fp8 = 1; }
    else { const int e = r / 352, q = r % 352;
        t.src = P.w_down + (size_t)e * FF * DM; t.dst = (bf16_t*)(P.ws + WS_WD + (size_t)e * DM * FF);
        t.K = FF; t.N = DM; t.k0 = (q / 8) * 64; t.n0 = (q % 8) * 256; t.blk = 128; t.off = 0; t.fp8 = 1; }
    return t;
}
constexpr int CW_QG = 4096, CW_QU = 4160, CW_QD = 4224;

template <int KIND> __device__ __forceinline__ void cvt_static(const Params& P, LAS unsigned char* lds) {
    const int tid = threadIdx.x, G = gridDim.x; constexpr int NT = cvt_count<KIND>();
    int idA = blockIdx.x, idB = blockIdx.x + G;
    f32x4 vA[8], vB[8];
    CvtTile tA = cvt_decode<KIND>(P, idA < NT ? idA : 0), tB = cvt_decode<KIND>(P, idB < NT ? idB : 0);
    if (idA < NT) cvt_load(tA.src, tA.N, tA.k0, tA.n0, tid, vA, tA.kscale);
    if (idB < NT) cvt_load(tB.src, tB.N, tB.k0, tB.n0, tid, vB, tB.kscale);
    for (;;) {
        if (idA >= NT) break;
        cvt_to_lds_any(lds, tid, vA, tA.fp8);
        { const int nid = idA + 2 * G; CvtTile tn = cvt_decode<KIND>(P, nid < NT ? nid : 0);
          if (nid < NT) cvt_load(tn.src, tn.N, tn.k0, tn.n0, tid, vA, tn.kscale);
          asm volatile("s_waitcnt lgkmcnt(0)" ::: "memory"); __builtin_amdgcn_s_barrier(); asm volatile("" ::: "memory");
          cvt_store_any(lds, tA, tid);
          tA = tn; idA = nid; }
        if (idB >= NT) break;
        cvt_to_lds_any(lds + 36864, tid, vB, tB.fp8);
        { const int nid = idB + 2 * G; CvtTile tn = cvt_decode<KIND>(P, nid < NT ? nid : 0);
          if (nid < NT) cvt_load(tn.src, tn.N, tn.k0, tn.n0, tid, vB, tn.kscale);
          asm volatile("s_waitcnt lgkmcnt(0)" ::: "memory"); __builtin_amdgcn_s_barrier(); asm volatile("" ::: "memory");
          cvt_store_any(lds + 36864, tB, tid);
          tB = tn; idB = nid; }
    }
}
__device__ __forceinline__ void p0_prologue(const Params& P, LAS unsigned char* lds) {
    int tid = threadIdx.x; asm volatile("" : "+v"(tid)); const int lane = tid & 63, wid = tid >> 6;
    {
        bf16_t* H = (bf16_t*)(P.ws + WS_H);
        for (int row = blockIdx.x * 8 + wid; row < MTOK; row += gridDim.x * 8) {
            const f32x4* xp = (const f32x4*)(P.x + (size_t)row * DM);
            f32x4 v[8]; float ss = 0.f;
#pragma unroll
            for (int i = 0; i < 8; ++i) { v[i] = xp[i * 64 + lane]; ss += v[i][0] * v[i][0] + v[i][1] * v[i][1] + v[i][2] * v[i][2] + v[i][3] * v[i][3]; }
            ss = wave_sum(ss);
            const float rstd = rsqrtf(ss * (1.0f / DM) + RMS_EPS);
#pragma unroll
            for (int i = 0; i < 8; ++i) {
                const f32x4 g = ((const f32x4*)P.ln1_g)[i * 64 + lane];
                u32x2 w; w.x = cvtpk(v[i][0] * rstd * g[0], v[i][1] * rstd * g[1]); w.y = cvtpk(v[i][2] * rstd * g[2], v[i][3] * rstd * g[3]);
                *(u32x2*)(H + (size_t)row * DM + (i * 64 + lane) * 4) = w;
            }
        }
    }
    cvt_static<0>(P, lds); __syncthreads(); cvt_static<1>(P, lds);
    { float* wrt = (float*)(P.ws + WS_WRT);
      for (int i = blockIdx.x * NTHR + tid; i < NEXP * DM; i += gridDim.x * NTHR) { const int e = i >> 11, c = i & 2047; wrt[i] = P.w_router[c * 16 + e]; } }
}
__device__ __forceinline__ void cvt_load_asm(const float* __restrict__ src, int N, int k0, int n0, int tid, f32x4 (&v)[8]) {
    const int ln = tid & 63, kq = tid >> 6;
    const float* p = src + (size_t)(k0 + kq * 8) * N + n0 + ln * 4;
#pragma unroll
    for (int i = 0; i < 8; ++i) { const float* q = p + (size_t)i * N; asm volatile("global_load_dwordx4 %0, %1, off nt" : "=v"(v[i]) : "v"(q) : "memory"); }
}
__device__ __forceinline__ void cvt_load_asm_s(const float* tile  , int N, unsigned voff, f32x4 (&v)[8]) {
#pragma unroll
    for (int i = 0; i < 8; ++i) { const float* q = tile + (size_t)i * N; asm volatile("global_load_dwordx4 %0, %1, %2 nt" : "=v"(v[i]) : "v"(voff), "s"(q) : "memory"); }
}
#define CVT_WAIT_SET(v, N) asm volatile("s_waitcnt vmcnt(" #N ")" : "+v"(v[0]), "+v"(v[1]), "+v"(v[2]), "+v"(v[3]), "+v"(v[4]), "+v"(v[5]), "+v"(v[6]), "+v"(v[7]) :: "memory")
template <int KIND> __device__ __forceinline__ void cvt_queue(const Params& P, LAS unsigned char* lds, unsigned* qhead) {
    const int tid = threadIdx.x; constexpr unsigned n = (unsigned)cvt_count<KIND>(); constexpr unsigned CH = 8;
    LAS unsigned* slot = (LAS unsigned*)(lds + 73728);
#define QCLAIM() __hip_atomic_fetch_add(qhead, CH, __ATOMIC_RELAXED, __HIP_MEMORY_SCOPE_AGENT)
    __syncthreads();
    if (tid == 0) { const unsigned s0 = QCLAIM(), s1 = QCLAIM(); slot[0] = s0; slot[1] = s1; }
    __syncthreads();
    unsigned cbase = slot[0], pos = 0, par = 1;
#define QGEN(dst) do { dst = cbase + pos; if (++pos == CH) { pos = 0; cbase = slot[par]; \
        if (tid == 0) { const unsigned nb_ = (cbase < n) ? QCLAIM() : 0xffffff00u; slot[par ^ 1] = nb_; } par ^= 1; } } while (0)
    unsigned id[4]; f32x4 v[4][8]; CvtTile t[4];
    const unsigned lvoff = (unsigned)(((tid >> 6) * 8 * cvt_decode<KIND>(P, 0).N + (tid & 63) * 4) * 4);
#pragma unroll
    for (int i = 0; i < 4; ++i) { unsigned g; QGEN(g); id[i] = __builtin_amdgcn_readfirstlane(g); t[i] = cvt_decode<KIND>(P, id[i] < n ? (int)id[i] : 0);
        cvt_load_asm_s(t[i].src + (size_t)t[i].k0 * t[i].N + t[i].n0, t[i].N, lvoff, v[i]); }
    CVT_WAIT_SET(v[0], 0); CVT_WAIT_SET(v[1], 0); CVT_WAIT_SET(v[2], 0); CVT_WAIT_SET(v[3], 0);
    bool more = true;
    while (more) {
#pragma unroll
        for (int i = 0; i < 4; ++i) {
            if (id[i] >= n) { more = false; break; }
            CVT_WAIT_SET(v[i], 32);
            LAS unsigned char* buf = lds + (i & 1) * 36864;
            cvt_to_lds_any(buf, tid, v[i], t[i].fp8);
            unsigned g; QGEN(g);
            asm volatile("s_waitcnt lgkmcnt(0)" ::: "memory"); __builtin_amdgcn_s_barrier(); asm volatile("" ::: "memory");
            const unsigned nx = __builtin_amdgcn_readfirstlane(g);
            CvtTile tn = cvt_decode<KIND>(P, nx < n ? (int)nx : 0);
            cvt_load_asm_s(tn.src + (size_t)tn.k0 * tn.N + tn.n0, tn.N, lvoff, v[i]);
            cvt_store_any(buf, t[i], tid);
            t[i] = tn; id[i] = nx;
        }
    }
    asm volatile("s_waitcnt vmcnt(0)" ::: "memory");
#undef QCLAIM
#undef QGEN
    __syncthreads();
}

namespace pg8 {
constexpr int BM = 256, BK = 64, HALF = 128, HTB = HALF * BK * 2, NXCD = 8, WGM = 8;
__device__ __forceinline__ int lds_byte(int r, int c) { const int st = (r >> 4) * 2 + (c >> 5), rr = r & 15, cc = c & 31, ob = rr * 64 + cc * 2; return st * 1024 + (ob ^ (((ob >> 9) & 1) << 5)); }
__device__ __forceinline__ void stage_rc(int b, int& R, int& C) { const int st = b / 1024, sb = b % 1024, swz = sb ^ (((sb >> 9) & 1) << 5); R = (st >> 1) * 16 + swz / 64; C = (st & 1) * 32 + (swz % 64) / 2; }
__device__ __forceinline__ int perm32(int rho) { const int n = rho >> 4, i = rho & 15; return 8 * (i >> 2) + 4 * n + (i & 3); }

struct Unit { int pm, pn, e; };

template <bool GATHER, bool HOOK, bool FP8, class Epi, class Sched>
__device__ __forceinline__ void gemm_phase(LAS unsigned char* lds, const int K, const Sched& S, const Epi& E, const LAS unsigned* gtab) {
    int tid = threadIdx.x; asm volatile("" : "+v"(tid));
    const int wid = __builtin_amdgcn_readfirstlane(tid >> 6), lane = tid & 63, wr = wid >> 2, wc = wid & 3, fr = lane & 15, fq = lane >> 4;
    const int nt = K / BK;
    unsigned voffA[2], voffB[2]; int RA[2], CA2[2];
#pragma unroll
    for (int i = 0; i < 2; ++i) { int R, C; stage_rc(tid * 16 + i * 8192, R, C); const int Rb = (R & ~31) + perm32(R & 31);
        voffA[i] = (unsigned)(R * K + C) * 2u; voffB[i] = (unsigned)(Rb * K + C) * 2u; RA[i] = R; CA2[i] = C * 2; }
    const size_t kstep = (size_t)(BK * 2);
    const size_t hstep = (size_t)HALF * K * 2;
    const unsigned ldsw = (unsigned)wid * 1024u;
    const int aoff = lds_byte(wr * 64 + fr, fq * 8), boff = lds_byte(wc * 32 + fr, fq * 8);
#define PG8_SA(b, h) (((b) * 2 + (h)) * HTB)
#define PG8_SB(b, h) ((4 + (b) * 2 + (h)) * HTB)
#define PG8_STAGE(bufoff, gbase, voff) do { _Pragma("unroll") for (int _i = 0; _i < 2; ++_i) \
        __builtin_amdgcn_global_load_lds((const unsigned*)((const char*)(gbase) + (voff)[_i]), (LAS unsigned*)(lds + (bufoff) + ldsw + _i * 8192), 16, 0, 0); } while (0)
#define PG8_STAGE_A(bufoff, ubase, kbytes, h, gv) do { if (GATHER) { PG8_STAGE(bufoff, (ubase) + (kbytes), (gv)[h]); } else { PG8_STAGE(bufoff, (ubase) + (kbytes) + (h) * hstep, voffA); } } while (0)
#define PG8_LD2(addr) __builtin_shufflevector(*(const LAS i32x4*)(addr), *(const LAS i32x4*)((addr) + 1024), 0, 1, 2, 3, 4, 5, 6, 7)
#define PG8_LDA(dst, b, h) do { if (FP8) { _Pragma("unroll") for (int m = 0; m < 4; ++m) dst##_f8[m] = PG8_LD2(lds + PG8_SA(b, h) + aoff + m * 2048); } \
        else { _Pragma("unroll") for (int m = 0; m < 4; ++m) _Pragma("unroll") for (int k = 0; k < 2; ++k) dst##_bf[m][k] = *(const LAS bf16x8*)(lds + PG8_SA(b, h) + aoff + m * 2048 + k * 1024); } } while (0)
#define PG8_LDB(dst, b, h) do { if (FP8) { _Pragma("unroll") for (int n = 0; n < 2; ++n) dst##_f8[n] = PG8_LD2(lds + PG8_SB(b, h) + boff + n * 2048); } \
        else { _Pragma("unroll") for (int n = 0; n < 2; ++n) _Pragma("unroll") for (int k = 0; k < 2; ++k) dst##_bf[n][k] = *(const LAS bf16x8*)(lds + PG8_SB(b, h) + boff + n * 2048 + k * 1024); } } while (0)
#define PG8_MMA(ai, bj, At, Bt) do { __builtin_amdgcn_s_setprio(1); \
        if (FP8) { _Pragma("unroll") for (int m = 0; m < 4; ++m) _Pragma("unroll") for (int n = 0; n < 2; ++n) \
            asm volatile("v_mfma_scale_f32_16x16x128_f8f6f4 %0, %1, %2, %0, %3, %3 op_sel_hi:[0,0,0]" : "+v"(acc[ai][bj][m][n]) : "v"(Bt##_f8[n]), "v"(At##_f8[m]), "v"(sc1)); } \
        else { _Pragma("unroll") for (int m = 0; m < 4; ++m) _Pragma("unroll") for (int n = 0; n < 2; ++n) _Pragma("unroll") for (int k = 0; k < 2; ++k) \
            acc[ai][bj][m][n] = __builtin_amdgcn_mfma_f32_16x16x32_bf16(Bt##_bf[n][k], At##_bf[m][k], acc[ai][bj][m][n], 0, 0, 0); } \
        __builtin_amdgcn_s_setprio(0); } while (0)
#define PG8_WAIT_V(n) asm volatile("s_waitcnt vmcnt(" #n ")" ::: "memory")
#define PG8_WAIT_L(n) asm volatile("s_waitcnt lgkmcnt(" #n ")" ::: "memory")
#define PG8_BAR __builtin_amdgcn_s_barrier()
#define PG8_SCHED __builtin_amdgcn_sched_barrier(0)
#define PG8_GLOAD(gv, i) do { if (GATHER) { _Pragma("unroll") for (int _h = 0; _h < 2; ++_h) _Pragma("unroll") for (int _i = 0; _i < 2; ++_i) (gv)[_h][_i] = gtab[(i) * 256 + _h * 128 + RA[_i]] + (unsigned)CA2[_i]; } } while (0)
    Unit cur, nxt; int ui = 0;
    if (!S.next(0, cur)) return;
    f32x4 acc[2][2][4][2];
    if constexpr (Epi::INIT) E.init(acc, cur, wr, wc, fr, fq, gtab);
    else {
#pragma unroll
    for (int a = 0; a < 2; ++a)
#pragma unroll
        for (int b = 0; b < 2; ++b)
#pragma unroll
            for (int m = 0; m < 4; ++m)
#pragma unroll
                for (int n = 0; n < 2; ++n) acc[a][b][m][n] = (f32x4){0.f, 0.f, 0.f, 0.f};
    }
    i32x8 At_f8[4], B0_f8[2], B1_f8[2]; bf16x8 At_bf[4][2], B0_bf[2][2], B1_bf[2][2];
    int sc1 = 0x7F7F7F7F; asm volatile("" : "+v"(sc1));
    unsigned gc[2][2] = {{0u, 0u}, {0u, 0u}}, gn[2][2] = {{0u, 0u}, {0u, 0u}};
    PG8_GLOAD(gc, 0);
    const char* cA = S.abase(cur); const char* cB = S.bbase(cur);
    PG8_STAGE(PG8_SB(0, 0), cB, voffB); PG8_STAGE_A(PG8_SA(0, 0), cA, 0, 0, gc); PG8_STAGE(PG8_SB(0, 1), cB + hstep, voffB); PG8_STAGE_A(PG8_SA(0, 1), cA, 0, 1, gc);
    if (wr == 1) PG8_BAR;
    PG8_WAIT_V(4); PG8_BAR;
    PG8_STAGE(PG8_SB(1, 0), cB + kstep, voffB); PG8_STAGE_A(PG8_SA(1, 0), cA, kstep, 0, gc); PG8_STAGE(PG8_SB(1, 1), cB + hstep + kstep, voffB);
    PG8_WAIT_V(6); PG8_BAR;
    for (;;) {
        const bool has_next = S.next(ui + 1, nxt);
        const char* nA = has_next ? S.abase(nxt) : cA; const char* nB = has_next ? S.bbase(nxt) : cB;
        if (GATHER) { if (has_next) { PG8_GLOAD(gn, ui + 1); } else {
#pragma unroll
            for (int _h = 0; _h < 2; ++_h)
#pragma unroll
                for (int _i = 0; _i < 2; ++_i) gn[_h][_i] = gc[_h][_i]; } }
        for (int t = 0; t < nt; t += 2) {
            const bool last = (t == nt - 2);
            const size_t k1 = (size_t)(t + 1) * kstep;
            const char* a2 = last ? nA : cA + (size_t)(t + 2) * kstep; const char* b2 = last ? nB : cB + (size_t)(t + 2) * kstep;
            const char* a3 = a2 + kstep; const char* b3 = b2 + kstep;
            unsigned g2[2][2];
#pragma unroll
            for (int _h = 0; _h < 2; ++_h)
#pragma unroll
                for (int _i = 0; _i < 2; ++_i) g2[_h][_i] = last ? gn[_h][_i] : gc[_h][_i];
            if (HOOK && t == 16) {
                const LAS float* ht = (const LAS float*)gtab;
#pragma unroll
                for (int a = 0; a < 2; ++a)
#pragma unroll
                    for (int m = 0; m < 4; ++m) { const float sc = ht[a * 128 + wr * 64 + m * 16 + fr];
#pragma unroll
                        for (int b = 0; b < 2; ++b)
#pragma unroll
                            for (int n = 0; n < 2; ++n) acc[a][b][m][n] = acc[a][b][m][n] * sc; }
            }
            PG8_LDB(B0, 0, 0); PG8_SCHED; PG8_LDA(At, 0, 0); PG8_STAGE_A(PG8_SA(1, 1), cA, k1, 1, gc);
            PG8_WAIT_L(8); PG8_BAR; PG8_WAIT_L(0); PG8_MMA(0, 0, At, B0); PG8_BAR; PG8_SCHED;
            PG8_LDB(B1, 0, 1); PG8_STAGE(PG8_SB(0, 0), b2, voffB);
            PG8_BAR; PG8_WAIT_L(0); PG8_MMA(0, 1, At, B1); PG8_BAR;
            PG8_LDA(At, 0, 1); PG8_STAGE_A(PG8_SA(0, 0), a2, 0, 0, g2);
            PG8_BAR; PG8_WAIT_L(0); PG8_MMA(1, 0, At, B0); PG8_BAR; PG8_SCHED;
            PG8_STAGE(PG8_SB(0, 1), b2 + hstep, voffB);
            PG8_WAIT_V(6); PG8_BAR; PG8_MMA(1, 1, At, B1); PG8_BAR;
            PG8_LDB(B0, 1, 0); PG8_SCHED; PG8_LDA(At, 1, 0); PG8_STAGE_A(PG8_SA(0, 1), a2, 0, 1, g2);
            PG8_WAIT_L(8); PG8_BAR; PG8_WAIT_L(0); PG8_MMA(0, 0, At, B0); PG8_BAR; PG8_SCHED;
            PG8_LDB(B1, 1, 1); PG8_STAGE(PG8_SB(1, 0), b3, voffB);
            PG8_BAR; PG8_WAIT_L(0); PG8_MMA(0, 1, At, B1); PG8_BAR;
            PG8_LDA(At, 1, 1); PG8_STAGE_A(PG8_SA(1, 0), a3, 0, 0, g2);
            PG8_BAR; PG8_WAIT_L(0); PG8_MMA(1, 0, At, B0); PG8_BAR; PG8_SCHED;
            PG8_STAGE(PG8_SB(1, 1), b3 + hstep, voffB);
            PG8_WAIT_V(6); PG8_BAR; PG8_MMA(1, 1, At, B1); PG8_BAR;
        }
        E(acc, cur, wr, wc, fr, fq, lds);
        if (!has_next) break;
#pragma unroll
        for (int a = 0; a < 2; ++a)
#pragma unroll
            for (int b = 0; b < 2; ++b)
#pragma unroll
                for (int m = 0; m < 4; ++m)
#pragma unroll
                    for (int n = 0; n < 2; ++n) acc[a][b][m][n] = (f32x4){0.f, 0.f, 0.f, 0.f};
        cur = nxt; cA = nA; cB = nB; ++ui;
#pragma unroll
        for (int _h = 0; _h < 2; ++_h)
#pragma unroll
            for (int _i = 0; _i < 2; ++_i) gc[_h][_i] = gn[_h][_i];
    }
    PG8_WAIT_V(0);
    if (wr == 0) PG8_BAR;
    PG8_BAR;
#undef PG8_SA
#undef PG8_SB
#undef PG8_STAGE
#undef PG8_STAGE_A
#undef PG8_LDA
#undef PG8_LDB
#undef PG8_MMA
#undef PG8_LD2
#undef PG8_WAIT_V
#undef PG8_WAIT_L
#undef PG8_BAR
#undef PG8_SCHED
#undef PG8_GLOAD
}

struct OrderMN {
    int nM, nN, nwg, G, c; const char* A; const char* Bt; size_t tstep;
    __device__ __forceinline__ void init(const void* A_, const void* Bt_, int M, int N, int K, int G_, int c_) { nM = M / BM; nN = N / BM; nwg = nM * nN; G = G_; c = c_; A = (const char*)A_; Bt = (const char*)Bt_; tstep = (size_t)BM * K * 2; }
    __device__ __forceinline__ bool next(int i, Unit& u) const {
        if (c >= G) return false;
        const long L = (long)i * G + c; if (L >= nwg) return false;
        int wgid = (int)L; { const int q = nwg / NXCD, r = nwg % NXCD, xcd = wgid % NXCD, off = wgid / NXCD; wgid = (xcd < r ? xcd * (q + 1) : r * (q + 1) + (xcd - r) * q) + off; }
        const int nig = WGM * nN, gid = wgid / nig, fm = gid * WGM, gsz = (nM - fm) < WGM ? (nM - fm) : WGM;
        u.pm = fm + ((wgid % nig) % gsz); u.pn = (wgid % nig) / gsz; u.e = 0; return true;
    }
    __device__ __forceinline__ const char* abase(const Unit& u) const { return A + (size_t)u.pm * tstep; }
    __device__ __forceinline__ const char* bbase(const Unit& u) const { return Bt + (size_t)u.pn * tstep; }
};
struct OrderExpert {
    int nN, ntile, G, c, per; const char* A; const char* Bt; size_t a_estride, b_estride, tstepA, tstepB; bool gather;
    __device__ __forceinline__ void init(const void* A_, const void* Bt_, int N, int K, size_t a_es, size_t b_es, bool gather_, int G_, int c_, int per_) {
        nN = N / BM; ntile = NEXP * nN; G = G_; c = c_; per = per_; A = (const char*)A_; Bt = (const char*)Bt_; a_estride = a_es; b_estride = b_es; tstepA = (size_t)BM * K * 2; tstepB = tstepA; gather = gather_; }
    __device__ __forceinline__ bool next(int i, Unit& u) const {
        int T, pm;
        if ((G & 7) == 0) {
            const int x = c & 7, j = c >> 3; if (j >= per) return false;
            const int q = i * per + j, U = 4 * nN; if (q >= 2 * U) return false;
            const int el = q >= U ? 1 : 0, r = q - el * U, chunk = r >> 5, w = r & 31;
            pm = w & 3; const int pn = chunk * 8 + (w >> 2);
            T = (2 * x + el) * nN + pn;
            if (pn >= nN) return false;
        }
        else { const int q = i * G + c; T = q >> 2; pm = q & 3; }
        if (T >= ntile) return false;
        u.e = T / nN; u.pn = T % nN; u.pm = pm; return true;
    }
    __device__ __forceinline__ const char* abase(const Unit& u) const { return gather ? A : A + (size_t)u.e * a_estride + (size_t)u.pm * tstepA; }
    __device__ __forceinline__ const char* bbase(const Unit& u) const { return Bt + (size_t)u.e * b_estride + (size_t)u.pn * tstepB; }
};
}

struct EpiInProj {
    static constexpr bool INIT = false;
    bf16_t* proj;
    __device__ __forceinline__ void operator()(const f32x4 (&acc)[2][2][4][2], const pg8::Unit& u, int wr, int wc, int fr, int fq, LAS unsigned char* lds) const {
        const int pn = u.pn, grp = pn >> 2;
        const int row0 = u.pm * 256 + wr * 64 + fr;
        if (grp == 5 || grp == 2) {
#pragma unroll
            for (int ai = 0; ai < 2; ++ai)
#pragma unroll
                for (int m = 0; m < 4; ++m) {
                    bf16_t* rowp = proj + (size_t)(row0 + ai * 128 + m * 16) * INC + pn * 256 + wc * 32 + 8 * fq;
#pragma unroll
                    for (int bj = 0; bj < 2; ++bj) { const f32x4 v0 = acc[ai][bj][m][0], v1 = acc[ai][bj][m][1];
                        u32x4 w; w.x = cvtpk(v0[0], v0[1]); w.y = cvtpk(v0[2], v0[3]); w.z = cvtpk(v1[0], v1[1]); w.w = cvtpk(v1[2], v1[3]);
                        *(u32x4*)(rowp + bj * 128) = w; }
                }
            return;
        }
        const int gsel = (grp == 0) ? 0 : (grp == 1) ? 1 : (grp == 3) ? 2 : 3;
        const LAS float* gain = (const LAS float*)(lds + SCR_OFF + 8192) + gsel * 128;
        const float osc = (grp == 0 || grp == 3) ? QSCALE : 1.0f;
        LAS float* Pt = (LAS float*)(lds + SCR_OFF);
#pragma unroll
        for (int ai = 0; ai < 2; ++ai)
#pragma unroll
            for (int m = 0; m < 4; ++m)
#pragma unroll
                for (int bj = 0; bj < 2; ++bj) {
                    const f32x4 v0 = acc[ai][bj][m][0], v1 = acc[ai][bj][m][1];
                    float s = (v0[0] * v0[0] + v0[1] * v0[1]) + (v0[2] * v0[2] + v0[3] * v0[3]) + (v1[0] * v1[0] + v1[1] * v1[1]) + (v1[2] * v1[2] + v1[3] * v1[3]);
                    s += __shfl_xor(s, 16); s += __shfl_xor(s, 32);
                    if (fq == 0) Pt[((ai * 128 + wr * 64 + m * 16 + fr) * 2 + bj) * 4 + wc] = s;
                }
        asm volatile("s_waitcnt lgkmcnt(0)" ::: "memory"); __builtin_amdgcn_s_barrier(); asm volatile("" ::: "memory");
        const f32x4 g0 = *(const LAS f32x4*)(gain + wc * 32 + 8 * fq), g1 = *(const LAS f32x4*)(gain + wc * 32 + 8 * fq + 4);
#pragma unroll
        for (int ai = 0; ai < 2; ++ai)
#pragma unroll
            for (int m = 0; m < 4; ++m) {
                bf16_t* rowp = proj + (size_t)(row0 + ai * 128 + m * 16) * INC + pn * 256 + wc * 32 + 8 * fq;
#pragma unroll
                for (int bj = 0; bj < 2; ++bj) {
                    const f32x4 ps = *(const LAS f32x4*)(Pt + ((ai * 128 + wr * 64 + m * 16 + fr) * 2 + bj) * 4);
                    const float rstd = rsqrtf(((ps[0] + ps[1]) + (ps[2] + ps[3])) * (1.0f / 128.0f) + RMS_EPS) * osc;
                    const f32x4 v0 = acc[ai][bj][m][0] * rstd * g0, v1 = acc[ai][bj][m][1] * rstd * g1;
                    u32x4 w; w.x = cvtpk(v0[0], v0[1]); w.y = cvtpk(v0[2], v0[3]); w.z = cvtpk(v1[0], v1[1]); w.w = cvtpk(v1[2], v1[3]);
                    *(u32x4*)(rowp + bj * 128) = w;
                }
            }
    }
};
struct EpiOutProj {
    static constexpr bool INIT = true;
    const float* x; bf16_t* x1b; float* rowss;
    __device__ __forceinline__ void init(f32x4 (&acc)[2][2][4][2], const pg8::Unit& u, int wr, int wc, int fr, int fq, const LAS unsigned* gtab) const {
        const LAS float* ht = (const LAS float*)gtab;
        const int row0 = u.pm * 256 + wr * 64 + fr, col0 = u.pn * 256 + wc * 32 + 8 * fq;
#pragma unroll
        for (int ai = 0; ai < 2; ++ai)
#pragma unroll
            for (int m = 0; m < 4; ++m) {
                const float isc = __builtin_amdgcn_rcpf(ht[ai * 128 + wr * 64 + m * 16 + fr]);
                const float* xp = x + (size_t)(row0 + ai * 128 + m * 16) * DM + col0;
#pragma unroll
                for (int bj = 0; bj < 2; ++bj)
#pragma unroll
                    for (int n = 0; n < 2; ++n) acc[ai][bj][m][n] = *(const f32x4*)(xp + bj * 128 + 4 * n) * isc;
            }
    }
    __device__ __forceinline__ void operator()(const f32x4 (&acc)[2][2][4][2], const pg8::Unit& u, int wr, int wc, int fr, int fq, LAS unsigned char* lds) const {
        const int row0 = u.pm * 256 + wr * 64 + fr, col0 = u.pn * 256 + wc * 32 + 8 * fq;
#pragma unroll
        for (int ai = 0; ai < 2; ++ai)
#pragma unroll
            for (int m = 0; m < 4; ++m) {
                const int row = row0 + ai * 128 + m * 16;
                bf16_t* op = x1b + (size_t)row * DM + col0;
                float s = 0.f;
#pragma unroll
                for (int bj = 0; bj < 2; ++bj) {
                    const f32x4 v0 = acc[ai][bj][m][0], v1 = acc[ai][bj][m][1];
                    u32x4 w; w.x = cvtpk(v0[0], v0[1]); w.y = cvtpk(v0[2], v0[3]); w.z = cvtpk(v1[0], v1[1]); w.w = cvtpk(v1[2], v1[3]);
                    *(u32x4*)(op + bj * 128) = w;
                    s += (v0[0] * v0[0] + v0[1] * v0[1]) + (v0[2] * v0[2] + v0[3] * v0[3]) + (v1[0] * v1[0] + v1[1] * v1[1]) + (v1[2] * v1[2] + v1[3] * v1[3]);
                }
                s += __shfl_xor(s, 16); s += __shfl_xor(s, 32);
                if (fq == 0) rowss[(size_t)row * 32 + u.pn * 4 + wc] = s;
            }
    }
};
struct EpiGateUp {
    static constexpr bool INIT = false;
    unsigned char* act;
    __device__ __forceinline__ void operator()(const f32x4 (&acc)[2][2][4][2], const pg8::Unit& u, int wr, int wc, int fr, int fq, LAS unsigned char* lds) const {
        const int row0 = u.pm * 256 + wr * 64 + fr;
        unsigned char* base = act + (size_t)u.e * EROWS * FF + u.pn * 128 + wc * 32 + 8 * fq;
        constexpr float DS = 1.0f / (WSC8 * HSC8);
#pragma unroll
        for (int ai = 0; ai < 2; ++ai)
#pragma unroll
            for (int m = 0; m < 4; ++m) {
                float r[8];
#pragma unroll
                for (int n = 0; n < 2; ++n)
#pragma unroll
                    for (int j = 0; j < 4; ++j) { const float g = acc[ai][0][m][n][j] * DS, uu = acc[ai][1][m][n][j] * DS;
                        const float a = g * __builtin_amdgcn_rcpf(1.0f + __builtin_amdgcn_exp2f(-g * LOG2E)) * uu * ASC8;
                        r[n * 4 + j] = fminf(fmaxf(a, -448.0f), 448.0f); }
                u32x2 w; w.x = cvt4_fp8(r[0], r[1], r[2], r[3]); w.y = cvt4_fp8(r[4], r[5], r[6], r[7]);
                *(u32x2*)(base + (size_t)(row0 + ai * 128 + m * 16) * FF) = w;
            }
    }
};
struct EpiDown {
    static constexpr bool INIT = false;
    bf16_t* y; const float* selgate;
    __device__ __forceinline__ void operator()(const f32x4 (&acc)[2][2][4][2], const pg8::Unit& u, int wr, int wc, int fr, int fq, LAS unsigned char* lds) const {
        const int row0 = u.pm * 256 + wr * 64 + fr;
        bf16_t* base = y + (size_t)u.e * EROWS * DM + u.pn * 256 + wc * 32 + 8 * fq;
#pragma unroll
        for (int ai = 0; ai < 2; ++ai)
#pragma unroll
            for (int m = 0; m < 4; ++m) {
                const int row = row0 + ai * 128 + m * 16;
                const float gt = selgate[u.e * EROWS + row] * (1.0f / (WSC8 * ASC8));
#pragma unroll
                for (int bj = 0; bj < 2; ++bj) { const f32x4 v0 = acc[ai][bj][m][0] * gt, v1 = acc[ai][bj][m][1] * gt;
                    u32x4 w; w.x = cvtpk(v0[0], v0[1]); w.y = cvtpk(v0[2], v0[3]); w.z = cvtpk(v1[0], v1[1]); w.w = cvtpk(v1[2], v1[3]);
                    *(u32x4*)(base + (size_t)row * DM + bj * 128) = w; }
            }
    }
};

#define KSWZ(row, colB) ((row) * 256 + ((colB) ^ (((row) & 7) << 4)))
#define SBAR() __builtin_amdgcn_sched_barrier(0)
__device__ __forceinline__ int crow(int r, int hi) { return (r & 3) + 8 * (r >> 2) + 4 * hi; }
#define PK4(P, BASE, OUT) do { unsigned a0 = cvtpk(P[BASE + 0], P[BASE + 1]), a1 = cvtpk(P[BASE + 2], P[BASE + 3]);   \
    unsigned b0 = cvtpk(P[BASE + 4], P[BASE + 5]), b1 = cvtpk(P[BASE + 6], P[BASE + 7]);                              \
    auto r0 = __builtin_amdgcn_permlane32_swap(a0, b0, false, false); auto r1 = __builtin_amdgcn_permlane32_swap(a1, b1, false, false); \
    u32x4 w = {r0[0], r1[0], r0[1], r1[1]}; OUT = *reinterpret_cast<bf16x8*>(&w); } while (0)
__device__ __forceinline__ float swap_add(float v) { auto rr = __builtin_amdgcn_permlane32_swap(__float_as_uint(v), __float_as_uint(v), false, false); return __uint_as_float(rr[0]) + __uint_as_float(rr[1]); }

namespace da {
constexpr int D = 128, NW = 8, QBLK = 32, KVBLK = 64;
constexpr int SHM_V = KVBLK * D * 2, SHM_K = KVBLK * D * 2, SHM_ATTN = 2 * SHM_V + 2 * SHM_K + NW * 64 * 4;
constexpr int LDP = INC;

__device__ __forceinline__ void qkt(f32x16& p0, f32x16& p1, const LAS unsigned char* Ks, const bf16x8* qr, int r32, int hi) {
    p0 = f32x16{}; p1 = f32x16{};
#pragma unroll
    for (int d0 = 0; d0 < 8; ++d0) { const int cb = (d0 * 16 + hi * 8) * 2;
        const bf16x8 b0 = *(const LAS bf16x8*)(Ks + KSWZ(r32, cb));
        const bf16x8 b1 = *(const LAS bf16x8*)(Ks + KSWZ(32 + r32, cb));
        p0 = __builtin_amdgcn_mfma_f32_32x32x16_bf16(b0, qr[d0], p0, 0, 0, 0);
        p1 = __builtin_amdgcn_mfma_f32_32x32x16_bf16(b1, qr[d0], p1, 0, 0, 0); }
}
__device__ __forceinline__ int v_st(int k, int c) { const int kk = (k & ~0xC) | ((k & 4) << 1) | ((k & 8) >> 1); return ((kk >> 3) * 4 + (c >> 5)) * 512 + ((kk & 7) * 32 + (c & 31)) * 2; }
__device__ __forceinline__ int v_rd_base(int lane) { return ((lane & 3) << 3) | (((lane >> 2) & 3) << 6) | (((lane >> 4) & 1) << 5) | (((lane >> 5) & 1) << 8); }
constexpr int v_rd_off(int d0, int ks, int half) { return d0 * 512 + ks * 4096 + half * 2048; }
template <int OFF> __device__ __forceinline__ s16x4 tr_read(int vb) {
    s16x4 r; asm volatile("ds_read_b64_tr_b16 %0, %1 offset:%2" : "=&v"(r) : "v"(vb), "i"(OFF) : "memory"); return r;
}
template <int D0> __device__ __forceinline__ void pv_one(f32x16& od, int vb, bf16x8 pa0, bf16x8 pa1, bf16x8 pa2, bf16x8 pa3) {
    const s16x4 l0 = tr_read<v_rd_off(D0, 0, 0)>(vb), h0 = tr_read<v_rd_off(D0, 0, 1)>(vb), l1 = tr_read<v_rd_off(D0, 1, 0)>(vb), h1 = tr_read<v_rd_off(D0, 1, 1)>(vb);
    const s16x4 l2 = tr_read<v_rd_off(D0, 2, 0)>(vb), h2 = tr_read<v_rd_off(D0, 2, 1)>(vb), l3 = tr_read<v_rd_off(D0, 3, 0)>(vb), h3 = tr_read<v_rd_off(D0, 3, 1)>(vb);
    asm volatile("s_waitcnt lgkmcnt(0)" ::: "memory"); SBAR();
#define PKV(L, H) (bf16x8){L[0], L[1], L[2], L[3], H[0], H[1], H[2], H[3]}
    od = __builtin_amdgcn_mfma_f32_32x32x16_bf16(pa0, PKV(l0, h0), od, 0, 0, 0);
    od = __builtin_amdgcn_mfma_f32_32x32x16_bf16(pa1, PKV(l1, h1), od, 0, 0, 0);
    od = __builtin_amdgcn_mfma_f32_32x32x16_bf16(pa2, PKV(l2, h2), od, 0, 0, 0);
    od = __builtin_amdgcn_mfma_f32_32x32x16_bf16(pa3, PKV(l3, h3), od, 0, 0, 0);
#undef PKV
}
__device__ __forceinline__ void pv_d0(f32x16* o, int vb, bf16x8 pa0, bf16x8 pa1, bf16x8 pa2, bf16x8 pa3) {
    pv_one<0>(o[0], vb, pa0, pa1, pa2, pa3); pv_one<1>(o[1], vb, pa0, pa1, pa2, pa3); pv_one<2>(o[2], vb, pa0, pa1, pa2, pa3); pv_one<3>(o[3], vb, pa0, pa1, pa2, pa3);
}
__device__ __forceinline__ void sm_a(f32x16& p0, f32x16& p1, float dq, float slope2) {
#pragma unroll
    for (int r = 0; r < 16; ++r) { const float c = (float)((r & 3) + 8 * (r >> 2)); p0[r] = __builtin_amdgcn_exp2f(p0[r] - slope2 * fabsf(dq - c)); }
#pragma unroll
    for (int r = 0; r < 16; ++r) { const float c = (float)((r & 3) + 8 * (r >> 2) + 32); p1[r] = p1[r] - slope2 * fabsf(dq - c); }
}
__device__ __forceinline__ void sm_b(f32x16& p0, f32x16& p1, float& l_reg, bf16x8& pa0, bf16x8& pa1, bf16x8& pa2, bf16x8& pa3) {
#pragma unroll
    for (int r = 0; r < 16; ++r) p1[r] = __builtin_amdgcn_exp2f(p1[r]);
    float ps = 0;
#pragma unroll
    for (int r = 0; r < 16; ++r) ps += p0[r];
#pragma unroll
    for (int r = 0; r < 16; ++r) ps += p1[r];
    l_reg += swap_add(ps);
    PK4(p0, 0, pa0); PK4(p0, 8, pa1); PK4(p1, 0, pa2); PK4(p1, 8, pa3);
}
__device__ __forceinline__ void attn_body(const bf16_t* __restrict__ Qb, const bf16_t* __restrict__ Kh, const bf16_t* __restrict__ Vh, float* __restrict__ Ob, int q0, float slope2, LAS unsigned char* lds) {
    const int tid = threadIdx.x, wid = tid >> 6, lane = tid & 63, r32 = lane & 31, hi = lane >> 5;
    LAS unsigned char* V_lds = lds; LAS unsigned char* K_lds = lds + 2 * SHM_V;
    LAS float* li_l = (LAS float*)(lds + 2 * SHM_V + 2 * SHM_K) + wid * 64;
    float l_reg = 0; f32x16 o[4] = {}; bf16x8 qr[8];
    const bf16_t* Qw = Qb + (size_t)(wid * QBLK + r32) * LDP + hi * 8;
#pragma unroll
    for (int d0 = 0; d0 < 8; ++d0) qr[d0] = *(const bf16x8*)(Qw + d0 * 16);
    const int sr = tid >> 4, sc = (tid & 15) * 8, vst0 = v_st(sr, sc), vst1 = v_st(32 + sr, sc);
    const int vb0 = (int)(uintptr_t)V_lds + v_rd_base(lane);
    const float dqbase = (float)(q0 + wid * QBLK + r32 - 4 * hi);
    struct { bf16x8 vs0, vs1, ks0, ks1; } sr_[1];
    const unsigned so0 = (unsigned)(sr * LDP + sc) * 2u, so1 = (unsigned)((32 + sr) * LDP + sc) * 2u;
#define SLOAD(i, k0) do { const char* vb_ = (const char*)Vh + (size_t)(k0) * (LDP * 2); const char* kb_ = (const char*)Kh + (size_t)(k0) * (LDP * 2); \
    sr_[i].vs0 = *(const bf16x8*)(vb_ + so0); sr_[i].vs1 = *(const bf16x8*)(vb_ + so1); \
    sr_[i].ks0 = *(const bf16x8*)(kb_ + so0); sr_[i].ks1 = *(const bf16x8*)(kb_ + so1); } while (0)
#define SWRITE(b, i) do { *(LAS bf16x8*)(V_lds + (b) * SHM_V + vst0) = sr_[i].vs0;          \
    *(LAS bf16x8*)(V_lds + (b) * SHM_V + vst1) = sr_[i].vs1; const int kc = sc * 2;               \
    *(LAS bf16x8*)(K_lds + (b) * SHM_K + KSWZ(sr, kc)) = sr_[i].ks0;                       \
    *(LAS bf16x8*)(K_lds + (b) * SHM_K + KSWZ(32 + sr, kc)) = sr_[i].ks1; } while (0)
#define SWAIT() asm volatile("s_waitcnt vmcnt(0)" ::: "memory")
    f32x16 pA0, pA1, pB0, pB1; bf16x8 pa0, pa1, pa2, pa3; constexpr int NT = SEQ / KVBLK;
    SLOAD(0, 0); SWAIT(); SWRITE(0, 0); __syncthreads();
    qkt(pA0, pA1, K_lds, qr, r32, hi); sm_a(pA0, pA1, dqbase, slope2);
    SLOAD(0, KVBLK);
    SWAIT(); SWRITE(1, 0); __syncthreads();
    for (int j = 1; j + 1 < NT; j += 2) {
        SBAR(); qkt(pB0, pB1, K_lds + SHM_K, qr, r32, hi);
        sm_b(pA0, pA1, l_reg, pa0, pa1, pa2, pa3); SBAR();
        SLOAD(0, (j + 1) * KVBLK); SBAR();
        pv_d0(o, vb0, pa0, pa1, pa2, pa3); sm_a(pB0, pB1, dqbase - (float)(j * KVBLK), slope2);
        __syncthreads(); SWAIT(); SWRITE(0, 0);
        __syncthreads();
        SBAR(); qkt(pA0, pA1, K_lds, qr, r32, hi);
        sm_b(pB0, pB1, l_reg, pa0, pa1, pa2, pa3); SBAR();
        SLOAD(0, (j + 2) * KVBLK); SBAR();
        pv_d0(o, vb0 + SHM_V, pa0, pa1, pa2, pa3); sm_a(pA0, pA1, dqbase - (float)((j + 1) * KVBLK), slope2);
        __syncthreads(); SWAIT(); SWRITE(1, 0);
        __syncthreads();
    }
    SBAR(); qkt(pB0, pB1, K_lds + SHM_K, qr, r32, hi);
    sm_b(pA0, pA1, l_reg, pa0, pa1, pa2, pa3); SBAR();
    pv_d0(o, vb0, pa0, pa1, pa2, pa3); sm_a(pB0, pB1, dqbase - (float)((NT - 1) * KVBLK), slope2);
    __syncthreads();
    sm_b(pB0, pB1, l_reg, pa0, pa1, pa2, pa3); SBAR();
    pv_d0(o, vb0 + SHM_V, pa0, pa1, pa2, pa3);
    if (hi == 0) li_l[r32] = l_reg; asm volatile("s_waitcnt lgkmcnt(0)" ::: "memory");
    float rli[16];
#pragma unroll
    for (int r = 0; r < 16; ++r) rli[r] = __builtin_amdgcn_rcpf(li_l[crow(r, hi)]);
    float* Ow = Ob + (size_t)(wid * QBLK) * DM;
#pragma unroll
    for (int r = 0; r < 16; ++r) { const int orow = crow(r, hi);
#pragma unroll
        for (int d0 = 0; d0 < 4; ++d0) Ow[(size_t)orow * DM + d0 * 32 + r32] = o[d0][r] * rli[r]; }
    __syncthreads();
#undef SLOAD
#undef SWRITE
#undef SWAIT
}
}

namespace da2 {
constexpr int BUFB = 65536, KB = 16384;
__device__ __forceinline__ int v_rd_base(int lane) { return ((lane & 3) << 3) | (((lane >> 2) & 3) << 6) | (((lane >> 4) & 1) << 5) | (((lane >> 5) & 1) << 8); }
template <int OFF> __device__ __forceinline__ s16x4 tr_read(int vb) {
    s16x4 r; asm volatile("ds_read_b64_tr_b16 %0, %1 offset:%2" : "=&v"(r) : "v"(vb), "i"(OFF) : "memory"); return r;
}
template <int NCB, int CB> __device__ __forceinline__ void pv_one(f32x16& od, int vb, bf16x8 pa0, bf16x8 pa1, bf16x8 pa2, bf16x8 pa3) {
    constexpr int S = NCB * 512;
    const s16x4 l0 = tr_read<CB * 512 + 0 * S>(vb), h0 = tr_read<CB * 512 + 1 * S>(vb), l1 = tr_read<CB * 512 + 2 * S>(vb), h1 = tr_read<CB * 512 + 3 * S>(vb);
    const s16x4 l2 = tr_read<CB * 512 + 4 * S>(vb), h2 = tr_read<CB * 512 + 5 * S>(vb), l3 = tr_read<CB * 512 + 6 * S>(vb), h3 = tr_read<CB * 512 + 7 * S>(vb);
    asm volatile("s_waitcnt lgkmcnt(0)" ::: "memory"); SBAR();
#define PKV(L, H) (bf16x8){L[0], L[1], L[2], L[3], H[0], H[1], H[2], H[3]}
    od = __builtin_amdgcn_mfma_f32_32x32x16_bf16(pa0, PKV(l0, h0), od, 0, 0, 0);
    od = __builtin_amdgcn_mfma_f32_32x32x16_bf16(pa1, PKV(l1, h1), od, 0, 0, 0);
    od = __builtin_amdgcn_mfma_f32_32x32x16_bf16(pa2, PKV(l2, h2), od, 0, 0, 0);
    od = __builtin_amdgcn_mfma_f32_32x32x16_bf16(pa3, PKV(l3, h3), od, 0, 0, 0);
#undef PKV
}
__device__ __forceinline__ void qkt(f32x16& p0, f32x16& p1, const LAS unsigned char* Ks, const bf16x8* qr, int r32, int hi) {
    p0 = f32x16{}; p1 = f32x16{};
#pragma unroll
    for (int d0 = 0; d0 < 8; ++d0) { const int cb = (d0 * 16 + hi * 8) * 2;
        const bf16x8 b0 = *(const LAS bf16x8*)(Ks + KSWZ(r32, cb));
        const bf16x8 b1 = *(const LAS bf16x8*)(Ks + KSWZ(32 + r32, cb));
        p0 = __builtin_amdgcn_mfma_f32_32x32x16_bf16(b0, qr[d0], p0, 0, 0, 0);
        p1 = __builtin_amdgcn_mfma_f32_32x32x16_bf16(b1, qr[d0], p1, 0, 0, 0); }
}
__device__ __forceinline__ int unswap23(int kk) { return (kk & ~0xC) | ((kk & 4) << 1) | ((kk & 8) >> 1); }

__device__ __forceinline__ void epilogue(const Params& P, LAS unsigned char* lds, f32x16 (&o)[8], float l_reg, int tz, int it) {
    const int wid = __builtin_amdgcn_readfirstlane(tz >> 6), lane = tz & 63, r32 = lane & 31, hi = lane >> 5;
    float lam;
    { float a = P.lam_q1[lane] * P.lam_k1[lane] + P.lam_q1[lane + 64] * P.lam_k1[lane + 64];
      float c = P.lam_q2[lane] * P.lam_k2[lane] + P.lam_q2[lane + 64] * P.lam_k2[lane + 64];
      a = wave_sum(a); c = wave_sum(c); lam = expf(a) - expf(c) + 0.2f; }
    const int br = wid >> 2, w4 = wid & 3;
    const int b = it >> 7, h = (it >> 5) & 3, qt = it & 31;
    const size_t row0 = (size_t)b * SEQ; const int q0 = qt * 128;
    LAS float* li_l = (LAS float*)(lds + SCR_OFF) + wid * 32;
    if (hi == 0) li_l[r32] = l_reg;
    asm volatile("s_waitcnt lgkmcnt(0)" ::: "memory");
    __syncthreads();
    LAS float* X = (LAS float*)lds + w4 * 8192;
    if (br == 1) {
#pragma unroll
        for (int r = 0; r < 16; ++r) { const float rl = __builtin_amdgcn_rcpf(li_l[crow(r, hi)]);
#pragma unroll
            for (int d = 0; d < 8; ++d) X[(r * 8 + d) * 64 + lane] = o[d][r] * rl; }
    }
    __syncthreads();
    if (br == 0) {
        LAS unsigned char* T = (LAS unsigned char*)X;
        float g[8];
#pragma unroll
        for (int d = 0; d < 8; ++d) g[d] = P.subln_b[d * 32 + r32];
#pragma unroll
        for (int r = 0; r < 16; ++r) {
            const float rl = __builtin_amdgcn_rcpf(li_l[crow(r, hi)]);
            float v[8], sq = 0.f;
#pragma unroll
            for (int d = 0; d < 8; ++d) { v[d] = o[d][r] * rl - lam * X[(r * 8 + d) * 64 + lane]; sq += v[d] * v[d]; }
#pragma unroll
            for (int sh = 16; sh >= 1; sh >>= 1) sq += __shfl_xor(sq, sh);
            const float rstd = rsqrtf(sq * (1.0f / 256.0f) + RMS_EPS) * 0.8f;
#pragma unroll
            for (int d = 0; d < 8; ++d) { const unsigned w = cvtpk(v[d] * rstd * g[d], 0.f); *(LAS bf16_t*)(T + (2 * r + hi) * 512 + (d * 32 + r32) * 2) = (bf16_t)(w & 0xffffu); }
        }
        asm volatile("s_waitcnt lgkmcnt(0)" ::: "memory");
        char* mixb = (char*)((bf16_t*)(P.ws + WS_MIX) + (row0 + q0 + w4 * 32) * DM + 1024 + h * 256);
        const unsigned loff = (unsigned)(hi * 4 * DM * 2 + r32 * 16);
#pragma unroll
        for (int i = 0; i < 16; ++i) {
            const u32x4 w = *(const LAS u32x4*)(T + (2 * i + hi) * 512 + r32 * 16);
            *(u32x4*)(mixb + (size_t)((i & 3) + 8 * (i >> 2)) * (DM * 2) + loff) = w;
        }
    }
    __syncthreads();
}
__device__ __forceinline__ void item(const Params& P, int it, LAS unsigned char* lds) {
    int tid = threadIdx.x; asm volatile("" : "+v"(tid));
    const int wid = __builtin_amdgcn_readfirstlane(tid >> 6), lane = tid & 63, r32 = lane & 31, hi = lane >> 5;
    const int br = wid >> 2, w4 = wid & 3;
    const int b = it >> 7, h = (it >> 5) & 3, qt = it & 31;
    const bf16_t* proj = (const bf16_t*)(P.ws + WS_PROJ);
    const size_t row0 = (size_t)b * SEQ; const int q0 = qt * 128;
    bf16x8 qr[8];
    { const bf16_t* Qw = proj + (row0 + q0 + w4 * 32 + r32) * INC + 3072 + br * 512 + h * 128 + hi * 8;
#pragma unroll
      for (int d0 = 0; d0 < 8; ++d0) qr[d0] = *(const bf16x8*)(Qw + d0 * 16); }
    const char* kbase = (const char*)(proj + row0 * INC + 4096 + h * 128);
    const char* vbase = (const char*)(proj + row0 * INC + 5120 + h * 256);
    const int krow = wid * 8 + (lane >> 4);
    const unsigned voffK0 = (unsigned)(krow * INC * 2 + (((lane & 15) ^ (lane >> 4)) << 4));
    const unsigned voffK1 = (unsigned)((krow + 4) * INC * 2 + (((lane & 15) ^ (4 + (lane >> 4))) << 4));
    const unsigned voffV = (unsigned)(unswap23(wid * 8 + ((lane & 31) >> 2)) * INC * 2 + (lane >> 5) * 64 + (lane & 3) * 16);
#define DA2_ISSUE(t, bufi) do { const char* kb_ = kbase + (size_t)(t) * (64 * INC * 2); const char* vb_ = vbase + (size_t)(t) * (64 * INC * 2); \
        LAS unsigned char* lb_ = lds + (bufi) * BUFB; \
        __builtin_amdgcn_global_load_lds((const unsigned*)(kb_ + voffK0), (LAS unsigned*)(lb_ + wid * 2048), 16, 0, 0); \
        __builtin_amdgcn_global_load_lds((const unsigned*)(kb_ + voffK1), (LAS unsigned*)(lb_ + wid * 2048 + 1024), 16, 0, 0); \
        __builtin_amdgcn_global_load_lds((const unsigned*)(kb_ + 1024 + voffK0), (LAS unsigned*)(lb_ + KB + wid * 2048), 16, 0, 0); \
        __builtin_amdgcn_global_load_lds((const unsigned*)(kb_ + 1024 + voffK1), (LAS unsigned*)(lb_ + KB + wid * 2048 + 1024), 16, 0, 0); \
        _Pragma("unroll") for (int i_ = 0; i_ < 4; ++i_) \
            __builtin_amdgcn_global_load_lds((const unsigned*)(vb_ + i_ * 128 + voffV), (LAS unsigned*)(lb_ + 2 * KB + wid * 4096 + i_ * 1024), 16, 0, 0); } while (0)
    const float slope2 = exp2f(-2.0f * (float)(h + 1)) * LOG2E;
    float dq = (float)(q0 + w4 * 32 + r32 - 4 * hi);
    f32x16 o[8];
#pragma unroll
    for (int d = 0; d < 8; ++d) o[d] = f32x16{};
    float l_reg = 0.f;
    const int vb0 = (int)(uintptr_t)(lds + 2 * KB) + v_rd_base(lane);
    DA2_ISSUE(0, 0);
#pragma unroll 1
    for (int j = 0; j < SEQ / 64; ++j) {
        asm volatile("s_waitcnt vmcnt(0)" ::: "memory");
        __builtin_amdgcn_s_barrier();
        asm volatile("" ::: "memory");
        if (j + 1 < SEQ / 64) DA2_ISSUE(j + 1, (j + 1) & 1);
        const LAS unsigned char* Kb = lds + (j & 1) * BUFB + br * KB;
        f32x16 p0, p1;
        qkt(p0, p1, Kb, qr, r32, hi);
        float ps = 0.f;
#pragma unroll
        for (int r = 0; r < 16; ++r) { const float c = (float)((r & 3) + 8 * (r >> 2)); p0[r] = __builtin_amdgcn_exp2f(p0[r] - slope2 * fabsf(dq - c)); ps += p0[r]; }
#pragma unroll
        for (int r = 0; r < 16; ++r) { const float c = (float)((r & 3) + 8 * (r >> 2) + 32); p1[r] = __builtin_amdgcn_exp2f(p1[r] - slope2 * fabsf(dq - c)); ps += p1[r]; }
        l_reg += swap_add(ps);
        bf16x8 pa0, pa1, pa2, pa3;
        PK4(p0, 0, pa0); PK4(p0, 8, pa1); PK4(p1, 0, pa2); PK4(p1, 8, pa3);
        const int vb = vb0 + (j & 1) * BUFB;
        pv_one<8, 0>(o[0], vb, pa0, pa1, pa2, pa3); pv_one<8, 1>(o[1], vb, pa0, pa1, pa2, pa3); pv_one<8, 2>(o[2], vb, pa0, pa1, pa2, pa3); pv_one<8, 3>(o[3], vb, pa0, pa1, pa2, pa3);
        pv_one<8, 4>(o[4], vb, pa0, pa1, pa2, pa3); pv_one<8, 5>(o[5], vb, pa0, pa1, pa2, pa3); pv_one<8, 6>(o[6], vb, pa0, pa1, pa2, pa3); pv_one<8, 7>(o[7], vb, pa0, pa1, pa2, pa3);
        dq -= 64.0f;
    }
#undef DA2_ISSUE
    int tz = threadIdx.x; asm volatile("" : "+v"(tz));
    epilogue(P, lds, o, l_reg, tz, it);
}
}

namespace da3 {
constexpr int BUFB = 65536, KB = 16384;
__device__ __forceinline__ void qk_softmax(const LAS unsigned char* Kb, const bf16x8* qr, int r32, int hi, float dq, float slope2, int rel  ,
                                           float& l_reg, bf16x8& pa0, bf16x8& pa1, bf16x8& pa2, bf16x8& pa3) {
    f32x16 p0, p1;
    if (rel != 0) {
        const float ss = rel < 0 ? slope2 : -slope2, A = -ss * dq;
#pragma unroll
        for (int r = 0; r < 16; ++r) { const float c = (float)((r & 3) + 8 * (r >> 2)); p0[r] = fmaf(ss, c, A); p1[r] = fmaf(ss, c + 32.0f, A); }
    } else {
#pragma unroll
        for (int r = 0; r < 16; ++r) { const float c = (float)((r & 3) + 8 * (r >> 2)); p0[r] = -slope2 * fabsf(dq - c); p1[r] = -slope2 * fabsf(dq - c - 32.0f); }
    }
#pragma unroll
    for (int d0 = 0; d0 < 8; ++d0) { const int cb = (d0 * 16 + hi * 8) * 2;
        const bf16x8 b0 = *(const LAS bf16x8*)(Kb + KSWZ(r32, cb));
        const bf16x8 b1 = *(const LAS bf16x8*)(Kb + KSWZ(32 + r32, cb));
        p0 = __builtin_amdgcn_mfma_f32_32x32x16_bf16(b0, qr[d0], p0, 0, 0, 0);
        p1 = __builtin_amdgcn_mfma_f32_32x32x16_bf16(b1, qr[d0], p1, 0, 0, 0); }
    f32x2 s2 = {0.f, 0.f};
#pragma unroll
    for (int r = 0; r < 16; r += 2) { p0[r] = __builtin_amdgcn_exp2f(p0[r]); p0[r + 1] = __builtin_amdgcn_exp2f(p0[r + 1]); s2 += (f32x2){p0[r], p0[r + 1]}; }
#pragma unroll
    for (int r = 0; r < 16; r += 2) { p1[r] = __builtin_amdgcn_exp2f(p1[r]); p1[r + 1] = __builtin_amdgcn_exp2f(p1[r + 1]); s2 += (f32x2){p1[r], p1[r + 1]}; }
    l_reg += swap_add(s2[0] + s2[1]);
    PK4(p0, 0, pa0); PK4(p0, 8, pa1); PK4(p1, 0, pa2); PK4(p1, 8, pa3);
}
struct VFrag { s16x4 l0, h0, l1, h1, l2, h2, l3, h3; };
template <int CB> __device__ __forceinline__ void vread(VFrag& f, int vb) {
    constexpr int S = 8 * 512;
    f.l0 = da2::tr_read<CB * 512 + 0 * S>(vb); f.h0 = da2::tr_read<CB * 512 + 1 * S>(vb); f.l1 = da2::tr_read<CB * 512 + 2 * S>(vb); f.h1 = da2::tr_read<CB * 512 + 3 * S>(vb);
    f.l2 = da2::tr_read<CB * 512 + 4 * S>(vb); f.h2 = da2::tr_read<CB * 512 + 5 * S>(vb); f.l3 = da2::tr_read<CB * 512 + 6 * S>(vb); f.h3 = da2::tr_read<CB * 512 + 7 * S>(vb);
}
__device__ __forceinline__ void vmma(f32x16& od, const VFrag& f, bf16x8 pa0, bf16x8 pa1, bf16x8 pa2, bf16x8 pa3) {
#define PKV(L, H) (bf16x8){L[0], L[1], L[2], L[3], H[0], H[1], H[2], H[3]}
    od = __builtin_amdgcn_mfma_f32_32x32x16_bf16(pa0, PKV(f.l0, f.h0), od, 0, 0, 0);
    od = __builtin_amdgcn_mfma_f32_32x32x16_bf16(pa1, PKV(f.l1, f.h1), od, 0, 0, 0);
    od = __builtin_amdgcn_mfma_f32_32x32x16_bf16(pa2, PKV(f.l2, f.h2), od, 0, 0, 0);
    od = __builtin_amdgcn_mfma_f32_32x32x16_bf16(pa3, PKV(f.l3, f.h3), od, 0, 0, 0);
#undef PKV
}
#define DA3_LW(n) do { asm volatile("s_waitcnt lgkmcnt(" #n ")" ::: "memory"); SBAR(); } while (0)
__device__ __forceinline__ void pv8(f32x16 (&o)[8], int vb, bf16x8 pa0, bf16x8 pa1, bf16x8 pa2, bf16x8 pa3) {
    VFrag fa, fb;
    vread<0>(fa, vb);
    vread<1>(fb, vb); DA3_LW(8); vmma(o[0], fa, pa0, pa1, pa2, pa3);
    vread<2>(fa, vb); DA3_LW(8); vmma(o[1], fb, pa0, pa1, pa2, pa3);
    vread<3>(fb, vb); DA3_LW(8); vmma(o[2], fa, pa0, pa1, pa2, pa3);
    vread<4>(fa, vb); DA3_LW(8); vmma(o[3], fb, pa0, pa1, pa2, pa3);
    vread<5>(fb, vb); DA3_LW(8); vmma(o[4], fa, pa0, pa1, pa2, pa3);
    vread<6>(fa, vb); DA3_LW(8); vmma(o[5], fb, pa0, pa1, pa2, pa3);
    vread<7>(fb, vb); DA3_LW(8); vmma(o[6], fa, pa0, pa1, pa2, pa3);
    DA3_LW(0); vmma(o[7], fb, pa0, pa1, pa2, pa3);
}
__device__ __forceinline__ void item(const Params& P, int it, LAS unsigned char* lds) {
    int tid = threadIdx.x; asm volatile("" : "+v"(tid));
    const int wid = __builtin_amdgcn_readfirstlane(tid >> 6), lane = tid & 63, r32 = lane & 31, hi = lane >> 5;
    const int br = wid >> 2, w4 = wid & 3;
    const int b = it >> 7, h = (it >> 5) & 3, qt = it & 31;
    const bf16_t* proj = (const bf16_t*)(P.ws + WS_PROJ);
    const size_t row0 = (size_t)b * SEQ; const int q0 = qt * 128;
    bf16x8 qr[8];
    { const bf16_t* Qw = proj + (row0 + q0 + w4 * 32 + r32) * INC + 3072 + br * 512 + h * 128 + hi * 8;
#pragma unroll
      for (int d0 = 0; d0 < 8; ++d0) qr[d0] = *(const bf16x8*)(Qw + d0 * 16); }
    const char* kbase = (const char*)(proj + row0 * INC + 4096 + br * 512 + h * 128);
    const char* vbase = (const char*)(proj + row0 * INC + 5120 + h * 256);
#define DA3_LANE() int lz_ = lane; asm volatile("" : "+v"(lz_)); const int krow_ = w4 * 16 + (lz_ >> 4)
#define DA3_ISSUE_K(t, bufi) do { DA3_LANE(); \
        const unsigned voffK0 = (unsigned)(krow_ * INC * 2 + (((lz_ & 15) ^ (lz_ >> 4)) << 4)); \
        const unsigned voffK1 = (unsigned)((krow_ + 4) * INC * 2 + (((lz_ & 15) ^ (4 + (lz_ >> 4))) << 4)); \
        const char* kb_ = kbase + (size_t)(t) * (64 * INC * 2); LAS unsigned char* lb_ = lds + (bufi) * BUFB + br * KB + w4 * 4096; \
        __builtin_amdgcn_global_load_lds((const unsigned*)(kb_ + voffK0), (LAS unsigned*)(lb_), 16, 0, 0); \
        __builtin_amdgcn_global_load_lds((const unsigned*)(kb_ + voffK1), (LAS unsigned*)(lb_ + 1024), 16, 0, 0); \
        __builtin_amdgcn_global_load_lds((const unsigned*)(kb_ + 8 * INC * 2 + voffK0), (LAS unsigned*)(lb_ + 2048), 16, 0, 0); \
        __builtin_amdgcn_global_load_lds((const unsigned*)(kb_ + 8 * INC * 2 + voffK1), (LAS unsigned*)(lb_ + 3072), 16, 0, 0); } while (0)
#define DA3_ISSUE_V(t, bufi) do { DA3_LANE(); (void)krow_; \
        const unsigned voffV = (unsigned)(da2::unswap23(wid * 8 + ((lz_ & 31) >> 2)) * INC * 2 + (lz_ >> 5) * 64 + (lz_ & 3) * 16); \
        const char* vb_ = vbase + (size_t)(t) * (64 * INC * 2); LAS unsigned char* lb_ = lds + (bufi) * BUFB + 2 * KB + wid * 4096; \
        _Pragma("unroll") for (int i_ = 0; i_ < 4; ++i_) \
            __builtin_amdgcn_global_load_lds((const unsigned*)(vb_ + i_ * 128 + voffV), (LAS unsigned*)(lb_ + i_ * 1024), 16, 0, 0); } while (0)
#define DA3_BAR() do { asm volatile("" ::: "memory"); __builtin_amdgcn_s_barrier(); asm volatile("" ::: "memory"); } while (0)
    const float slope2 = exp2f(-2.0f * (float)(h + 1)) * LOG2E;
    const int qlo = q0 + w4 * 32, jd = qlo >> 6;
    int jlo = 0, jhi = SEQ / 64 - 1;
    { float gq = fmaxf(fabsf(P.qn_b[lane]), fabsf(P.qn_b[lane + 64])), gk = fmaxf(fabsf(P.kn_b[lane]), fabsf(P.kn_b[lane + 64]));
#pragma unroll
      for (int o_ = 32; o_ >= 1; o_ >>= 1) { gq = fmaxf(gq, __shfl_xor(gq, o_)); gk = fmaxf(gk, __shfl_xor(gk, o_)); }
      const float smax = 128.0f * QSCALE * gq * gk, dmax = (160.0f + smax) / slope2;
      const int di = dmax < 8192.0f ? (int)dmax + 1 : 8192;
      const int klo = q0 - di, khi = q0 + 127 + di;
      jlo = __builtin_amdgcn_readfirstlane(klo <= 0 ? 0 : (klo >> 6)); jhi = __builtin_amdgcn_readfirstlane(khi >= SEQ - 1 ? SEQ / 64 - 1 : (khi >> 6)); }
    float dq = (float)(qlo + r32 - 4 * hi - 64 * jlo);
    f32x16 o[8];
#pragma unroll
    for (int d = 0; d < 8; ++d) o[d] = f32x16{};
    float l_reg = 0.f;
    const int vb0 = (int)(uintptr_t)(lds + 2 * KB) + da2::v_rd_base(lane);
    bf16x8 pa0, pa1, pa2, pa3;
    DA3_ISSUE_K(jlo, 0); DA3_ISSUE_V(jlo, 0);
    if (br == 0) {
        asm volatile("s_waitcnt vmcnt(4)" ::: "memory");
#pragma unroll 1
        for (int j = jlo; j <= jhi; ++j) {
            const int jn = (j + 1 <= jhi) ? j + 1 : jhi, bc = (j - jlo) & 1, bn = bc ^ 1;
            DA3_BAR();
            DA3_ISSUE_K(jn, bn);
            qk_softmax(lds + bc * BUFB, qr, r32, hi, dq, slope2, j - jd, l_reg, pa0, pa1, pa2, pa3);
            asm volatile("s_waitcnt vmcnt(4)" ::: "memory");
            DA3_BAR();
            DA3_ISSUE_V(jn, bn);
            pv8(o, vb0 + bc * BUFB, pa0, pa1, pa2, pa3);
            asm volatile("s_waitcnt vmcnt(4)" ::: "memory");
            dq -= 64.0f;
        }
        DA3_BAR();
    } else {
        DA3_BAR();
        asm volatile("s_waitcnt vmcnt(0)" ::: "memory");
#pragma unroll 1
        for (int j = jlo; j <= jhi; ++j) {
            const int jn = (j + 1 <= jhi) ? j + 1 : jhi, bc = (j - jlo) & 1, bn = bc ^ 1;
            DA3_BAR();
            DA3_ISSUE_K(jn, bn); DA3_ISSUE_V(jn, bn);
            qk_softmax(lds + bc * BUFB + KB, qr, r32, hi, dq, slope2, j - jd, l_reg, pa0, pa1, pa2, pa3);
            DA3_BAR();
            pv8(o, vb0 + bc * BUFB, pa0, pa1, pa2, pa3);
            asm volatile("s_waitcnt vmcnt(0)" ::: "memory");
            dq -= 64.0f;
        }
    }
#undef DA3_ISSUE_K
#undef DA3_LANE
#undef DA3_ISSUE_V
#undef DA3_BAR
    asm volatile("s_waitcnt vmcnt(0)" ::: "memory");
    int tz = threadIdx.x; asm volatile("" : "+v"(tz));
    da2::epilogue(P, lds, o, l_reg, tz, it);
}
}

namespace da5 {
constexpr int BUFB = 65536, KB = 16384;
typedef float f32x4v __attribute__((ext_vector_type(4)));
template <int OFF> __device__ __forceinline__ s16x4 trr(int a) { s16x4 r; asm volatile("ds_read_b64_tr_b16 %0, %1 offset:%2" : "=&v"(r) : "v"(a), "i"(OFF) : "memory"); return r; }
#define D5_LW(n) do { asm volatile("s_waitcnt lgkmcnt(" #n ")" ::: "memory"); SBAR(); } while (0)

__device__ __forceinline__ void qk_softmax(const LAS unsigned char* Kb, const bf16x8 (&qr)[4][2], int lane_, float dqb, float slope2, int rel, float (&l)[2], bf16x8 (&pa)[2][2]) {
    asm volatile("" : "+v"(lane_));
    const int l16 = lane_ & 15, g = lane_ >> 4;
    f32x4v S[4][2];
    if (rel != 0) {
        const float ss = rel < 0 ? slope2 : -slope2, A = -ss * dqb;
#pragma unroll
        for (int kg = 0; kg < 4; ++kg)
#pragma unroll
            for (int qg = 0; qg < 2; ++qg)
#pragma unroll
                for (int r = 0; r < 4; ++r) S[kg][qg][r] = fmaf(ss, (float)(16 * kg + r - 16 * qg), A);
    } else {
#pragma unroll
        for (int kg = 0; kg < 4; ++kg)
#pragma unroll
            for (int qg = 0; qg < 2; ++qg)
#pragma unroll
                for (int r = 0; r < 4; ++r) S[kg][qg][r] = -slope2 * fabsf(dqb - (float)(16 * kg + r - 16 * qg));
    }
    const int krow = l16 * 256, kx = (l16 & 7) << 4;
#pragma unroll
    for (int s = 0; s < 4; ++s) {
        const int ka = krow + ((64 * s + 16 * g) ^ kx);
        const bf16x8 k0 = *(const LAS bf16x8*)(Kb + ka), k1 = *(const LAS bf16x8*)(Kb + ka + 4096), k2 = *(const LAS bf16x8*)(Kb + ka + 8192), k3 = *(const LAS bf16x8*)(Kb + ka + 12288);
#pragma unroll
        for (int qg = 0; qg < 2; ++qg) {
            S[0][qg] = __builtin_amdgcn_mfma_f32_16x16x32_bf16(k0, qr[s][qg], S[0][qg], 0, 0, 0);
            S[1][qg] = __builtin_amdgcn_mfma_f32_16x16x32_bf16(k1, qr[s][qg], S[1][qg], 0, 0, 0);
            S[2][qg] = __builtin_amdgcn_mfma_f32_16x16x32_bf16(k2, qr[s][qg], S[2][qg], 0, 0, 0);
            S[3][qg] = __builtin_amdgcn_mfma_f32_16x16x32_bf16(k3, qr[s][qg], S[3][qg], 0, 0, 0);
        }
    }
#pragma unroll
    for (int qg = 0; qg < 2; ++qg) {
        f32x2 s2 = {0.f, 0.f};
#pragma unroll
        for (int kg = 0; kg < 4; ++kg) {
#pragma unroll
            for (int r = 0; r < 4; ++r) S[kg][qg][r] = __builtin_amdgcn_exp2f(S[kg][qg][r]);
            s2 += (f32x2){S[kg][qg][0], S[kg][qg][1]}; s2 += (f32x2){S[kg][qg][2], S[kg][qg][3]};
        }
        float ps = s2[0] + s2[1];
        ps += __shfl_xor(ps, 16); ps += __shfl_xor(ps, 32);
        l[qg] += ps;
#pragma unroll
        for (int ks = 0; ks < 2; ++ks) {
            u32x4 w; w.x = cvtpk(S[2 * ks][qg][0], S[2 * ks][qg][1]); w.y = cvtpk(S[2 * ks][qg][2], S[2 * ks][qg][3]);
            w.z = cvtpk(S[2 * ks + 1][qg][0], S[2 * ks + 1][qg][1]); w.w = cvtpk(S[2 * ks + 1][qg][2], S[2 * ks + 1][qg][3]);
            pa[qg][ks] = *reinterpret_cast<bf16x8*>(&w);
        }
    }
}
struct VF { s16x4 a0, a1, b0, b1; };
template <int HI> __device__ __forceinline__ void vread(VF& f, int a) {
    f.a0 = trr<HI * 256 + 0>(a); f.a1 = trr<HI * 256 + 8192>(a); f.b0 = trr<HI * 256 + 16384>(a); f.b1 = trr<HI * 256 + 24576>(a);
}
__device__ __forceinline__ void vmma(f32x4v& o0, f32x4v& o1, const VF& f, const bf16x8 (&pa)[2][2]) {
#define PKV(L, H) (bf16x8){L[0], L[1], L[2], L[3], H[0], H[1], H[2], H[3]}
    const bf16x8 v0 = PKV(f.a0, f.a1), v1 = PKV(f.b0, f.b1);
    o0 = __builtin_amdgcn_mfma_f32_16x16x32_bf16(pa[0][0], v0, o0, 0, 0, 0);
    o1 = __builtin_amdgcn_mfma_f32_16x16x32_bf16(pa[1][0], v0, o1, 0, 0, 0);
    o0 = __builtin_amdgcn_mfma_f32_16x16x32_bf16(pa[0][1], v1, o0, 0, 0, 0);
    o1 = __builtin_amdgcn_mfma_f32_16x16x32_bf16(pa[1][1], v1, o1, 0, 0, 0);
#undef PKV
}
__device__ __forceinline__ void pv16(f32x4v (&o)[2][16], int vbuf, int lane_, const bf16x8 (&pa)[2][2]) {
    asm volatile("" : "+v"(lane_));
    const int l16 = lane_ & 15, g = lane_ >> 4, q4 = l16 >> 2, p = l16 & 3;
    const int lb = (4 * g + q4) * 512 + ((4 * (g & 1) + q4) << 5) + 8 * p;
    VF fa, fb;
#define VA(vt) (vbuf + (lb ^ (((vt) & 7) << 5)))
    vread<0>(fa, VA(0));
    vread<0>(fb, VA(1)); D5_LW(4); vmma(o[0][0], o[1][0], fa, pa);
    vread<0>(fa, VA(2)); D5_LW(4); vmma(o[0][1], o[1][1], fb, pa);
    vread<0>(fb, VA(3)); D5_LW(4); vmma(o[0][2], o[1][2], fa, pa);
    vread<0>(fa, VA(4)); D5_LW(4); vmma(o[0][3], o[1][3], fb, pa);
    vread<0>(fb, VA(5)); D5_LW(4); vmma(o[0][4], o[1][4], fa, pa);
    vread<0>(fa, VA(6)); D5_LW(4); vmma(o[0][5], o[1][5], fb, pa);
    vread<0>(fb, VA(7)); D5_LW(4); vmma(o[0][6], o[1][6], fa, pa);
    vread<1>(fa, VA(8)); D5_LW(4); vmma(o[0][7], o[1][7], fb, pa);
    vread<1>(fb, VA(9)); D5_LW(4); vmma(o[0][8], o[1][8], fa, pa);
    vread<1>(fa, VA(10)); D5_LW(4); vmma(o[0][9], o[1][9], fb, pa);
    vread<1>(fb, VA(11)); D5_LW(4); vmma(o[0][10], o[1][10], fa, pa);
    vread<1>(fa, VA(12)); D5_LW(4); vmma(o[0][11], o[1][11], fb, pa);
    vread<1>(fb, VA(13)); D5_LW(4); vmma(o[0][12], o[1][12], fa, pa);
    vread<1>(fa, VA(14)); D5_LW(4); vmma(o[0][13], o[1][13], fb, pa);
    vread<1>(fb, VA(15)); D5_LW(4); vmma(o[0][14], o[1][14], fa, pa);
    D5_LW(0); vmma(o[0][15], o[1][15], fb, pa);
#undef VA
}
__device__ __forceinline__ void epilogue(const Params& P, LAS unsigned char* lds, f32x4v (&o)[2][16], const float (&l)[2], int tz, int it) {
    const int wid = __builtin_amdgcn_readfirstlane(tz >> 6), lane = tz & 63, l16 = lane & 15, g = lane >> 4;
    float lam;
    { float a = P.lam_q1[lane] * P.lam_k1[lane] + P.lam_q1[lane + 64] * P.lam_k1[lane + 64];
      float c = P.lam_q2[lane] * P.lam_k2[lane] + P.lam_q2[lane + 64] * P.lam_k2[lane + 64];
      a = wave_sum(a); c = wave_sum(c); lam = expf(a) - expf(c) + 0.2f; }
    const int br = wid >> 2, w4 = wid & 3;
    const int b = it >> 7, h = (it >> 5) & 3, qt = it & 31;
    const size_t row0 = (size_t)b * SEQ; const int q0 = qt * 128;
    LAS float* li_l = (LAS float*)(lds + SCR_OFF) + wid * 32;
    if (g == 0) { li_l[l16] = l[0]; li_l[16 + l16] = l[1]; }
    asm volatile("s_waitcnt lgkmcnt(0)" ::: "memory");
    __syncthreads();
    LAS float* X = (LAS float*)lds + w4 * 8192;
    if (br == 1) {
#pragma unroll
        for (int qg = 0; qg < 2; ++qg)
#pragma unroll
            for (int r = 0; r < 4; ++r) { const float rl = __builtin_amdgcn_rcpf(li_l[16 * qg + 4 * g + r]);
#pragma unroll
                for (int vt = 0; vt < 16; ++vt) X[((qg * 4 + r) * 16 + vt) * 64 + lane] = o[qg][vt][r] * rl; }
    }
    __syncthreads();
    if (br == 0) {
        LAS unsigned char* T = (LAS unsigned char*)X;
        float gw[16];
#pragma unroll
        for (int vt = 0; vt < 16; ++vt) gw[vt] = P.subln_b[16 * vt + l16];
#pragma unroll
        for (int qg = 0; qg < 2; ++qg)
#pragma unroll
            for (int r = 0; r < 4; ++r) {
                const int u = qg * 4 + r;
                const float rl = __builtin_amdgcn_rcpf(li_l[16 * qg + 4 * g + r]);
                float v[16], sq = 0.f;
#pragma unroll
                for (int vt = 0; vt < 16; ++vt) { v[vt] = o[qg][vt][r] * rl - lam * X[(u * 16 + vt) * 64 + lane]; sq += v[vt] * v[vt]; }
                sq += __shfl_xor(sq, 1); sq += __shfl_xor(sq, 2); sq += __shfl_xor(sq, 4); sq += __shfl_xor(sq, 8);
                const float rstd = rsqrtf(sq * (1.0f / 256.0f) + RMS_EPS) * 0.8f;
#pragma unroll
                for (int vt = 0; vt < 16; ++vt) { const unsigned w = cvtpk(v[vt] * rstd * gw[vt], 0.f); *(LAS bf16_t*)(T + (4 * u + g) * 512 + (16 * vt + l16) * 2) = (bf16_t)(w & 0xffffu); }
            }
        asm volatile("s_waitcnt lgkmcnt(0)" ::: "memory");
        char* mixb = (char*)((bf16_t*)(P.ws + WS_MIX) + (row0 + q0 + w4 * 32) * DM + 1024 + h * 256);
#pragma unroll
        for (int i = 0; i < 16; ++i) {
            const int ti = 2 * i + (lane >> 5), u = ti >> 2, gg = ti & 3, q = 16 * (u >> 2) + 4 * gg + (u & 3);
            const u32x4 w = *(const LAS u32x4*)(T + ti * 512 + (lane & 31) * 16);
            *(u32x4*)(mixb + (size_t)q * (DM * 2) + (lane & 31) * 16) = w;
        }
    }
    __syncthreads();
}
__device__ __forceinline__ void item(const Params& P, int it, LAS unsigned char* lds) {
    int tid = threadIdx.x; asm volatile("" : "+v"(tid));
    const int wid = __builtin_amdgcn_readfirstlane(tid >> 6), lane = tid & 63, l16 = lane & 15, g = lane >> 4;
    const int br = wid >> 2, w4 = wid & 3;
    const int b = it >> 7, h = (it >> 5) & 3, qt = it & 31;
    const bf16_t* proj = (const bf16_t*)(P.ws + WS_PROJ);
    const size_t row0 = (size_t)b * SEQ; const int q0 = qt * 128;
    bf16x8 qr[4][2];
    { const bf16_t* Qw = proj + (row0 + q0 + w4 * 32 + l16) * INC + 3072 + br * 512 + h * 128 + 8 * g;
#pragma unroll
      for (int s = 0; s < 4; ++s)
#pragma unroll
          for (int qg = 0; qg < 2; ++qg) qr[s][qg] = *(const bf16x8*)(Qw + (size_t)(16 * qg) * INC + 32 * s); }
    const char* kbase = (const char*)(proj + row0 * INC + 4096 + br * 512 + h * 128);
    const char* vbase = (const char*)(proj + row0 * INC + 5120 + h * 256);
#define D5_LANE() int lz_ = lane; asm volatile("" : "+v"(lz_))
#define D5_ISSUE_K(t, bufi) do { D5_LANE(); const int krow_ = w4 * 16 + (lz_ >> 4); \
        const unsigned voffK0 = (unsigned)(krow_ * INC * 2 + (((lz_ & 15) ^ (lz_ >> 4)) << 4)); \
        const unsigned voffK1 = (unsigned)((krow_ + 4) * INC * 2 + (((lz_ & 15) ^ (4 + (lz_ >> 4))) << 4)); \
        const char* kb_ = kbase + (size_t)(t) * (64 * INC * 2); LAS unsigned char* lb_ = lds + (bufi) * BUFB + br * KB + w4 * 4096; \
        __builtin_amdgcn_global_load_lds((const unsigned*)(kb_ + voffK0), (LAS unsigned*)(lb_), 16, 0, 0); \
        __builtin_amdgcn_global_load_lds((const unsigned*)(kb_ + voffK1), (LAS unsigned*)(lb_ + 1024), 16, 0, 0); \
        __builtin_amdgcn_global_load_lds((const unsigned*)(kb_ + 8 * INC * 2 + voffK0), (LAS unsigned*)(lb_ + 2048), 16, 0, 0); \
        __builtin_amdgcn_global_load_lds((const unsigned*)(kb_ + 8 * INC * 2 + voffK1), (LAS unsigned*)(lb_ + 3072), 16, 0, 0); } while (0)
#define D5_ISSUE_V(t, bufi) do { D5_LANE(); const char* vb_ = vbase + (size_t)(t) * (64 * INC * 2) + (size_t)(wid * 8) * (INC * 2); LAS unsigned char* lb_ = lds + (bufi) * BUFB + 2 * KB + wid * 4096; \
        _Pragma("unroll") for (int i_ = 0; i_ < 4; ++i_) { const int rr_ = 2 * i_ + (lz_ >> 5); \
            const unsigned vo_ = (unsigned)(rr_ * INC * 2 + (((lz_ & 31) ^ (rr_ << 1)) << 4)); \
            __builtin_amdgcn_global_load_lds((const unsigned*)(vb_ + vo_), (LAS unsigned*)(lb_ + i_ * 1024), 16, 0, 0); } } while (0)
#define D5_BAR() do { asm volatile("" ::: "memory"); __builtin_amdgcn_s_barrier(); asm volatile("" ::: "memory"); } while (0)
    const float slope2 = __int_as_float(__builtin_amdgcn_readfirstlane(__float_as_int(exp2f(-2.0f * (float)(h + 1)) * LOG2E)));
    const int qlo = q0 + w4 * 32, jd = qlo >> 6;
    int jlo = 0, jhi = SEQ / 64 - 1;
    { float gq = fmaxf(fabsf(P.qn_b[lane]), fabsf(P.qn_b[lane + 64])), gk = fmaxf(fabsf(P.kn_b[lane]), fabsf(P.kn_b[lane + 64]));
#pragma unroll
      for (int o_ = 32; o_ >= 1; o_ >>= 1) { gq = fmaxf(gq, __shfl_xor(gq, o_)); gk = fmaxf(gk, __shfl_xor(gk, o_)); }
      const float smax = 128.0f * QSCALE * gq * gk, dmax = (160.0f + smax) / slope2;
      const int di = dmax < 8192.0f ? (int)dmax + 1 : 8192;
      const int klo = q0 - di, khi = q0 + 127 + di;
      jlo = __builtin_amdgcn_readfirstlane(klo <= 0 ? 0 : (klo >> 6)); jhi = __builtin_amdgcn_readfirstlane(khi >= SEQ - 1 ? SEQ / 64 - 1 : (khi >> 6)); }
    float dqb = (float)(qlo + l16 - 4 * g - 64 * jlo);
    f32x4v o[2][16];
#pragma unroll
    for (int qg = 0; qg < 2; ++qg)
#pragma unroll
        for (int vt = 0; vt < 16; ++vt) o[qg][vt] = (f32x4v){0.f, 0.f, 0.f, 0.f};
    float l[2] = {0.f, 0.f};
    const int vbuf0 = (int)(uintptr_t)(lds + 2 * KB);
    bf16x8 pa[2][2];
    D5_ISSUE_K(jlo, 0); D5_ISSUE_V(jlo, 0);
    if (br == 0) {
        asm volatile("s_waitcnt vmcnt(4)" ::: "memory");
#pragma unroll 1
        for (int j = jlo; j <= jhi; ++j) {
            const int jn = (j + 1 <= jhi) ? j + 1 : jhi, bc = (j - jlo) & 1, bn = bc ^ 1;
            D5_BAR();
            D5_ISSUE_K(jn, bn);
            qk_softmax(lds + bc * BUFB, qr, lane, dqb, slope2, j - jd, l, pa);
            asm volatile("s_waitcnt vmcnt(4)" ::: "memory");
            D5_BAR();
            D5_ISSUE_V(jn, bn);
            pv16(o, vbuf0 + bc * BUFB, lane, pa);
            asm volatile("s_waitcnt vmcnt(4)" ::: "memory");
            dqb -= 64.0f;
        }
        D5_BAR();
    } else {
        D5_BAR();
        asm volatile("s_waitcnt vmcnt(0)" ::: "memory");
#pragma unroll 1
        for (int j = jlo; j <= jhi; ++j) {
            const int jn = (j + 1 <= jhi) ? j + 1 : jhi, bc = (j - jlo) & 1, bn = bc ^ 1;
            D5_BAR();
            D5_ISSUE_K(jn, bn); D5_ISSUE_V(jn, bn);
            qk_softmax(lds + bc * BUFB + KB, qr, lane, dqb, slope2, j - jd, l, pa);
            D5_BAR();
            pv16(o, vbuf0 + bc * BUFB, lane, pa);
            asm volatile("s_waitcnt vmcnt(0)" ::: "memory");
            dqb -= 64.0f;
        }
    }
#undef D5_ISSUE_K
#undef D5_ISSUE_V
#undef D5_BAR
#undef D5_LANE
    asm volatile("s_waitcnt vmcnt(0)" ::: "memory");
    int tz = threadIdx.x; asm volatile("" : "+v"(tz));
    epilogue(P, lds, o, l, tz, it);
}
#undef D5_LW
}

namespace na2 {
__device__ __forceinline__ void item(const Params& P, int it, LAS unsigned char* lds) {
    int tid = threadIdx.x; asm volatile("" : "+v"(tid));
    const int wid = __builtin_amdgcn_readfirstlane(tid >> 6), lane = tid & 63, r32 = lane & 31, hi = lane >> 5;
    const int b = it >> 7, h = (it >> 4) & 7, r0 = (it & 15) * 4;
    const int r = r0 + (wid >> 1), cq0 = (wid & 1) * 32;
    const bf16_t* proj = (const bf16_t*)(P.ws + WS_PROJ);
    LAS float* tab = (LAS float*)(lds + SCR_OFF);
    LAS float* li_l = (LAS float*)(lds + SCR_OFF + 2048) + wid * 32;
    for (int i = tid; i < 15 * 31; i += NTHR) tab[(i / 31) * 32 + (i % 31)] = P.rpb_a[h * 465 + i] * LOG2E;
    bf16x8 qr[8];
    { const bf16_t* Qw = proj + ((size_t)b * SEQ + r * 64 + cq0 + r32) * INC + h * 128 + hi * 8;
#pragma unroll
      for (int d0 = 0; d0 < 8; ++d0) qr[d0] = *(const bf16x8*)(Qw + d0 * 16); }
    int kr_lo = r0 - 4; kr_lo = kr_lo < 0 ? 0 : (kr_lo > 56 ? 56 : kr_lo);
    int kr_hi = r0 - 1; kr_hi = (kr_hi < 0 ? 0 : (kr_hi > 56 ? 56 : kr_hi)) + 7;
    int rs = r - 4; rs = rs < 0 ? 0 : (rs > 56 ? 56 : rs);
    const int cq = cq0 + r32; int cs = cq - 8; cs = cs < 0 ? 0 : (cs > 48 ? 48 : cs);
    const char* kbase = (const char*)(proj + (size_t)b * SEQ * INC + 1024 + h * 128);
    const char* vbase = (const char*)(proj + (size_t)b * SEQ * INC + 2048 + h * 128);
    const int krow = wid * 8 + (lane >> 4);
    const unsigned voffK0 = (unsigned)(krow * INC * 2 + (((lane & 15) ^ (lane >> 4)) << 4));
    const unsigned voffK1 = (unsigned)((krow + 4) * INC * 2 + (((lane & 15) ^ (4 + (lane >> 4))) << 4));
    const unsigned voffV = (unsigned)(da2::unswap23(wid * 8 + ((lane & 31) >> 2)) * INC * 2 + (lane >> 5) * 64 + (lane & 3) * 16);
#define NA2_ISSUE(kr, bufi) do { const char* kb_ = kbase + (size_t)(kr) * (64 * INC * 2); const char* vb_ = vbase + (size_t)(kr) * (64 * INC * 2); \
        LAS unsigned char* lb_ = lds + (bufi) * 32768; \
        __builtin_amdgcn_global_load_lds((const unsigned*)(kb_ + voffK0), (LAS unsigned*)(lb_ + wid * 2048), 16, 0, 0); \
        __builtin_amdgcn_global_load_lds((const unsigned*)(kb_ + voffK1), (LAS unsigned*)(lb_ + wid * 2048 + 1024), 16, 0, 0); \
        __builtin_amdgcn_global_load_lds((const unsigned*)(vb_ + voffV), (LAS unsigned*)(lb_ + 16384 + wid * 2048), 16, 0, 0); \
        __builtin_amdgcn_global_load_lds((const unsigned*)(vb_ + 128 + voffV), (LAS unsigned*)(lb_ + 16384 + wid * 2048 + 1024), 16, 0, 0); } while (0)
    f32x16 o[4];
#pragma unroll
    for (int d = 0; d < 4; ++d) o[d] = f32x16{};
    float l_reg = 0.f;
    const int vb0 = (int)(uintptr_t)(lds + 16384) + da2::v_rd_base(lane);
    NA2_ISSUE(kr_lo, 0);
#pragma unroll 1
    for (int kr = kr_lo; kr <= kr_hi; ++kr) {
        const int bi = (kr - kr_lo) & 1;
        asm volatile("s_waitcnt vmcnt(0) lgkmcnt(0)" ::: "memory");
        __builtin_amdgcn_s_barrier();
        asm volatile("" ::: "memory");
        if (kr < kr_hi) NA2_ISSUE(kr + 1, bi ^ 1);
        if (kr >= rs && kr < rs + 8) {
            f32x16 p0, p1;
            da2::qkt(p0, p1, lds + bi * 32768, qr, r32, hi);
            const LAS float* trow = tab + (kr - r + 7) * 32;
            float ps = 0.f;
#pragma unroll
            for (int rr = 0; rr < 16; ++rr) {
                const int ck = crow(rr, hi);
                { const int rel = ck - cq + 15; const bool valid = (ck >= cs) && (ck < cs + 16); const int idx = rel < 0 ? 0 : (rel > 30 ? 30 : rel);
                  const float v = valid ? __builtin_amdgcn_exp2f(p0[rr] + trow[idx]) : 0.f; p0[rr] = v; ps += v; }
                { const int ck1 = ck + 32; const int rel = ck1 - cq + 15; const bool valid = (ck1 >= cs) && (ck1 < cs + 16); const int idx = rel < 0 ? 0 : (rel > 30 ? 30 : rel);
                  const float v = valid ? __builtin_amdgcn_exp2f(p1[rr] + trow[idx]) : 0.f; p1[rr] = v; ps += v; }
            }
            l_reg += swap_add(ps);
            bf16x8 pa0, pa1, pa2, pa3;
            PK4(p0, 0, pa0); PK4(p0, 8, pa1); PK4(p1, 0, pa2); PK4(p1, 8, pa3);
            const int vb = vb0 + bi * 32768;
            da2::pv_one<4, 0>(o[0], vb, pa0, pa1, pa2, pa3); da2::pv_one<4, 1>(o[1], vb, pa0, pa1, pa2, pa3);
            da2::pv_one<4, 2>(o[2], vb, pa0, pa1, pa2, pa3); da2::pv_one<4, 3>(o[3], vb, pa0, pa1, pa2, pa3);
        }
    }
#undef NA2_ISSUE
    if (hi == 0) li_l[r32] = l_reg;
    asm volatile("s_waitcnt lgkmcnt(0)" ::: "memory");
    __syncthreads();
    LAS unsigned char* T = lds + wid * 8192;
    float* nassq = (float*)(P.ws + WS_NASSQ);
    const size_t t0 = (size_t)b * SEQ + r * 64 + cq0;
#pragma unroll
    for (int rr = 0; rr < 16; ++rr) {
        const float rl = __builtin_amdgcn_rcpf(li_l[crow(rr, hi)]);
        float sq = 0.f;
#pragma unroll
        for (int d = 0; d < 4; ++d) {
            const unsigned w = cvtpk(o[d][rr] * rl, 0.f); const float vq = __uint_as_float(w << 16);
            sq += vq * vq;
            *(LAS bf16_t*)(T + (2 * rr + hi) * 256 + (d * 32 + r32) * 2) = (bf16_t)(w & 0xffffu);
        }
#pragma unroll
        for (int sh = 16; sh >= 1; sh >>= 1) sq += __shfl_xor(sq, sh);
        if (r32 == 0) nassq[(t0 + crow(rr, hi)) * 8 + h] = sq;
    }
    asm volatile("s_waitcnt lgkmcnt(0)" ::: "memory");
    char* mixb = (char*)((bf16_t*)(P.ws + WS_MIX) + t0 * DM + h * 128);
#pragma unroll
    for (int i = 0; i < 8; ++i) {
        const int tr = i * 4 + (lane >> 4), rr2 = tr >> 1, h2 = tr & 1;
        const u32x4 w = *(const LAS u32x4*)(T + tr * 256 + (lane & 15) * 16);
        *(u32x4*)(mixb + (size_t)crow(rr2, h2) * (DM * 2) + (lane & 15) * 16) = w;
    }
    __syncthreads();
}
}

__device__ __forceinline__ void da_combine(const Params& P) {
    int tid = threadIdx.x; asm volatile("" : "+v"(tid)); const int wid = tid >> 6, lane = tid & 63;
    float a = P.lam_q1[lane] * P.lam_k1[lane] + P.lam_q1[lane + 64] * P.lam_k1[lane + 64];
    float c = P.lam_q2[lane] * P.lam_k2[lane] + P.lam_q2[lane + 64] * P.lam_k2[lane + 64];
    a = wave_sum(a); c = wave_sum(c);
    const float lam = expf(a) - expf(c) + 0.2f;
    const float* op = (const float*)(P.ws + WS_OPART);
    bf16_t* mix = (bf16_t*)(P.ws + WS_MIX);
    const f32x4 g = ((const f32x4*)P.subln_b)[lane];
    for (int it = blockIdx.x * 8 + wid; it < MTOK * 4; it += gridDim.x * 8) {
        const int tok = it >> 2, h = it & 3;
        const float* p = op + (size_t)tok * DM + h * 512;
        const f32x4 o1 = ((const f32x4*)p)[lane], o2 = ((const f32x4*)(p + 256))[lane];
        const f32x4 v = o1 - lam * o2;
        float ss = (v[0] * v[0] + v[1] * v[1]) + (v[2] * v[2] + v[3] * v[3]);
        ss = wave_sum(ss);
        const float rstd = rsqrtf(ss * (1.0f / 256.0f) + RMS_EPS) * 0.8f;
        u32x2 w; w.x = cvtpk(v[0] * rstd * g[0], v[1] * rstd * g[1]); w.y = cvtpk(v[2] * rstd * g[2], v[3] * rstd * g[3]);
        *(u32x2*)(mix + (size_t)tok * DM + 1024 + h * 256 + lane * 4) = w;
    }
}

__device__ __forceinline__ f32x4 ldx1(const bf16_t* p) { const u32x2 w = *(const u32x2*)p; return (f32x4){__uint_as_float(w.x << 16), __uint_as_float(w.x & 0xffff0000u), __uint_as_float(w.y << 16), __uint_as_float(w.y & 0xffff0000u)}; }
__device__ __forceinline__ void router_phase(const Params& P, LAS unsigned char* lds) {
    int tid = threadIdx.x; asm volatile("" : "+v"(tid)); const int wid = tid >> 6, lane = tid & 63;
    { const f32x4* src = (const f32x4*)(P.ws + WS_WRT);
#pragma unroll
      for (int i = 0; i < 16; ++i) *(LAS f32x4*)(lds + (size_t)(i * NTHR + tid) * 16) = src[i * NTHR + tid];
      __syncthreads(); }
    const LAS float* wl = (const LAS float*)lds;
    const bf16_t* x1b = (const bf16_t*)(P.ws + WS_OPART);
    const float* rowss = (const float*)(P.ws + WS_ROWSS);
    unsigned char* H2 = (unsigned char*)(P.ws + WS_H2);
    float* aff = (float*)(P.ws + WS_AFF);
    LAS float* red = (LAS float*)(lds + 131072) + wid * 64;
    for (int g4 = blockIdx.x * 8 + wid; g4 < MTOK / 4; g4 += gridDim.x * 8) {
        const int row0 = g4 * 4;
        f32x4 xa[4], xb[4];
#pragma unroll
        for (int t = 0; t < 4; ++t) { xa[t] = ldx1(x1b + (size_t)(row0 + t) * DM + (0 * 64 + lane) * 4); xb[t] = ldx1(x1b + (size_t)(row0 + t) * DM + (1 * 64 + lane) * 4); }
        float rstd[4];
#pragma unroll
        for (int t = 0; t < 4; ++t) { float s = (lane < 32) ? rowss[(size_t)(row0 + t) * 32 + lane] : 0.f; s = wave_sum(s); rstd[t] = rsqrtf(s * (1.0f / DM) + RMS_EPS); }
        float acc[64];
#pragma unroll
        for (int k = 0; k < 64; ++k) acc[k] = 0.f;
#pragma unroll
        for (int i = 0; i < 8; ++i) {
            const int c0 = (i * 64 + lane) * 4;
            const f32x4 g = *(const f32x4*)(P.ln2_g + c0);
            f32x4 hv[4];
#pragma unroll
            for (int t = 0; t < 4; ++t) {
                const f32x4 xc = (i & 1) ? xb[t] : xa[t];
                if (i + 2 < 8) { const f32x4 nx = ldx1(x1b + (size_t)(row0 + t) * DM + ((i + 2) * 64 + lane) * 4); if (i & 1) xb[t] = nx; else xa[t] = nx; }
                hv[t] = xc * rstd[t] * g;
                *(unsigned*)(H2 + (size_t)(row0 + t) * DM + c0) = cvt4_fp8(hv[t][0] * HSC8, hv[t][1] * HSC8, hv[t][2] * HSC8, hv[t][3] * HSC8);
            }
#pragma unroll
            for (int e = 0; e < 16; ++e) {
                const f32x4 w = *(const LAS f32x4*)(wl + e * DM + c0);
#pragma unroll
                for (int t = 0; t < 4; ++t) acc[t * 16 + e] += (hv[t][0] * w[0] + hv[t][1] * w[1]) + (hv[t][2] * w[2] + hv[t][3] * w[3]);
            }
        }
#pragma unroll
        for (int step = 0; step < 6; ++step) {
            const int m = 32 >> step, half = 32 >> step;
            const bool up = (lane & m) != 0;
#pragma unroll
            for (int k = 0; k < half; ++k) {
                const float keep = up ? acc[k + half] : acc[k], send = up ? acc[k] : acc[k + half];
                acc[k] = keep + __shfl_xor(send, m);
            }
        }
        red[lane] = acc[0];
        asm volatile("s_waitcnt lgkmcnt(0)" ::: "memory");
        if (lane < 4) {
            const int t = lane; float lg[16], mx = -1e30f;
#pragma unroll
            for (int e = 0; e < 16; ++e) { lg[e] = red[t * 16 + e]; mx = fmaxf(mx, lg[e]); }
            float sum = 0.f;
#pragma unroll
            for (int e = 0; e < 16; ++e) { lg[e] = expf(lg[e] - mx); sum += lg[e]; }
            const float inv = 1.0f / sum;
            const int row = row0 + t, bb = row >> 12, sq = row & 4095;
#pragma unroll
            for (int e = 0; e < 16; ++e) aff[((size_t)bb * 16 + e) * SEQ + sq] = lg[e] * inv;
        }
    }
}

__device__ __forceinline__ void topk_phase(const Params& P, LAS unsigned char* lds) {
    int tid = threadIdx.x; asm volatile("" : "+v"(tid)); const int wid = tid >> 6, lane = tid & 63;
    const float* aff = (const float*)(P.ws + WS_AFF);
    int* selidx = (int*)(P.ws + WS_SELIDX); float* selgate = (float*)(P.ws + WS_SELGATE); int* slot = (int*)(P.ws + WS_SLOT);
    LAS unsigned* red = (LAS unsigned*)lds;
    for (int it = blockIdx.x; it < NB * NEXP; it += gridDim.x) {
        const int b = it >> 4, e = it & 15;
        const float* ap = aff + (size_t)it * SEQ + tid * 8;
        const f32x4 a0 = *(const f32x4*)ap, a1 = *(const f32x4*)(ap + 4);
        unsigned v[8];
#pragma unroll
        for (int j = 0; j < 4; ++j) { v[j] = __float_as_uint(a0[j]); v[4 + j] = __float_as_uint(a1[j]); }
        LAS unsigned* hist = red + 64;
        unsigned T = 0u, pmask = 0u, needk = (unsigned)CAP;
#pragma unroll 1
        for (int pass = 0; pass < 4; ++pass) {
            const int shift = 24 - 8 * pass;
            if (tid < 256) hist[tid] = 0u;
            __syncthreads();
#pragma unroll
            for (int j = 0; j < 8; ++j) if ((v[j] & pmask) == T) atomicAdd((unsigned*)(hist + ((v[j] >> shift) & 255u)), 1u);
            __syncthreads();
            unsigned hv = 0, incl = 0;
            if (tid < 256) { hv = hist[255 - tid]; incl = hv;
#pragma unroll
                for (int o = 1; o < 64; o <<= 1) { const unsigned up = __shfl_up(incl, o); if (lane >= o) incl += up; }
                if (lane == 63) hist[260 + wid] = incl; }
            __syncthreads();
            if (tid < 256) {
                for (int w = 0; w < wid; ++w) incl += hist[260 + w];
                const unsigned sfx = incl - hv;
                if (sfx < needk && incl >= needk) { hist[256] = (unsigned)(255 - tid); hist[257] = needk - sfx; }
            }
            __syncthreads();
            T |= hist[256] << shift; pmask |= 255u << shift; needk = hist[257];
            __syncthreads();
        }
        unsigned g[8], q[8], gsum = 0, qsum = 0;
#pragma unroll
        for (int j = 0; j < 8; ++j) { g[j] = v[j] > T ? 1u : 0u; q[j] = v[j] == T ? 1u : 0u; gsum += g[j]; qsum += q[j]; }
        unsigned gi = gsum, qi = qsum;
#pragma unroll
        for (int o = 1; o < 64; o <<= 1) { const unsigned tg = __shfl_up(gi, o), tq = __shfl_up(qi, o); if (lane >= o) { gi += tg; qi += tq; } }
        LAS unsigned* sc = red + 32;
        __syncthreads();
        if (lane == 63) { sc[wid] = gi; sc[8 + wid] = qi; }
        __syncthreads();
        unsigned gbase = 0, qbase = 0, gtot = 0;
#pragma unroll
        for (int w = 0; w < 8; ++w) { const unsigned a = sc[w], c2 = sc[8 + w]; if (w < wid) { gbase += a; qbase += c2; } gtot += a; }
        unsigned G = gbase + gi - gsum, Q = qbase + qi - qsum;
        const unsigned need = (unsigned)CAP - gtot;
#pragma unroll
        for (int j = 0; j < 8; ++j) {
            const int tok = tid * 8 + j;
            const bool sel = g[j] || (q[j] && Q < need);
            const unsigned sl = G + (Q < need ? Q : need);
            if (sel) { selidx[e * EROWS + b * CAP + sl] = b * SEQ + tok; selgate[e * EROWS + b * CAP + sl] = __uint_as_float(v[j]); }
            slot[(size_t)it * SEQ + tok] = sel ? (int)sl : -1;
            G += g[j]; Q += q[j];
        }
        __syncthreads();
    }
}

__device__ __forceinline__ void combine_phase(const Params& P, const float ysc) {
    int tid = threadIdx.x; asm volatile("" : "+v"(tid)); const int wid = tid >> 6, lane = tid & 63;
    const int* slot = (const int*)(P.ws + WS_SLOT);
    const bf16_t* Y = (const bf16_t*)(P.ws + WS_Y);
    for (int row = blockIdx.x * 8 + wid; row < MTOK; row += gridDim.x * 8) {
        const int b = row >> 12, s = row & 4095;
        const int sl = (lane < 16) ? slot[((size_t)b * 16 + lane) * SEQ + s] : -1;
        unsigned long long mask = __ballot(sl >= 0);
        float* op = P.out + (size_t)row * DM;
        const bf16_t* xp = (const bf16_t*)(P.ws + WS_OPART) + (size_t)row * DM;
        f32x4 a[8];
#pragma unroll
        for (int i = 0; i < 4; ++i) { const u32x4 w = *(const u32x4*)(xp + i * 512 + lane * 8);
            a[2 * i] = (f32x4){__uint_as_float(w.x << 16), __uint_as_float(w.x & 0xffff0000u), __uint_as_float(w.y << 16), __uint_as_float(w.y & 0xffff0000u)};
            a[2 * i + 1] = (f32x4){__uint_as_float(w.z << 16), __uint_as_float(w.z & 0xffff0000u), __uint_as_float(w.w << 16), __uint_as_float(w.w & 0xffff0000u)}; }
        while (mask) {
            const int e = __builtin_ctzll(mask); mask &= mask - 1;
            const int se = __shfl(sl, e);
            const bf16_t* yp = Y + ((size_t)e * EROWS + b * CAP + se) * DM + lane * 8;
#pragma unroll
            for (int i = 0; i < 4; ++i) {
                const u32x4 w = *(const u32x4*)(yp + i * 512);
                a[2 * i][0] += ysc * __uint_as_float(w.x << 16); a[2 * i][1] += ysc * __uint_as_float(w.x & 0xffff0000u);
                a[2 * i][2] += ysc * __uint_as_float(w.y << 16); a[2 * i][3] += ysc * __uint_as_float(w.y & 0xffff0000u);
                a[2 * i + 1][0] += ysc * __uint_as_float(w.z << 16); a[2 * i + 1][1] += ysc * __uint_as_float(w.z & 0xffff0000u);
                a[2 * i + 1][2] += ysc * __uint_as_float(w.w << 16); a[2 * i + 1][3] += ysc * __uint_as_float(w.w & 0xffff0000u);
            }
        }
#pragma unroll
        for (int i = 0; i < 4; ++i) { *(f32x4*)(op + i * 512 + lane * 8) = a[2 * i]; *(f32x4*)(op + i * 512 + lane * 8 + 4) = a[2 * i + 1]; }
    }
}

#ifndef P1_COMPUTE_WGS
#define P1_COMPUTE_WGS 160
#endif
#ifndef P7_PER_XCD
#define P7_PER_XCD 30
#endif
constexpr int N_PHASES = 10;
__global__ void __launch_bounds__(NTHR, 2) fwd_kernel(Params P) {
    extern __shared__ __attribute__((aligned(16))) unsigned char lds_raw[];
    LAS unsigned char* lds = (LAS unsigned char*)lds_raw;
    const int tid = threadIdx.x;
    volatile LAS unsigned* MISC = (volatile LAS unsigned*)(lds + MISC_OFF);
    if (tid < 16) MISC[tid] = 0u;
    __syncthreads();
    XcdBarrier bar; bar.bar = (unsigned*)(P.ws + WS_CTL); bar.x = 0; bar.st = nullptr;
#if MK_N_LAUNCHES == 1
    bar = xcd_barrier_post((unsigned*)(P.ws + WS_CTL), MISC);
#define GRID_BAR() xcd_barrier(bar)
#else
#define GRID_BAR() do { } while (0)
#endif
    const int lo = P.ph_lo, hi = P.ph_hi;
#ifndef PH_MASK
#define PH_MASK 0x3ff
#endif
#define IN(k) (((PH_MASK >> (k)) & 1) && lo <= (k) && (k) < hi)
#define BOTH(k) (IN(k) && IN((k) + 1))

#ifndef PROBE_DUP
#define PROBE_DUP -1
#endif
#define DUP(k) for (int rep_ = 0; rep_ < ((PROBE_DUP) == (k) ? 2 : 1); ++rep_)
    if (IN(0)) { DUP(0) { p0_prologue(P, lds); __syncthreads(); } if (BOTH(0)) GRID_BAR(); }

    if (IN(1)) {
        { LAS float* gl = (LAS float*)(lds + SCR_OFF + 8192);
          if (tid < 128) { gl[tid] = P.qn_a[tid]; gl[128 + tid] = P.kn_a[tid]; gl[256 + tid] = P.qn_b[tid]; gl[384 + tid] = P.kn_b[tid]; }
          __syncthreads(); }
        DUP(1) {
        pg8::OrderMN S; S.init(P.ws + WS_H, P.ws + WS_WIN, MTOK, INC, DM, P1_COMPUTE_WGS, blockIdx.x);
        EpiInProj E{(bf16_t*)(P.ws + WS_PROJ)};
        pg8::gemm_phase<false, false, false>(lds, DM, S, E, nullptr);
        }
        cvt_queue<2>(P, lds, (unsigned*)(P.ws + WS_CTL) + CW_QG); cvt_queue<3>(P, lds, (unsigned*)(P.ws + WS_CTL) + CW_QU);
        if (BOTH(1)) GRID_BAR();
    }

    if (IN(2)) {
        const bf16_t* proj = (const bf16_t*)(P.ws + WS_PROJ);
        float* opart = (float*)(P.ws + WS_OPART);
        const int da_it = (blockIdx.x & 7) * 32 + (blockIdx.x >> 3);
        DUP(2) {
        if (blockIdx.x < 256) da5::item(P, da_it, lds);
        }
        DUP(12) {
        if (blockIdx.x < 256 && ((da_it >> 5) & 3) == 0) {
            const int r64 = (da_it >> 7) * 32 + (da_it & 31);
#pragma unroll 1
            for (int k = 0; k < 4; ++k) na2::item(P, r64 * 4 + k, lds);
        }
        }
        if (BOTH(2)) GRID_BAR();
    }


    if (IN(4)) {
        DUP(4) {
        pg8::OrderMN S; S.init(P.ws + WS_MIX, P.ws + WS_WOUT, MTOK, DM, DM, gridDim.x, blockIdx.x);
        LAS float* ht = (LAS float*)(lds + SCR_OFF);
        { pg8::Unit u; if (S.next(0, u) && tid < 256) { const float* q = (const float*)(P.ws + WS_NASSQ) + (size_t)(u.pm * 256 + tid) * 8;
            const f32x4 a = *(const f32x4*)q, c = *(const f32x4*)(q + 4);
            ht[tid] = rsqrtf(((a[0] + a[1]) + (a[2] + a[3]) + (c[0] + c[1]) + (c[2] + c[3])) * (1.0f / 1024.0f) + RMS_EPS); } }
        __syncthreads();
        EpiOutProj E{P.x, (bf16_t*)(P.ws + WS_OPART), (float*)(P.ws + WS_ROWSS)};
        pg8::gemm_phase<false, true, false>(lds, DM, S, E, (const LAS unsigned*)ht);
        }
        if (BOTH(4)) GRID_BAR();
    }

    if (IN(5)) { DUP(5) { router_phase(P, lds); __syncthreads(); } if (BOTH(5)) GRID_BAR(); }

    if (IN(6)) { DUP(6) { topk_phase(P, lds); } if (BOTH(6)) GRID_BAR(); }

    if (IN(7)) {
        pg8::OrderExpert S; S.init(P.ws + WS_H2, P.ws + WS_WGU, 2 * FF, DM / 2, 0, (size_t)2 * FF * DM, true, gridDim.x, blockIdx.x, P7_PER_XCD);
        LAS unsigned* gtab = (LAS unsigned*)(lds + SCR_OFF);
        const int* selidx = (const int*)(P.ws + WS_SELIDX);
        { pg8::Unit u; for (int i = 0; i < 12 && S.next(i, u); ++i) { if (tid < 256) gtab[i * 256 + tid] = (unsigned)selidx[u.e * EROWS + u.pm * 256 + tid] * (unsigned)DM; } }
        __syncthreads();
        DUP(7) {
        EpiGateUp E{(unsigned char*)(P.ws + WS_ACT)};
        pg8::gemm_phase<true, false, true>(lds, DM / 2, S, E, gtab);
        }
        cvt_queue<4>(P, lds, (unsigned*)(P.ws + WS_CTL) + CW_QD);
        if (BOTH(7)) GRID_BAR();
    }

    if (IN(8)) {
        DUP(8) {
        pg8::OrderExpert S; S.init(P.ws + WS_ACT, P.ws + WS_WD, DM, FF / 2, (size_t)EROWS * FF, (size_t)DM * FF, false, gridDim.x, blockIdx.x, 32);
        EpiDown E{(bf16_t*)(P.ws + WS_Y), (const float*)(P.ws + WS_SELGATE)};
        pg8::gemm_phase<false, false, true>(lds, FF / 2, S, E, nullptr);
        }
        if (BOTH(8)) GRID_BAR();
    }

    if (IN(9)) { if (PROBE_DUP == 9) { combine_phase(P, 0.5f); __syncthreads(); combine_phase(P, 0.5f); } else combine_phase(P, 1.0f); }
#undef IN
#undef BOTH
}

extern "C" void kernel_launch(void* const* d_in, const int* in_sizes, int n_in, void* d_out, int out_size, void* d_ws, size_t ws_size, hipStream_t stream) {
    static int grid = 0;
    if (grid == 0) {
        if (n_in != 20 || out_size != MTOK * DM || ws_size < WS_END) { fprintf(stderr, "kernel_launch: unexpected shapes (n_in %d out %d ws %zu need %zu)\n", n_in, out_size, ws_size, (size_t)WS_END); grid = -1; return; }
        int dev = 0, cus = 0, per_cu = 0;
        if (hipGetDevice(&dev) != hipSuccess || hipDeviceGetAttribute(&cus, hipDeviceAttributeMultiprocessorCount, dev) != hipSuccess) { grid = -1; return; }
        if (hipFuncSetAttribute((const void*)fwd_kernel, hipFuncAttributeMaxDynamicSharedMemorySize, LDS_BYTES) != hipSuccess) { fprintf(stderr, "kernel_launch: hipFuncSetAttribute failed\n"); grid = -1; return; }
        if (hipOccupancyMaxActiveBlocksPerMultiprocessor(&per_cu, (const void*)fwd_kernel, NTHR, LDS_BYTES) != hipSuccess || per_cu < 1) fprintf(stderr, "kernel_launch: occupancy query reports %d\n", per_cu);
        (void)hipGetLastError();
        if (cus != 256) { fprintf(stderr, "kernel_launch: built for a 256-CU device, found %d\n", cus); grid = -1; return; }
        grid = cus;
    }
    if (grid < 0) return;
    hipMemsetAsync((char*)d_ws + WS_CTL, 0, CTL_BYTES, stream);
    Params p{};
    p.x = (const float*)d_in[0]; p.ln1_g = (const float*)d_in[1]; p.w_in = (const float*)d_in[2]; p.qn_a = (const float*)d_in[3]; p.kn_a = (const float*)d_in[4];
    p.rpb_a = (const float*)d_in[5]; p.on_a = (const float*)d_in[6]; p.qn_b = (const float*)d_in[7]; p.kn_b = (const float*)d_in[8];
    p.lam_q1 = (const float*)d_in[9]; p.lam_k1 = (const float*)d_in[10]; p.lam_q2 = (const float*)d_in[11]; p.lam_k2 = (const float*)d_in[12]; p.subln_b = (const float*)d_in[13];
    p.w_out = (const float*)d_in[14]; p.ln2_g = (const float*)d_in[15]; p.w_router = (const float*)d_in[16]; p.w_gate = (const float*)d_in[17]; p.w_up = (const float*)d_in[18]; p.w_down = (const float*)d_in[19];
    p.out = (float*)d_out; p.ws = (unsigned char*)d_ws;
#if MK_N_LAUNCHES == 1
    p.ph_lo = 0; p.ph_hi = N_PHASES;
    hipLaunchKernelGGL(fwd_kernel, dim3(grid), dim3(NTHR), LDS_BYTES, stream, p);
#else
#ifndef PROBE_LDUP
#define PROBE_LDUP -1
#endif
    for (int ph = 0; ph < N_PHASES; ++ph) { p.ph_lo = ph; p.ph_hi = ph + 1;
        for (int rep = 0; rep < ((ph == PROBE_LDUP && ph != 9) ? 2 : 1); ++rep) hipLaunchKernelGGL(fwd_kernel, dim3(grid), dim3(NTHR), LDS_BYTES, stream, p); }
#endif
    const hipError_t le = hipPeekAtLastError();
    if (le != hipSuccess) fprintf(stderr, "kernel_launch: launch failed: %s\n", hipGetErrorName(le));
}
```

```cpp
#include <hip/hip_runtime.h>
#include <stdint.h>
#include <stdio.h>

#ifndef MK_N_LAUNCHES
#define MK_N_LAUNCHES 1
#endif

#define LAS __attribute__((address_space(3)))
typedef unsigned short bf16_t;
typedef short bf16x8 __attribute__((ext_vector_type(8)));
typedef short s16x4 __attribute__((ext_vector_type(4)));
typedef float f32x4 __attribute__((ext_vector_type(4)));
typedef float f32x2 __attribute__((ext_vector_type(2)));
typedef float f32x16 __attribute__((ext_vector_type(16)));
typedef unsigned u32x4 __attribute__((ext_vector_type(4)));
typedef unsigned u32x2 __attribute__((ext_vector_type(2)));
typedef int i32x8 __attribute__((ext_vector_type(8)));
typedef int i32x4 __attribute__((ext_vector_type(4)));

constexpr int NB = 2, SEQ = 4096, DM = 2048, MTOK = NB * SEQ;
constexpr int INC = 6144;
constexpr int NEXP = 16, CAP = 512, FF = 2816, EROWS = NB * CAP;
constexpr float RMS_EPS = 1e-6f;
constexpr float LOG2E = 1.4426950408889634f;
constexpr float QSCALE = 0.088388347648318440f * LOG2E;
constexpr int NTHR = 512;

constexpr size_t al256(size_t x) { return (x + 255) / 256 * 256; }
constexpr size_t WS_CTL = 0, CTL_BYTES = 65536;
constexpr size_t WS_WIN = WS_CTL + CTL_BYTES;
constexpr size_t WS_WOUT = WS_WIN + (size_t)INC * DM * 2;
constexpr size_t WS_WGU = WS_WOUT + (size_t)DM * DM * 2;
constexpr size_t WS_WD = WS_WGU + (size_t)NEXP * 2 * FF * DM * 2;
constexpr size_t WS_H = WS_WD + (size_t)NEXP * DM * FF * 2;
constexpr size_t WS_PROJ = WS_H + (size_t)MTOK * DM * 2;
constexpr size_t WS_NASSQ = WS_PROJ + (size_t)MTOK * INC * 2;
constexpr size_t WS_MIX = WS_NASSQ + (size_t)MTOK * 1024 * 2;
constexpr size_t WS_OPART = WS_MIX + (size_t)MTOK * DM * 2;
constexpr size_t WS_ROWSS = WS_OPART + (size_t)MTOK * DM * 4;
constexpr size_t WS_AFF = WS_ROWSS + (size_t)MTOK * 32 * 4;
constexpr size_t WS_SELIDX = WS_AFF + (size_t)NB * NEXP * SEQ * 4;
constexpr size_t WS_SELGATE = WS_SELIDX + (size_t)NEXP * EROWS * 4;
constexpr size_t WS_SLOT = WS_SELGATE + (size_t)NEXP * EROWS * 4;
constexpr size_t WS_H2 = WS_SLOT + (size_t)NB * NEXP * SEQ * 4;
constexpr size_t WS_ACT = WS_H2 + (size_t)MTOK * DM * 2;
constexpr size_t WS_Y = WS_ACT + (size_t)NEXP * EROWS * FF * 2;
constexpr size_t WS_WRT = WS_Y + (size_t)NEXP * EROWS * DM * 2;
constexpr size_t WS_END = WS_WRT + (size_t)NEXP * DM * 4;

constexpr int STAGE_BYTES = 131072;
constexpr int SCR_OFF = STAGE_BYTES;
constexpr int SCR_BYTES = 16384;
constexpr int MISC_OFF = SCR_OFF + SCR_BYTES - 64;
constexpr int LDS_BYTES = SCR_OFF + SCR_BYTES;

__device__ __forceinline__ unsigned cvtpk(float lo, float hi) { unsigned r; asm volatile("v_cvt_pk_bf16_f32 %0, %1, %2" : "=v"(r) : "v"(lo), "v"(hi)); return r; }
__device__ __forceinline__ float wave_sum(float v) {
#pragma unroll
    for (int o = 32; o >= 1; o >>= 1) v += __shfl_xor(v, o);
    return v;
}
__device__ __forceinline__ unsigned cvt4_fp8(float a, float b, float c, float d) { int w = 0; w = __builtin_amdgcn_cvt_pk_fp8_f32(a, b, w, false); w = __builtin_amdgcn_cvt_pk_fp8_f32(c, d, w, true); return (unsigned)w; }
constexpr float WSC8 = 128.0f, HSC8 = 4.0f, ASC8 = 8.0f, YSC8 = 64.0f;
__device__ __forceinline__ float bf2f(bf16_t b) { return __uint_as_float(((unsigned)b) << 16); }

#define XB_TMO      128
#define XB_XCNT(j)  (256  + 64 * (j))
#define XB_XSUB(j)  (1280 + 64 * (j))
#define XB_XGEN(j)  (2304 + 64 * (j))
#define XB_TOP      3328
#define XB_TOPGEN   3392
#define XCD_BAR_WORDS 3456
#define XB_SPIN_CAP (1u << 18)

__device__ __forceinline__ unsigned xb_ld(unsigned* p)              { return __hip_atomic_load(p, __ATOMIC_RELAXED, __HIP_MEMORY_SCOPE_AGENT); }
__device__ __forceinline__ unsigned xb_add(unsigned* p, unsigned v) { return __hip_atomic_fetch_add(p, v, __ATOMIC_RELAXED, __HIP_MEMORY_SCOPE_AGENT); }
__device__ __forceinline__ unsigned xb_xcc_id() { return (unsigned)__builtin_amdgcn_s_getreg((3 << 11) | 20) & 0xFu; }
#define XB_SPIN(cond, bar) do { unsigned _sp = 0; while (cond) { __builtin_amdgcn_s_sleep(1); \
    if ((++_sp & 255u) == 0u) { if (xb_ld(&(bar)[XB_TMO])) break; if (_sp > XB_SPIN_CAP) { atomicAdd(&(bar)[XB_TMO], 1u); break; } } } } while (0)

struct XcdBarrier { unsigned* bar; unsigned x; volatile LAS unsigned* st; };

__device__ __forceinline__ XcdBarrier xcd_barrier_post(unsigned* bar, volatile LAS unsigned* st) {
    XcdBarrier b; b.bar = bar; b.x = xb_xcc_id(); b.st = st;
    if (threadIdx.x == 0) (void)xb_add(&bar[XB_XCNT(b.x)], 1u);
    return b;
}
__device__ __forceinline__ void xcd_barrier_complete(unsigned* bar, unsigned x, unsigned& nloc, unsigned& nx) {
    const unsigned G = gridDim.x * gridDim.y * gridDim.z;
    unsigned sum, cnt, mine, sp = 0u;
    for (;;) {
        sum = 0u; cnt = 0u; mine = 0u;
#pragma unroll
        for (unsigned j = 0; j < 16; ++j) { const unsigned c = xb_ld(&bar[XB_XCNT(j)]); sum += c; cnt += (c > 0u) ? 1u : 0u; mine = (j == x) ? c : mine; }
        if (sum == G) break;
        __builtin_amdgcn_s_sleep(1);
        if ((++sp & 255u) == 0u) { if (xb_ld(&bar[XB_TMO])) break; if (sp > XB_SPIN_CAP) { atomicAdd(&bar[XB_TMO], 1u); break; } }
    }
    nloc = mine > 0u ? mine : 1u; nx = cnt > 0u ? cnt : 1u;
}
__device__ __forceinline__ void xcd_barrier(const XcdBarrier& b) {
    asm volatile("s_waitcnt vmcnt(0)" ::: "memory");
    __syncthreads();
    if (threadIdx.x == 0) {
        unsigned* bar = b.bar;
        __builtin_amdgcn_s_waitcnt(0);
        unsigned nloc = b.st[0], nx = b.st[1];
        if (nloc == 0u) { xcd_barrier_complete(bar, b.x, nloc, nx); b.st[0] = nloc; b.st[1] = nx; }
        const unsigned old = xb_add(&bar[XB_XSUB(b.x)], 1u);
        const unsigned gen = old / nloc;
        if (old + 1u == (gen + 1u) * nloc) {
            __builtin_amdgcn_fence(__ATOMIC_RELEASE, "agent");
            asm volatile("s_waitcnt vmcnt(0)" ::: "memory");
            const unsigned og = xb_add(&bar[XB_TOP], 1u);
            const unsigned tg = og / nx;
            if (og + 1u == (tg + 1u) * nx) xb_add(&bar[XB_TOPGEN], 1u);
            else XB_SPIN(xb_ld(&bar[XB_TOPGEN]) == tg, bar);
            __builtin_amdgcn_fence(__ATOMIC_ACQUIRE, "agent");
            xb_add(&bar[XB_XGEN(b.x)], 1u);
            asm volatile("s_waitcnt vmcnt(0)" ::: "memory");
        } else {
            XB_SPIN(xb_ld(&bar[XB_XGEN(b.x)]) == gen, bar);
            __builtin_amdgcn_fence(__ATOMIC_ACQUIRE, "agent");
            asm volatile("s_waitcnt vmcnt(0)" ::: "memory");
        }
    }
    __syncthreads();
}

struct Params {
    const float* x; const float* ln1_g; const float* w_in; const float* qn_a; const float* kn_a; const float* rpb_a; const float* on_a;
    const float* qn_b; const float* kn_b; const float* lam_q1; const float* lam_k1; const float* lam_q2; const float* lam_k2; const float* subln_b;
    const float* w_out; const float* ln2_g; const float* w_router; const float* w_gate; const float* w_up; const float* w_down;
    float* out; unsigned char* ws; int ph_lo, ph_hi;
};

__device__ __forceinline__ void cvt_load(const float* __restrict__ src, int N, int k0, int n0, int tid, f32x4 (&v)[8], const float* kscale) {
    const int ln = tid & 63, kq = tid >> 6;
    const float* p = src + (size_t)(k0 + kq * 8) * N + n0 + ln * 4;
#pragma unroll
    for (int i = 0; i < 8; ++i) v[i] = __builtin_nontemporal_load((const f32x4*)(p + (size_t)i * N));
    if (kscale) {
#pragma unroll
        for (int i = 0; i < 8; ++i) v[i] = v[i] * kscale[k0 + kq * 8 + i];
    }
}
__device__ __forceinline__ void cvt_to_lds(LAS unsigned char* buf, int tid, const f32x4 (&v)[8]) {
    const int ln = tid & 63, kq = tid >> 6;
#pragma unroll
    for (int j = 0; j < 4; ++j) {
        u32x4 w; w.x = cvtpk(v[0][j], v[1][j]); w.y = cvtpk(v[2][j], v[3][j]); w.z = cvtpk(v[4][j], v[5][j]); w.w = cvtpk(v[6][j], v[7][j]);
        *(LAS u32x4*)(buf + (ln * 4 + j) * 144 + kq * 16) = w;
    }
}
__device__ __forceinline__ void cvt_store(const LAS unsigned char* buf, bf16_t* __restrict__ dst, int K, int k0, int n0, int blk, int off, int tid) {
#pragma unroll
    for (int q = 0; q < 4; ++q) {
        const int p = tid + q * 512, n = p >> 3, kp = p & 7, ng = n0 + n;
        const u32x4 w = *(const LAS u32x4*)(buf + n * 144 + kp * 16);
        const size_t drow = (size_t)(ng >> 7) * blk + off + (ng & 127);
        *(u32x4*)(dst + drow * K + k0 + kp * 8) = w;
    }
}
__device__ __forceinline__ void cvt_to_lds8(LAS unsigned char* buf, int tid, const f32x4 (&v)[8]) {
    const int ln = tid & 63, kq = tid >> 6, slot = (kq ^ (ln & 7)) * 8;
    f32x4 u[8];
#pragma unroll
    for (int i = 0; i < 8; ++i) u[i] = v[i] * WSC8;
#pragma unroll
    for (int j = 0; j < 4; ++j) {
        u32x2 w; w.x = cvt4_fp8(u[0][j], u[1][j], u[2][j], u[3][j]); w.y = cvt4_fp8(u[4][j], u[5][j], u[6][j], u[7][j]);
        *(LAS u32x2*)(buf + (ln * 4 + j) * 64 + slot) = w;
    }
}
__device__ __forceinline__ void cvt_store8(const LAS unsigned char* buf, unsigned char* __restrict__ dst, int Kb, int k0, int n0, int blk, int off, int tid) {
#pragma unroll
    for (int q = 0; q < 2; ++q) {
        const int p = tid + q * 512, n = p >> 2, kp = p & 3, ng = n0 + n, sw = (n >> 2) & 7;
        const u32x2 lo = *(const LAS u32x2*)(buf + n * 64 + ((2 * kp) ^ sw) * 8), hi = *(const LAS u32x2*)(buf + n * 64 + ((2 * kp + 1) ^ sw) * 8);
        const u32x4 w = {lo.x, lo.y, hi.x, hi.y};
        const size_t drow = (size_t)(ng >> 7) * blk + off + (ng & 127);
        __builtin_nontemporal_store(w, (u32x4*)(dst + drow * Kb + k0 + kp * 16));
    }
}
struct CvtTile { const float* src; bf16_t* dst; int K, N, k0, n0, blk, off; const float* kscale; int fp8; };
__device__ __forceinline__ void cvt_to_lds_any(LAS unsigned char* buf, int tid, const f32x4 (&v)[8], int fp8) { if (fp8) cvt_to_lds8(buf, tid, v); else cvt_to_lds(buf, tid, v); }
__device__ __forceinline__ void cvt_store_any(const LAS unsigned char* buf, const CvtTile& t, int tid) {
    if (t.fp8) cvt_store8(buf, (unsigned char*)t.dst, t.K, t.k0, t.n0, t.blk, t.off, tid); else cvt_store(buf, t.dst, t.K, t.k0, t.n0, t.blk, t.off, tid); }
template <int KIND> __device__ __forceinline__ constexpr int cvt_count() { return KIND == 0 ? 768 : KIND == 1 ? 256 : 16 * 352; }
template <int KIND> __device__ __forceinline__ CvtTile cvt_decode(const Params& P, int r) {
    CvtTile t; t.kscale = nullptr; t.fp8 = 0;
    if (KIND == 0) { t.src = P.w_in; t.dst = (bf16_t*)(P.ws + WS_WIN); t.K = DM; t.N = INC; t.k0 = (r / 24) * 64; t.n0 = (r % 24) * 256; t.blk = 128; t.off = 0; }
    else if (KIND == 1) { t.src = P.w_out; t.dst = (bf16_t*)(P.ws + WS_WOUT); t.K = DM; t.N = DM; t.k0 = (r / 8) * 64; t.n0 = (r % 8) * 256; t.blk = 128; t.off = 0; t.kscale = (t.k0 < 1024) ? P.on_a : nullptr; }
    else if (KIND == 2 || KIND == 3) { const int e = r / 352, q = r % 352;
        t.src = (KIND == 3 ? P.w_up : P.w_gate) + (size_t)e * DM * FF; t.dst = (bf16_t*)(P.ws + WS_WGU + (size_t)e * 2 * FF * DM);
        t.K = DM; t.N = FF; t.k0 = (q / 11) * 64; t.n0 = (q % 11) * 256; t.blk = 256; t.off = (KIND == 3) ? 128 : 0; t.fp8 = 1; }
    else { const int e = r / 352, q = r % 352;
        t.src = P.w_down + (size_t)e * FF * DM; t.dst = (bf16_t*)(P.ws + WS_WD + (size_t)e * DM * FF);
        t.K = FF; t.N = DM; t.k0 = (q / 8) * 64; t.n0 = (q % 8) * 256; t.blk = 128; t.off = 0; t.fp8 = 1; }
    return t;
}
constexpr int CW_QG = 4096, CW_QU = 4160, CW_QD = 4224;

template <int KIND> __device__ __forceinline__ void cvt_static(const Params& P, LAS unsigned char* lds) {
    const int tid = threadIdx.x, G = gridDim.x; constexpr int NT = cvt_count<KIND>();
    int idA = blockIdx.x, idB = blockIdx.x + G;
    f32x4 vA[8], vB[8];
    CvtTile tA = cvt_decode<KIND>(P, idA < NT ? idA : 0), tB = cvt_decode<KIND>(P, idB < NT ? idB : 0);
    if (idA < NT) cvt_load(tA.src, tA.N, tA.k0, tA.n0, tid, vA, tA.kscale);
    if (idB < NT) cvt_load(tB.src, tB.N, tB.k0, tB.n0, tid, vB, tB.kscale);
    for (;;) {
        if (idA >= NT) break;
        cvt_to_lds_any(lds, tid, vA, tA.fp8);
        { const int nid = idA + 2 * G; CvtTile tn = cvt_decode<KIND>(P, nid < NT ? nid : 0);
          if (nid < NT) cvt_load(tn.src, tn.N, tn.k0, tn.n0, tid, vA, tn.kscale);
          asm volatile("s_waitcnt lgkmcnt(0)" ::: "memory"); __builtin_amdgcn_s_barrier(); asm volatile("" ::: "memory");
          cvt_store_any(lds, tA, tid);
          tA = tn; idA = nid; }
        if (idB >= NT) break;
        cvt_to_lds_any(lds + 36864, tid, vB, tB.fp8);
        { const int nid = idB + 2 * G; CvtTile tn = cvt_decode<KIND>(P, nid < NT ? nid : 0);
          if (nid < NT) cvt_load(tn.src, tn.N, tn.k0, tn.n0, tid, vB, tn.kscale);
          asm volatile("s_waitcnt lgkmcnt(0)" ::: "memory"); __builtin_amdgcn_s_barrier(); asm volatile("" ::: "memory");
          cvt_store_any(lds + 36864, tB, tid);
          tB = tn; idB = nid; }
    }
}
__device__ __forceinline__ void p0_prologue(const Params& P, LAS unsigned char* lds) {
    int tid = threadIdx.x; asm volatile("" : "+v"(tid)); const int lane = tid & 63, wid = tid >> 6;
    {
        bf16_t* H = (bf16_t*)(P.ws + WS_H);
        for (int row = blockIdx.x * 8 + wid; row < MTOK; row += gridDim.x * 8) {
            const f32x4* xp = (const f32x4*)(P.x + (size_t)row * DM);
            f32x4 v[8]; float ss = 0.f;
#pragma unroll
            for (int i = 0; i < 8; ++i) { v[i] = xp[i * 64 + lane]; ss += v[i][0] * v[i][0] + v[i][1] * v[i][1] + v[i][2] * v[i][2] + v[i][3] * v[i][3]; }
            ss = wave_sum(ss);
            const float rstd = rsqrtf(ss * (1.0f / DM) + RMS_EPS);
#pragma unroll
            for (int i = 0; i < 8; ++i) {
                const f32x4 g = ((const f32x4*)P.ln1_g)[i * 64 + lane];
                u32x2 w; w.x = cvtpk(v[i][0] * rstd * g[0], v[i][1] * rstd * g[1]); w.y = cvtpk(v[i][2] * rstd * g[2], v[i][3] * rstd * g[3]);
                *(u32x2*)(H + (size_t)row * DM + (i * 64 + lane) * 4) = w;
            }
        }
    }
    cvt_static<0>(P, lds); __syncthreads(); cvt_static<1>(P, lds);
    { float* wrt = (float*)(P.ws + WS_WRT);
      for (int i = blockIdx.x * NTHR + tid; i < NEXP * DM; i += gridDim.x * NTHR) { const int e = i >> 11, c = i & 2047; wrt[i] = P.w_router[c * 16 + e]; } }
}
__device__ __forceinline__ void cvt_load_asm(const float* __restrict__ src, int N, int k0, int n0, int tid, f32x4 (&v)[8]) {
    const int ln = tid & 63, kq = tid >> 6;
    const float* p = src + (size_t)(k0 + kq * 8) * N + n0 + ln * 4;
#pragma unroll
    for (int i = 0; i < 8; ++i) { const float* q = p + (size_t)i * N; asm volatile("global_load_dwordx4 %0, %1, off nt" : "=v"(v[i]) : "v"(q) : "memory"); }
}
__device__ __forceinline__ void cvt_load_asm_s(const float* tile  , int N, unsigned voff, f32x4 (&v)[8]) {
#pragma unroll
    for (int i = 0; i < 8; ++i) { const float* q = tile + (size_t)i * N; asm volatile("global_load_dwordx4 %0, %1, %2 nt" : "=v"(v[i]) : "v"(voff), "s"(q) : "memory"); }
}
#define CVT_WAIT_SET(v, N) asm volatile("s_waitcnt vmcnt(" #N ")" : "+v"(v[0]), "+v"(v[1]), "+v"(v[2]), "+v"(v[3]), "+v"(v[4]), "+v"(v[5]), "+v"(v[6]), "+v"(v[7]) :: "memory")
template <int KIND> __device__ __forceinline__ void cvt_queue(const Params& P, LAS unsigned char* lds, unsigned* qhead) {
    const int tid = threadIdx.x; constexpr unsigned n = (unsigned)cvt_count<KIND>(); constexpr unsigned CH = 8;
    LAS unsigned* slot = (LAS unsigned*)(lds + 73728);
#define QCLAIM() __hip_atomic_fetch_add(qhead, CH, __ATOMIC_RELAXED, __HIP_MEMORY_SCOPE_AGENT)
    __syncthreads();
    if (tid == 0) { const unsigned s0 = QCLAIM(), s1 = QCLAIM(); slot[0] = s0; slot[1] = s1; }
    __syncthreads();
    unsigned cbase = slot[0], pos = 0, par = 1;
#define QGEN(dst) do { dst = cbase + pos; if (++pos == CH) { pos = 0; cbase = slot[par]; \
        if (tid == 0) { const unsigned nb_ = (cbase < n) ? QCLAIM() : 0xffffff00u; slot[par ^ 1] = nb_; } par ^= 1; } } while (0)
    unsigned id[4]; f32x4 v[4][8]; CvtTile t[4];
    const unsigned lvoff = (unsigned)(((tid >> 6) * 8 * cvt_decode<KIND>(P, 0).N + (tid & 63) * 4) * 4);
#pragma unroll
    for (int i = 0; i < 4; ++i) { unsigned g; QGEN(g); id[i] = __builtin_amdgcn_readfirstlane(g); t[i] = cvt_decode<KIND>(P, id[i] < n ? (int)id[i] : 0);
        cvt_load_asm_s(t[i].src + (size_t)t[i].k0 * t[i].N + t[i].n0, t[i].N, lvoff, v[i]); }
    CVT_WAIT_SET(v[0], 0); CVT_WAIT_SET(v[1], 0); CVT_WAIT_SET(v[2], 0); CVT_WAIT_SET(v[3], 0);
    bool more = true;
    while (more) {
#pragma unroll
        for (int i = 0; i < 4; ++i) {
            if (id[i] >= n) { more = false; break; }
            CVT_WAIT_SET(v[i], 32);
            LAS unsigned char* buf = lds + (i & 1) * 36864;
            cvt_to_lds_any(buf, tid, v[i], t[i].fp8);
            unsigned g; QGEN(g);
            asm volatile("s_waitcnt lgkmcnt(0)" ::: "memory"); __builtin_amdgcn_s_barrier(); asm volatile("" ::: "memory");
            const unsigned nx = __builtin_amdgcn_readfirstlane(g);
            CvtTile tn = cvt_decode<KIND>(P, nx < n ? (int)nx : 0);
            cvt_load_asm_s(tn.src + (size_t)tn.k0 * tn.N + tn.n0, tn.N, lvoff, v[i]);
            cvt_store_any(buf, t[i], tid);
            t[i] = tn; id[i] = nx;
        }
    }
    asm volatile("s_waitcnt vmcnt(0)" ::: "memory");
#undef QCLAIM
#undef QGEN
    __syncthreads();
}

namespace pg8 {
constexpr int BM = 256, BK = 64, HALF = 128, HTB = HALF * BK * 2, NXCD = 8, WGM = 8;
__device__ __forceinline__ int lds_byte(int r, int c) { const int st = (r >> 4) * 2 + (c >> 5), rr = r & 15, cc = c & 31, ob = rr * 64 + cc * 2; return st * 1024 + (ob ^ (((ob >> 9) & 1) << 5)); }
__device__ __forceinline__ void stage_rc(int b, int& R, int& C) { const int st = b / 1024, sb = b % 1024, swz = sb ^ (((sb >> 9) & 1) << 5); R = (st >> 1) * 16 + swz / 64; C = (st & 1) * 32 + (swz % 64) / 2; }
__device__ __forceinline__ int perm32(int rho) { const int n = rho >> 4, i = rho & 15; return 8 * (i >> 2) + 4 * n + (i & 3); }

struct Unit { int pm, pn, e; };

template <bool GATHER, bool HOOK, bool FP8, class Epi, class Sched>
__device__ __forceinline__ void gemm_phase(LAS unsigned char* lds, const int K, const Sched& S, const Epi& E, const LAS unsigned* gtab) {
    int tid = threadIdx.x; asm volatile("" : "+v"(tid));
    const int wid = __builtin_amdgcn_readfirstlane(tid >> 6), lane = tid & 63, wr = wid >> 2, wc = wid & 3, fr = lane & 15, fq = lane >> 4;
    const int nt = K / BK;
    unsigned voffA[2], voffB[2]; int RA[2], CA2[2];
#pragma unroll
    for (int i = 0; i < 2; ++i) { int R, C; stage_rc(tid * 16 + i * 8192, R, C); const int Rb = (R & ~31) + perm32(R & 31);
        voffA[i] = (unsigned)(R * K + C) * 2u; voffB[i] = (unsigned)(Rb * K + C) * 2u; RA[i] = R; CA2[i] = C * 2; }
    const size_t kstep = (size_t)(BK * 2);
    const size_t hstep = (size_t)HALF * K * 2;
    const unsigned ldsw = (unsigned)wid * 1024u;
    const int aoff = lds_byte(wr * 64 + fr, fq * 8), boff = lds_byte(wc * 32 + fr, fq * 8);
#define PG8_SA(b, h) (((b) * 2 + (h)) * HTB)
#define PG8_SB(b, h) ((4 + (b) * 2 + (h)) * HTB)
#define PG8_STAGE(bufoff, gbase, voff) do { _Pragma("unroll") for (int _i = 0; _i < 2; ++_i) \
        __builtin_amdgcn_global_load_lds((const unsigned*)((const char*)(gbase) + (voff)[_i]), (LAS unsigned*)(lds + (bufoff) + ldsw + _i * 8192), 16, 0, 0); } while (0)
#define PG8_STAGE_A(bufoff, ubase, kbytes, h, gv) do { if (GATHER) { PG8_STAGE(bufoff, (ubase) + (kbytes), (gv)[h]); } else { PG8_STAGE(bufoff, (ubase) + (kbytes) + (h) * hstep, voffA); } } while (0)
#define PG8_LD2(addr) __builtin_shufflevector(*(const LAS i32x4*)(addr), *(const LAS i32x4*)((addr) + 1024), 0, 1, 2, 3, 4, 5, 6, 7)
#define PG8_LDA(dst, b, h) do { if (FP8) { _Pragma("unroll") for (int m = 0; m < 4; ++m) dst##_f8[m] = PG8_LD2(lds + PG8_SA(b, h) + aoff + m * 2048); } \
        else { _Pragma("unroll") for (int m = 0; m < 4; ++m) _Pragma("unroll") for (int k = 0; k < 2; ++k) dst##_bf[m][k] = *(const LAS bf16x8*)(lds + PG8_SA(b, h) + aoff + m * 2048 + k * 1024); } } while (0)
#define PG8_LDB(dst, b, h) do { if (FP8) { _Pragma("unroll") for (int n = 0; n < 2; ++n) dst##_f8[n] = PG8_LD2(lds + PG8_SB(b, h) + boff + n * 2048); } \
        else { _Pragma("unroll") for (int n = 0; n < 2; ++n) _Pragma("unroll") for (int k = 0; k < 2; ++k) dst##_bf[n][k] = *(const LAS bf16x8*)(lds + PG8_SB(b, h) + boff + n * 2048 + k * 1024); } } while (0)
#define PG8_MMA(ai, bj, At, Bt) do { __builtin_amdgcn_s_setprio(1); \
        if (FP8) { _Pragma("unroll") for (int m = 0; m < 4; ++m) _Pragma("unroll") for (int n = 0; n < 2; ++n) \
            asm volatile("v_mfma_scale_f32_16x16x128_f8f6f4 %0, %1, %2, %0, %3, %3 op_sel_hi:[0,0,0]" : "+v"(acc[ai][bj][m][n]) : "v"(Bt##_f8[n]), "v"(At##_f8[m]), "v"(sc1)); } \
        else { _Pragma("unroll") for (int m = 0; m < 4; ++m) _Pragma("unroll") for (int n = 0; n < 2; ++n) _Pragma("unroll") for (int k = 0; k < 2; ++k) \
            acc[ai][bj][m][n] = __builtin_amdgcn_mfma_f32_16x16x32_bf16(Bt##_bf[n][k], At##_bf[m][k], acc[ai][bj][m][n], 0, 0, 0); } \
        __builtin_amdgcn_s_setprio(0); } while (0)
#define PG8_WAIT_V(n) asm volatile("s_waitcnt vmcnt(" #n ")" ::: "memory")
#define PG8_WAIT_L(n) asm volatile("s_waitcnt lgkmcnt(" #n ")" ::: "memory")
#define PG8_BAR __builtin_amdgcn_s_barrier()
#define PG8_SCHED __builtin_amdgcn_sched_barrier(0)
#define PG8_GLOAD(gv, i) do { if (GATHER) { _Pragma("unroll") for (int _h = 0; _h < 2; ++_h) _Pragma("unroll") for (int _i = 0; _i < 2; ++_i) (gv)[_h][_i] = gtab[(i) * 256 + _h * 128 + RA[_i]] + (unsigned)CA2[_i]; } } while (0)
    Unit cur, nxt; int ui = 0;
    if (!S.next(0, cur)) return;
    f32x4 acc[2][2][4][2];
    if constexpr (Epi::INIT) E.init(acc, cur, wr, wc, fr, fq, gtab);
    else {
#pragma unroll
    for (int a = 0; a < 2; ++a)
#pragma unroll
        for (int b = 0; b < 2; ++b)
#pragma unroll
            for (int m = 0; m < 4; ++m)
#pragma unroll
                for (int n = 0; n < 2; ++n) acc[a][b][m][n] = (f32x4){0.f, 0.f, 0.f, 0.f};
    }
    i32x8 At_f8[4], B0_f8[2], B1_f8[2]; bf16x8 At_bf[4][2], B0_bf[2][2], B1_bf[2][2];
    int sc1 = 0x7F7F7F7F; asm volatile("" : "+v"(sc1));
    unsigned gc[2][2] = {{0u, 0u}, {0u, 0u}}, gn[2][2] = {{0u, 0u}, {0u, 0u}};
    PG8_GLOAD(gc, 0);
    const char* cA = S.abase(cur); const char* cB = S.bbase(cur);
    PG8_STAGE(PG8_SB(0, 0), cB, voffB); PG8_STAGE_A(PG8_SA(0, 0), cA, 0, 0, gc); PG8_STAGE(PG8_SB(0, 1), cB + hstep, voffB); PG8_STAGE_A(PG8_SA(0, 1), cA, 0, 1, gc);
    if (wr == 1) PG8_BAR;
    PG8_WAIT_V(4); PG8_BAR;
    PG8_STAGE(PG8_SB(1, 0), cB + kstep, voffB); PG8_STAGE_A(PG8_SA(1, 0), cA, kstep, 0, gc); PG8_STAGE(PG8_SB(1, 1), cB + hstep + kstep, voffB);
    PG8_WAIT_V(6); PG8_BAR;
    for (;;) {
        const bool has_next = S.next(ui + 1, nxt);
        const char* nA = has_next ? S.abase(nxt) : cA; const char* nB = has_next ? S.bbase(nxt) : cB;
        if (GATHER) { if (has_next) { PG8_GLOAD(gn, ui + 1); } else {
#pragma unroll
            for (int _h = 0; _h < 2; ++_h)
#pragma unroll
                for (int _i = 0; _i < 2; ++_i) gn[_h][_i] = gc[_h][_i]; } }
        for (int t = 0; t < nt; t += 2) {
            const bool last = (t == nt - 2);
            const size_t k1 = (size_t)(t + 1) * kstep;
            const char* a2 = last ? nA : cA + (size_t)(t + 2) * kstep; const char* b2 = last ? nB : cB + (size_t)(t + 2) * kstep;
            const char* a3 = a2 + kstep; const char* b3 = b2 + kstep;
            unsigned g2[2][2];
#pragma unroll
            for (int _h = 0; _h < 2; ++_h)
#pragma unroll
                for (int _i = 0; _i < 2; ++_i) g2[_h][_i] = last ? gn[_h][_i] : gc[_h][_i];
            if (HOOK && t == 16) {
                const LAS float* ht = (const LAS float*)gtab;
#pragma unroll
                for (int a = 0; a < 2; ++a)
#pragma unroll
                    for (int m = 0; m < 4; ++m) { const float sc = ht[a * 128 + wr * 64 + m * 16 + fr];
#pragma unroll
                        for (int b = 0; b < 2; ++b)
#pragma unroll
                            for (int n = 0; n < 2; ++n) acc[a][b][m][n] = acc[a][b][m][n] * sc; }
            }
            PG8_LDB(B0, 0, 0); PG8_SCHED; PG8_LDA(At, 0, 0); PG8_STAGE_A(PG8_SA(1, 1), cA, k1, 1, gc);
            PG8_WAIT_L(8); PG8_BAR; PG8_WAIT_L(0); PG8_MMA(0, 0, At, B0); PG8_BAR; PG8_SCHED;
            PG8_LDB(B1, 0, 1); PG8_STAGE(PG8_SB(0, 0), b2, voffB);
            PG8_BAR; PG8_WAIT_L(0); PG8_MMA(0, 1, At, B1); PG8_BAR;
            PG8_LDA(At, 0, 1); PG8_STAGE_A(PG8_SA(0, 0), a2, 0, 0, g2);
            PG8_BAR; PG8_WAIT_L(0); PG8_MMA(1, 0, At, B0); PG8_BAR; PG8_SCHED;
            PG8_STAGE(PG8_SB(0, 1), b2 + hstep, voffB);
            PG8_WAIT_V(6); PG8_BAR; PG8_MMA(1, 1, At, B1); PG8_BAR;
            PG8_LDB(B0, 1, 0); PG8_SCHED; PG8_LDA(At, 1, 0); PG8_STAGE_A(PG8_SA(0, 1), a2, 0, 1, g2);
            PG8_WAIT_L(8); PG8_BAR; PG8_WAIT_L(0); PG8_MMA(0, 0, At, B0); PG8_BAR; PG8_SCHED;
            PG8_LDB(B1, 1, 1); PG8_STAGE(PG8_SB(1, 0), b3, voffB);
            PG8_BAR; PG8_WAIT_L(0); PG8_MMA(0, 1, At, B1); PG8_BAR;
            PG8_LDA(At, 1, 1); PG8_STAGE_A(PG8_SA(1, 0), a3, 0, 0, g2);
            PG8_BAR; PG8_WAIT_L(0); PG8_MMA(1, 0, At, B0); PG8_BAR; PG8_SCHED;
            PG8_STAGE(PG8_SB(1, 1), b3 + hstep, voffB);
            PG8_WAIT_V(6); PG8_BAR; PG8_MMA(1, 1, At, B1); PG8_BAR;
        }
        E(acc, cur, wr, wc, fr, fq, lds);
        if (!has_next) break;
#pragma unroll
        for (int a = 0; a < 2; ++a)
#pragma unroll
            for (int b = 0; b < 2; ++b)
#pragma unroll
                for (int m = 0; m < 4; ++m)
#pragma unroll
                    for (int n = 0; n < 2; ++n) acc[a][b][m][n] = (f32x4){0.f, 0.f, 0.f, 0.f};
        cur = nxt; cA = nA; cB = nB; ++ui;
#pragma unroll
        for (int _h = 0; _h < 2; ++_h)
#pragma unroll
            for (int _i = 0; _i < 2; ++_i) gc[_h][_i] = gn[_h][_i];
    }
    PG8_WAIT_V(0);
    if (wr == 0) PG8_BAR;
    PG8_BAR;
#undef PG8_SA
#undef PG8_SB
#undef PG8_STAGE
#undef PG8_STAGE_A
#undef PG8_LDA
#undef PG8_LDB
#undef PG8_MMA
#undef PG8_LD2
#undef PG8_WAIT_V
#undef PG8_WAIT_L
#undef PG8_BAR
#undef PG8_SCHED
#undef PG8_GLOAD
}

struct OrderMN {
    int nM, nN, nwg, G, c; const char* A; const char* Bt; size_t tstep;
    __device__ __forceinline__ void init(const void* A_, const void* Bt_, int M, int N, int K, int G_, int c_) { nM = M / BM; nN = N / BM; nwg = nM * nN; G = G_; c = c_; A = (const char*)A_; Bt = (const char*)Bt_; tstep = (size_t)BM * K * 2; }
    __device__ __forceinline__ bool next(int i, Unit& u) const {
        if (c >= G) return false;
        const long L = (long)i * G + c; if (L >= nwg) return false;
        int wgid = (int)L; { const int q = nwg / NXCD, r = nwg % NXCD, xcd = wgid % NXCD, off = wgid / NXCD; wgid = (xcd < r ? xcd * (q + 1) : r * (q + 1) + (xcd - r) * q) + off; }
        const int nig = WGM * nN, gid = wgid / nig, fm = gid * WGM, gsz = (nM - fm) < WGM ? (nM - fm) : WGM;
        u.pm = fm + ((wgid % nig) % gsz); u.pn = (wgid % nig) / gsz; u.e = 0; return true;
    }
    __device__ __forceinline__ const char* abase(const Unit& u) const { return A + (size_t)u.pm * tstep; }
    __device__ __forceinline__ const char* bbase(const Unit& u) const { return Bt + (size_t)u.pn * tstep; }
};
struct OrderExpert {
    int nN, ntile, G, c, per; const char* A; const char* Bt; size_t a_estride, b_estride, tstepA, tstepB; bool gather;
    __device__ __forceinline__ void init(const void* A_, const void* Bt_, int N, int K, size_t a_es, size_t b_es, bool gather_, int G_, int c_, int per_) {
        nN = N / BM; ntile = NEXP * nN; G = G_; c = c_; per = per_; A = (const char*)A_; Bt = (const char*)Bt_; a_estride = a_es; b_estride = b_es; tstepA = (size_t)BM * K * 2; tstepB = tstepA; gather = gather_; }
    __device__ __forceinline__ bool next(int i, Unit& u) const {
        int T, pm;
        if ((G & 7) == 0) {
            const int x = c & 7, j = c >> 3; if (j >= per) return false;
            const int q = i * per + j, U = 4 * nN; if (q >= 2 * U) return false;
            const int el = q >= U ? 1 : 0, r = q - el * U, chunk = r >> 5, w = r & 31;
            pm = w & 3; const int pn = chunk * 8 + (w >> 2);
            T = (2 * x + el) * nN + pn;
            if (pn >= nN) return false;
        }
        else { const int q = i * G + c; T = q >> 2; pm = q & 3; }
        if (T >= ntile) return false;
        u.e = T / nN; u.pn = T % nN; u.pm = pm; return true;
    }
    __device__ __forceinline__ const char* abase(const Unit& u) const { return gather ? A : A + (size_t)u.e * a_estride + (size_t)u.pm * tstepA; }
    __device__ __forceinline__ const char* bbase(const Unit& u) const { return Bt + (size_t)u.e * b_estride + (size_t)u.pn * tstepB; }
};
}

struct EpiInProj {
    static constexpr bool INIT = false;
    bf16_t* proj;
    __device__ __forceinline__ void operator()(const f32x4 (&acc)[2][2][4][2], const pg8::Unit& u, int wr, int wc, int fr, int fq, LAS unsigned char* lds) const {
        const int pn = u.pn, grp = pn >> 2;
        const int row0 = u.pm * 256 + wr * 64 + fr;
        if (grp == 5 || grp == 2) {
#pragma unroll
            for (int ai = 0; ai < 2; ++ai)
#pragma unroll
                for (int m = 0; m < 4; ++m) {
                    bf16_t* rowp = proj + (size_t)(row0 + ai * 128 + m * 16) * INC + pn * 256 + wc * 32 + 8 * fq;
#pragma unroll
                    for (int bj = 0; bj < 2; ++bj) { const f32x4 v0 = acc[ai][bj][m][0], v1 = acc[ai][bj][m][1];
                        u32x4 w; w.x = cvtpk(v0[0], v0[1]); w.y = cvtpk(v0[2], v0[3]); w.z = cvtpk(v1[0], v1[1]); w.w = cvtpk(v1[2], v1[3]);
                        *(u32x4*)(rowp + bj * 128) = w; }
                }
            return;
        }
        const int gsel = (grp == 0) ? 0 : (grp == 1) ? 1 : (grp == 3) ? 2 : 3;
        const LAS float* gain = (const LAS float*)(lds + SCR_OFF + 8192) + gsel * 128;
        const float osc = (grp == 0 || grp == 3) ? QSCALE : 1.0f;
        LAS float* Pt = (LAS float*)(lds + SCR_OFF);
#pragma unroll
        for (int ai = 0; ai < 2; ++ai)
#pragma unroll
            for (int m = 0; m < 4; ++m)
#pragma unroll
                for (int bj = 0; bj < 2; ++bj) {
                    const f32x4 v0 = acc[ai][bj][m][0], v1 = acc[ai][bj][m][1];
                    float s = (v0[0] * v0[0] + v0[1] * v0[1]) + (v0[2] * v0[2] + v0[3] * v0[3]) + (v1[0] * v1[0] + v1[1] * v1[1]) + (v1[2] * v1[2] + v1[3] * v1[3]);
                    s += __shfl_xor(s, 16); s += __shfl_xor(s, 32);
                    if (fq == 0) Pt[((ai * 128 + wr * 64 + m * 16 + fr) * 2 + bj) * 4 + wc] = s;
                }
        asm volatile("s_waitcnt lgkmcnt(0)" ::: "memory"); __builtin_amdgcn_s_barrier(); asm volatile("" ::: "memory");
        const f32x4 g0 = *(const LAS f32x4*)(gain + wc * 32 + 8 * fq), g1 = *(const LAS f32x4*)(gain + wc * 32 + 8 * fq + 4);
#pragma unroll
        for (int ai = 0; ai < 2; ++ai)
#pragma unroll
            for (int m = 0; m < 4; ++m) {
                bf16_t* rowp = proj + (size_t)(row0 + ai * 128 + m * 16) * INC + pn * 256 + wc * 32 + 8 * fq;
#pragma unroll
                for (int bj = 0; bj < 2; ++bj) {
                    const f32x4 ps = *(const LAS f32x4*)(Pt + ((ai * 128 + wr * 64 + m * 16 + fr) * 2 + bj) * 4);
                    const float rstd = rsqrtf(((ps[0] + ps[1]) + (ps[2] + ps[3])) * (1.0f / 128.0f) + RMS_EPS) * osc;
                    const f32x4 v0 = acc[ai][bj][m][0] * rstd * g0, v1 = acc[ai][bj][m][1] * rstd * g1;
                    u32x4 w; w.x = cvtpk(v0[0], v0[1]); w.y = cvtpk(v0[2], v0[3]); w.z = cvtpk(v1[0], v1[1]); w.w = cvtpk(v1[2], v1[3]);
                    *(u32x4*)(rowp + bj * 128) = w;
                }
            }
    }
};
struct EpiOutProj {
    static constexpr bool INIT = true;
    const float* x; bf16_t* x1b; float* rowss;
    __device__ __forceinline__ void init(f32x4 (&acc)[2][2][4][2], const pg8::Unit& u, int wr, int wc, int fr, int fq, const LAS unsigned* gtab) const {
        const LAS float* ht = (const LAS float*)gtab;
        const int row0 = u.pm * 256 + wr * 64 + fr, col0 = u.pn * 256 + wc * 32 + 8 * fq;
#pragma unroll
        for (int ai = 0; ai < 2; ++ai)
#pragma unroll
            for (int m = 0; m < 4; ++m) {
                const float isc = __builtin_amdgcn_rcpf(ht[ai * 128 + wr * 64 + m * 16 + fr]);
                const float* xp = x + (size_t)(row0 + ai * 128 + m * 16) * DM + col0;
#pragma unroll
                for (int bj = 0; bj < 2; ++bj)
#pragma unroll
                    for (int n = 0; n < 2; ++n) acc[ai][bj][m][n] = *(const f32x4*)(xp + bj * 128 + 4 * n) * isc;
            }
    }
    __device__ __forceinline__ void operator()(const f32x4 (&acc)[2][2][4][2], const pg8::Unit& u, int wr, int wc, int fr, int fq, LAS unsigned char* lds) const {
        const int row0 = u.pm * 256 + wr * 64 + fr, col0 = u.pn * 256 + wc * 32 + 8 * fq;
#pragma unroll
        for (int ai = 0; ai < 2; ++ai)
#pragma unroll
            for (int m = 0; m < 4; ++m) {
                const int row = row0 + ai * 128 + m * 16;
                bf16_t* op = x1b + (size_t)row * DM + col0;
                float s = 0.f;
#pragma unroll
                for (int bj = 0; bj < 2; ++bj) {
                    const f32x4 v0 = acc[ai][bj][m][0], v1 = acc[ai][bj][m][1];
                    u32x4 w; w.x = cvtpk(v0[0], v0[1]); w.y = cvtpk(v0[2], v0[3]); w.z = cvtpk(v1[0], v1[1]); w.w = cvtpk(v1[2], v1[3]);
                    *(u32x4*)(op + bj * 128) = w;
                    s += (v0[0] * v0[0] + v0[1] * v0[1]) + (v0[2] * v0[2] + v0[3] * v0[3]) + (v1[0] * v1[0] + v1[1] * v1[1]) + (v1[2] * v1[2] + v1[3] * v1[3]);
                }
                s += __shfl_xor(s, 16); s += __shfl_xor(s, 32);
                if (fq == 0) rowss[(size_t)row * 32 + u.pn * 4 + wc] = s;
            }
    }
};
struct EpiGateUp {
    static constexpr bool INIT = false;
    unsigned char* act;
    __device__ __forceinline__ void operator()(const f32x4 (&acc)[2][2][4][2], const pg8::Unit& u, int wr, int wc, int fr, int fq, LAS unsigned char* lds) const {
        const int row0 = u.pm * 256 + wr * 64 + fr;
        unsigned char* base = act + (size_t)u.e * EROWS * FF + u.pn * 128 + wc * 32 + 8 * fq;
        constexpr float DS = 1.0f / (WSC8 * HSC8);
#pragma unroll
        for (int ai = 0; ai < 2; ++ai)
#pragma unroll
            for (int m = 0; m < 4; ++m) {
                float r[8];
#pragma unroll
                for (int n = 0; n < 2; ++n)
#pragma unroll
                    for (int j = 0; j < 4; ++j) { const float g = acc[ai][0][m][n][j] * DS, uu = acc[ai][1][m][n][j] * DS;
                        const float a = g * __builtin_amdgcn_rcpf(1.0f + __builtin_amdgcn_exp2f(-g * LOG2E)) * uu * ASC8;
                        r[n * 4 + j] = fminf(fmaxf(a, -448.0f), 448.0f); }
                u32x2 w; w.x = cvt4_fp8(r[0], r[1], r[2], r[3]); w.y = cvt4_fp8(r[4], r[5], r[6], r[7]);
                *(u32x2*)(base + (size_t)(row0 + ai * 128 + m * 16) * FF) = w;
            }
    }
};
struct EpiDown {
    static constexpr bool INIT = false;
    unsigned char* y; const float* selgate;
    __device__ __forceinline__ void operator()(const f32x4 (&acc)[2][2][4][2], const pg8::Unit& u, int wr, int wc, int fr, int fq, LAS unsigned char* lds) const {
        const int row0 = u.pm * 256 + wr * 64 + fr;
        unsigned char* base = y + (size_t)u.e * EROWS * DM + u.pn * 256 + wc * 32 + 8 * fq;
#pragma unroll
        for (int ai = 0; ai < 2; ++ai)
#pragma unroll
            for (int m = 0; m < 4; ++m) {
                const int row = row0 + ai * 128 + m * 16;
                const float gt = selgate[u.e * EROWS + row] * (YSC8 / (WSC8 * ASC8));
#pragma unroll
                for (int bj = 0; bj < 2; ++bj) { const f32x4 v0 = acc[ai][bj][m][0] * gt, v1 = acc[ai][bj][m][1] * gt;
                    u32x2 w; w.x = cvt4_fp8(fminf(fmaxf(v0[0], -448.f), 448.f), fminf(fmaxf(v0[1], -448.f), 448.f), fminf(fmaxf(v0[2], -448.f), 448.f), fminf(fmaxf(v0[3], -448.f), 448.f));
                    w.y = cvt4_fp8(fminf(fmaxf(v1[0], -448.f), 448.f), fminf(fmaxf(v1[1], -448.f), 448.f), fminf(fmaxf(v1[2], -448.f), 448.f), fminf(fmaxf(v1[3], -448.f), 448.f));
                    *(u32x2*)(base + (size_t)row * DM + bj * 128) = w; }
            }
    }
};

#define KSWZ(row, colB) ((row) * 256 + ((colB) ^ (((row) & 7) << 4)))
#define SBAR() __builtin_amdgcn_sched_barrier(0)
__device__ __forceinline__ int crow(int r, int hi) { return (r & 3) + 8 * (r >> 2) + 4 * hi; }
#define PK4(P, BASE, OUT) do { unsigned a0 = cvtpk(P[BASE + 0], P[BASE + 1]), a1 = cvtpk(P[BASE + 2], P[BASE + 3]);   \
    unsigned b0 = cvtpk(P[BASE + 4], P[BASE + 5]), b1 = cvtpk(P[BASE + 6], P[BASE + 7]);                              \
    auto r0 = __builtin_amdgcn_permlane32_swap(a0, b0, false, false); auto r1 = __builtin_amdgcn_permlane32_swap(a1, b1, false, false); \
    u32x4 w = {r0[0], r1[0], r0[1], r1[1]}; OUT = *reinterpret_cast<bf16x8*>(&w); } while (0)
__device__ __forceinline__ float swap_add(float v) { auto rr = __builtin_amdgcn_permlane32_swap(__float_as_uint(v), __float_as_uint(v), false, false); return __uint_as_float(rr[0]) + __uint_as_float(rr[1]); }

namespace da {
constexpr int D = 128, NW = 8, QBLK = 32, KVBLK = 64;
constexpr int SHM_V = KVBLK * D * 2, SHM_K = KVBLK * D * 2, SHM_ATTN = 2 * SHM_V + 2 * SHM_K + NW * 64 * 4;
constexpr int LDP = INC;

__device__ __forceinline__ void qkt(f32x16& p0, f32x16& p1, const LAS unsigned char* Ks, const bf16x8* qr, int r32, int hi) {
    p0 = f32x16{}; p1 = f32x16{};
#pragma unroll
    for (int d0 = 0; d0 < 8; ++d0) { const int cb = (d0 * 16 + hi * 8) * 2;
        const bf16x8 b0 = *(const LAS bf16x8*)(Ks + KSWZ(r32, cb));
        const bf16x8 b1 = *(const LAS bf16x8*)(Ks + KSWZ(32 + r32, cb));
        p0 = __builtin_amdgcn_mfma_f32_32x32x16_bf16(b0, qr[d0], p0, 0, 0, 0);
        p1 = __builtin_amdgcn_mfma_f32_32x32x16_bf16(b1, qr[d0], p1, 0, 0, 0); }
}
__device__ __forceinline__ int v_st(int k, int c) { const int kk = (k & ~0xC) | ((k & 4) << 1) | ((k & 8) >> 1); return ((kk >> 3) * 4 + (c >> 5)) * 512 + ((kk & 7) * 32 + (c & 31)) * 2; }
__device__ __forceinline__ int v_rd_base(int lane) { return ((lane & 3) << 3) | (((lane >> 2) & 3) << 6) | (((lane >> 4) & 1) << 5) | (((lane >> 5) & 1) << 8); }
constexpr int v_rd_off(int d0, int ks, int half) { return d0 * 512 + ks * 4096 + half * 2048; }
template <int OFF> __device__ __forceinline__ s16x4 tr_read(int vb) {
    s16x4 r; asm volatile("ds_read_b64_tr_b16 %0, %1 offset:%2" : "=&v"(r) : "v"(vb), "i"(OFF) : "memory"); return r;
}
template <int D0> __device__ __forceinline__ void pv_one(f32x16& od, int vb, bf16x8 pa0, bf16x8 pa1, bf16x8 pa2, bf16x8 pa3) {
    const s16x4 l0 = tr_read<v_rd_off(D0, 0, 0)>(vb), h0 = tr_read<v_rd_off(D0, 0, 1)>(vb), l1 = tr_read<v_rd_off(D0, 1, 0)>(vb), h1 = tr_read<v_rd_off(D0, 1, 1)>(vb);
    const s16x4 l2 = tr_read<v_rd_off(D0, 2, 0)>(vb), h2 = tr_read<v_rd_off(D0, 2, 1)>(vb), l3 = tr_read<v_rd_off(D0, 3, 0)>(vb), h3 = tr_read<v_rd_off(D0, 3, 1)>(vb);
    asm volatile("s_waitcnt lgkmcnt(0)" ::: "memory"); SBAR();
#define PKV(L, H) (bf16x8){L[0], L[1], L[2], L[3], H[0], H[1], H[2], H[3]}
    od = __builtin_amdgcn_mfma_f32_32x32x16_bf16(pa0, PKV(l0, h0), od, 0, 0, 0);
    od = __builtin_amdgcn_mfma_f32_32x32x16_bf16(pa1, PKV(l1, h1), od, 0, 0, 0);
    od = __builtin_amdgcn_mfma_f32_32x32x16_bf16(pa2, PKV(l2, h2), od, 0, 0, 0);
    od = __builtin_amdgcn_mfma_f32_32x32x16_bf16(pa3, PKV(l3, h3), od, 0, 0, 0);
#undef PKV
}
__device__ __forceinline__ void pv_d0(f32x16* o, int vb, bf16x8 pa0, bf16x8 pa1, bf16x8 pa2, bf16x8 pa3) {
    pv_one<0>(o[0], vb, pa0, pa1, pa2, pa3); pv_one<1>(o[1], vb, pa0, pa1, pa2, pa3); pv_one<2>(o[2], vb, pa0, pa1, pa2, pa3); pv_one<3>(o[3], vb, pa0, pa1, pa2, pa3);
}
__device__ __forceinline__ void sm_a(f32x16& p0, f32x16& p1, float dq, float slope2) {
#pragma unroll
    for (int r = 0; r < 16; ++r) { const float c = (float)((r & 3) + 8 * (r >> 2)); p0[r] = __builtin_amdgcn_exp2f(p0[r] - slope2 * fabsf(dq - c)); }
#pragma unroll
    for (int r = 0; r < 16; ++r) { const float c = (float)((r & 3) + 8 * (r >> 2) + 32); p1[r] = p1[r] - slope2 * fabsf(dq - c); }
}
__device__ __forceinline__ void sm_b(f32x16& p0, f32x16& p1, float& l_reg, bf16x8& pa0, bf16x8& pa1, bf16x8& pa2, bf16x8& pa3) {
#pragma unroll
    for (int r = 0; r < 16; ++r) p1[r] = __builtin_amdgcn_exp2f(p1[r]);
    float ps = 0;
#pragma unroll
    for (int r = 0; r < 16; ++r) ps += p0[r];
#pragma unroll
    for (int r = 0; r < 16; ++r) ps += p1[r];
    l_reg += swap_add(ps);
    PK4(p0, 0, pa0); PK4(p0, 8, pa1); PK4(p1, 0, pa2); PK4(p1, 8, pa3);
}
__device__ __forceinline__ void attn_body(const bf16_t* __restrict__ Qb, const bf16_t* __restrict__ Kh, const bf16_t* __restrict__ Vh, float* __restrict__ Ob, int q0, float slope2, LAS unsigned char* lds) {
    const int tid = threadIdx.x, wid = tid >> 6, lane = tid & 63, r32 = lane & 31, hi = lane >> 5;
    LAS unsigned char* V_lds = lds; LAS unsigned char* K_lds = lds + 2 * SHM_V;
    LAS float* li_l = (LAS float*)(lds + 2 * SHM_V + 2 * SHM_K) + wid * 64;
    float l_reg = 0; f32x16 o[4] = {}; bf16x8 qr[8];
    const bf16_t* Qw = Qb + (size_t)(wid * QBLK + r32) * LDP + hi * 8;
#pragma unroll
    for (int d0 = 0; d0 < 8; ++d0) qr[d0] = *(const bf16x8*)(Qw + d0 * 16);
    const int sr = tid >> 4, sc = (tid & 15) * 8, vst0 = v_st(sr, sc), vst1 = v_st(32 + sr, sc);
    const int vb0 = (int)(uintptr_t)V_lds + v_rd_base(lane);
    const float dqbase = (float)(q0 + wid * QBLK + r32 - 4 * hi);
    struct { bf16x8 vs0, vs1, ks0, ks1; } sr_[1];
    const unsigned so0 = (unsigned)(sr * LDP + sc) * 2u, so1 = (unsigned)((32 + sr) * LDP + sc) * 2u;
#define SLOAD(i, k0) do { const char* vb_ = (const char*)Vh + (size_t)(k0) * (LDP * 2); const char* kb_ = (const char*)Kh + (size_t)(k0) * (LDP * 2); \
    sr_[i].vs0 = *(const bf16x8*)(vb_ + so0); sr_[i].vs1 = *(const bf16x8*)(vb_ + so1); \
    sr_[i].ks0 = *(const bf16x8*)(kb_ + so0); sr_[i].ks1 = *(const bf16x8*)(kb_ + so1); } while (0)
#define SWRITE(b, i) do { *(LAS bf16x8*)(V_lds + (b) * SHM_V + vst0) = sr_[i].vs0;          \
    *(LAS bf16x8*)(V_lds + (b) * SHM_V + vst1) = sr_[i].vs1; const int kc = sc * 2;               \
    *(LAS bf16x8*)(K_lds + (b) * SHM_K + KSWZ(sr, kc)) = sr_[i].ks0;                       \
    *(LAS bf16x8*)(K_lds + (b) * SHM_K + KSWZ(32 + sr, kc)) = sr_[i].ks1; } while (0)
#define SWAIT() asm volatile("s_waitcnt vmcnt(0)" ::: "memory")
    f32x16 pA0, pA1, pB0, pB1; bf16x8 pa0, pa1, pa2, pa3; constexpr int NT = SEQ / KVBLK;
    SLOAD(0, 0); SWAIT(); SWRITE(0, 0); __syncthreads();
    qkt(pA0, pA1, K_lds, qr, r32, hi); sm_a(pA0, pA1, dqbase, slope2);
    SLOAD(0, KVBLK);
    SWAIT(); SWRITE(1, 0); __syncthreads();
    for (int j = 1; j + 1 < NT; j += 2) {
        SBAR(); qkt(pB0, pB1, K_lds + SHM_K, qr, r32, hi);
        sm_b(pA0, pA1, l_reg, pa0, pa1, pa2, pa3); SBAR();
        SLOAD(0, (j + 1) * KVBLK); SBAR();
        pv_d0(o, vb0, pa0, pa1, pa2, pa3); sm_a(pB0, pB1, dqbase - (float)(j * KVBLK), slope2);
        __syncthreads(); SWAIT(); SWRITE(0, 0);
        __syncthreads();
        SBAR(); qkt(pA0, pA1, K_lds, qr, r32, hi);
        sm_b(pB0, pB1, l_reg, pa0, pa1, pa2, pa3); SBAR();
        SLOAD(0, (j + 2) * KVBLK); SBAR();
        pv_d0(o, vb0 + SHM_V, pa0, pa1, pa2, pa3); sm_a(pA0, pA1, dqbase - (float)((j + 1) * KVBLK), slope2);
        __syncthreads(); SWAIT(); SWRITE(1, 0);
        __syncthreads();
    }
    SBAR(); qkt(pB0, pB1, K_lds + SHM_K, qr, r32, hi);
    sm_b(pA0, pA1, l_reg, pa0, pa1, pa2, pa3); SBAR();
    pv_d0(o, vb0, pa0, pa1, pa2, pa3); sm_a(pB0, pB1, dqbase - (float)((NT - 1) * KVBLK), slope2);
    __syncthreads();
    sm_b(pB0, pB1, l_reg, pa0, pa1, pa2, pa3); SBAR();
    pv_d0(o, vb0 + SHM_V, pa0, pa1, pa2, pa3);
    if (hi == 0) li_l[r32] = l_reg; asm volatile("s_waitcnt lgkmcnt(0)" ::: "memory");
    float rli[16];
#pragma unroll
    for (int r = 0; r < 16; ++r) rli[r] = __builtin_amdgcn_rcpf(li_l[crow(r, hi)]);
    float* Ow = Ob + (size_t)(wid * QBLK) * DM;
#pragma unroll
    for (int r = 0; r < 16; ++r) { const int orow = crow(r, hi);
#pragma unroll
        for (int d0 = 0; d0 < 4; ++d0) Ow[(size_t)orow * DM + d0 * 32 + r32] = o[d0][r] * rli[r]; }
    __syncthreads();
#undef SLOAD
#undef SWRITE
#undef SWAIT
}
}

namespace da2 {
constexpr int BUFB = 65536, KB = 16384;
__device__ __forceinline__ int v_rd_base(int lane) { return ((lane & 3) << 3) | (((lane >> 2) & 3) << 6) | (((lane >> 4) & 1) << 5) | (((lane >> 5) & 1) << 8); }
template <int OFF> __device__ __forceinline__ s16x4 tr_read(int vb) {
    s16x4 r; asm volatile("ds_read_b64_tr_b16 %0, %1 offset:%2" : "=&v"(r) : "v"(vb), "i"(OFF) : "memory"); return r;
}
template <int NCB, int CB> __device__ __forceinline__ void pv_one(f32x16& od, int vb, bf16x8 pa0, bf16x8 pa1, bf16x8 pa2, bf16x8 pa3) {
    constexpr int S = NCB * 512;
    const s16x4 l0 = tr_read<CB * 512 + 0 * S>(vb), h0 = tr_read<CB * 512 + 1 * S>(vb), l1 = tr_read<CB * 512 + 2 * S>(vb), h1 = tr_read<CB * 512 + 3 * S>(vb);
    const s16x4 l2 = tr_read<CB * 512 + 4 * S>(vb), h2 = tr_read<CB * 512 + 5 * S>(vb), l3 = tr_read<CB * 512 + 6 * S>(vb), h3 = tr_read<CB * 512 + 7 * S>(vb);
    asm volatile("s_waitcnt lgkmcnt(0)" ::: "memory"); SBAR();
#define PKV(L, H) (bf16x8){L[0], L[1], L[2], L[3], H[0], H[1], H[2], H[3]}
    od = __builtin_amdgcn_mfma_f32_32x32x16_bf16(pa0, PKV(l0, h0), od, 0, 0, 0);
    od = __builtin_amdgcn_mfma_f32_32x32x16_bf16(pa1, PKV(l1, h1), od, 0, 0, 0);
    od = __builtin_amdgcn_mfma_f32_32x32x16_bf16(pa2, PKV(l2, h2), od, 0, 0, 0);
    od = __builtin_amdgcn_mfma_f32_32x32x16_bf16(pa3, PKV(l3, h3), od, 0, 0, 0);
#undef PKV
}
__device__ __forceinline__ void qkt(f32x16& p0, f32x16& p1, const LAS unsigned char* Ks, const bf16x8* qr, int r32, int hi) {
    p0 = f32x16{}; p1 = f32x16{};
#pragma unroll
    for (int d0 = 0; d0 < 8; ++d0) { const int cb = (d0 * 16 + hi * 8) * 2;
        const bf16x8 b0 = *(const LAS bf16x8*)(Ks + KSWZ(r32, cb));
        const bf16x8 b1 = *(const LAS bf16x8*)(Ks + KSWZ(32 + r32, cb));
        p0 = __builtin_amdgcn_mfma_f32_32x32x16_bf16(b0, qr[d0], p0, 0, 0, 0);
        p1 = __builtin_amdgcn_mfma_f32_32x32x16_bf16(b1, qr[d0], p1, 0, 0, 0); }
}
__device__ __forceinline__ int unswap23(int kk) { return (kk & ~0xC) | ((kk & 4) << 1) | ((kk & 8) >> 1); }

__device__ __forceinline__ void epilogue(const Params& P, LAS unsigned char* lds, f32x16 (&o)[8], float l_reg, int tz, int it) {
    const int wid = __builtin_amdgcn_readfirstlane(tz >> 6), lane = tz & 63, r32 = lane & 31, hi = lane >> 5;
    float lam;
    { float a = P.lam_q1[lane] * P.lam_k1[lane] + P.lam_q1[lane + 64] * P.lam_k1[lane + 64];
      float c = P.lam_q2[lane] * P.lam_k2[lane] + P.lam_q2[lane + 64] * P.lam_k2[lane + 64];
      a = wave_sum(a); c = wave_sum(c); lam = expf(a) - expf(c) + 0.2f; }
    const int br = wid >> 2, w4 = wid & 3;
    const int b = it >> 7, h = (it >> 5) & 3, qt = it & 31;
    const size_t row0 = (size_t)b * SEQ; const int q0 = qt * 128;
    LAS float* li_l = (LAS float*)(lds + SCR_OFF) + wid * 32;
    if (hi == 0) li_l[r32] = l_reg;
    asm volatile("s_waitcnt lgkmcnt(0)" ::: "memory");
    __syncthreads();
    LAS float* X = (LAS float*)lds + w4 * 8192;
    if (br == 1) {
#pragma unroll
        for (int r = 0; r < 16; ++r) { const float rl = __builtin_amdgcn_rcpf(li_l[crow(r, hi)]);
#pragma unroll
            for (int d = 0; d < 8; ++d) X[(r * 8 + d) * 64 + lane] = o[d][r] * rl; }
    }
    __syncthreads();
    if (br == 0) {
        LAS unsigned char* T = (LAS unsigned char*)X;
        float g[8];
#pragma unroll
        for (int d = 0; d < 8; ++d) g[d] = P.subln_b[d * 32 + r32];
#pragma unroll
        for (int r = 0; r < 16; ++r) {
            const float rl = __builtin_amdgcn_rcpf(li_l[crow(r, hi)]);
            float v[8], sq = 0.f;
#pragma unroll
            for (int d = 0; d < 8; ++d) { v[d] = o[d][r] * rl - lam * X[(r * 8 + d) * 64 + lane]; sq += v[d] * v[d]; }
#pragma unroll
            for (int sh = 16; sh >= 1; sh >>= 1) sq += __shfl_xor(sq, sh);
            const float rstd = rsqrtf(sq * (1.0f / 256.0f) + RMS_EPS) * 0.8f;
#pragma unroll
            for (int d = 0; d < 8; ++d) { const unsigned w = cvtpk(v[d] * rstd * g[d], 0.f); *(LAS bf16_t*)(T + (2 * r + hi) * 512 + (d * 32 + r32) * 2) = (bf16_t)(w & 0xffffu); }
        }
        asm volatile("s_waitcnt lgkmcnt(0)" ::: "memory");
        char* mixb = (char*)((bf16_t*)(P.ws + WS_MIX) + (row0 + q0 + w4 * 32) * DM + 1024 + h * 256);
        const unsigned loff = (unsigned)(hi * 4 * DM * 2 + r32 * 16);
#pragma unroll
        for (int i = 0; i < 16; ++i) {
            const u32x4 w = *(const LAS u32x4*)(T + (2 * i + hi) * 512 + r32 * 16);
            *(u32x4*)(mixb + (size_t)((i & 3) + 8 * (i >> 2)) * (DM * 2) + loff) = w;
        }
    }
    __syncthreads();
}
__device__ __forceinline__ void item(const Params& P, int it, LAS unsigned char* lds) {
    int tid = threadIdx.x; asm volatile("" : "+v"(tid));
    const int wid = __builtin_amdgcn_readfirstlane(tid >> 6), lane = tid & 63, r32 = lane & 31, hi = lane >> 5;
    const int br = wid >> 2, w4 = wid & 3;
    const int b = it >> 7, h = (it >> 5) & 3, qt = it & 31;
    const bf16_t* proj = (const bf16_t*)(P.ws + WS_PROJ);
    const size_t row0 = (size_t)b * SEQ; const int q0 = qt * 128;
    bf16x8 qr[8];
    { const bf16_t* Qw = proj + (row0 + q0 + w4 * 32 + r32) * INC + 3072 + br * 512 + h * 128 + hi * 8;
#pragma unroll
      for (int d0 = 0; d0 < 8; ++d0) qr[d0] = *(const bf16x8*)(Qw + d0 * 16); }
    const char* kbase = (const char*)(proj + row0 * INC + 4096 + h * 128);
    const char* vbase = (const char*)(proj + row0 * INC + 5120 + h * 256);
    const int krow = wid * 8 + (lane >> 4);
    const unsigned voffK0 = (unsigned)(krow * INC * 2 + (((lane & 15) ^ (lane >> 4)) << 4));
    const unsigned voffK1 = (unsigned)((krow + 4) * INC * 2 + (((lane & 15) ^ (4 + (lane >> 4))) << 4));
    const unsigned voffV = (unsigned)(unswap23(wid * 8 + ((lane & 31) >> 2)) * INC * 2 + (lane >> 5) * 64 + (lane & 3) * 16);
#define DA2_ISSUE(t, bufi) do { const char* kb_ = kbase + (size_t)(t) * (64 * INC * 2); const char* vb_ = vbase + (size_t)(t) * (64 * INC * 2); \
        LAS unsigned char* lb_ = lds + (bufi) * BUFB; \
        __builtin_amdgcn_global_load_lds((const unsigned*)(kb_ + voffK0), (LAS unsigned*)(lb_ + wid * 2048), 16, 0, 0); \
        __builtin_amdgcn_global_load_lds((const unsigned*)(kb_ + voffK1), (LAS unsigned*)(lb_ + wid * 2048 + 1024), 16, 0, 0); \
        __builtin_amdgcn_global_load_lds((const unsigned*)(kb_ + 1024 + voffK0), (LAS unsigned*)(lb_ + KB + wid * 2048), 16, 0, 0); \
        __builtin_amdgcn_global_load_lds((const unsigned*)(kb_ + 1024 + voffK1), (LAS unsigned*)(lb_ + KB + wid * 2048 + 1024), 16, 0, 0); \
        _Pragma("unroll") for (int i_ = 0; i_ < 4; ++i_) \
            __builtin_amdgcn_global_load_lds((const unsigned*)(vb_ + i_ * 128 + voffV), (LAS unsigned*)(lb_ + 2 * KB + wid * 4096 + i_ * 1024), 16, 0, 0); } while (0)
    const float slope2 = exp2f(-2.0f * (float)(h + 1)) * LOG2E;
    float dq = (float)(q0 + w4 * 32 + r32 - 4 * hi);
    f32x16 o[8];
#pragma unroll
    for (int d = 0; d < 8; ++d) o[d] = f32x16{};
    float l_reg = 0.f;
    const int vb0 = (int)(uintptr_t)(lds + 2 * KB) + v_rd_base(lane);
    DA2_ISSUE(0, 0);
#pragma unroll 1
    for (int j = 0; j < SEQ / 64; ++j) {
        asm volatile("s_waitcnt vmcnt(0)" ::: "memory");
        __builtin_amdgcn_s_barrier();
        asm volatile("" ::: "memory");
        if (j + 1 < SEQ / 64) DA2_ISSUE(j + 1, (j + 1) & 1);
        const LAS unsigned char* Kb = lds + (j & 1) * BUFB + br * KB;
        f32x16 p0, p1;
        qkt(p0, p1, Kb, qr, r32, hi);
        float ps = 0.f;
#pragma unroll
        for (int r = 0; r < 16; ++r) { const float c = (float)((r & 3) + 8 * (r >> 2)); p0[r] = __builtin_amdgcn_exp2f(p0[r] - slope2 * fabsf(dq - c)); ps += p0[r]; }
#pragma unroll
        for (int r = 0; r < 16; ++r) { const float c = (float)((r & 3) + 8 * (r >> 2) + 32); p1[r] = __builtin_amdgcn_exp2f(p1[r] - slope2 * fabsf(dq - c)); ps += p1[r]; }
        l_reg += swap_add(ps);
        bf16x8 pa0, pa1, pa2, pa3;
        PK4(p0, 0, pa0); PK4(p0, 8, pa1); PK4(p1, 0, pa2); PK4(p1, 8, pa3);
        const int vb = vb0 + (j & 1) * BUFB;
        pv_one<8, 0>(o[0], vb, pa0, pa1, pa2, pa3); pv_one<8, 1>(o[1], vb, pa0, pa1, pa2, pa3); pv_one<8, 2>(o[2], vb, pa0, pa1, pa2, pa3); pv_one<8, 3>(o[3], vb, pa0, pa1, pa2, pa3);
        pv_one<8, 4>(o[4], vb, pa0, pa1, pa2, pa3); pv_one<8, 5>(o[5], vb, pa0, pa1, pa2, pa3); pv_one<8, 6>(o[6], vb, pa0, pa1, pa2, pa3); pv_one<8, 7>(o[7], vb, pa0, pa1, pa2, pa3);
        dq -= 64.0f;
    }
#undef DA2_ISSUE
    int tz = threadIdx.x; asm volatile("" : "+v"(tz));
    epilogue(P, lds, o, l_reg, tz, it);
}
}

namespace da3 {
constexpr int BUFB = 65536, KB = 16384;
__device__ __forceinline__ void qk_softmax(const LAS unsigned char* Kb, const bf16x8* qr, int r32, int hi, float dq, float slope2, int rel  ,
                                           float& l_reg, bf16x8& pa0, bf16x8& pa1, bf16x8& pa2, bf16x8& pa3) {
    f32x16 p0, p1;
    if (rel != 0) {
        const float ss = rel < 0 ? slope2 : -slope2, A = -ss * dq;
#pragma unroll
        for (int r = 0; r < 16; ++r) { const float c = (float)((r & 3) + 8 * (r >> 2)); p0[r] = fmaf(ss, c, A); p1[r] = fmaf(ss, c + 32.0f, A); }
    } else {
#pragma unroll
        for (int r = 0; r < 16; ++r) { const float c = (float)((r & 3) + 8 * (r >> 2)); p0[r] = -slope2 * fabsf(dq - c); p1[r] = -slope2 * fabsf(dq - c - 32.0f); }
    }
#pragma unroll
    for (int d0 = 0; d0 < 8; ++d0) { const int cb = (d0 * 16 + hi * 8) * 2;
        const bf16x8 b0 = *(const LAS bf16x8*)(Kb + KSWZ(r32, cb));
        const bf16x8 b1 = *(const LAS bf16x8*)(Kb + KSWZ(32 + r32, cb));
        p0 = __builtin_amdgcn_mfma_f32_32x32x16_bf16(b0, qr[d0], p0, 0, 0, 0);
        p1 = __builtin_amdgcn_mfma_f32_32x32x16_bf16(b1, qr[d0], p1, 0, 0, 0); }
    f32x2 s2 = {0.f, 0.f};
#pragma unroll
    for (int r = 0; r < 16; r += 2) { p0[r] = __builtin_amdgcn_exp2f(p0[r]); p0[r + 1] = __builtin_amdgcn_exp2f(p0[r + 1]); s2 += (f32x2){p0[r], p0[r + 1]}; }
#pragma unroll
    for (int r = 0; r < 16; r += 2) { p1[r] = __builtin_amdgcn_exp2f(p1[r]); p1[r + 1] = __builtin_amdgcn_exp2f(p1[r + 1]); s2 += (f32x2){p1[r], p1[r + 1]}; }
    l_reg += swap_add(s2[0] + s2[1]);
    PK4(p0, 0, pa0); PK4(p0, 8, pa1); PK4(p1, 0, pa2); PK4(p1, 8, pa3);
}
struct VFrag { s16x4 l0, h0, l1, h1, l2, h2, l3, h3; };
template <int CB> __device__ __forceinline__ void vread(VFrag& f, int vb) {
    constexpr int S = 8 * 512;
    f.l0 = da2::tr_read<CB * 512 + 0 * S>(vb); f.h0 = da2::tr_read<CB * 512 + 1 * S>(vb); f.l1 = da2::tr_read<CB * 512 + 2 * S>(vb); f.h1 = da2::tr_read<CB * 512 + 3 * S>(vb);
    f.l2 = da2::tr_read<CB * 512 + 4 * S>(vb); f.h2 = da2::tr_read<CB * 512 + 5 * S>(vb); f.l3 = da2::tr_read<CB * 512 + 6 * S>(vb); f.h3 = da2::tr_read<CB * 512 + 7 * S>(vb);
}
__device__ __forceinline__ void vmma(f32x16& od, const VFrag& f, bf16x8 pa0, bf16x8 pa1, bf16x8 pa2, bf16x8 pa3) {
#define PKV(L, H) (bf16x8){L[0], L[1], L[2], L[3], H[0], H[1], H[2], H[3]}
    od = __builtin_amdgcn_mfma_f32_32x32x16_bf16(pa0, PKV(f.l0, f.h0), od, 0, 0, 0);
    od = __builtin_amdgcn_mfma_f32_32x32x16_bf16(pa1, PKV(f.l1, f.h1), od, 0, 0, 0);
    od = __builtin_amdgcn_mfma_f32_32x32x16_bf16(pa2, PKV(f.l2, f.h2), od, 0, 0, 0);
    od = __builtin_amdgcn_mfma_f32_32x32x16_bf16(pa3, PKV(f.l3, f.h3), od, 0, 0, 0);
#undef PKV
}
#define DA3_LW(n) do { asm volatile("s_waitcnt lgkmcnt(" #n ")" ::: "memory"); SBAR(); } while (0)
__device__ __forceinline__ void pv8(f32x16 (&o)[8], int vb, bf16x8 pa0, bf16x8 pa1, bf16x8 pa2, bf16x8 pa3) {
    VFrag fa, fb;
    vread<0>(fa, vb);
    vread<1>(fb, vb); DA3_LW(8); vmma(o[0], fa, pa0, pa1, pa2, pa3);
    vread<2>(fa, vb); DA3_LW(8); vmma(o[1], fb, pa0, pa1, pa2, pa3);
    vread<3>(fb, vb); DA3_LW(8); vmma(o[2], fa, pa0, pa1, pa2, pa3);
    vread<4>(fa, vb); DA3_LW(8); vmma(o[3], fb, pa0, pa1, pa2, pa3);
    vread<5>(fb, vb); DA3_LW(8); vmma(o[4], fa, pa0, pa1, pa2, pa3);
    vread<6>(fa, vb); DA3_LW(8); vmma(o[5], fb, pa0, pa1, pa2, pa3);
    vread<7>(fb, vb); DA3_LW(8); vmma(o[6], fa, pa0, pa1, pa2, pa3);
    DA3_LW(0); vmma(o[7], fb, pa0, pa1, pa2, pa3);
}
__device__ __forceinline__ void item(const Params& P, int it, LAS unsigned char* lds) {
    int tid = threadIdx.x; asm volatile("" : "+v"(tid));
    const int wid = __builtin_amdgcn_readfirstlane(tid >> 6), lane = tid & 63, r32 = lane & 31, hi = lane >> 5;
    const int br = wid >> 2, w4 = wid & 3;
    const int b = it >> 7, h = (it >> 5) & 3, qt = it & 31;
    const bf16_t* proj = (const bf16_t*)(P.ws + WS_PROJ);
    const size_t row0 = (size_t)b * SEQ; const int q0 = qt * 128;
    bf16x8 qr[8];
    { const bf16_t* Qw = proj + (row0 + q0 + w4 * 32 + r32) * INC + 3072 + br * 512 + h * 128 + hi * 8;
#pragma unroll
      for (int d0 = 0; d0 < 8; ++d0) qr[d0] = *(const bf16x8*)(Qw + d0 * 16); }
    const char* kbase = (const char*)(proj + row0 * INC + 4096 + br * 512 + h * 128);
    const char* vbase = (const char*)(proj + row0 * INC + 5120 + h * 256);
#define DA3_LANE() int lz_ = lane; asm volatile("" : "+v"(lz_)); const int krow_ = w4 * 16 + (lz_ >> 4)
#define DA3_ISSUE_K(t, bufi) do { DA3_LANE(); \
        const unsigned voffK0 = (unsigned)(krow_ * INC * 2 + (((lz_ & 15) ^ (lz_ >> 4)) << 4)); \
        const unsigned voffK1 = (unsigned)((krow_ + 4) * INC * 2 + (((lz_ & 15) ^ (4 + (lz_ >> 4))) << 4)); \
        const char* kb_ = kbase + (size_t)(t) * (64 * INC * 2); LAS unsigned char* lb_ = lds + (bufi) * BUFB + br * KB + w4 * 4096; \
        __builtin_amdgcn_global_load_lds((const unsigned*)(kb_ + voffK0), (LAS unsigned*)(lb_), 16, 0, 0); \
        __builtin_amdgcn_global_load_lds((const unsigned*)(kb_ + voffK1), (LAS unsigned*)(lb_ + 1024), 16, 0, 0); \
        __builtin_amdgcn_global_load_lds((const unsigned*)(kb_ + 8 * INC * 2 + voffK0), (LAS unsigned*)(lb_ + 2048), 16, 0, 0); \
        __builtin_amdgcn_global_load_lds((const unsigned*)(kb_ + 8 * INC * 2 + voffK1), (LAS unsigned*)(lb_ + 3072), 16, 0, 0); } while (0)
#define DA3_ISSUE_V(t, bufi) do { DA3_LANE(); (void)krow_; \
        const unsigned voffV = (unsigned)(da2::unswap23(wid * 8 + ((lz_ & 31) >> 2)) * INC * 2 + (lz_ >> 5) * 64 + (lz_ & 3) * 16); \
        const char* vb_ = vbase + (size_t)(t) * (64 * INC * 2); LAS unsigned char* lb_ = lds + (bufi) * BUFB + 2 * KB + wid * 4096; \
        _Pragma("unroll") for (int i_ = 0; i_ < 4; ++i_) \
            __builtin_amdgcn_global_load_lds((const unsigned*)(vb_ + i_ * 128 + voffV), (LAS unsigned*)(lb_ + i_ * 1024), 16, 0, 0); } while (0)
#define DA3_BAR() do { asm volatile("" ::: "memory"); __builtin_amdgcn_s_barrier(); asm volatile("" ::: "memory"); } while (0)
    const float slope2 = exp2f(-2.0f * (float)(h + 1)) * LOG2E;
    const int qlo = q0 + w4 * 32, jd = qlo >> 6;
    int jlo = 0, jhi = SEQ / 64 - 1;
    { float gq = fmaxf(fabsf(P.qn_b[lane]), fabsf(P.qn_b[lane + 64])), gk = fmaxf(fabsf(P.kn_b[lane]), fabsf(P.kn_b[lane + 64]));
#pragma unroll
      for (int o_ = 32; o_ >= 1; o_ >>= 1) { gq = fmaxf(gq, __shfl_xor(gq, o_)); gk = fmaxf(gk, __shfl_xor(gk, o_)); }
      const float smax = 128.0f * QSCALE * gq * gk, dmax = (160.0f + smax) / slope2;
      const int di = dmax < 8192.0f ? (int)dmax + 1 : 8192;
      const int klo = q0 - di, khi = q0 + 127 + di;
      jlo = __builtin_amdgcn_readfirstlane(klo <= 0 ? 0 : (klo >> 6)); jhi = __builtin_amdgcn_readfirstlane(khi >= SEQ - 1 ? SEQ / 64 - 1 : (khi >> 6)); }
    float dq = (float)(qlo + r32 - 4 * hi - 64 * jlo);
    f32x16 o[8];
#pragma unroll
    for (int d = 0; d < 8; ++d) o[d] = f32x16{};
    float l_reg = 0.f;
    const int vb0 = (int)(uintptr_t)(lds + 2 * KB) + da2::v_rd_base(lane);
    bf16x8 pa0, pa1, pa2, pa3;
    DA3_ISSUE_K(jlo, 0); DA3_ISSUE_V(jlo, 0);
    if (br == 0) {
        asm volatile("s_waitcnt vmcnt(4)" ::: "memory");
#pragma unroll 1
        for (int j = jlo; j <= jhi; ++j) {
            const int jn = (j + 1 <= jhi) ? j + 1 : jhi, bc = (j - jlo) & 1, bn = bc ^ 1;
            DA3_BAR();
            DA3_ISSUE_K(jn, bn);
            qk_softmax(lds + bc * BUFB, qr, r32, hi, dq, slope2, j - jd, l_reg, pa0, pa1, pa2, pa3);
            asm volatile("s_waitcnt vmcnt(4)" ::: "memory");
            DA3_BAR();
            DA3_ISSUE_V(jn, bn);
            pv8(o, vb0 + bc * BUFB, pa0, pa1, pa2, pa3);
            asm volatile("s_waitcnt vmcnt(4)" ::: "memory");
            dq -= 64.0f;
        }
        DA3_BAR();
    } else {
        DA3_BAR();
        asm volatile("s_waitcnt vmcnt(0)" ::: "memory");
#pragma unroll 1
        for (int j = jlo; j <= jhi; ++j) {
            const int jn = (j + 1 <= jhi) ? j + 1 : jhi, bc = (j - jlo) & 1, bn = bc ^ 1;
            DA3_BAR();
            DA3_ISSUE_K(jn, bn); DA3_ISSUE_V(jn, bn);
            qk_softmax(lds + bc * BUFB + KB, qr, r32, hi, dq, slope2, j - jd, l_reg, pa0, pa1, pa2, pa3);
            DA3_BAR();
            pv8(o, vb0 + bc * BUFB, pa0, pa1, pa2, pa3);
            asm volatile("s_waitcnt vmcnt(0)" ::: "memory");
            dq -= 64.0f;
        }
    }
#undef DA3_ISSUE_K
#undef DA3_LANE
#undef DA3_ISSUE_V
#undef DA3_BAR
    asm volatile("s_waitcnt vmcnt(0)" ::: "memory");
    int tz = threadIdx.x; asm volatile("" : "+v"(tz));
    da2::epilogue(P, lds, o, l_reg, tz, it);
}
}

namespace da5 {
constexpr int BUFB = 65536, KB = 16384;
typedef float f32x4v __attribute__((ext_vector_type(4)));
template <int OFF> __device__ __forceinline__ s16x4 trr(int a) { s16x4 r; asm volatile("ds_read_b64_tr_b16 %0, %1 offset:%2" : "=&v"(r) : "v"(a), "i"(OFF) : "memory"); return r; }
#define D5_LW(n) do { asm volatile("s_waitcnt lgkmcnt(" #n ")" ::: "memory"); SBAR(); } while (0)

__device__ __forceinline__ void qk_softmax(const LAS unsigned char* Kb, const bf16x8 (&qr)[4][2], int lane_, float dqb, float slope2, int rel, float (&l)[2], bf16x8 (&pa)[2][2]) {
    asm volatile("" : "+v"(lane_));
    const int l16 = lane_ & 15, g = lane_ >> 4;
    f32x4v S[4][2];
    if (rel != 0) {
        const float ss = rel < 0 ? slope2 : -slope2, A = -ss * dqb;
#pragma unroll
        for (int kg = 0; kg < 4; ++kg)
#pragma unroll
            for (int qg = 0; qg < 2; ++qg)
#pragma unroll
                for (int r = 0; r < 4; ++r) S[kg][qg][r] = fmaf(ss, (float)(16 * kg + r - 16 * qg), A);
    } else {
#pragma unroll
        for (int kg = 0; kg < 4; ++kg)
#pragma unroll
            for (int qg = 0; qg < 2; ++qg)
#pragma unroll
                for (int r = 0; r < 4; ++r) S[kg][qg][r] = -slope2 * fabsf(dqb - (float)(16 * kg + r - 16 * qg));
    }
    const int krow = l16 * 256, kx = (l16 & 7) << 4;
#pragma unroll
    for (int s = 0; s < 4; ++s) {
        const int ka = krow + ((64 * s + 16 * g) ^ kx);
        const bf16x8 k0 = *(const LAS bf16x8*)(Kb + ka), k1 = *(const LAS bf16x8*)(Kb + ka + 4096), k2 = *(const LAS bf16x8*)(Kb + ka + 8192), k3 = *(const LAS bf16x8*)(Kb + ka + 12288);
#pragma unroll
        for (int qg = 0; qg < 2; ++qg) {
            S[0][qg] = __builtin_amdgcn_mfma_f32_16x16x32_bf16(k0, qr[s][qg], S[0][qg], 0, 0, 0);
            S[1][qg] = __builtin_amdgcn_mfma_f32_16x16x32_bf16(k1, qr[s][qg], S[1][qg], 0, 0, 0);
            S[2][qg] = __builtin_amdgcn_mfma_f32_16x16x32_bf16(k2, qr[s][qg], S[2][qg], 0, 0, 0);
            S[3][qg] = __builtin_amdgcn_mfma_f32_16x16x32_bf16(k3, qr[s][qg], S[3][qg], 0, 0, 0);
        }
    }
#pragma unroll
    for (int qg = 0; qg < 2; ++qg) {
        f32x2 s2 = {0.f, 0.f};
#pragma unroll
        for (int kg = 0; kg < 4; ++kg) {
#pragma unroll
            for (int r = 0; r < 4; ++r) S[kg][qg][r] = __builtin_amdgcn_exp2f(S[kg][qg][r]);
            s2 += (f32x2){S[kg][qg][0], S[kg][qg][1]}; s2 += (f32x2){S[kg][qg][2], S[kg][qg][3]};
        }
        float ps = s2[0] + s2[1];
        ps += __shfl_xor(ps, 16); ps += __shfl_xor(ps, 32);
        l[qg] += ps;
#pragma unroll
        for (int ks = 0; ks < 2; ++ks) {
            u32x4 w; w.x = cvtpk(S[2 * ks][qg][0], S[2 * ks][qg][1]); w.y = cvtpk(S[2 * ks][qg][2], S[2 * ks][qg][3]);
            w.z = cvtpk(S[2 * ks + 1][qg][0], S[2 * ks + 1][qg][1]); w.w = cvtpk(S[2 * ks + 1][qg][2], S[2 * ks + 1][qg][3]);
            pa[qg][ks] = *reinterpret_cast<bf16x8*>(&w);
        }
    }
}
struct VF { s16x4 a0, a1, b0, b1; };
template <int HI> __device__ __forceinline__ void vread(VF& f, int a) {
    f.a0 = trr<HI * 256 + 0>(a); f.a1 = trr<HI * 256 + 8192>(a); f.b0 = trr<HI * 256 + 16384>(a); f.b1 = trr<HI * 256 + 24576>(a);
}
__device__ __forceinline__ void vmma(f32x4v& o0, f32x4v& o1, const VF& f, const bf16x8 (&pa)[2][2]) {
#define PKV(L, H) (bf16x8){L[0], L[1], L[2], L[3], H[0], H[1], H[2], H[3]}
    const bf16x8 v0 = PKV(f.a0, f.a1), v1 = PKV(f.b0, f.b1);
    o0 = __builtin_amdgcn_mfma_f32_16x16x32_bf16(pa[0][0], v0, o0, 0, 0, 0);
    o1 = __builtin_amdgcn_mfma_f32_16x16x32_bf16(pa[1][0], v0, o1, 0, 0, 0);
    o0 = __builtin_amdgcn_mfma_f32_16x16x32_bf16(pa[0][1], v1, o0, 0, 0, 0);
    o1 = __builtin_amdgcn_mfma_f32_16x16x32_bf16(pa[1][1], v1, o1, 0, 0, 0);
#undef PKV
}
__device__ __forceinline__ void pv16(f32x4v (&o)[2][16], int vbuf, int lane_, const bf16x8 (&pa)[2][2]) {
    asm volatile("" : "+v"(lane_));
    const int l16 = lane_ & 15, g = lane_ >> 4, q4 = l16 >> 2, p = l16 & 3;
    const int lb = (4 * g + q4) * 512 + ((4 * (g & 1) + q4) << 5) + 8 * p;
    VF fa, fb;
#define VA(vt) (vbuf + (lb ^ (((vt) & 7) << 5)))
    vread<0>(fa, VA(0));
    vread<0>(fb, VA(1)); D5_LW(4); vmma(o[0][0], o[1][0], fa, pa);
    vread<0>(fa, VA(2)); D5_LW(4); vmma(o[0][1], o[1][1], fb, pa);
    vread<0>(fb, VA(3)); D5_LW(4); vmma(o[0][2], o[1][2], fa, pa);
    vread<0>(fa, VA(4)); D5_LW(4); vmma(o[0][3], o[1][3], fb, pa);
    vread<0>(fb, VA(5)); D5_LW(4); vmma(o[0][4], o[1][4], fa, pa);
    vread<0>(fa, VA(6)); D5_LW(4); vmma(o[0][5], o[1][5], fb, pa);
    vread<0>(fb, VA(7)); D5_LW(4); vmma(o[0][6], o[1][6], fa, pa);
    vread<1>(fa, VA(8)); D5_LW(4); vmma(o[0][7], o[1][7], fb, pa);
    vread<1>(fb, VA(9)); D5_LW(4); vmma(o[0][8], o[1][8], fa, pa);
    vread<1>(fa, VA(10)); D5_LW(4); vmma(o[0][9], o[1][9], fb, pa);
    vread<1>(fb, VA(11)); D5_LW(4); vmma(o[0][10], o[1][10], fa, pa);
    vread<1>(fa, VA(12)); D5_LW(4); vmma(o[0][11], o[1][11], fb, pa);
    vread<1>(fb, VA(13)); D5_LW(4); vmma(o[0][12], o[1][12], fa, pa);
    vread<1>(fa, VA(14)); D5_LW(4); vmma(o[0][13], o[1][13], fb, pa);
    vread<1>(fb, VA(15)); D5_LW(4); vmma(o[0][14], o[1][14], fa, pa);
    D5_LW(0); vmma(o[0][15], o[1][15], fb, pa);
#undef VA
}
__device__ __forceinline__ void epilogue(const Params& P, LAS unsigned char* lds, f32x4v (&o)[2][16], const float (&l)[2], int tz, int it) {
    const int wid = __builtin_amdgcn_readfirstlane(tz >> 6), lane = tz & 63, l16 = lane & 15, g = lane >> 4;
    float lam;
    { float a = P.lam_q1[lane] * P.lam_k1[lane] + P.lam_q1[lane + 64] * P.lam_k1[lane + 64];
      float c = P.lam_q2[lane] * P.lam_k2[lane] + P.lam_q2[lane + 64] * P.lam_k2[lane + 64];
      a = wave_sum(a); c = wave_sum(c); lam = expf(a) - expf(c) + 0.2f; }
    const int br = wid >> 2, w4 = wid & 3;
    const int b = it >> 7, h = (it >> 5) & 3, qt = it & 31;
    const size_t row0 = (size_t)b * SEQ; const int q0 = qt * 128;
    LAS float* li_l = (LAS float*)(lds + SCR_OFF) + wid * 32;
    if (g == 0) { li_l[l16] = l[0]; li_l[16 + l16] = l[1]; }
    asm volatile("s_waitcnt lgkmcnt(0)" ::: "memory");
    __syncthreads();
    LAS float* X = (LAS float*)lds + w4 * 8192;
    if (br == 1) {
#pragma unroll
        for (int qg = 0; qg < 2; ++qg)
#pragma unroll
            for (int r = 0; r < 4; ++r) { const float rl = __builtin_amdgcn_rcpf(li_l[16 * qg + 4 * g + r]);
#pragma unroll
                for (int vt = 0; vt < 16; ++vt) X[((qg * 4 + r) * 16 + vt) * 64 + lane] = o[qg][vt][r] * rl; }
    }
    __syncthreads();
    if (br == 0) {
        LAS unsigned char* T = (LAS unsigned char*)X;
        float gw[16];
#pragma unroll
        for (int vt = 0; vt < 16; ++vt) gw[vt] = P.subln_b[16 * vt + l16];
#pragma unroll
        for (int qg = 0; qg < 2; ++qg)
#pragma unroll
            for (int r = 0; r < 4; ++r) {
                const int u = qg * 4 + r;
                const float rl = __builtin_amdgcn_rcpf(li_l[16 * qg + 4 * g + r]);
                float v[16], sq = 0.f;
#pragma unroll
                for (int vt = 0; vt < 16; ++vt) { v[vt] = o[qg][vt][r] * rl - lam * X[(u * 16 + vt) * 64 + lane]; sq += v[vt] * v[vt]; }
                sq += __shfl_xor(sq, 1); sq += __shfl_xor(sq, 2); sq += __shfl_xor(sq, 4); sq += __shfl_xor(sq, 8);
                const float rstd = rsqrtf(sq * (1.0f / 256.0f) + RMS_EPS) * 0.8f;
#pragma unroll
                for (int vt = 0; vt < 16; ++vt) { const unsigned w = cvtpk(v[vt] * rstd * gw[vt], 0.f); *(LAS bf16_t*)(T + (4 * u + g) * 512 + (16 * vt + l16) * 2) = (bf16_t)(w & 0xffffu); }
            }
        asm volatile("s_waitcnt lgkmcnt(0)" ::: "memory");
        char* mixb = (char*)((bf16_t*)(P.ws + WS_MIX) + (row0 + q0 + w4 * 32) * DM + 1024 + h * 256);
#pragma unroll
        for (int i = 0; i < 16; ++i) {
            const int ti = 2 * i + (lane >> 5), u = ti >> 2, gg = ti & 3, q = 16 * (u >> 2) + 4 * gg + (u & 3);
            const u32x4 w = *(const LAS u32x4*)(T + ti * 512 + (lane & 31) * 16);
            *(u32x4*)(mixb + (size_t)q * (DM * 2) + (lane & 31) * 16) = w;
        }
    }
    __syncthreads();
}
__device__ __forceinline__ void item(const Params& P, int it, LAS unsigned char* lds) {
    int tid = threadIdx.x; asm volatile("" : "+v"(tid));
    const int wid = __builtin_amdgcn_readfirstlane(tid >> 6), lane = tid & 63, l16 = lane & 15, g = lane >> 4;
    const int br = wid >> 2, w4 = wid & 3;
    const int b = it >> 7, h = (it >> 5) & 3, qt = it & 31;
    const bf16_t* proj = (const bf16_t*)(P.ws + WS_PROJ);
    const size_t row0 = (size_t)b * SEQ; const int q0 = qt * 128;
    bf16x8 qr[4][2];
    { const bf16_t* Qw = proj + (row0 + q0 + w4 * 32 + l16) * INC + 3072 + br * 512 + h * 128 + 8 * g;
#pragma unroll
      for (int s = 0; s < 4; ++s)
#pragma unroll
          for (int qg = 0; qg < 2; ++qg) qr[s][qg] = *(const bf16x8*)(Qw + (size_t)(16 * qg) * INC + 32 * s); }
    const char* kbase = (const char*)(proj + row0 * INC + 4096 + br * 512 + h * 128);
    const char* vbase = (const char*)(proj + row0 * INC + 5120 + h * 256);
#define D5_LANE() int lz_ = lane; asm volatile("" : "+v"(lz_))
#define D5_ISSUE_K(t, bufi) do { D5_LANE(); const int krow_ = w4 * 16 + (lz_ >> 4); \
        const unsigned voffK0 = (unsigned)(krow_ * INC * 2 + (((lz_ & 15) ^ (lz_ >> 4)) << 4)); \
        const unsigned voffK1 = (unsigned)((krow_ + 4) * INC * 2 + (((lz_ & 15) ^ (4 + (lz_ >> 4))) << 4)); \
        const char* kb_ = kbase + (size_t)(t) * (64 * INC * 2); LAS unsigned char* lb_ = lds + (bufi) * BUFB + br * KB + w4 * 4096; \
        __builtin_amdgcn_global_load_lds((const unsigned*)(kb_ + voffK0), (LAS unsigned*)(lb_), 16, 0, 0); \
        __builtin_amdgcn_global_load_lds((const unsigned*)(kb_ + voffK1), (LAS unsigned*)(lb_ + 1024), 16, 0, 0); \
        __builtin_amdgcn_global_load_lds((const unsigned*)(kb_ + 8 * INC * 2 + voffK0), (LAS unsigned*)(lb_ + 2048), 16, 0, 0); \
        __builtin_amdgcn_global_load_lds((const unsigned*)(kb_ + 8 * INC * 2 + voffK1), (LAS unsigned*)(lb_ + 3072), 16, 0, 0); } while (0)
#define D5_ISSUE_V(t, bufi) do { D5_LANE(); const char* vb_ = vbase + (size_t)(t) * (64 * INC * 2) + (size_t)(wid * 8) * (INC * 2); LAS unsigned char* lb_ = lds + (bufi) * BUFB + 2 * KB + wid * 4096; \
        _Pragma("unroll") for (int i_ = 0; i_ < 4; ++i_) { const int rr_ = 2 * i_ + (lz_ >> 5); \
            const unsigned vo_ = (unsigned)(rr_ * INC * 2 + (((lz_ & 31) ^ (rr_ << 1)) << 4)); \
            __builtin_amdgcn_global_load_lds((const unsigned*)(vb_ + vo_), (LAS unsigned*)(lb_ + i_ * 1024), 16, 0, 0); } } while (0)
#define D5_BAR() do { asm volatile("" ::: "memory"); __builtin_amdgcn_s_barrier(); asm volatile("" ::: "memory"); } while (0)
    const float slope2 = __int_as_float(__builtin_amdgcn_readfirstlane(__float_as_int(exp2f(-2.0f * (float)(h + 1)) * LOG2E)));
    const int qlo = q0 + w4 * 32, jd = qlo >> 6;
    int jlo = 0, jhi = SEQ / 64 - 1;
    { float gq = fmaxf(fabsf(P.qn_b[lane]), fabsf(P.qn_b[lane + 64])), gk = fmaxf(fabsf(P.kn_b[lane]), fabsf(P.kn_b[lane + 64]));
#pragma unroll
      for (int o_ = 32; o_ >= 1; o_ >>= 1) { gq = fmaxf(gq, __shfl_xor(gq, o_)); gk = fmaxf(gk, __shfl_xor(gk, o_)); }
      const float smax = 128.0f * QSCALE * gq * gk, dmax = (160.0f + smax) / slope2;
      const int di = dmax < 8192.0f ? (int)dmax + 1 : 8192;
      const int klo = q0 - di, khi = q0 + 127 + di;
      jlo = __builtin_amdgcn_readfirstlane(klo <= 0 ? 0 : (klo >> 6)); jhi = __builtin_amdgcn_readfirstlane(khi >= SEQ - 1 ? SEQ / 64 - 1 : (khi >> 6)); }
    float dqb = (float)(qlo + l16 - 4 * g - 64 * jlo);
    f32x4v o[2][16];
#pragma unroll
    for (int qg = 0; qg < 2; ++qg)
#pragma unroll
        for (int vt = 0; vt < 16; ++vt) o[qg][vt] = (f32x4v){0.f, 0.f, 0.f, 0.f};
    float l[2] = {0.f, 0.f};
    const int vbuf0 = (int)(uintptr_t)(lds + 2 * KB);
    bf16x8 pa[2][2];
    D5_ISSUE_K(jlo, 0); D5_ISSUE_V(jlo, 0);
    if (br == 0) {
        asm volatile("s_waitcnt vmcnt(4)" ::: "memory");
#pragma unroll 1
        for (int j = jlo; j <= jhi; ++j) {
            const int jn = (j + 1 <= jhi) ? j + 1 : jhi, bc = (j - jlo) & 1, bn = bc ^ 1;
            D5_BAR();
            D5_ISSUE_K(jn, bn);
            qk_softmax(lds + bc * BUFB, qr, lane, dqb, slope2, j - jd, l, pa);
            asm volatile("s_waitcnt vmcnt(4)" ::: "memory");
            D5_BAR();
            D5_ISSUE_V(jn, bn);
            pv16(o, vbuf0 + bc * BUFB, lane, pa);
            asm volatile("s_waitcnt vmcnt(4)" ::: "memory");
            dqb -= 64.0f;
        }
        D5_BAR();
    } else {
        D5_BAR();
        asm volatile("s_waitcnt vmcnt(0)" ::: "memory");
#pragma unroll 1
        for (int j = jlo; j <= jhi; ++j) {
            const int jn = (j + 1 <= jhi) ? j + 1 : jhi, bc = (j - jlo) & 1, bn = bc ^ 1;
            D5_BAR();
            D5_ISSUE_K(jn, bn); D5_ISSUE_V(jn, bn);
            qk_softmax(lds + bc * BUFB + KB, qr, lane, dqb, slope2, j - jd, l, pa);
            D5_BAR();
            pv16(o, vbuf0 + bc * BUFB, lane, pa);
            asm volatile("s_waitcnt vmcnt(0)" ::: "memory");
            dqb -= 64.0f;
        }
    }
#undef D5_ISSUE_K
#undef D5_ISSUE_V
#undef D5_BAR
#undef D5_LANE
    asm volatile("s_waitcnt vmcnt(0)" ::: "memory");
    int tz = threadIdx.x; asm volatile("" : "+v"(tz));
    epilogue(P, lds, o, l, tz, it);
}
#undef D5_LW
}

namespace na2 {
__device__ __forceinline__ void item(const Params& P, int it, LAS unsigned char* lds) {
    int tid = threadIdx.x; asm volatile("" : "+v"(tid));
    const int wid = __builtin_amdgcn_readfirstlane(tid >> 6), lane = tid & 63, r32 = lane & 31, hi = lane >> 5;
    const int b = it >> 7, h = (it >> 4) & 7, r0 = (it & 15) * 4;
    const int r = r0 + (wid >> 1), cq0 = (wid & 1) * 32;
    const bf16_t* proj = (const bf16_t*)(P.ws + WS_PROJ);
    LAS float* tab = (LAS float*)(lds + SCR_OFF);
    LAS float* li_l = (LAS float*)(lds + SCR_OFF + 2048) + wid * 32;
    for (int i = tid; i < 15 * 31; i += NTHR) tab[(i / 31) * 32 + (i % 31)] = P.rpb_a[h * 465 + i] * LOG2E;
    bf16x8 qr[8];
    { const bf16_t* Qw = proj + ((size_t)b * SEQ + r * 64 + cq0 + r32) * INC + h * 128 + hi * 8;
#pragma unroll
      for (int d0 = 0; d0 < 8; ++d0) qr[d0] = *(const bf16x8*)(Qw + d0 * 16); }
    int kr_lo = r0 - 4; kr_lo = kr_lo < 0 ? 0 : (kr_lo > 56 ? 56 : kr_lo);
    int kr_hi = r0 - 1; kr_hi = (kr_hi < 0 ? 0 : (kr_hi > 56 ? 56 : kr_hi)) + 7;
    int rs = r - 4; rs = rs < 0 ? 0 : (rs > 56 ? 56 : rs);
    const int cq = cq0 + r32; int cs = cq - 8; cs = cs < 0 ? 0 : (cs > 48 ? 48 : cs);
    const char* kbase = (const char*)(proj + (size_t)b * SEQ * INC + 1024 + h * 128);
    const char* vbase = (const char*)(proj + (size_t)b * SEQ * INC + 2048 + h * 128);
    const int krow = wid * 8 + (lane >> 4);
    const unsigned voffK0 = (unsigned)(krow * INC * 2 + (((lane & 15) ^ (lane >> 4)) << 4));
    const unsigned voffK1 = (unsigned)((krow + 4) * INC * 2 + (((lane & 15) ^ (4 + (lane >> 4))) << 4));
    const unsigned voffV = (unsigned)(da2::unswap23(wid * 8 + ((lane & 31) >> 2)) * INC * 2 + (lane >> 5) * 64 + (lane & 3) * 16);
#define NA2_ISSUE(kr, bufi) do { const char* kb_ = kbase + (size_t)(kr) * (64 * INC * 2); const char* vb_ = vbase + (size_t)(kr) * (64 * INC * 2); \
        LAS unsigned char* lb_ = lds + (bufi) * 32768; \
        __builtin_amdgcn_global_load_lds((const unsigned*)(kb_ + voffK0), (LAS unsigned*)(lb_ + wid * 2048), 16, 0, 0); \
        __builtin_amdgcn_global_load_lds((const unsigned*)(kb_ + voffK1), (LAS unsigned*)(lb_ + wid * 2048 + 1024), 16, 0, 0); \
        __builtin_amdgcn_global_load_lds((const unsigned*)(vb_ + voffV), (LAS unsigned*)(lb_ + 16384 + wid * 2048), 16, 0, 0); \
        __builtin_amdgcn_global_load_lds((const unsigned*)(vb_ + 128 + voffV), (LAS unsigned*)(lb_ + 16384 + wid * 2048 + 1024), 16, 0, 0); } while (0)
    f32x16 o[4];
#pragma unroll
    for (int d = 0; d < 4; ++d) o[d] = f32x16{};
    float l_reg = 0.f;
    const int vb0 = (int)(uintptr_t)(lds + 16384) + da2::v_rd_base(lane);
    NA2_ISSUE(kr_lo, 0);
#pragma unroll 1
    for (int kr = kr_lo; kr <= kr_hi; ++kr) {
        const int bi = (kr - kr_lo) & 1;
        asm volatile("s_waitcnt vmcnt(0) lgkmcnt(0)" ::: "memory");
        __builtin_amdgcn_s_barrier();
        asm volatile("" ::: "memory");
        if (kr < kr_hi) NA2_ISSUE(kr + 1, bi ^ 1);
        if (kr >= rs && kr < rs + 8) {
            f32x16 p0, p1;
            da2::qkt(p0, p1, lds + bi * 32768, qr, r32, hi);
            const LAS float* trow = tab + (kr - r + 7) * 32;
            float ps = 0.f;
#pragma unroll
            for (int rr = 0; rr < 16; ++rr) {
                const int ck = crow(rr, hi);
                { const int rel = ck - cq + 15; const bool valid = (ck >= cs) && (ck < cs + 16); const int idx = rel < 0 ? 0 : (rel > 30 ? 30 : rel);
                  const float v = valid ? __builtin_amdgcn_exp2f(p0[rr] + trow[idx]) : 0.f; p0[rr] = v; ps += v; }
                { const int ck1 = ck + 32; const int rel = ck1 - cq + 15; const bool valid = (ck1 >= cs) && (ck1 < cs + 16); const int idx = rel < 0 ? 0 : (rel > 30 ? 30 : rel);
                  const float v = valid ? __builtin_amdgcn_exp2f(p1[rr] + trow[idx]) : 0.f; p1[rr] = v; ps += v; }
            }
            l_reg += swap_add(ps);
            bf16x8 pa0, pa1, pa2, pa3;
            PK4(p0, 0, pa0); PK4(p0, 8, pa1); PK4(p1, 0, pa2); PK4(p1, 8, pa3);
            const int vb = vb0 + bi * 32768;
            da2::pv_one<4, 0>(o[0], vb, pa0, pa1, pa2, pa3); da2::pv_one<4, 1>(o[1], vb, pa0, pa1, pa2, pa3);
            da2::pv_one<4, 2>(o[2], vb, pa0, pa1, pa2, pa3); da2::pv_one<4, 3>(o[3], vb, pa0, pa1, pa2, pa3);
        }
    }
#undef NA2_ISSUE
    if (hi == 0) li_l[r32] = l_reg;
    asm volatile("s_waitcnt lgkmcnt(0)" ::: "memory");
    __syncthreads();
    LAS unsigned char* T = lds + wid * 8192;
    float* nassq = (float*)(P.ws + WS_NASSQ);
    const size_t t0 = (size_t)b * SEQ + r * 64 + cq0;
#pragma unroll
    for (int rr = 0; rr < 16; ++rr) {
        const float rl = __builtin_amdgcn_rcpf(li_l[crow(rr, hi)]);
        float sq = 0.f;
#pragma unroll
        for (int d = 0; d < 4; ++d) {
            const unsigned w = cvtpk(o[d][rr] * rl, 0.f); const float vq = __uint_as_float(w << 16);
            sq += vq * vq;
            *(LAS bf16_t*)(T + (2 * rr + hi) * 256 + (d * 32 + r32) * 2) = (bf16_t)(w & 0xffffu);
        }
#pragma unroll
        for (int sh = 16; sh >= 1; sh >>= 1) sq += __shfl_xor(sq, sh);
        if (r32 == 0) nassq[(t0 + crow(rr, hi)) * 8 + h] = sq;
    }
    asm volatile("s_waitcnt lgkmcnt(0)" ::: "memory");
    char* mixb = (char*)((bf16_t*)(P.ws + WS_MIX) + t0 * DM + h * 128);
#pragma unroll
    for (int i = 0; i < 8; ++i) {
        const int tr = i * 4 + (lane >> 4), rr2 = tr >> 1, h2 = tr & 1;
        const u32x4 w = *(const LAS u32x4*)(T + tr * 256 + (lane & 15) * 16);
        *(u32x4*)(mixb + (size_t)crow(rr2, h2) * (DM * 2) + (lane & 15) * 16) = w;
    }
    __syncthreads();
}
}

__device__ __forceinline__ void da_combine(const Params& P) {
    int tid = threadIdx.x; asm volatile("" : "+v"(tid)); const int wid = tid >> 6, lane = tid & 63;
    float a = P.lam_q1[lane] * P.lam_k1[lane] + P.lam_q1[lane + 64] * P.lam_k1[lane + 64];
    float c = P.lam_q2[lane] * P.lam_k2[lane] + P.lam_q2[lane + 64] * P.lam_k2[lane + 64];
    a = wave_sum(a); c = wave_sum(c);
    const float lam = expf(a) - expf(c) + 0.2f;
    const float* op = (const float*)(P.ws + WS_OPART);
    bf16_t* mix = (bf16_t*)(P.ws + WS_MIX);
    const f32x4 g = ((const f32x4*)P.subln_b)[lane];
    for (int it = blockIdx.x * 8 + wid; it < MTOK * 4; it += gridDim.x * 8) {
        const int tok = it >> 2, h = it & 3;
        const float* p = op + (size_t)tok * DM + h * 512;
        const f32x4 o1 = ((const f32x4*)p)[lane], o2 = ((const f32x4*)(p + 256))[lane];
        const f32x4 v = o1 - lam * o2;
        float ss = (v[0] * v[0] + v[1] * v[1]) + (v[2] * v[2] + v[3] * v[3]);
        ss = wave_sum(ss);
        const float rstd = rsqrtf(ss * (1.0f / 256.0f) + RMS_EPS) * 0.8f;
        u32x2 w; w.x = cvtpk(v[0] * rstd * g[0], v[1] * rstd * g[1]); w.y = cvtpk(v[2] * rstd * g[2], v[3] * rstd * g[3]);
        *(u32x2*)(mix + (size_t)tok * DM + 1024 + h * 256 + lane * 4) = w;
    }
}

__device__ __forceinline__ f32x4 ldx1(const bf16_t* p) { const u32x2 w = *(const u32x2*)p; return (f32x4){__uint_as_float(w.x << 16), __uint_as_float(w.x & 0xffff0000u), __uint_as_float(w.y << 16), __uint_as_float(w.y & 0xffff0000u)}; }
__device__ __forceinline__ void router_phase(const Params& P, LAS unsigned char* lds) {
    int tid = threadIdx.x; asm volatile("" : "+v"(tid)); const int wid = tid >> 6, lane = tid & 63;
    { const f32x4* src = (const f32x4*)(P.ws + WS_WRT);
#pragma unroll
      for (int i = 0; i < 16; ++i) *(LAS f32x4*)(lds + (size_t)(i * NTHR + tid) * 16) = src[i * NTHR + tid];
      __syncthreads(); }
    const LAS float* wl = (const LAS float*)lds;
    const bf16_t* x1b = (const bf16_t*)(P.ws + WS_OPART);
    const float* rowss = (const float*)(P.ws + WS_ROWSS);
    unsigned char* H2 = (unsigned char*)(P.ws + WS_H2);
    float* aff = (float*)(P.ws + WS_AFF);
    LAS float* red = (LAS float*)(lds + 131072) + wid * 64;
    for (int g4 = blockIdx.x * 8 + wid; g4 < MTOK / 4; g4 += gridDim.x * 8) {
        const int row0 = g4 * 4;
        f32x4 xa[4], xb[4];
#pragma unroll
        for (int t = 0; t < 4; ++t) { xa[t] = ldx1(x1b + (size_t)(row0 + t) * DM + (0 * 64 + lane) * 4); xb[t] = ldx1(x1b + (size_t)(row0 + t) * DM + (1 * 64 + lane) * 4); }
        float rstd[4];
#pragma unroll
        for (int t = 0; t < 4; ++t) { float s = (lane < 32) ? rowss[(size_t)(row0 + t) * 32 + lane] : 0.f; s = wave_sum(s); rstd[t] = rsqrtf(s * (1.0f / DM) + RMS_EPS); }
        float acc[64];
#pragma unroll
        for (int k = 0; k < 64; ++k) acc[k] = 0.f;
#pragma unroll
        for (int i = 0; i < 8; ++i) {
            const int c0 = (i * 64 + lane) * 4;
            const f32x4 g = *(const f32x4*)(P.ln2_g + c0);
            f32x4 hv[4];
#pragma unroll
            for (int t = 0; t < 4; ++t) {
                const f32x4 xc = (i & 1) ? xb[t] : xa[t];
                if (i + 2 < 8) { const f32x4 nx = ldx1(x1b + (size_t)(row0 + t) * DM + ((i + 2) * 64 + lane) * 4); if (i & 1) xb[t] = nx; else xa[t] = nx; }
                hv[t] = xc * rstd[t] * g;
                *(unsigned*)(H2 + (size_t)(row0 + t) * DM + c0) = cvt4_fp8(hv[t][0] * HSC8, hv[t][1] * HSC8, hv[t][2] * HSC8, hv[t][3] * HSC8);
            }
#pragma unroll
            for (int e = 0; e < 16; ++e) {
                const f32x4 w = *(const LAS f32x4*)(wl + e * DM + c0);
#pragma unroll
                for (int t = 0; t < 4; ++t) acc[t * 16 + e] += (hv[t][0] * w[0] + hv[t][1] * w[1]) + (hv[t][2] * w[2] + hv[t][3] * w[3]);
            }
        }
#pragma unroll
        for (int step = 0; step < 6; ++step) {
            const int m = 32 >> step, half = 32 >> step;
            const bool up = (lane & m) != 0;
#pragma unroll
            for (int k = 0; k < half; ++k) {
                const float keep = up ? acc[k + half] : acc[k], send = up ? acc[k] : acc[k + half];
                acc[k] = keep + __shfl_xor(send, m);
            }
        }
        red[lane] = acc[0];
        asm volatile("s_waitcnt lgkmcnt(0)" ::: "memory");
        if (lane < 4) {
            const int t = lane; float lg[16], mx = -1e30f;
#pragma unroll
            for (int e = 0; e < 16; ++e) { lg[e] = red[t * 16 + e]; mx = fmaxf(mx, lg[e]); }
            float sum = 0.f;
#pragma unroll
            for (int e = 0; e < 16; ++e) { lg[e] = expf(lg[e] - mx); sum += lg[e]; }
            const float inv = 1.0f / sum;
            const int row = row0 + t, bb = row >> 12, sq = row & 4095;
#pragma unroll
            for (int e = 0; e < 16; ++e) aff[((size_t)bb * 16 + e) * SEQ + sq] = lg[e] * inv;
        }
    }
}

__device__ __forceinline__ void topk_phase(const Params& P, LAS unsigned char* lds) {
    int tid = threadIdx.x; asm volatile("" : "+v"(tid)); const int wid = tid >> 6, lane = tid & 63;
    const float* aff = (const float*)(P.ws + WS_AFF);
    int* selidx = (int*)(P.ws + WS_SELIDX); float* selgate = (float*)(P.ws + WS_SELGATE); int* slot = (int*)(P.ws + WS_SLOT);
    LAS unsigned* red = (LAS unsigned*)lds;
    for (int it = blockIdx.x; it < NB * NEXP; it += gridDim.x) {
        const int b = it >> 4, e = it & 15;
        const float* ap = aff + (size_t)it * SEQ + tid * 8;
        const f32x4 a0 = *(const f32x4*)ap, a1 = *(const f32x4*)(ap + 4);
        unsigned v[8];
#pragma unroll
        for (int j = 0; j < 4; ++j) { v[j] = __float_as_uint(a0[j]); v[4 + j] = __float_as_uint(a1[j]); }
        LAS unsigned* hist = red + 64;
        unsigned T = 0u, pmask = 0u, needk = (unsigned)CAP;
#pragma unroll 1
        for (int pass = 0; pass < 4; ++pass) {
            const int shift = 24 - 8 * pass;
            if (tid < 256) hist[tid] = 0u;
            __syncthreads();
#pragma unroll
            for (int j = 0; j < 8; ++j) if ((v[j] & pmask) == T) atomicAdd((unsigned*)(hist + ((v[j] >> shift) & 255u)), 1u);
            __syncthreads();
            unsigned hv = 0, incl = 0;
            if (tid < 256) { hv = hist[255 - tid]; incl = hv;
#pragma unroll
                for (int o = 1; o < 64; o <<= 1) { const unsigned up = __shfl_up(incl, o); if (lane >= o) incl += up; }
                if (lane == 63) hist[260 + wid] = incl; }
            __syncthreads();
            if (tid < 256) {
                for (int w = 0; w < wid; ++w) incl += hist[260 + w];
                const unsigned sfx = incl - hv;
                if (sfx < needk && incl >= needk) { hist[256] = (unsigned)(255 - tid); hist[257] = needk - sfx; }
            }
            __syncthreads();
            T |= hist[256] << shift; pmask |= 255u << shift; needk = hist[257];
            __syncthreads();
        }
        unsigned g[8], q[8], gsum = 0, qsum = 0;
#pragma unroll
        for (int j = 0; j < 8; ++j) { g[j] = v[j] > T ? 1u : 0u; q[j] = v[j] == T ? 1u : 0u; gsum += g[j]; qsum += q[j]; }
        unsigned gi = gsum, qi = qsum;
#pragma unroll
        for (int o = 1; o < 64; o <<= 1) { const unsigned tg = __shfl_up(gi, o), tq = __shfl_up(qi, o); if (lane >= o) { gi += tg; qi += tq; } }
        LAS unsigned* sc = red + 32;
        __syncthreads();
        if (lane == 63) { sc[wid] = gi; sc[8 + wid] = qi; }
        __syncthreads();
        unsigned gbase = 0, qbase = 0, gtot = 0;
#pragma unroll
        for (int w = 0; w < 8; ++w) { const unsigned a = sc[w], c2 = sc[8 + w]; if (w < wid) { gbase += a; qbase += c2; } gtot += a; }
        unsigned G = gbase + gi - gsum, Q = qbase + qi - qsum;
        const unsigned need = (unsigned)CAP - gtot;
#pragma unroll
        for (int j = 0; j < 8; ++j) {
            const int tok = tid * 8 + j;
            const bool sel = g[j] || (q[j] && Q < need);
            const unsigned sl = G + (Q < need ? Q : need);
            if (sel) { selidx[e * EROWS + b * CAP + sl] = b * SEQ + tok; selgate[e * EROWS + b * CAP + sl] = __uint_as_float(v[j]); }
            slot[(size_t)it * SEQ + tok] = sel ? (int)sl : -1;
            G += g[j]; Q += q[j];
        }
        __syncthreads();
    }
}

__device__ __forceinline__ void combine_phase(const Params& P, const float ysc) {
    int tid = threadIdx.x; asm volatile("" : "+v"(tid)); const int wid = tid >> 6, lane = tid & 63;
    const int* slot = (const int*)(P.ws + WS_SLOT);
    const unsigned char* Y = (const unsigned char*)(P.ws + WS_Y);
    for (int row = blockIdx.x * 8 + wid; row < MTOK; row += gridDim.x * 8) {
        const int b = row >> 12, s = row & 4095;
        const int sl = (lane < 16) ? slot[((size_t)b * 16 + lane) * SEQ + s] : -1;
        unsigned long long mask = __ballot(sl >= 0);
        float* op = P.out + (size_t)row * DM;
        const bf16_t* xp = (const bf16_t*)(P.ws + WS_OPART) + (size_t)row * DM;
        f32x4 a[8];
#pragma unroll
        for (int i = 0; i < 4; ++i) { const u32x4 w = *(const u32x4*)(xp + i * 512 + lane * 8);
            a[2 * i] = (f32x4){__uint_as_float(w.x << 16), __uint_as_float(w.x & 0xffff0000u), __uint_as_float(w.y << 16), __uint_as_float(w.y & 0xffff0000u)};
            a[2 * i + 1] = (f32x4){__uint_as_float(w.z << 16), __uint_as_float(w.z & 0xffff0000u), __uint_as_float(w.w << 16), __uint_as_float(w.w & 0xffff0000u)}; }
        while (mask) {
            const int e = __builtin_ctzll(mask); mask &= mask - 1;
            const int se = __shfl(sl, e);
            const unsigned char* yp = Y + ((size_t)e * EROWS + b * CAP + se) * DM + lane * 8;
#pragma unroll
            for (int i = 0; i < 4; ++i) {
                const u32x2 w = *(const u32x2*)(yp + i * 512);
                const f32x2 p0 = __builtin_amdgcn_cvt_pk_f32_fp8((int)w.x, false), p1 = __builtin_amdgcn_cvt_pk_f32_fp8((int)w.x, true);
                const f32x2 p2 = __builtin_amdgcn_cvt_pk_f32_fp8((int)w.y, false), p3 = __builtin_amdgcn_cvt_pk_f32_fp8((int)w.y, true);
                a[2 * i] += (f32x4){p0[0], p0[1], p1[0], p1[1]} * (ysc * (1.0f / YSC8));
                a[2 * i + 1] += (f32x4){p2[0], p2[1], p3[0], p3[1]} * (ysc * (1.0f / YSC8));
            }
        }
#pragma unroll
        for (int i = 0; i < 4; ++i) { *(f32x4*)(op + i * 512 + lane * 8) = a[2 * i]; *(f32x4*)(op + i * 512 + lane * 8 + 4) = a[2 * i + 1]; }
    }
}

#ifndef P1_COMPUTE_WGS
#define P1_COMPUTE_WGS 160
#endif
#ifndef P7_PER_XCD
#define P7_PER_XCD 30
#endif
constexpr int N_PHASES = 10;
__global__ void __launch_bounds__(NTHR, 2) fwd_kernel(Params P) {
    extern __shared__ __attribute__((aligned(16))) unsigned char lds_raw[];
    LAS unsigned char* lds = (LAS unsigned char*)lds_raw;
    const int tid = threadIdx.x;
    volatile LAS unsigned* MISC = (volatile LAS unsigned*)(lds + MISC_OFF);
    if (tid < 16) MISC[tid] = 0u;
    __syncthreads();
    XcdBarrier bar; bar.bar = (unsigned*)(P.ws + WS_CTL); bar.x = 0; bar.st = nullptr;
#if MK_N_LAUNCHES == 1
    bar = xcd_barrier_post((unsigned*)(P.ws + WS_CTL), MISC);
#define GRID_BAR() xcd_barrier(bar)
#else
#define GRID_BAR() do { } while (0)
#endif
    const int lo = P.ph_lo, hi = P.ph_hi;
#ifndef PH_MASK
#define PH_MASK 0x3ff
#endif
#define IN(k) (((PH_MASK >> (k)) & 1) && lo <= (k) && (k) < hi)
#define BOTH(k) (IN(k) && IN((k) + 1))

#ifndef PROBE_DUP
#define PROBE_DUP -1
#endif
#define DUP(k) for (int rep_ = 0; rep_ < ((PROBE_DUP) == (k) ? 2 : 1); ++rep_)
    if (IN(0)) { DUP(0) { p0_prologue(P, lds); __syncthreads(); } if (BOTH(0)) GRID_BAR(); }

    if (IN(1)) {
        { LAS float* gl = (LAS float*)(lds + SCR_OFF + 8192);
          if (tid < 128) { gl[tid] = P.qn_a[tid]; gl[128 + tid] = P.kn_a[tid]; gl[256 + tid] = P.qn_b[tid]; gl[384 + tid] = P.kn_b[tid]; }
          __syncthreads(); }
        DUP(1) {
        pg8::OrderMN S; S.init(P.ws + WS_H, P.ws + WS_WIN, MTOK, INC, DM, P1_COMPUTE_WGS, blockIdx.x);
        EpiInProj E{(bf16_t*)(P.ws + WS_PROJ)};
        pg8::gemm_phase<false, false, false>(lds, DM, S, E, nullptr);
        }
        cvt_queue<2>(P, lds, (unsigned*)(P.ws + WS_CTL) + CW_QG); cvt_queue<3>(P, lds, (unsigned*)(P.ws + WS_CTL) + CW_QU);
        if (BOTH(1)) GRID_BAR();
    }

    if (IN(2)) {
        const bf16_t* proj = (const bf16_t*)(P.ws + WS_PROJ);
        float* opart = (float*)(P.ws + WS_OPART);
        const int da_it = (blockIdx.x & 7) * 32 + (blockIdx.x >> 3);
        DUP(2) {
        if (blockIdx.x < 256) da5::item(P, da_it, lds);
        }
        DUP(12) {
        if (blockIdx.x < 256 && ((da_it >> 5) & 3) == 0) {
            const int r64 = (da_it >> 7) * 32 + (da_it & 31);
#pragma unroll 1
            for (int k = 0; k < 4; ++k) na2::item(P, r64 * 4 + k, lds);
        }
        }
        if (BOTH(2)) GRID_BAR();
    }


    if (IN(4)) {
        DUP(4) {
        pg8::OrderMN S; S.init(P.ws + WS_MIX, P.ws + WS_WOUT, MTOK, DM, DM, gridDim.x, blockIdx.x);
        LAS float* ht = (LAS float*)(lds + SCR_OFF);
        { pg8::Unit u; if (S.next(0, u) && tid < 256) { const float* q = (const float*)(P.ws + WS_NASSQ) + (size_t)(u.pm * 256 + tid) * 8;
            const f32x4 a = *(const f32x4*)q, c = *(const f32x4*)(q + 4);
            ht[tid] = rsqrtf(((a[0] + a[1]) + (a[2] + a[3]) + (c[0] + c[1]) + (c[2] + c[3])) * (1.0f / 1024.0f) + RMS_EPS); } }
        __syncthreads();
        EpiOutProj E{P.x, (bf16_t*)(P.ws + WS_OPART), (float*)(P.ws + WS_ROWSS)};
        pg8::gemm_phase<false, true, false>(lds, DM, S, E, (const LAS unsigned*)ht);
        }
        if (BOTH(4)) GRID_BAR();
    }

    if (IN(5)) { DUP(5) { router_phase(P, lds); __syncthreads(); } if (BOTH(5)) GRID_BAR(); }

    if (IN(6)) { DUP(6) { topk_phase(P, lds); } if (BOTH(6)) GRID_BAR(); }

    if (IN(7)) {
        pg8::OrderExpert S; S.init(P.ws + WS_H2, P.ws + WS_WGU, 2 * FF, DM / 2, 0, (size_t)2 * FF * DM, true, gridDim.x, blockIdx.x, P7_PER_XCD);
        LAS unsigned* gtab = (LAS unsigned*)(lds + SCR_OFF);
        const int* selidx = (const int*)(P.ws + WS_SELIDX);
        { pg8::Unit u; for (int i = 0; i < 12 && S.next(i, u); ++i) { if (tid < 256) gtab[i * 256 + tid] = (unsigned)selidx[u.e * EROWS + u.pm * 256 + tid] * (unsigned)DM; } }
        __syncthreads();
        DUP(7) {
        EpiGateUp E{(unsigned char*)(P.ws + WS_ACT)};
        pg8::gemm_phase<true, false, true>(lds, DM / 2, S, E, gtab);
        }
        cvt_queue<4>(P, lds, (unsigned*)(P.ws + WS_CTL) + CW_QD);
        if (BOTH(7)) GRID_BAR();
    }

    if (IN(8)) {
        DUP(8) {
        pg8::OrderExpert S; S.init(P.ws + WS_ACT, P.ws + WS_WD, DM, FF / 2, (size_t)EROWS * FF, (size_t)DM * FF, false, gridDim.x, blockIdx.x, 32);
        EpiDown E{(unsigned char*)(P.ws + WS_Y), (const float*)(P.ws + WS_SELGATE)};
        pg8::gemm_phase<false, false, true>(lds, FF / 2, S, E, nullptr);
        }
        if (BOTH(8)) GRID_BAR();
    }

    if (IN(9)) { if (PROBE_DUP == 9) { combine_phase(P, 0.5f); __syncthreads(); combine_phase(P, 0.5f); } else combine_phase(P, 1.0f); }
#undef IN
#undef BOTH
}

extern "C" void kernel_launch(void* const* d_in, const int* in_sizes, int n_in, void* d_out, int out_size, void* d_ws, size_t ws_size, hipStream_t stream) {
    static int grid = 0;
    if (grid == 0) {
        if (n_in != 20 || out_size != MTOK * DM || ws_size < WS_END) { fprintf(stderr, "kernel_launch: unexpected shapes (n_in %d out %d ws %zu need %zu)\n", n_in, out_size, ws_size, (size_t)WS_END); grid = -1; return; }
        int dev = 0, cus = 0, per_cu = 0;
        if (hipGetDevice(&dev) != hipSuccess || hipDeviceGetAttribute(&cus, hipDeviceAttributeMultiprocessorCount, dev) != hipSuccess) { grid = -1; return; }
        if (hipFuncSetAttribute((const void*)fwd_kernel, hipFuncAttributeMaxDynamicSharedMemorySize, LDS_BYTES) != hipSuccess) { fprintf(stderr, "kernel_launch: hipFuncSetAttribute failed\n"); grid = -1; return; }
        if (hipOccupancyMaxActiveBlocksPerMultiprocessor(&per_cu, (const void*)fwd_kernel, NTHR, LDS_BYTES) != hipSuccess || per_cu < 1) fprintf(stderr, "kernel_launch: occupancy query reports %d\n", per_cu);
        (void)hipGetLastError();
        if (cus != 256) { fprintf(stderr, "kernel_launch: built for a 256-CU device, found %d\n", cus); grid = -1; return; }
        grid = cus;
    }
    if (grid < 0) return;
    hipMemsetAsync((char*)d_ws + WS_CTL, 0, CTL_BYTES, stream);
    Params p{};
    p.x = (const float*)d_in[0]; p.ln1_g = (const float*)d_in[1]; p.w_in = (const float*)d_in[2]; p.qn_a = (const float*)d_in[3]; p.kn_a = (const float*)d_in[4];
    p.rpb_a = (const float*)d_in[5]; p.on_a = (const float*)d_in[6]; p.qn_b = (const float*)d_in[7]; p.kn_b = (const float*)d_in[8];
    p.lam_q1 = (const float*)d_in[9]; p.lam_k1 = (const float*)d_in[10]; p.lam_q2 = (const float*)d_in[11]; p.lam_k2 = (const float*)d_in[12]; p.subln_b = (const float*)d_in[13];
    p.w_out = (const float*)d_in[14]; p.ln2_g = (const float*)d_in[15]; p.w_router = (const float*)d_in[16]; p.w_gate = (const float*)d_in[17]; p.w_up = (const float*)d_in[18]; p.w_down = (const float*)d_in[19];
    p.out = (float*)d_out; p.ws = (unsigned char*)d_ws;
#if MK_N_LAUNCHES == 1
    p.ph_lo = 0; p.ph_hi = N_PHASES;
    hipLaunchKernelGGL(fwd_kernel, dim3(grid), dim3(NTHR), LDS_BYTES, stream, p);
#else
#ifndef PROBE_LDUP
#define PROBE_LDUP -1
#endif
    for (int ph = 0; ph < N_PHASES; ++ph) { p.ph_lo = ph; p.ph_hi = ph + 1;
        for (int rep = 0; rep < ((ph == PROBE_LDUP && ph != 9) ? 2 : 1); ++rep) hipLaunchKernelGGL(fwd_kernel, dim3(grid), dim3(NTHR), LDS_BYTES, stream, p); }
#endif
    const hipError_t le = hipPeekAtLastError();
    if (le != hipSuccess) fprintf(stderr, "kernel_launch: launch failed: %s\n", hipGetErrorName(le));
}
```

```cpp
#include <hip/hip_runtime.h>
#include <stdint.h>
#include <stdio.h>

#ifndef MK_N_LAUNCHES
#define MK_N_LAUNCHES 1
#endif

#define LAS __attribute__((address_space(3)))
typedef unsigned short bf16_t;
typedef short bf16x8 __attribute__((ext_vector_type(8)));
typedef short s16x4 __attribute__((ext_vector_type(4)));
typedef float f32x4 __attribute__((ext_vector_type(4)));
typedef float f32x2 __attribute__((ext_vector_type(2)));
typedef float f32x16 __attribute__((ext_vector_type(16)));
typedef unsigned u32x4 __attribute__((ext_vector_type(4)));
typedef unsigned u32x2 __attribute__((ext_vector_type(2)));
typedef int i32x8 __attribute__((ext_vector_type(8)));
typedef int i32x4 __attribute__((ext_vector_type(4)));

constexpr int NB = 2, SEQ = 4096, DM = 2048, MTOK = NB * SEQ;
constexpr int INC = 6144;
constexpr int NEXP = 16, CAP = 512, FF = 2816, EROWS = NB * CAP;
constexpr float RMS_EPS = 1e-6f;
constexpr float LOG2E = 1.4426950408889634f;
constexpr float QSCALE = 0.088388347648318440f * LOG2E;
constexpr int NTHR = 512;

constexpr size_t al256(size_t x) { return (x + 255) / 256 * 256; }
constexpr size_t WS_CTL = 0, CTL_BYTES = 65536;
constexpr size_t WS_WIN = WS_CTL + CTL_BYTES;
constexpr size_t WS_WOUT = WS_WIN + (size_t)INC * DM * 2;
constexpr size_t WS_WGU = WS_WOUT + (size_t)DM * DM * 2;
constexpr size_t WS_WD = WS_WGU + (size_t)NEXP * 2 * FF * DM * 2;
constexpr size_t WS_H = WS_WD + (size_t)NEXP * DM * FF * 2;
constexpr size_t WS_PROJ = WS_H + (size_t)MTOK * DM * 2;
constexpr size_t WS_NASSQ = WS_PROJ + (size_t)MTOK * INC * 2;
constexpr size_t WS_MIX = WS_NASSQ + (size_t)MTOK * 1024 * 2;
constexpr size_t WS_OPART = WS_MIX + (size_t)MTOK * DM * 2;
constexpr size_t WS_ROWSS = WS_OPART + (size_t)MTOK * DM * 4;
constexpr size_t WS_AFF = WS_ROWSS + (size_t)MTOK * 32 * 4;
constexpr size_t WS_SELIDX = WS_AFF + (size_t)NB * NEXP * SEQ * 4;
constexpr size_t WS_SELGATE = WS_SELIDX + (size_t)NEXP * EROWS * 4;
constexpr size_t WS_SLOT = WS_SELGATE + (size_t)NEXP * EROWS * 4;
constexpr size_t WS_H2 = WS_SLOT + (size_t)NB * NEXP * SEQ * 4;
constexpr size_t WS_ACT = WS_H2 + (size_t)MTOK * DM * 2;
constexpr size_t WS_Y = WS_ACT + (size_t)NEXP * EROWS * FF * 2;
constexpr size_t WS_WRT = WS_Y + (size_t)NEXP * EROWS * DM * 2;
constexpr size_t WS_END = WS_WRT + (size_t)NEXP * DM * 4;

constexpr int STAGE_BYTES = 131072;
constexpr int SCR_OFF = STAGE_BYTES;
constexpr int SCR_BYTES = 16384;
constexpr int MISC_OFF = SCR_OFF + SCR_BYTES - 64;
constexpr int CVS_OFF = SCR_OFF + SCR_BYTES;
constexpr int LDS_BYTES = CVS_OFF + 16384;

__device__ __forceinline__ unsigned cvtpk(float lo, float hi) { unsigned r; asm volatile("v_cvt_pk_bf16_f32 %0, %1, %2" : "=v"(r) : "v"(lo), "v"(hi)); return r; }
__device__ __forceinline__ float wave_sum(float v) {
#pragma unroll
    for (int o = 32; o >= 1; o >>= 1) v += __shfl_xor(v, o);
    return v;
}
__device__ __forceinline__ unsigned cvt4_fp8(float a, float b, float c, float d) { int w = 0; w = __builtin_amdgcn_cvt_pk_fp8_f32(a, b, w, false); w = __builtin_amdgcn_cvt_pk_fp8_f32(c, d, w, true); return (unsigned)w; }
constexpr float WSC8 = 128.0f, HSC8 = 4.0f, ASC8 = 8.0f, YSC8 = 64.0f;
__device__ __forceinline__ float bf2f(bf16_t b) { return __uint_as_float(((unsigned)b) << 16); }

#define XB_TMO      128
#define XB_XCNT(j)  (256  + 64 * (j))
#define XB_XSUB(j)  (1280 + 64 * (j))
#define XB_XGEN(j)  (2304 + 64 * (j))
#define XB_TOP      3328
#define XB_TOPGEN   3392
#define XCD_BAR_WORDS 3456
#define XB_SPIN_CAP (1u << 18)

__device__ __forceinline__ unsigned xb_ld(unsigned* p)              { return __hip_atomic_load(p, __ATOMIC_RELAXED, __HIP_MEMORY_SCOPE_AGENT); }
__device__ __forceinline__ unsigned xb_add(unsigned* p, unsigned v) { return __hip_atomic_fetch_add(p, v, __ATOMIC_RELAXED, __HIP_MEMORY_SCOPE_AGENT); }
__device__ __forceinline__ unsigned xb_xcc_id() { return (unsigned)__builtin_amdgcn_s_getreg((3 << 11) | 20) & 0xFu; }
#define XB_SPIN(cond, bar) do { unsigned _sp = 0; while (cond) { __builtin_amdgcn_s_sleep(1); \
    if ((++_sp & 255u) == 0u) { if (xb_ld(&(bar)[XB_TMO])) break; if (_sp > XB_SPIN_CAP) { atomicAdd(&(bar)[XB_TMO], 1u); break; } } } } while (0)

struct XcdBarrier { unsigned* bar; unsigned x; volatile LAS unsigned* st; };

__device__ __forceinline__ XcdBarrier xcd_barrier_post(unsigned* bar, volatile LAS unsigned* st) {
    XcdBarrier b; b.bar = bar; b.x = xb_xcc_id(); b.st = st;
    if (threadIdx.x == 0) (void)xb_add(&bar[XB_XCNT(b.x)], 1u);
    return b;
}
__device__ __forceinline__ void xcd_barrier_complete(unsigned* bar, unsigned x, unsigned& nloc, unsigned& nx) {
    const unsigned G = gridDim.x * gridDim.y * gridDim.z;
    unsigned sum, cnt, mine, sp = 0u;
    for (;;) {
        sum = 0u; cnt = 0u; mine = 0u;
#pragma unroll
        for (unsigned j = 0; j < 16; ++j) { const unsigned c = xb_ld(&bar[XB_XCNT(j)]); sum += c; cnt += (c > 0u) ? 1u : 0u; mine = (j == x) ? c : mine; }
        if (sum == G) break;
        __builtin_amdgcn_s_sleep(1);
        if ((++sp & 255u) == 0u) { if (xb_ld(&bar[XB_TMO])) break; if (sp > XB_SPIN_CAP) { atomicAdd(&bar[XB_TMO], 1u); break; } }
    }
    nloc = mine > 0u ? mine : 1u; nx = cnt > 0u ? cnt : 1u;
}
__device__ __forceinline__ void xcd_barrier(const XcdBarrier& b) {
    asm volatile("s_waitcnt vmcnt(0)" ::: "memory");
    __syncthreads();
    if (threadIdx.x == 0) {
        unsigned* bar = b.bar;
        __builtin_amdgcn_s_waitcnt(0);
        unsigned nloc = b.st[0], nx = b.st[1];
        if (nloc == 0u) { xcd_barrier_complete(bar, b.x, nloc, nx); b.st[0] = nloc; b.st[1] = nx; }
        const unsigned old = xb_add(&bar[XB_XSUB(b.x)], 1u);
        const unsigned gen = old / nloc;
        if (old + 1u == (gen + 1u) * nloc) {
            __builtin_amdgcn_fence(__ATOMIC_RELEASE, "agent");
            asm volatile("s_waitcnt vmcnt(0)" ::: "memory");
            const unsigned og = xb_add(&bar[XB_TOP], 1u);
            const unsigned tg = og / nx;
            if (og + 1u == (tg + 1u) * nx) xb_add(&bar[XB_TOPGEN], 1u);
            else XB_SPIN(xb_ld(&bar[XB_TOPGEN]) == tg, bar);
            __builtin_amdgcn_fence(__ATOMIC_ACQUIRE, "agent");
            xb_add(&bar[XB_XGEN(b.x)], 1u);
            asm volatile("s_waitcnt vmcnt(0)" ::: "memory");
        } else {
            XB_SPIN(xb_ld(&bar[XB_XGEN(b.x)]) == gen, bar);
            __builtin_amdgcn_fence(__ATOMIC_ACQUIRE, "agent");
            asm volatile("s_waitcnt vmcnt(0)" ::: "memory");
        }
    }
    __syncthreads();
}

struct Params {
    const float* x; const float* ln1_g; const float* w_in; const float* qn_a; const float* kn_a; const float* rpb_a; const float* on_a;
    const float* qn_b; const float* kn_b; const float* lam_q1; const float* lam_k1; const float* lam_q2; const float* lam_k2; const float* subln_b;
    const float* w_out; const float* ln2_g; const float* w_router; const float* w_gate; const float* w_up; const float* w_down;
    float* out; unsigned char* ws; int ph_lo, ph_hi;
};

__device__ __forceinline__ void cvt_load(const float* __restrict__ src, int N, int k0, int n0, int tid, f32x4 (&v)[8], const float* kscale) {
    const int ln = tid & 63, kq = tid >> 6;
    const float* p = src + (size_t)(k0 + kq * 8) * N + n0 + ln * 4;
#pragma unroll
    for (int i = 0; i < 8; ++i) v[i] = __builtin_nontemporal_load((const f32x4*)(p + (size_t)i * N));
    if (kscale) {
#pragma unroll
        for (int i = 0; i < 8; ++i) v[i] = v[i] * kscale[k0 + kq * 8 + i];
    }
}
__device__ __forceinline__ void cvt_to_lds(LAS unsigned char* buf, int tid, const f32x4 (&v)[8]) {
    const int ln = tid & 63, kq = tid >> 6;
#pragma unroll
    for (int j = 0; j < 4; ++j) {
        u32x4 w; w.x = cvtpk(v[0][j], v[1][j]); w.y = cvtpk(v[2][j], v[3][j]); w.z = cvtpk(v[4][j], v[5][j]); w.w = cvtpk(v[6][j], v[7][j]);
        *(LAS u32x4*)(buf + (ln * 4 + j) * 144 + kq * 16) = w;
    }
}
__device__ __forceinline__ void cvt_store(const LAS unsigned char* buf, bf16_t* __restrict__ dst, int K, int k0, int n0, int blk, int off, int tid) {
#pragma unroll
    for (int q = 0; q < 4; ++q) {
        const int p = tid + q * 512, n = p >> 3, kp = p & 7, ng = n0 + n;
        const u32x4 w = *(const LAS u32x4*)(buf + n * 144 + kp * 16);
        const size_t drow = (size_t)(ng >> 7) * blk + off + (ng & 127);
        *(u32x4*)(dst + drow * K + k0 + kp * 8) = w;
    }
}
__device__ __forceinline__ void cvt_to_lds8(LAS unsigned char* buf, int tid, const f32x4 (&v)[8]) {
    const int ln = tid & 63, kq = tid >> 6, slot = (kq ^ (ln & 7)) * 8;
    f32x4 u[8];
#pragma unroll
    for (int i = 0; i < 8; ++i) u[i] = v[i] * WSC8;
#pragma unroll
    for (int j = 0; j < 4; ++j) {
        u32x2 w; w.x = cvt4_fp8(u[0][j], u[1][j], u[2][j], u[3][j]); w.y = cvt4_fp8(u[4][j], u[5][j], u[6][j], u[7][j]);
        *(LAS u32x2*)(buf + (ln * 4 + j) * 64 + slot) = w;
    }
}
__device__ __forceinline__ void cvt_store8(const LAS unsigned char* buf, unsigned char* __restrict__ dst, int Kb, int k0, int n0, int blk, int off, int tid) {
#pragma unroll
    for (int q = 0; q < 2; ++q) {
        const int p = tid + q * 512, n = p >> 2, kp = p & 3, ng = n0 + n, sw = (n >> 2) & 7;
        const u32x2 lo = *(const LAS u32x2*)(buf + n * 64 + ((2 * kp) ^ sw) * 8), hi = *(const LAS u32x2*)(buf + n * 64 + ((2 * kp + 1) ^ sw) * 8);
        const u32x4 w = {lo.x, lo.y, hi.x, hi.y};
        const size_t drow = (size_t)(ng >> 7) * blk + off + (ng & 127);
        __builtin_nontemporal_store(w, (u32x4*)(dst + drow * Kb + k0 + kp * 16));
    }
}
struct CvtTile { const float* src; bf16_t* dst; int K, N, k0, n0, blk, off; const float* kscale; int fp8; };
__device__ __forceinline__ void cvt_to_lds_any(LAS unsigned char* buf, int tid, const f32x4 (&v)[8], int fp8) { if (fp8) cvt_to_lds8(buf, tid, v); else cvt_to_lds(buf, tid, v); }
__device__ __forceinline__ void cvt_store_any(const LAS unsigned char* buf, const CvtTile& t, int tid) {
    if (t.fp8) cvt_store8(buf, (unsigned char*)t.dst, t.K, t.k0, t.n0, t.blk, t.off, tid); else cvt_store(buf, t.dst, t.K, t.k0, t.n0, t.blk, t.off, tid); }
template <int KIND> __device__ __forceinline__ constexpr int cvt_count() { return KIND == 0 ? 768 : KIND == 1 ? 256 : 16 * 352; }
template <int KIND> __device__ __forceinline__ CvtTile cvt_decode(const Params& P, int r) {
    CvtTile t; t.kscale = nullptr; t.fp8 = 0;
    if (KIND == 0) { t.src = P.w_in; t.dst = (bf16_t*)(P.ws + WS_WIN); t.K = DM; t.N = INC; t.k0 = (r / 24) * 64; t.n0 = (r % 24) * 256; t.blk = 128; t.off = 0; }
    else if (KIND == 1) { t.src = P.w_out; t.dst = (bf16_t*)(P.ws + WS_WOUT); t.K = DM; t.N = DM; t.k0 = (r / 8) * 64; t.n0 = (r % 8) * 256; t.blk = 128; t.off = 0; t.kscale = (t.k0 < 1024) ? P.on_a : nullptr; }
    else if (KIND == 2 || KIND == 3) { const int e = r / 352, q = r % 352;
        t.src = (KIND == 3 ? P.w_up : P.w_gate) + (size_t)e * DM * FF; t.dst = (bf16_t*)(P.ws + WS_WGU + (size_t)e * 2 * FF * DM);
        t.K = DM; t.N = FF; t.k0 = (q / 11) * 64; t.n0 = (q % 11) * 256; t.blk = 256; t.off = (KIND == 3) ? 128 : 0; t.fp8 = 1; }
    else { const int e = r / 352, q = r % 352;
        t.src = P.w_down + (size_t)e * FF * DM; t.dst = (bf16_t*)(P.ws + WS_WD + (size_t)e * DM * FF);
        t.K = FF; t.N = DM; t.k0 = (q / 8) * 64; t.n0 = (q % 8) * 256; t.blk = 128; t.off = 0; t.fp8 = 1; }
    return t;
}
constexpr int CW_QG = 4096, CW_QU = 4160, CW_QD = 4224;

template <int KIND> __device__ __forceinline__ void cvt_static(const Params& P, LAS unsigned char* lds) {
    const int tid = threadIdx.x, G = gridDim.x; constexpr int NT = cvt_count<KIND>();
    int idA = blockIdx.x, idB = blockIdx.x + G;
    f32x4 vA[8], vB[8];
    CvtTile tA = cvt_decode<KIND>(P, idA < NT ? idA : 0), tB = cvt_decode<KIND>(P, idB < NT ? idB : 0);
    if (idA < NT) cvt_load(tA.src, tA.N, tA.k0, tA.n0, tid, vA, tA.kscale);
    if (idB < NT) cvt_load(tB.src, tB.N, tB.k0, tB.n0, tid, vB, tB.kscale);
    for (;;) {
        if (idA >= NT) break;
        cvt_to_lds_any(lds, tid, vA, tA.fp8);
        { const int nid = idA + 2 * G; CvtTile tn = cvt_decode<KIND>(P, nid < NT ? nid : 0);
          if (nid < NT) cvt_load(tn.src, tn.N, tn.k0, tn.n0, tid, vA, tn.kscale);
          asm volatile("s_waitcnt lgkmcnt(0)" ::: "memory"); __builtin_amdgcn_s_barrier(); asm volatile("" ::: "memory");
          cvt_store_any(lds, tA, tid);
          tA = tn; idA = nid; }
        if (idB >= NT) break;
        cvt_to_lds_any(lds + 36864, tid, vB, tB.fp8);
        { const int nid = idB + 2 * G; CvtTile tn = cvt_decode<KIND>(P, nid < NT ? nid : 0);
          if (nid < NT) cvt_load(tn.src, tn.N, tn.k0, tn.n0, tid, vB, tn.kscale);
          asm volatile("s_waitcnt lgkmcnt(0)" ::: "memory"); __builtin_amdgcn_s_barrier(); asm volatile("" ::: "memory");
          cvt_store_any(lds + 36864, tB, tid);
          tB = tn; idB = nid; }
    }
}
__device__ __forceinline__ void p0_prologue(const Params& P, LAS unsigned char* lds) {
    int tid = threadIdx.x; asm volatile("" : "+v"(tid)); const int lane = tid & 63, wid = tid >> 6;
    {
        bf16_t* H = (bf16_t*)(P.ws + WS_H);
        for (int row = blockIdx.x * 8 + wid; row < MTOK; row += gridDim.x * 8) {
            const f32x4* xp = (const f32x4*)(P.x + (size_t)row * DM);
            f32x4 v[8]; float ss = 0.f;
#pragma unroll
            for (int i = 0; i < 8; ++i) { v[i] = xp[i * 64 + lane]; ss += v[i][0] * v[i][0] + v[i][1] * v[i][1] + v[i][2] * v[i][2] + v[i][3] * v[i][3]; }
            ss = wave_sum(ss);
            const float rstd = rsqrtf(ss * (1.0f / DM) + RMS_EPS);
#pragma unroll
            for (int i = 0; i < 8; ++i) {
                const f32x4 g = ((const f32x4*)P.ln1_g)[i * 64 + lane];
                u32x2 w; w.x = cvtpk(v[i][0] * rstd * g[0], v[i][1] * rstd * g[1]); w.y = cvtpk(v[i][2] * rstd * g[2], v[i][3] * rstd * g[3]);
                *(u32x2*)(H + (size_t)row * DM + (i * 64 + lane) * 4) = w;
            }
        }
    }
    cvt_static<0>(P, lds); __syncthreads(); cvt_static<1>(P, lds);
    { float* wrt = (float*)(P.ws + WS_WRT);
      for (int i = blockIdx.x * NTHR + tid; i < NEXP * DM; i += gridDim.x * NTHR) { const int e = i >> 11, c = i & 2047; wrt[i] = P.w_router[c * 16 + e]; } }
}
__device__ __forceinline__ void cvt_load_asm(const float* __restrict__ src, int N, int k0, int n0, int tid, f32x4 (&v)[8]) {
    const int ln = tid & 63, kq = tid >> 6;
    const float* p = src + (size_t)(k0 + kq * 8) * N + n0 + ln * 4;
#pragma unroll
    for (int i = 0; i < 8; ++i) { const float* q = p + (size_t)i * N; asm volatile("global_load_dwordx4 %0, %1, off nt" : "=v"(v[i]) : "v"(q) : "memory"); }
}
__device__ __forceinline__ void cvt_load_asm_s(const float* tile  , int N, unsigned voff, f32x4 (&v)[8]) {
#pragma unroll
    for (int i = 0; i < 8; ++i) { const float* q = tile + (size_t)i * N; asm volatile("global_load_dwordx4 %0, %1, %2 nt" : "=v"(v[i]) : "v"(voff), "s"(q) : "memory"); }
}
#define CVT_WAIT_SET(v, N) asm volatile("s_waitcnt vmcnt(" #N ")" : "+v"(v[0]), "+v"(v[1]), "+v"(v[2]), "+v"(v[3]), "+v"(v[4]), "+v"(v[5]), "+v"(v[6]), "+v"(v[7]) :: "memory")
struct CvtT { const float* src; unsigned char* dst; int N, Kb, k0, drow0; };
template <int KIND> __device__ __forceinline__ CvtT cvt_decode8(const Params& P, int r) {
    CvtT t; const int e = r / 352, q = r % 352;
    if (KIND == 2 || KIND == 3) { const int kt = q / 22, nt = q % 22;
        t.N = FF; t.Kb = DM; t.k0 = kt * 128; t.src = (KIND == 3 ? P.w_up : P.w_gate) + (size_t)e * DM * FF + (size_t)t.k0 * FF + nt * 128;
        t.dst = P.ws + WS_WGU + (size_t)e * 2 * FF * DM; t.drow0 = nt * 256 + (KIND == 3 ? 128 : 0); }
    else { const int kt = q / 16, nt = q % 16;
        t.N = DM; t.Kb = FF; t.k0 = kt * 128; t.src = P.w_down + (size_t)e * FF * DM + (size_t)t.k0 * DM + nt * 128;
        t.dst = P.ws + WS_WD + (size_t)e * DM * FF; t.drow0 = nt * 128; }
    return t;
}
template <int KIND> __device__ __forceinline__ void cvt_queue(const Params& P, LAS unsigned char* lds, unsigned* qhead) {
    int tid = threadIdx.x; asm volatile("" : "+v"(tid));
    const int wid = __builtin_amdgcn_readfirstlane(tid >> 6), lane = tid & 63, ln32 = lane & 31, kq = tid >> 5;
    constexpr unsigned n = (unsigned)cvt_count<KIND>(); constexpr unsigned CH = 8;
    LAS unsigned* slot = (LAS unsigned*)(lds + SCR_OFF + 12288);
    LAS unsigned char* stg = lds + CVS_OFF;
#define QCLAIM() __hip_atomic_fetch_add(qhead, CH, __ATOMIC_RELAXED, __HIP_MEMORY_SCOPE_AGENT)
    __syncthreads();
    if (tid == 0) { const unsigned s0 = QCLAIM(), s1 = QCLAIM(); slot[0] = s0; slot[1] = s1; }
    __syncthreads();
    unsigned cbase = slot[0], pos = 0, par = 1;
#define QGEN(dst) do { dst = cbase + pos; if (++pos == CH) { pos = 0; cbase = slot[par]; \
        if (tid == 0) { const unsigned nb_ = (cbase < n) ? QCLAIM() : 0xffffff00u; slot[par ^ 1] = nb_; } par ^= 1; } } while (0)
#define CVT_DMA(t, sl) do { const char* gb_ = (const char*)(t).src + (size_t)(wid * 16 + (lane >> 5)) * ((t).N * 4) + ln32 * 16; LAS unsigned char* lb_ = lds + (sl) * 65536 + wid * 8192; \
        _Pragma("unroll") for (int i_ = 0; i_ < 8; ++i_) __builtin_amdgcn_global_load_lds((const unsigned*)(gb_ + (size_t)(2 * i_) * ((t).N * 4)), (LAS unsigned*)(lb_ + i_ * 1024), 16, 0, 2); } while (0)
    unsigned id0, id1; QGEN(id0); QGEN(id1);
    id0 = __builtin_amdgcn_readfirstlane(id0); id1 = __builtin_amdgcn_readfirstlane(id1);
    CvtT tc = cvt_decode8<KIND>(P, id0 < n ? (int)id0 : 0), tn = cvt_decode8<KIND>(P, id1 < n ? (int)id1 : 0);
    CVT_DMA(tc, 0); CVT_DMA(tn, 1);
    unsigned idc = id0, idn = id1; int k = 0;
    while (idc < n) {
        const int sl = k & 1;
        if (k < 2) asm volatile("s_waitcnt vmcnt(0)" ::: "memory"); else asm volatile("s_waitcnt vmcnt(12)" ::: "memory");
        f32x4 v[8];
        { const LAS unsigned char* rb = lds + sl * 65536 + wid * 8192 + (lane >> 5) * 4096 + ln32 * 16;
#pragma unroll
          for (int i = 0; i < 8; ++i) v[i] = *(const LAS f32x4*)(rb + i * 512) * WSC8; }
        unsigned w8[4][2];
#pragma unroll
        for (int j = 0; j < 4; ++j) { w8[j][0] = cvt4_fp8(v[0][j], v[1][j], v[2][j], v[3][j]); w8[j][1] = cvt4_fp8(v[4][j], v[5][j], v[6][j], v[7][j]); }
        unsigned idx; QGEN(idx); idx = __builtin_amdgcn_readfirstlane(idx);
        const CvtT tx = cvt_decode8<KIND>(P, idx < n ? (int)idx : 0);
        asm volatile("s_waitcnt lgkmcnt(0)" ::: "memory");
        CVT_DMA(tx, sl);
        __builtin_amdgcn_s_barrier(); asm volatile("" ::: "memory");
#pragma unroll
        for (int j = 0; j < 4; ++j) { u32x2 w; w.x = w8[j][0]; w.y = w8[j][1]; *(LAS u32x2*)(stg + (ln32 * 4 + j) * 128 + ((kq ^ (ln32 & 15)) << 3)) = w; }
        asm volatile("s_waitcnt lgkmcnt(0)" ::: "memory"); __builtin_amdgcn_s_barrier(); asm volatile("" ::: "memory");
#pragma unroll
        for (int q = 0; q < 2; ++q) {
            const int p = tid + q * 512, nn = p >> 3, kp = p & 7, sw = (nn >> 2) & 15;
            const u32x2 lo = *(const LAS u32x2*)(stg + nn * 128 + (((2 * kp) ^ sw) << 3)), hi = *(const LAS u32x2*)(stg + nn * 128 + (((2 * kp + 1) ^ sw) << 3));
            const u32x4 w = {lo.x, lo.y, hi.x, hi.y};
            __builtin_nontemporal_store(w, (u32x4*)(tc.dst + (size_t)(tc.drow0 + nn) * tc.Kb + tc.k0 + kp * 16));
        }
        tc = tn; tn = tx; idc = idn; idn = idx; ++k;
    }
    asm volatile("s_waitcnt vmcnt(0)" ::: "memory");
#undef QCLAIM
#undef QGEN
#undef CVT_DMA
    __syncthreads();
}

namespace pg8 {
constexpr int BM = 256, BK = 64, HALF = 128, HTB = HALF * BK * 2, NXCD = 8, WGM = 8;
__device__ __forceinline__ int lds_byte(int r, int c) { const int st = (r >> 4) * 2 + (c >> 5), rr = r & 15, cc = c & 31, ob = rr * 64 + cc * 2; return st * 1024 + (ob ^ (((ob >> 9) & 1) << 5)); }
__device__ __forceinline__ void stage_rc(int b, int& R, int& C) { const int st = b / 1024, sb = b % 1024, swz = sb ^ (((sb >> 9) & 1) << 5); R = (st >> 1) * 16 + swz / 64; C = (st & 1) * 32 + (swz % 64) / 2; }
__device__ __forceinline__ int perm32(int rho) { const int n = rho >> 4, i = rho & 15; return 8 * (i >> 2) + 4 * n + (i & 3); }

struct Unit { int pm, pn, e; };

template <bool GATHER, bool HOOK, bool FP8, class Epi, class Sched>
__device__ __forceinline__ void gemm_phase(LAS unsigned char* lds, const int K, const Sched& S, const Epi& E, const LAS unsigned* gtab) {
    int tid = threadIdx.x; asm volatile("" : "+v"(tid));
    const int wid = __builtin_amdgcn_readfirstlane(tid >> 6), lane = tid & 63, wr = wid >> 2, wc = wid & 3, fr = lane & 15, fq = lane >> 4;
    const int nt = K / BK;
    unsigned voffA[2], voffB[2]; int RA[2], CA2[2];
#pragma unroll
    for (int i = 0; i < 2; ++i) { int R, C; stage_rc(tid * 16 + i * 8192, R, C); const int Rb = (R & ~31) + perm32(R & 31);
        voffA[i] = (unsigned)(R * K + C) * 2u; voffB[i] = (unsigned)(Rb * K + C) * 2u; RA[i] = R; CA2[i] = C * 2; }
    const size_t kstep = (size_t)(BK * 2);
    const size_t hstep = (size_t)HALF * K * 2;
    const unsigned ldsw = (unsigned)wid * 1024u;
    const int aoff = lds_byte(wr * 64 + fr, fq * 8), boff = lds_byte(wc * 32 + fr, fq * 8);
#define PG8_SA(b, h) (((b) * 2 + (h)) * HTB)
#define PG8_SB(b, h) ((4 + (b) * 2 + (h)) * HTB)
#define PG8_STAGE(bufoff, gbase, voff) do { _Pragma("unroll") for (int _i = 0; _i < 2; ++_i) \
        __builtin_amdgcn_global_load_lds((const unsigned*)((const char*)(gbase) + (voff)[_i]), (LAS unsigned*)(lds + (bufoff) + ldsw + _i * 8192), 16, 0, 0); } while (0)
#define PG8_STAGE_A(bufoff, ubase, kbytes, h, gv) do { if (GATHER) { PG8_STAGE(bufoff, (ubase) + (kbytes), (gv)[h]); } else { PG8_STAGE(bufoff, (ubase) + (kbytes) + (h) * hstep, voffA); } } while (0)
#define PG8_LD2(addr) __builtin_shufflevector(*(const LAS i32x4*)(addr), *(const LAS i32x4*)((addr) + 1024), 0, 1, 2, 3, 4, 5, 6, 7)
#define PG8_LDA(dst, b, h) do { if (FP8) { _Pragma("unroll") for (int m = 0; m < 4; ++m) dst##_f8[m] = PG8_LD2(lds + PG8_SA(b, h) + aoff + m * 2048); } \
        else { _Pragma("unroll") for (int m = 0; m < 4; ++m) _Pragma("unroll") for (int k = 0; k < 2; ++k) dst##_bf[m][k] = *(const LAS bf16x8*)(lds + PG8_SA(b, h) + aoff + m * 2048 + k * 1024); } } while (0)
#define PG8_LDB(dst, b, h) do { if (FP8) { _Pragma("unroll") for (int n = 0; n < 2; ++n) dst##_f8[n] = PG8_LD2(lds + PG8_SB(b, h) + boff + n * 2048); } \
        else { _Pragma("unroll") for (int n = 0; n < 2; ++n) _Pragma("unroll") for (int k = 0; k < 2; ++k) dst##_bf[n][k] = *(const LAS bf16x8*)(lds + PG8_SB(b, h) + boff + n * 2048 + k * 1024); } } while (0)
#define PG8_MMA(ai, bj, At, Bt) do { __builtin_amdgcn_s_setprio(1); \
        if (FP8) { _Pragma("unroll") for (int m = 0; m < 4; ++m) _Pragma("unroll") for (int n = 0; n < 2; ++n) \
            asm volatile("v_mfma_scale_f32_16x16x128_f8f6f4 %0, %1, %2, %0, %3, %3 op_sel_hi:[0,0,0]" : "+v"(acc[ai][bj][m][n]) : "v"(Bt##_f8[n]), "v"(At##_f8[m]), "v"(sc1)); } \
        else { _Pragma("unroll") for (int m = 0; m < 4; ++m) _Pragma("unroll") for (int n = 0; n < 2; ++n) _Pragma("unroll") for (int k = 0; k < 2; ++k) \
            acc[ai][bj][m][n] = __builtin_amdgcn_mfma_f32_16x16x32_bf16(Bt##_bf[n][k], At##_bf[m][k], acc[ai][bj][m][n], 0, 0, 0); } \
        __builtin_amdgcn_s_setprio(0); } while (0)
#define PG8_WAIT_V(n) asm volatile("s_waitcnt vmcnt(" #n ")" ::: "memory")
#define PG8_WAIT_L(n) asm volatile("s_waitcnt lgkmcnt(" #n ")" ::: "memory")
#define PG8_BAR __builtin_amdgcn_s_barrier()
#define PG8_SCHED __builtin_amdgcn_sched_barrier(0)
#define PG8_GLOAD(gv, i) do { if (GATHER) { _Pragma("unroll") for (int _h = 0; _h < 2; ++_h) _Pragma("unroll") for (int _i = 0; _i < 2; ++_i) (gv)[_h][_i] = gtab[(i) * 256 + _h * 128 + RA[_i]] + (unsigned)CA2[_i]; } } while (0)
    Unit cur, nxt; int ui = 0;
    if (!S.next(0, cur)) return;
    f32x4 acc[2][2][4][2];
    if constexpr (Epi::INIT) E.init(acc, cur, wr, wc, fr, fq, gtab);
    else {
#pragma unroll
    for (int a = 0; a < 2; ++a)
#pragma unroll
        for (int b = 0; b < 2; ++b)
#pragma unroll
            for (int m = 0; m < 4; ++m)
#pragma unroll
                for (int n = 0; n < 2; ++n) acc[a][b][m][n] = (f32x4){0.f, 0.f, 0.f, 0.f};
    }
    i32x8 At_f8[4], B0_f8[2], B1_f8[2]; bf16x8 At_bf[4][2], B0_bf[2][2], B1_bf[2][2];
    int sc1 = 0x7F7F7F7F; asm volatile("" : "+v"(sc1));
    unsigned gc[2][2] = {{0u, 0u}, {0u, 0u}}, gn[2][2] = {{0u, 0u}, {0u, 0u}};
    PG8_GLOAD(gc, 0);
    const char* cA = S.abase(cur); const char* cB = S.bbase(cur);
    PG8_STAGE(PG8_SB(0, 0), cB, voffB); PG8_STAGE_A(PG8_SA(0, 0), cA, 0, 0, gc); PG8_STAGE(PG8_SB(0, 1), cB + hstep, voffB); PG8_STAGE_A(PG8_SA(0, 1), cA, 0, 1, gc);
    if (wr == 1) PG8_BAR;
    PG8_WAIT_V(4); PG8_BAR;
    PG8_STAGE(PG8_SB(1, 0), cB + kstep, voffB); PG8_STAGE_A(PG8_SA(1, 0), cA, kstep, 0, gc); PG8_STAGE(PG8_SB(1, 1), cB + hstep + kstep, voffB);
    PG8_WAIT_V(6); PG8_BAR;
    for (;;) {
        const bool has_next = S.next(ui + 1, nxt);
        const char* nA = has_next ? S.abase(nxt) : cA; const char* nB = has_next ? S.bbase(nxt) : cB;
        if (GATHER) { if (has_next) { PG8_GLOAD(gn, ui + 1); } else {
#pragma unroll
            for (int _h = 0; _h < 2; ++_h)
#pragma unroll
                for (int _i = 0; _i < 2; ++_i) gn[_h][_i] = gc[_h][_i]; } }
        for (int t = 0; t < nt; t += 2) {
            const bool last = (t == nt - 2);
            const size_t k1 = (size_t)(t + 1) * kstep;
            const char* a2 = last ? nA : cA + (size_t)(t + 2) * kstep; const char* b2 = last ? nB : cB + (size_t)(t + 2) * kstep;
            const char* a3 = a2 + kstep; const char* b3 = b2 + kstep;
            unsigned g2[2][2];
#pragma unroll
            for (int _h = 0; _h < 2; ++_h)
#pragma unroll
                for (int _i = 0; _i < 2; ++_i) g2[_h][_i] = last ? gn[_h][_i] : gc[_h][_i];
            if (HOOK && t == 16) {
                const LAS float* ht = (const LAS float*)gtab;
#pragma unroll
                for (int a = 0; a < 2; ++a)
#pragma unroll
                    for (int m = 0; m < 4; ++m) { const float sc = ht[a * 128 + wr * 64 + m * 16 + fr];
#pragma unroll
                        for (int b = 0; b < 2; ++b)
#pragma unroll
                            for (int n = 0; n < 2; ++n) acc[a][b][m][n] = acc[a][b][m][n] * sc; }
            }
            PG8_LDB(B0, 0, 0); PG8_SCHED; PG8_LDA(At, 0, 0); PG8_STAGE_A(PG8_SA(1, 1), cA, k1, 1, gc);
            PG8_WAIT_L(8); PG8_BAR; PG8_WAIT_L(0); PG8_MMA(0, 0, At, B0); PG8_BAR; PG8_SCHED;
            PG8_LDB(B1, 0, 1); PG8_STAGE(PG8_SB(0, 0), b2, voffB);
            PG8_BAR; PG8_WAIT_L(0); PG8_MMA(0, 1, At, B1); PG8_BAR;
            PG8_LDA(At, 0, 1); PG8_STAGE_A(PG8_SA(0, 0), a2, 0, 0, g2);
            PG8_BAR; PG8_WAIT_L(0); PG8_MMA(1, 0, At, B0); PG8_BAR; PG8_SCHED;
            PG8_STAGE(PG8_SB(0, 1), b2 + hstep, voffB);
            PG8_WAIT_V(6); PG8_BAR; PG8_MMA(1, 1, At, B1); PG8_BAR;
            PG8_LDB(B0, 1, 0); PG8_SCHED; PG8_LDA(At, 1, 0); PG8_STAGE_A(PG8_SA(0, 1), a2, 0, 1, g2);
            PG8_WAIT_L(8); PG8_BAR; PG8_WAIT_L(0); PG8_MMA(0, 0, At, B0); PG8_BAR; PG8_SCHED;
            PG8_LDB(B1, 1, 1); PG8_STAGE(PG8_SB(1, 0), b3, voffB);
            PG8_BAR; PG8_WAIT_L(0); PG8_MMA(0, 1, At, B1); PG8_BAR;
            PG8_LDA(At, 1, 1); PG8_STAGE_A(PG8_SA(1, 0), a3, 0, 0, g2);
            PG8_BAR; PG8_WAIT_L(0); PG8_MMA(1, 0, At, B0); PG8_BAR; PG8_SCHED;
            PG8_STAGE(PG8_SB(1, 1), b3 + hstep, voffB);
            PG8_WAIT_V(6); PG8_BAR; PG8_MMA(1, 1, At, B1); PG8_BAR;
        }
        E(acc, cur, wr, wc, fr, fq, lds);
        if (!has_next) break;
#pragma unroll
        for (int a = 0; a < 2; ++a)
#pragma unroll
            for (int b = 0; b < 2; ++b)
#pragma unroll
                for (int m = 0; m < 4; ++m)
#pragma unroll
                    for (int n = 0; n < 2; ++n) acc[a][b][m][n] = (f32x4){0.f, 0.f, 0.f, 0.f};
        cur = nxt; cA = nA; cB = nB; ++ui;
#pragma unroll
        for (int _h = 0; _h < 2; ++_h)
#pragma unroll
            for (int _i = 0; _i < 2; ++_i) gc[_h][_i] = gn[_h][_i];
    }
    PG8_WAIT_V(0);
    if (wr == 0) PG8_BAR;
    PG8_BAR;
#undef PG8_SA
#undef PG8_SB
#undef PG8_STAGE
#undef PG8_STAGE_A
#undef PG8_LDA
#undef PG8_LDB
#undef PG8_MMA
#undef PG8_LD2
#undef PG8_WAIT_V
#undef PG8_WAIT_L
#undef PG8_BAR
#undef PG8_SCHED
#undef PG8_GLOAD
}

struct OrderMN {
    int nM, nN, nwg, G, c; const char* A; const char* Bt; size_t tstep;
    __device__ __forceinline__ void init(const void* A_, const void* Bt_, int M, int N, int K, int G_, int c_) { nM = M / BM; nN = N / BM; nwg = nM * nN; G = G_; c = c_; A = (const char*)A_; Bt = (const char*)Bt_; tstep = (size_t)BM * K * 2; }
    __device__ __forceinline__ bool next(int i, Unit& u) const {
        if (c >= G) return false;
        const long L = (long)i * G + c; if (L >= nwg) return false;
        int wgid = (int)L; { const int q = nwg / NXCD, r = nwg % NXCD, xcd = wgid % NXCD, off = wgid / NXCD; wgid = (xcd < r ? xcd * (q + 1) : r * (q + 1) + (xcd - r) * q) + off; }
        const int nig = WGM * nN, gid = wgid / nig, fm = gid * WGM, gsz = (nM - fm) < WGM ? (nM - fm) : WGM;
        u.pm = fm + ((wgid % nig) % gsz); u.pn = (wgid % nig) / gsz; u.e = 0; return true;
    }
    __device__ __forceinline__ const char* abase(const Unit& u) const { return A + (size_t)u.pm * tstep; }
    __device__ __forceinline__ const char* bbase(const Unit& u) const { return Bt + (size_t)u.pn * tstep; }
};
struct OrderExpert {
    int nN, ntile, G, c, per; const char* A; const char* Bt; size_t a_estride, b_estride, tstepA, tstepB; bool gather;
    __device__ __forceinline__ void init(const void* A_, const void* Bt_, int N, int K, size_t a_es, size_t b_es, bool gather_, int G_, int c_, int per_) {
        nN = N / BM; ntile = NEXP * nN; G = G_; c = c_; per = per_; A = (const char*)A_; Bt = (const char*)Bt_; a_estride = a_es; b_estride = b_es; tstepA = (size_t)BM * K * 2; tstepB = tstepA; gather = gather_; }
    __device__ __forceinline__ bool next(int i, Unit& u) const {
        int T, pm;
        if ((G & 7) == 0) {
            const int x = c & 7, j = c >> 3; if (j >= per) return false;
            const int q = i * per + j, U = 4 * nN; if (q >= 2 * U) return false;
            const int el = q >= U ? 1 : 0, r = q - el * U, chunk = r >> 5, w = r & 31;
            pm = w & 3; const int pn = chunk * 8 + (w >> 2);
            T = (2 * x + el) * nN + pn;
            if (pn >= nN) return false;
        }
        else { const int q = i * G + c; T = q >> 2; pm = q & 3; }
        if (T >= ntile) return false;
        u.e = T / nN; u.pn = T % nN; u.pm = pm; return true;
    }
    __device__ __forceinline__ const char* abase(const Unit& u) const { return gather ? A : A + (size_t)u.e * a_estride + (size_t)u.pm * tstepA; }
    __device__ __forceinline__ const char* bbase(const Unit& u) const { return Bt + (size_t)u.e * b_estride + (size_t)u.pn * tstepB; }
};
}

struct EpiInProj {
    static constexpr bool INIT = false;
    bf16_t* proj;
    __device__ __forceinline__ void operator()(const f32x4 (&acc)[2][2][4][2], const pg8::Unit& u, int wr, int wc, int fr, int fq, LAS unsigned char* lds) const {
        const int pn = u.pn, grp = pn >> 2;
        const int row0 = u.pm * 256 + wr * 64 + fr;
        if (grp == 5 || grp == 2) {
#pragma unroll
            for (int ai = 0; ai < 2; ++ai)
#pragma unroll
                for (int m = 0; m < 4; ++m) {
                    bf16_t* rowp = proj + (size_t)(row0 + ai * 128 + m * 16) * INC + pn * 256 + wc * 32 + 8 * fq;
#pragma unroll
                    for (int bj = 0; bj < 2; ++bj) { const f32x4 v0 = acc[ai][bj][m][0], v1 = acc[ai][bj][m][1];
                        u32x4 w; w.x = cvtpk(v0[0], v0[1]); w.y = cvtpk(v0[2], v0[3]); w.z = cvtpk(v1[0], v1[1]); w.w = cvtpk(v1[2], v1[3]);
                        *(u32x4*)(rowp + bj * 128) = w; }
                }
            return;
        }
        const int gsel = (grp == 0) ? 0 : (grp == 1) ? 1 : (grp == 3) ? 2 : 3;
        const LAS float* gain = (const LAS float*)(lds + SCR_OFF + 8192) + gsel * 128;
        const float osc = (grp == 0 || grp == 3) ? QSCALE : 1.0f;
        LAS float* Pt = (LAS float*)(lds + SCR_OFF);
#pragma unroll
        for (int ai = 0; ai < 2; ++ai)
#pragma unroll
            for (int m = 0; m < 4; ++m)
#pragma unroll
                for (int bj = 0; bj < 2; ++bj) {
                    const f32x4 v0 = acc[ai][bj][m][0], v1 = acc[ai][bj][m][1];
                    float s = (v0[0] * v0[0] + v0[1] * v0[1]) + (v0[2] * v0[2] + v0[3] * v0[3]) + (v1[0] * v1[0] + v1[1] * v1[1]) + (v1[2] * v1[2] + v1[3] * v1[3]);
                    s += __shfl_xor(s, 16); s += __shfl_xor(s, 32);
                    if (fq == 0) Pt[((ai * 128 + wr * 64 + m * 16 + fr) * 2 + bj) * 4 + wc] = s;
                }
        asm volatile("s_waitcnt lgkmcnt(0)" ::: "memory"); __builtin_amdgcn_s_barrier(); asm volatile("" ::: "memory");
        const f32x4 g0 = *(const LAS f32x4*)(gain + wc * 32 + 8 * fq), g1 = *(const LAS f32x4*)(gain + wc * 32 + 8 * fq + 4);
#pragma unroll
        for (int ai = 0; ai < 2; ++ai)
#pragma unroll
            for (int m = 0; m < 4; ++m) {
                bf16_t* rowp = proj + (size_t)(row0 + ai * 128 + m * 16) * INC + pn * 256 + wc * 32 + 8 * fq;
#pragma unroll
                for (int bj = 0; bj < 2; ++bj) {
                    const f32x4 ps = *(const LAS f32x4*)(Pt + ((ai * 128 + wr * 64 + m * 16 + fr) * 2 + bj) * 4);
                    const float rstd = rsqrtf(((ps[0] + ps[1]) + (ps[2] + ps[3])) * (1.0f / 128.0f) + RMS_EPS) * osc;
                    const f32x4 v0 = acc[ai][bj][m][0] * rstd * g0, v1 = acc[ai][bj][m][1] * rstd * g1;
                    u32x4 w; w.x = cvtpk(v0[0], v0[1]); w.y = cvtpk(v0[2], v0[3]); w.z = cvtpk(v1[0], v1[1]); w.w = cvtpk(v1[2], v1[3]);
                    *(u32x4*)(rowp + bj * 128) = w;
                }
            }
    }
};
struct EpiOutProj {
    static constexpr bool INIT = true;
    const float* x; bf16_t* x1b; float* rowss;
    __device__ __forceinline__ void init(f32x4 (&acc)[2][2][4][2], const pg8::Unit& u, int wr, int wc, int fr, int fq, const LAS unsigned* gtab) const {
        const LAS float* ht = (const LAS float*)gtab;
        const int row0 = u.pm * 256 + wr * 64 + fr, col0 = u.pn * 256 + wc * 32 + 8 * fq;
#pragma unroll
        for (int ai = 0; ai < 2; ++ai)
#pragma unroll
            for (int m = 0; m < 4; ++m) {
                const float isc = __builtin_amdgcn_rcpf(ht[ai * 128 + wr * 64 + m * 16 + fr]);
                const float* xp = x + (size_t)(row0 + ai * 128 + m * 16) * DM + col0;
#pragma unroll
                for (int bj = 0; bj < 2; ++bj)
#pragma unroll
                    for (int n = 0; n < 2; ++n) acc[ai][bj][m][n] = *(const f32x4*)(xp + bj * 128 + 4 * n) * isc;
            }
    }
    __device__ __forceinline__ void operator()(const f32x4 (&acc)[2][2][4][2], const pg8::Unit& u, int wr, int wc, int fr, int fq, LAS unsigned char* lds) const {
        const int row0 = u.pm * 256 + wr * 64 + fr, col0 = u.pn * 256 + wc * 32 + 8 * fq;
#pragma unroll
        for (int ai = 0; ai < 2; ++ai)
#pragma unroll
            for (int m = 0; m < 4; ++m) {
                const int row = row0 + ai * 128 + m * 16;
                bf16_t* op = x1b + (size_t)row * DM + col0;
                float s = 0.f;
#pragma unroll
                for (int bj = 0; bj < 2; ++bj) {
                    const f32x4 v0 = acc[ai][bj][m][0], v1 = acc[ai][bj][m][1];
                    u32x4 w; w.x = cvtpk(v0[0], v0[1]); w.y = cvtpk(v0[2], v0[3]); w.z = cvtpk(v1[0], v1[1]); w.w = cvtpk(v1[2], v1[3]);
                    *(u32x4*)(op + bj * 128) = w;
                    s += (v0[0] * v0[0] + v0[1] * v0[1]) + (v0[2] * v0[2] + v0[3] * v0[3]) + (v1[0] * v1[0] + v1[1] * v1[1]) + (v1[2] * v1[2] + v1[3] * v1[3]);
                }
                s += __shfl_xor(s, 16); s += __shfl_xor(s, 32);
                if (fq == 0) rowss[(size_t)row * 32 + u.pn * 4 + wc] = s;
            }
    }
};
struct EpiGateUp {
    static constexpr bool INIT = false;
    unsigned char* act;
    __device__ __forceinline__ void operator()(const f32x4 (&acc)[2][2][4][2], const pg8::Unit& u, int wr, int wc, int fr, int fq, LAS unsigned char* lds) const {
        const int row0 = u.pm * 256 + wr * 64 + fr;
        unsigned char* base = act + (size_t)u.e * EROWS * FF + u.pn * 128 + wc * 32 + 8 * fq;
        constexpr float DS = 1.0f / (WSC8 * HSC8);
#pragma unroll
        for (int ai = 0; ai < 2; ++ai)
#pragma unroll
            for (int m = 0; m < 4; ++m) {
                float r[8];
#pragma unroll
                for (int n = 0; n < 2; ++n)
#pragma unroll
                    for (int j = 0; j < 4; ++j) { const float g = acc[ai][0][m][n][j] * DS, uu = acc[ai][1][m][n][j] * DS;
                        const float a = g * __builtin_amdgcn_rcpf(1.0f + __builtin_amdgcn_exp2f(-g * LOG2E)) * uu * ASC8;
                        r[n * 4 + j] = fminf(fmaxf(a, -448.0f), 448.0f); }
                u32x2 w; w.x = cvt4_fp8(r[0], r[1], r[2], r[3]); w.y = cvt4_fp8(r[4], r[5], r[6], r[7]);
                *(u32x2*)(base + (size_t)(row0 + ai * 128 + m * 16) * FF) = w;
            }
    }
};
struct EpiDown {
    static constexpr bool INIT = false;
    unsigned char* y; const float* selgate;
    __device__ __forceinline__ void operator()(const f32x4 (&acc)[2][2][4][2], const pg8::Unit& u, int wr, int wc, int fr, int fq, LAS unsigned char* lds) const {
        const int row0 = u.pm * 256 + wr * 64 + fr;
        unsigned char* base = y + (size_t)u.e * EROWS * DM + u.pn * 256 + wc * 32 + 8 * fq;
#pragma unroll
        for (int ai = 0; ai < 2; ++ai)
#pragma unroll
            for (int m = 0; m < 4; ++m) {
                const int row = row0 + ai * 128 + m * 16;
                const float gt = selgate[u.e * EROWS + row] * (YSC8 / (WSC8 * ASC8));
#pragma unroll
                for (int bj = 0; bj < 2; ++bj) { const f32x4 v0 = acc[ai][bj][m][0] * gt, v1 = acc[ai][bj][m][1] * gt;
                    u32x2 w; w.x = cvt4_fp8(fminf(fmaxf(v0[0], -448.f), 448.f), fminf(fmaxf(v0[1], -448.f), 448.f), fminf(fmaxf(v0[2], -448.f), 448.f), fminf(fmaxf(v0[3], -448.f), 448.f));
                    w.y = cvt4_fp8(fminf(fmaxf(v1[0], -448.f), 448.f), fminf(fmaxf(v1[1], -448.f), 448.f), fminf(fmaxf(v1[2], -448.f), 448.f), fminf(fmaxf(v1[3], -448.f), 448.f));
                    *(u32x2*)(base + (size_t)row * DM + bj * 128) = w; }
            }
    }
};

#define KSWZ(row, colB) ((row) * 256 + ((colB) ^ (((row) & 7) << 4)))
#define SBAR() __builtin_amdgcn_sched_barrier(0)
__device__ __forceinline__ int crow(int r, int hi) { return (r & 3) + 8 * (r >> 2) + 4 * hi; }
#define PK4(P, BASE, OUT) do { unsigned a0 = cvtpk(P[BASE + 0], P[BASE + 1]), a1 = cvtpk(P[BASE + 2], P[BASE + 3]);   \
    unsigned b0 = cvtpk(P[BASE + 4], P[BASE + 5]), b1 = cvtpk(P[BASE + 6], P[BASE + 7]);                              \
    auto r0 = __builtin_amdgcn_permlane32_swap(a0, b0, false, false); auto r1 = __builtin_amdgcn_permlane32_swap(a1, b1, false, false); \
    u32x4 w = {r0[0], r1[0], r0[1], r1[1]}; OUT = *reinterpret_cast<bf16x8*>(&w); } while (0)
__device__ __forceinline__ float swap_add(float v) { auto rr = __builtin_amdgcn_permlane32_swap(__float_as_uint(v), __float_as_uint(v), false, false); return __uint_as_float(rr[0]) + __uint_as_float(rr[1]); }

namespace da {
constexpr int D = 128, NW = 8, QBLK = 32, KVBLK = 64;
constexpr int SHM_V = KVBLK * D * 2, SHM_K = KVBLK * D * 2, SHM_ATTN = 2 * SHM_V + 2 * SHM_K + NW * 64 * 4;
constexpr int LDP = INC;

__device__ __forceinline__ void qkt(f32x16& p0, f32x16& p1, const LAS unsigned char* Ks, const bf16x8* qr, int r32, int hi) {
    p0 = f32x16{}; p1 = f32x16{};
#pragma unroll
    for (int d0 = 0; d0 < 8; ++d0) { const int cb = (d0 * 16 + hi * 8) * 2;
        const bf16x8 b0 = *(const LAS bf16x8*)(Ks + KSWZ(r32, cb));
        const bf16x8 b1 = *(const LAS bf16x8*)(Ks + KSWZ(32 + r32, cb));
        p0 = __builtin_amdgcn_mfma_f32_32x32x16_bf16(b0, qr[d0], p0, 0, 0, 0);
        p1 = __builtin_amdgcn_mfma_f32_32x32x16_bf16(b1, qr[d0], p1, 0, 0, 0); }
}
__device__ __forceinline__ int v_st(int k, int c) { const int kk = (k & ~0xC) | ((k & 4) << 1) | ((k & 8) >> 1); return ((kk >> 3) * 4 + (c >> 5)) * 512 + ((kk & 7) * 32 + (c & 31)) * 2; }
__device__ __forceinline__ int v_rd_base(int lane) { return ((lane & 3) << 3) | (((lane >> 2) & 3) << 6) | (((lane >> 4) & 1) << 5) | (((lane >> 5) & 1) << 8); }
constexpr int v_rd_off(int d0, int ks, int half) { return d0 * 512 + ks * 4096 + half * 2048; }
template <int OFF> __device__ __forceinline__ s16x4 tr_read(int vb) {
    s16x4 r; asm volatile("ds_read_b64_tr_b16 %0, %1 offset:%2" : "=&v"(r) : "v"(vb), "i"(OFF) : "memory"); return r;
}
template <int D0> __device__ __forceinline__ void pv_one(f32x16& od, int vb, bf16x8 pa0, bf16x8 pa1, bf16x8 pa2, bf16x8 pa3) {
    const s16x4 l0 = tr_read<v_rd_off(D0, 0, 0)>(vb), h0 = tr_read<v_rd_off(D0, 0, 1)>(vb), l1 = tr_read<v_rd_off(D0, 1, 0)>(vb), h1 = tr_read<v_rd_off(D0, 1, 1)>(vb);
    const s16x4 l2 = tr_read<v_rd_off(D0, 2, 0)>(vb), h2 = tr_read<v_rd_off(D0, 2, 1)>(vb), l3 = tr_read<v_rd_off(D0, 3, 0)>(vb), h3 = tr_read<v_rd_off(D0, 3, 1)>(vb);
    asm volatile("s_waitcnt lgkmcnt(0)" ::: "memory"); SBAR();
#define PKV(L, H) (bf16x8){L[0], L[1], L[2], L[3], H[0], H[1], H[2], H[3]}
    od = __builtin_amdgcn_mfma_f32_32x32x16_bf16(pa0, PKV(l0, h0), od, 0, 0, 0);
    od = __builtin_amdgcn_mfma_f32_32x32x16_bf16(pa1, PKV(l1, h1), od, 0, 0, 0);
    od = __builtin_amdgcn_mfma_f32_32x32x16_bf16(pa2, PKV(l2, h2), od, 0, 0, 0);
    od = __builtin_amdgcn_mfma_f32_32x32x16_bf16(pa3, PKV(l3, h3), od, 0, 0, 0);
#undef PKV
}
__device__ __forceinline__ void pv_d0(f32x16* o, int vb, bf16x8 pa0, bf16x8 pa1, bf16x8 pa2, bf16x8 pa3) {
    pv_one<0>(o[0], vb, pa0, pa1, pa2, pa3); pv_one<1>(o[1], vb, pa0, pa1, pa2, pa3); pv_one<2>(o[2], vb, pa0, pa1, pa2, pa3); pv_one<3>(o[3], vb, pa0, pa1, pa2, pa3);
}
__device__ __forceinline__ void sm_a(f32x16& p0, f32x16& p1, float dq, float slope2) {
#pragma unroll
    for (int r = 0; r < 16; ++r) { const float c = (float)((r & 3) + 8 * (r >> 2)); p0[r] = __builtin_amdgcn_exp2f(p0[r] - slope2 * fabsf(dq - c)); }
#pragma unroll
    for (int r = 0; r < 16; ++r) { const float c = (float)((r & 3) + 8 * (r >> 2) + 32); p1[r] = p1[r] - slope2 * fabsf(dq - c); }
}
__device__ __forceinline__ void sm_b(f32x16& p0, f32x16& p1, float& l_reg, bf16x8& pa0, bf16x8& pa1, bf16x8& pa2, bf16x8& pa3) {
#pragma unroll
    for (int r = 0; r < 16; ++r) p1[r] = __builtin_amdgcn_exp2f(p1[r]);
    float ps = 0;
#pragma unroll
    for (int r = 0; r < 16; ++r) ps += p0[r];
#pragma unroll
    for (int r = 0; r < 16; ++r) ps += p1[r];
    l_reg += swap_add(ps);
    PK4(p0, 0, pa0); PK4(p0, 8, pa1); PK4(p1, 0, pa2); PK4(p1, 8, pa3);
}
__device__ __forceinline__ void attn_body(const bf16_t* __restrict__ Qb, const bf16_t* __restrict__ Kh, const bf16_t* __restrict__ Vh, float* __restrict__ Ob, int q0, float slope2, LAS unsigned char* lds) {
    const int tid = threadIdx.x, wid = tid >> 6, lane = tid & 63, r32 = lane & 31, hi = lane >> 5;
    LAS unsigned char* V_lds = lds; LAS unsigned char* K_lds = lds + 2 * SHM_V;
    LAS float* li_l = (LAS float*)(lds + 2 * SHM_V + 2 * SHM_K) + wid * 64;
    float l_reg = 0; f32x16 o[4] = {}; bf16x8 qr[8];
    const bf16_t* Qw = Qb + (size_t)(wid * QBLK + r32) * LDP + hi * 8;
#pragma unroll
    for (int d0 = 0; d0 < 8; ++d0) qr[d0] = *(const bf16x8*)(Qw + d0 * 16);
    const int sr = tid >> 4, sc = (tid & 15) * 8, vst0 = v_st(sr, sc), vst1 = v_st(32 + sr, sc);
    const int vb0 = (int)(uintptr_t)V_lds + v_rd_base(lane);
    const float dqbase = (float)(q0 + wid * QBLK + r32 - 4 * hi);
    struct { bf16x8 vs0, vs1, ks0, ks1; } sr_[1];
    const unsigned so0 = (unsigned)(sr * LDP + sc) * 2u, so1 = (unsigned)((32 + sr) * LDP + sc) * 2u;
#define SLOAD(i, k0) do { const char* vb_ = (const char*)Vh + (size_t)(k0) * (LDP * 2); const char* kb_ = (const char*)Kh + (size_t)(k0) * (LDP * 2); \
    sr_[i].vs0 = *(const bf16x8*)(vb_ + so0); sr_[i].vs1 = *(const bf16x8*)(vb_ + so1); \
    sr_[i].ks0 = *(const bf16x8*)(kb_ + so0); sr_[i].ks1 = *(const bf16x8*)(kb_ + so1); } while (0)
#define SWRITE(b, i) do { *(LAS bf16x8*)(V_lds + (b) * SHM_V + vst0) = sr_[i].vs0;          \
    *(LAS bf16x8*)(V_lds + (b) * SHM_V + vst1) = sr_[i].vs1; const int kc = sc * 2;               \
    *(LAS bf16x8*)(K_lds + (b) * SHM_K + KSWZ(sr, kc)) = sr_[i].ks0;                       \
    *(LAS bf16x8*)(K_lds + (b) * SHM_K + KSWZ(32 + sr, kc)) = sr_[i].ks1; } while (0)
#define SWAIT() asm volatile("s_waitcnt vmcnt(0)" ::: "memory")
    f32x16 pA0, pA1, pB0, pB1; bf16x8 pa0, pa1, pa2, pa3; constexpr int NT = SEQ / KVBLK;
    SLOAD(0, 0); SWAIT(); SWRITE(0, 0); __syncthreads();
    qkt(pA0, pA1, K_lds, qr, r32, hi); sm_a(pA0, pA1, dqbase, slope2);
    SLOAD(0, KVBLK);
    SWAIT(); SWRITE(1, 0); __syncthreads();
    for (int j = 1; j + 1 < NT; j += 2) {
        SBAR(); qkt(pB0, pB1, K_lds + SHM_K, qr, r32, hi);
        sm_b(pA0, pA1, l_reg, pa0, pa1, pa2, pa3); SBAR();
        SLOAD(0, (j + 1) * KVBLK); SBAR();
        pv_d0(o, vb0, pa0, pa1, pa2, pa3); sm_a(pB0, pB1, dqbase - (float)(j * KVBLK), slope2);
        __syncthreads(); SWAIT(); SWRITE(0, 0);
        __syncthreads();
        SBAR(); qkt(pA0, pA1, K_lds, qr, r32, hi);
        sm_b(pB0, pB1, l_reg, pa0, pa1, pa2, pa3); SBAR();
        SLOAD(0, (j + 2) * KVBLK); SBAR();
        pv_d0(o, vb0 + SHM_V, pa0, pa1, pa2, pa3); sm_a(pA0, pA1, dqbase - (float)((j + 1) * KVBLK), slope2);
        __syncthreads(); SWAIT(); SWRITE(1, 0);
        __syncthreads();
    }
    SBAR(); qkt(pB0, pB1, K_lds + SHM_K, qr, r32, hi);
    sm_b(pA0, pA1, l_reg, pa0, pa1, pa2, pa3); SBAR();
    pv_d0(o, vb0, pa0, pa1, pa2, pa3); sm_a(pB0, pB1, dqbase - (float)((NT - 1) * KVBLK), slope2);
    __syncthreads();
    sm_b(pB0, pB1, l_reg, pa0, pa1, pa2, pa3); SBAR();
    pv_d0(o, vb0 + SHM_V, pa0, pa1, pa2, pa3);
    if (hi == 0) li_l[r32] = l_reg; asm volatile("s_waitcnt lgkmcnt(0)" ::: "memory");
    float rli[16];
#pragma unroll
    for (int r = 0; r < 16; ++r) rli[r] = __builtin_amdgcn_rcpf(li_l[crow(r, hi)]);
    float* Ow = Ob + (size_t)(wid * QBLK) * DM;
#pragma unroll
    for (int r = 0; r < 16; ++r) { const int orow = crow(r, hi);
#pragma unroll
        for (int d0 = 0; d0 < 4; ++d0) Ow[(size_t)orow * DM + d0 * 32 + r32] = o[d0][r] * rli[r]; }
    __syncthreads();
#undef SLOAD
#undef SWRITE
#undef SWAIT
}
}

namespace da2 {
constexpr int BUFB = 65536, KB = 16384;
__device__ __forceinline__ int v_rd_base(int lane) { return ((lane & 3) << 3) | (((lane >> 2) & 3) << 6) | (((lane >> 4) & 1) << 5) | (((lane >> 5) & 1) << 8); }
template <int OFF> __device__ __forceinline__ s16x4 tr_read(int vb) {
    s16x4 r; asm volatile("ds_read_b64_tr_b16 %0, %1 offset:%2" : "=&v"(r) : "v"(vb), "i"(OFF) : "memory"); return r;
}
template <int NCB, int CB> __device__ __forceinline__ void pv_one(f32x16& od, int vb, bf16x8 pa0, bf16x8 pa1, bf16x8 pa2, bf16x8 pa3) {
    constexpr int S = NCB * 512;
    const s16x4 l0 = tr_read<CB * 512 + 0 * S>(vb), h0 = tr_read<CB * 512 + 1 * S>(vb), l1 = tr_read<CB * 512 + 2 * S>(vb), h1 = tr_read<CB * 512 + 3 * S>(vb);
    const s16x4 l2 = tr_read<CB * 512 + 4 * S>(vb), h2 = tr_read<CB * 512 + 5 * S>(vb), l3 = tr_read<CB * 512 + 6 * S>(vb), h3 = tr_read<CB * 512 + 7 * S>(vb);
    asm volatile("s_waitcnt lgkmcnt(0)" ::: "memory"); SBAR();
#define PKV(L, H) (bf16x8){L[0], L[1], L[2], L[3], H[0], H[1], H[2], H[3]}
    od = __builtin_amdgcn_mfma_f32_32x32x16_bf16(pa0, PKV(l0, h0), od, 0, 0, 0);
    od = __builtin_amdgcn_mfma_f32_32x32x16_bf16(pa1, PKV(l1, h1), od, 0, 0, 0);
    od = __builtin_amdgcn_mfma_f32_32x32x16_bf16(pa2, PKV(l2, h2), od, 0, 0, 0);
    od = __builtin_amdgcn_mfma_f32_32x32x16_bf16(pa3, PKV(l3, h3), od, 0, 0, 0);
#undef PKV
}
__device__ __forceinline__ void qkt(f32x16& p0, f32x16& p1, const LAS unsigned char* Ks, const bf16x8* qr, int r32, int hi) {
    p0 = f32x16{}; p1 = f32x16{};
#pragma unroll
    for (int d0 = 0; d0 < 8; ++d0) { const int cb = (d0 * 16 + hi * 8) * 2;
        const bf16x8 b0 = *(const LAS bf16x8*)(Ks + KSWZ(r32, cb));
        const bf16x8 b1 = *(const LAS bf16x8*)(Ks + KSWZ(32 + r32, cb));
        p0 = __builtin_amdgcn_mfma_f32_32x32x16_bf16(b0, qr[d0], p0, 0, 0, 0);
        p1 = __builtin_amdgcn_mfma_f32_32x32x16_bf16(b1, qr[d0], p1, 0, 0, 0); }
}
__device__ __forceinline__ int unswap23(int kk) { return (kk & ~0xC) | ((kk & 4) << 1) | ((kk & 8) >> 1); }

__device__ __forceinline__ void epilogue(const Params& P, LAS unsigned char* lds, f32x16 (&o)[8], float l_reg, int tz, int it) {
    const int wid = __builtin_amdgcn_readfirstlane(tz >> 6), lane = tz & 63, r32 = lane & 31, hi = lane >> 5;
    float lam;
    { float a = P.lam_q1[lane] * P.lam_k1[lane] + P.lam_q1[lane + 64] * P.lam_k1[lane + 64];
      float c = P.lam_q2[lane] * P.lam_k2[lane] + P.lam_q2[lane + 64] * P.lam_k2[lane + 64];
      a = wave_sum(a); c = wave_sum(c); lam = expf(a) - expf(c) + 0.2f; }
    const int br = wid >> 2, w4 = wid & 3;
    const int b = it >> 7, h = (it >> 5) & 3, qt = it & 31;
    const size_t row0 = (size_t)b * SEQ; const int q0 = qt * 128;
    LAS float* li_l = (LAS float*)(lds + SCR_OFF) + wid * 32;
    if (hi == 0) li_l[r32] = l_reg;
    asm volatile("s_waitcnt lgkmcnt(0)" ::: "memory");
    __syncthreads();
    LAS float* X = (LAS float*)lds + w4 * 8192;
    if (br == 1) {
#pragma unroll
        for (int r = 0; r < 16; ++r) { const float rl = __builtin_amdgcn_rcpf(li_l[crow(r, hi)]);
#pragma unroll
            for (int d = 0; d < 8; ++d) X[(r * 8 + d) * 64 + lane] = o[d][r] * rl; }
    }
    __syncthreads();
    if (br == 0) {
        LAS unsigned char* T = (LAS unsigned char*)X;
        float g[8];
#pragma unroll
        for (int d = 0; d < 8; ++d) g[d] = P.subln_b[d * 32 + r32];
#pragma unroll
        for (int r = 0; r < 16; ++r) {
            const float rl = __builtin_amdgcn_rcpf(li_l[crow(r, hi)]);
            float v[8], sq = 0.f;
#pragma unroll
            for (int d = 0; d < 8; ++d) { v[d] = o[d][r] * rl - lam * X[(r * 8 + d) * 64 + lane]; sq += v[d] * v[d]; }
#pragma unroll
            for (int sh = 16; sh >= 1; sh >>= 1) sq += __shfl_xor(sq, sh);
            const float rstd = rsqrtf(sq * (1.0f / 256.0f) + RMS_EPS) * 0.8f;
#pragma unroll
            for (int d = 0; d < 8; ++d) { const unsigned w = cvtpk(v[d] * rstd * g[d], 0.f); *(LAS bf16_t*)(T + (2 * r + hi) * 512 + (d * 32 + r32) * 2) = (bf16_t)(w & 0xffffu); }
        }
        asm volatile("s_waitcnt lgkmcnt(0)" ::: "memory");
        char* mixb = (char*)((bf16_t*)(P.ws + WS_MIX) + (row0 + q0 + w4 * 32) * DM + 1024 + h * 256);
        const unsigned loff = (unsigned)(hi * 4 * DM * 2 + r32 * 16);
#pragma unroll
        for (int i = 0; i < 16; ++i) {
            const u32x4 w = *(const LAS u32x4*)(T + (2 * i + hi) * 512 + r32 * 16);
            *(u32x4*)(mixb + (size_t)((i & 3) + 8 * (i >> 2)) * (DM * 2) + loff) = w;
        }
    }
    __syncthreads();
}
__device__ __forceinline__ void item(const Params& P, int it, LAS unsigned char* lds) {
    int tid = threadIdx.x; asm volatile("" : "+v"(tid));
    const int wid = __builtin_amdgcn_readfirstlane(tid >> 6), lane = tid & 63, r32 = lane & 31, hi = lane >> 5;
    const int br = wid >> 2, w4 = wid & 3;
    const int b = it >> 7, h = (it >> 5) & 3, qt = it & 31;
    const bf16_t* proj = (const bf16_t*)(P.ws + WS_PROJ);
    const size_t row0 = (size_t)b * SEQ; const int q0 = qt * 128;
    bf16x8 qr[8];
    { const bf16_t* Qw = proj + (row0 + q0 + w4 * 32 + r32) * INC + 3072 + br * 512 + h * 128 + hi * 8;
#pragma unroll
      for (int d0 = 0; d0 < 8; ++d0) qr[d0] = *(const bf16x8*)(Qw + d0 * 16); }
    const char* kbase = (const char*)(proj + row0 * INC + 4096 + h * 128);
    const char* vbase = (const char*)(proj + row0 * INC + 5120 + h * 256);
    const int krow = wid * 8 + (lane >> 4);
    const unsigned voffK0 = (unsigned)(krow * INC * 2 + (((lane & 15) ^ (lane >> 4)) << 4));
    const unsigned voffK1 = (unsigned)((krow + 4) * INC * 2 + (((lane & 15) ^ (4 + (lane >> 4))) << 4));
    const unsigned voffV = (unsigned)(unswap23(wid * 8 + ((lane & 31) >> 2)) * INC * 2 + (lane >> 5) * 64 + (lane & 3) * 16);
#define DA2_ISSUE(t, bufi) do { const char* kb_ = kbase + (size_t)(t) * (64 * INC * 2); const char* vb_ = vbase + (size_t)(t) * (64 * INC * 2); \
        LAS unsigned char* lb_ = lds + (bufi) * BUFB; \
        __builtin_amdgcn_global_load_lds((const unsigned*)(kb_ + voffK0), (LAS unsigned*)(lb_ + wid * 2048), 16, 0, 0); \
        __builtin_amdgcn_global_load_lds((const unsigned*)(kb_ + voffK1), (LAS unsigned*)(lb_ + wid * 2048 + 1024), 16, 0, 0); \
        __builtin_amdgcn_global_load_lds((const unsigned*)(kb_ + 1024 + voffK0), (LAS unsigned*)(lb_ + KB + wid * 2048), 16, 0, 0); \
        __builtin_amdgcn_global_load_lds((const unsigned*)(kb_ + 1024 + voffK1), (LAS unsigned*)(lb_ + KB + wid * 2048 + 1024), 16, 0, 0); \
        _Pragma("unroll") for (int i_ = 0; i_ < 4; ++i_) \
            __builtin_amdgcn_global_load_lds((const unsigned*)(vb_ + i_ * 128 + voffV), (LAS unsigned*)(lb_ + 2 * KB + wid * 4096 + i_ * 1024), 16, 0, 0); } while (0)
    const float slope2 = exp2f(-2.0f * (float)(h + 1)) * LOG2E;
    float dq = (float)(q0 + w4 * 32 + r32 - 4 * hi);
    f32x16 o[8];
#pragma unroll
    for (int d = 0; d < 8; ++d) o[d] = f32x16{};
    float l_reg = 0.f;
    const int vb0 = (int)(uintptr_t)(lds + 2 * KB) + v_rd_base(lane);
    DA2_ISSUE(0, 0);
#pragma unroll 1
    for (int j = 0; j < SEQ / 64; ++j) {
        asm volatile("s_waitcnt vmcnt(0)" ::: "memory");
        __builtin_amdgcn_s_barrier();
        asm volatile("" ::: "memory");
        if (j + 1 < SEQ / 64) DA2_ISSUE(j + 1, (j + 1) & 1);
        const LAS unsigned char* Kb = lds + (j & 1) * BUFB + br * KB;
        f32x16 p0, p1;
        qkt(p0, p1, Kb, qr, r32, hi);
        float ps = 0.f;
#pragma unroll
        for (int r = 0; r < 16; ++r) { const float c = (float)((r & 3) + 8 * (r >> 2)); p0[r] = __builtin_amdgcn_exp2f(p0[r] - slope2 * fabsf(dq - c)); ps += p0[r]; }
#pragma unroll
        for (int r = 0; r < 16; ++r) { const float c = (float)((r & 3) + 8 * (r >> 2) + 32); p1[r] = __builtin_amdgcn_exp2f(p1[r] - slope2 * fabsf(dq - c)); ps += p1[r]; }
        l_reg += swap_add(ps);
        bf16x8 pa0, pa1, pa2, pa3;
        PK4(p0, 0, pa0); PK4(p0, 8, pa1); PK4(p1, 0, pa2); PK4(p1, 8, pa3);
        const int vb = vb0 + (j & 1) * BUFB;
        pv_one<8, 0>(o[0], vb, pa0, pa1, pa2, pa3); pv_one<8, 1>(o[1], vb, pa0, pa1, pa2, pa3); pv_one<8, 2>(o[2], vb, pa0, pa1, pa2, pa3); pv_one<8, 3>(o[3], vb, pa0, pa1, pa2, pa3);
        pv_one<8, 4>(o[4], vb, pa0, pa1, pa2, pa3); pv_one<8, 5>(o[5], vb, pa0, pa1, pa2, pa3); pv_one<8, 6>(o[6], vb, pa0, pa1, pa2, pa3); pv_one<8, 7>(o[7], vb, pa0, pa1, pa2, pa3);
        dq -= 64.0f;
    }
#undef DA2_ISSUE
    int tz = threadIdx.x; asm volatile("" : "+v"(tz));
    epilogue(P, lds, o, l_reg, tz, it);
}
}

namespace da3 {
constexpr int BUFB = 65536, KB = 16384;
__device__ __forceinline__ void qk_softmax(const LAS unsigned char* Kb, const bf16x8* qr, int r32, int hi, float dq, float slope2, int rel  ,
                                           float& l_reg, bf16x8& pa0, bf16x8& pa1, bf16x8& pa2, bf16x8& pa3) {
    f32x16 p0, p1;
    if (rel != 0) {
        const float ss = rel < 0 ? slope2 : -slope2, A = -ss * dq;
#pragma unroll
        for (int r = 0; r < 16; ++r) { const float c = (float)((r & 3) + 8 * (r >> 2)); p0[r] = fmaf(ss, c, A); p1[r] = fmaf(ss, c + 32.0f, A); }
    } else {
#pragma unroll
        for (int r = 0; r < 16; ++r) { const float c = (float)((r & 3) + 8 * (r >> 2)); p0[r] = -slope2 * fabsf(dq - c); p1[r] = -slope2 * fabsf(dq - c - 32.0f); }
    }
#pragma unroll
    for (int d0 = 0; d0 < 8; ++d0) { const int cb = (d0 * 16 + hi * 8) * 2;
        const bf16x8 b0 = *(const LAS bf16x8*)(Kb + KSWZ(r32, cb));
        const bf16x8 b1 = *(const LAS bf16x8*)(Kb + KSWZ(32 + r32, cb));
        p0 = __builtin_amdgcn_mfma_f32_32x32x16_bf16(b0, qr[d0], p0, 0, 0, 0);
        p1 = __builtin_amdgcn_mfma_f32_32x32x16_bf16(b1, qr[d0], p1, 0, 0, 0); }
    f32x2 s2 = {0.f, 0.f};
#pragma unroll
    for (int r = 0; r < 16; r += 2) { p0[r] = __builtin_amdgcn_exp2f(p0[r]); p0[r + 1] = __builtin_amdgcn_exp2f(p0[r + 1]); s2 += (f32x2){p0[r], p0[r + 1]}; }
#pragma unroll
    for (int r = 0; r < 16; r += 2) { p1[r] = __builtin_amdgcn_exp2f(p1[r]); p1[r + 1] = __builtin_amdgcn_exp2f(p1[r + 1]); s2 += (f32x2){p1[r], p1[r + 1]}; }
    l_reg += swap_add(s2[0] + s2[1]);
    PK4(p0, 0, pa0); PK4(p0, 8, pa1); PK4(p1, 0, pa2); PK4(p1, 8, pa3);
}
struct VFrag { s16x4 l0, h0, l1, h1, l2, h2, l3, h3; };
template <int CB> __device__ __forceinline__ void vread(VFrag& f, int vb) {
    constexpr int S = 8 * 512;
    f.l0 = da2::tr_read<CB * 512 + 0 * S>(vb); f.h0 = da2::tr_read<CB * 512 + 1 * S>(vb); f.l1 = da2::tr_read<CB * 512 + 2 * S>(vb); f.h1 = da2::tr_read<CB * 512 + 3 * S>(vb);
    f.l2 = da2::tr_read<CB * 512 + 4 * S>(vb); f.h2 = da2::tr_read<CB * 512 + 5 * S>(vb); f.l3 = da2::tr_read<CB * 512 + 6 * S>(vb); f.h3 = da2::tr_read<CB * 512 + 7 * S>(vb);
}
__device__ __forceinline__ void vmma(f32x16& od, const VFrag& f, bf16x8 pa0, bf16x8 pa1, bf16x8 pa2, bf16x8 pa3) {
#define PKV(L, H) (bf16x8){L[0], L[1], L[2], L[3], H[0], H[1], H[2], H[3]}
    od = __builtin_amdgcn_mfma_f32_32x32x16_bf16(pa0, PKV(f.l0, f.h0), od, 0, 0, 0);
    od = __builtin_amdgcn_mfma_f32_32x32x16_bf16(pa1, PKV(f.l1, f.h1), od, 0, 0, 0);
    od = __builtin_amdgcn_mfma_f32_32x32x16_bf16(pa2, PKV(f.l2, f.h2), od, 0, 0, 0);
    od = __builtin_amdgcn_mfma_f32_32x32x16_bf16(pa3, PKV(f.l3, f.h3), od, 0, 0, 0);
#undef PKV
}
#define DA3_LW(n) do { asm volatile("s_waitcnt lgkmcnt(" #n ")" ::: "memory"); SBAR(); } while (0)
__device__ __forceinline__ void pv8(f32x16 (&o)[8], int vb, bf16x8 pa0, bf16x8 pa1, bf16x8 pa2, bf16x8 pa3) {
    VFrag fa, fb;
    vread<0>(fa, vb);
    vread<1>(fb, vb); DA3_LW(8); vmma(o[0], fa, pa0, pa1, pa2, pa3);
    vread<2>(fa, vb); DA3_LW(8); vmma(o[1], fb, pa0, pa1, pa2, pa3);
    vread<3>(fb, vb); DA3_LW(8); vmma(o[2], fa, pa0, pa1, pa2, pa3);
    vread<4>(fa, vb); DA3_LW(8); vmma(o[3], fb, pa0, pa1, pa2, pa3);
    vread<5>(fb, vb); DA3_LW(8); vmma(o[4], fa, pa0, pa1, pa2, pa3);
    vread<6>(fa, vb); DA3_LW(8); vmma(o[5], fb, pa0, pa1, pa2, pa3);
    vread<7>(fb, vb); DA3_LW(8); vmma(o[6], fa, pa0, pa1, pa2, pa3);
    DA3_LW(0); vmma(o[7], fb, pa0, pa1, pa2, pa3);
}
__device__ __forceinline__ void item(const Params& P, int it, LAS unsigned char* lds) {
    int tid = threadIdx.x; asm volatile("" : "+v"(tid));
    const int wid = __builtin_amdgcn_readfirstlane(tid >> 6), lane = tid & 63, r32 = lane & 31, hi = lane >> 5;
    const int br = wid >> 2, w4 = wid & 3;
    const int b = it >> 7, h = (it >> 5) & 3, qt = it & 31;
    const bf16_t* proj = (const bf16_t*)(P.ws + WS_PROJ);
    const size_t row0 = (size_t)b * SEQ; const int q0 = qt * 128;
    bf16x8 qr[8];
    { const bf16_t* Qw = proj + (row0 + q0 + w4 * 32 + r32) * INC + 3072 + br * 512 + h * 128 + hi * 8;
#pragma unroll
      for (int d0 = 0; d0 < 8; ++d0) qr[d0] = *(const bf16x8*)(Qw + d0 * 16); }
    const char* kbase = (const char*)(proj + row0 * INC + 4096 + br * 512 + h * 128);
    const char* vbase = (const char*)(proj + row0 * INC + 5120 + h * 256);
#define DA3_LANE() int lz_ = lane; asm volatile("" : "+v"(lz_)); const int krow_ = w4 * 16 + (lz_ >> 4)
#define DA3_ISSUE_K(t, bufi) do { DA3_LANE(); \
        const unsigned voffK0 = (unsigned)(krow_ * INC * 2 + (((lz_ & 15) ^ (lz_ >> 4)) << 4)); \
        const unsigned voffK1 = (unsigned)((krow_ + 4) * INC * 2 + (((lz_ & 15) ^ (4 + (lz_ >> 4))) << 4)); \
        const char* kb_ = kbase + (size_t)(t) * (64 * INC * 2); LAS unsigned char* lb_ = lds + (bufi) * BUFB + br * KB + w4 * 4096; \
        __builtin_amdgcn_global_load_lds((const unsigned*)(kb_ + voffK0), (LAS unsigned*)(lb_), 16, 0, 0); \
        __builtin_amdgcn_global_load_lds((const unsigned*)(kb_ + voffK1), (LAS unsigned*)(lb_ + 1024), 16, 0, 0); \
        __builtin_amdgcn_global_load_lds((const unsigned*)(kb_ + 8 * INC * 2 + voffK0), (LAS unsigned*)(lb_ + 2048), 16, 0, 0); \
        __builtin_amdgcn_global_load_lds((const unsigned*)(kb_ + 8 * INC * 2 + voffK1), (LAS unsigned*)(lb_ + 3072), 16, 0, 0); } while (0)
#define DA3_ISSUE_V(t, bufi) do { DA3_LANE(); (void)krow_; \
        const unsigned voffV = (unsigned)(da2::unswap23(wid * 8 + ((lz_ & 31) >> 2)) * INC * 2 + (lz_ >> 5) * 64 + (lz_ & 3) * 16); \
        const char* vb_ = vbase + (size_t)(t) * (64 * INC * 2); LAS unsigned char* lb_ = lds + (bufi) * BUFB + 2 * KB + wid * 4096; \
        _Pragma("unroll") for (int i_ = 0; i_ < 4; ++i_) \
            __builtin_amdgcn_global_load_lds((const unsigned*)(vb_ + i_ * 128 + voffV), (LAS unsigned*)(lb_ + i_ * 1024), 16, 0, 0); } while (0)
#define DA3_BAR() do { asm volatile("" ::: "memory"); __builtin_amdgcn_s_barrier(); asm volatile("" ::: "memory"); } while (0)
    const float slope2 = exp2f(-2.0f * (float)(h + 1)) * LOG2E;
    const int qlo = q0 + w4 * 32, jd = qlo >> 6;
    int jlo = 0, jhi = SEQ / 64 - 1;
    { float gq = fmaxf(fabsf(P.qn_b[lane]), fabsf(P.qn_b[lane + 64])), gk = fmaxf(fabsf(P.kn_b[lane]), fabsf(P.kn_b[lane + 64]));
#pragma unroll
      for (int o_ = 32; o_ >= 1; o_ >>= 1) { gq = fmaxf(gq, __shfl_xor(gq, o_)); gk = fmaxf(gk, __shfl_xor(gk, o_)); }
      const float smax = 128.0f * QSCALE * gq * gk, dmax = (160.0f + smax) / slope2;
      const int di = dmax < 8192.0f ? (int)dmax + 1 : 8192;
      const int klo = q0 - di, khi = q0 + 127 + di;
      jlo = __builtin_amdgcn_readfirstlane(klo <= 0 ? 0 : (klo >> 6)); jhi = __builtin_amdgcn_readfirstlane(khi >= SEQ - 1 ? SEQ / 64 - 1 : (khi >> 6)); }
    float dq = (float)(qlo + r32 - 4 * hi - 64 * jlo);
    f32x16 o[8];
#pragma unroll
    for (int d = 0; d < 8; ++d) o[d] = f32x16{};
    float l_reg = 0.f;
    const int vb0 = (int)(uintptr_t)(lds + 2 * KB) + da2::v_rd_base(lane);
    bf16x8 pa0, pa1, pa2, pa3;
    DA3_ISSUE_K(jlo, 0); DA3_ISSUE_V(jlo, 0);
    if (br == 0) {
        asm volatile("s_waitcnt vmcnt(4)" ::: "memory");
#pragma unroll 1
        for (int j = jlo; j <= jhi; ++j) {
            const int jn = (j + 1 <= jhi) ? j + 1 : jhi, bc = (j - jlo) & 1, bn = bc ^ 1;
            DA3_BAR();
            DA3_ISSUE_K(jn, bn);
            qk_softmax(lds + bc * BUFB, qr, r32, hi, dq, slope2, j - jd, l_reg, pa0, pa1, pa2, pa3);
            asm volatile("s_waitcnt vmcnt(4)" ::: "memory");
            DA3_BAR();
            DA3_ISSUE_V(jn, bn);
            pv8(o, vb0 + bc * BUFB, pa0, pa1, pa2, pa3);
            asm volatile("s_waitcnt vmcnt(4)" ::: "memory");
            dq -= 64.0f;
        }
        DA3_BAR();
    } else {
        DA3_BAR();
        asm volatile("s_waitcnt vmcnt(0)" ::: "memory");
#pragma unroll 1
        for (int j = jlo; j <= jhi; ++j) {
            const int jn = (j + 1 <= jhi) ? j + 1 : jhi, bc = (j - jlo) & 1, bn = bc ^ 1;
            DA3_BAR();
            DA3_ISSUE_K(jn, bn); DA3_ISSUE_V(jn, bn);
            qk_softmax(lds + bc * BUFB + KB, qr, r32, hi, dq, slope2, j - jd, l_reg, pa0, pa1, pa2, pa3);
            DA3_BAR();
            pv8(o, vb0 + bc * BUFB, pa0, pa1, pa2, pa3);
            asm volatile("s_waitcnt vmcnt(0)" ::: "memory");
            dq -= 64.0f;
        }
    }
#undef DA3_ISSUE_K
#undef DA3_LANE
#undef DA3_ISSUE_V
#undef DA3_BAR
    asm volatile("s_waitcnt vmcnt(0)" ::: "memory");
    int tz = threadIdx.x; asm volatile("" : "+v"(tz));
    da2::epilogue(P, lds, o, l_reg, tz, it);
}
}

namespace da5 {
constexpr int BUFB = 65536, KB = 16384;
typedef float f32x4v __attribute__((ext_vector_type(4)));
template <int OFF> __device__ __forceinline__ s16x4 trr(int a) { s16x4 r; asm volatile("ds_read_b64_tr_b16 %0, %1 offset:%2" : "=&v"(r) : "v"(a), "i"(OFF) : "memory"); return r; }
#define D5_LW(n) do { asm volatile("s_waitcnt lgkmcnt(" #n ")" ::: "memory"); SBAR(); } while (0)

__device__ __forceinline__ void qk_softmax(const LAS unsigned char* Kb, const bf16x8 (&qr)[4][2], int lane_, float dqb, float slope2, int rel, float (&l)[2], bf16x8 (&pa)[2][2]) {
    asm volatile("" : "+v"(lane_));
    const int l16 = lane_ & 15, g = lane_ >> 4;
    f32x4v S[4][2];
    if (rel != 0) {
        const float ss = rel < 0 ? slope2 : -slope2, A = -ss * dqb;
#pragma unroll
        for (int kg = 0; kg < 4; ++kg)
#pragma unroll
            for (int qg = 0; qg < 2; ++qg)
#pragma unroll
                for (int r = 0; r < 4; ++r) S[kg][qg][r] = fmaf(ss, (float)(16 * kg + r - 16 * qg), A);
    } else {
#pragma unroll
        for (int kg = 0; kg < 4; ++kg)
#pragma unroll
            for (int qg = 0; qg < 2; ++qg)
#pragma unroll
                for (int r = 0; r < 4; ++r) S[kg][qg][r] = -slope2 * fabsf(dqb - (float)(16 * kg + r - 16 * qg));
    }
    const int krow = l16 * 256, kx = (l16 & 7) << 4;
#pragma unroll
    for (int s = 0; s < 4; ++s) {
        const int ka = krow + ((64 * s + 16 * g) ^ kx);
        const bf16x8 k0 = *(const LAS bf16x8*)(Kb + ka), k1 = *(const LAS bf16x8*)(Kb + ka + 4096), k2 = *(const LAS bf16x8*)(Kb + ka + 8192), k3 = *(const LAS bf16x8*)(Kb + ka + 12288);
#pragma unroll
        for (int qg = 0; qg < 2; ++qg) {
            S[0][qg] = __builtin_amdgcn_mfma_f32_16x16x32_bf16(k0, qr[s][qg], S[0][qg], 0, 0, 0);
            S[1][qg] = __builtin_amdgcn_mfma_f32_16x16x32_bf16(k1, qr[s][qg], S[1][qg], 0, 0, 0);
            S[2][qg] = __builtin_amdgcn_mfma_f32_16x16x32_bf16(k2, qr[s][qg], S[2][qg], 0, 0, 0);
            S[3][qg] = __builtin_amdgcn_mfma_f32_16x16x32_bf16(k3, qr[s][qg], S[3][qg], 0, 0, 0);
        }
    }
#pragma unroll
    for (int qg = 0; qg < 2; ++qg) {
        f32x2 s2 = {0.f, 0.f};
#pragma unroll
        for (int kg = 0; kg < 4; ++kg) {
#pragma unroll
            for (int r = 0; r < 4; ++r) S[kg][qg][r] = __builtin_amdgcn_exp2f(S[kg][qg][r]);
            s2 += (f32x2){S[kg][qg][0], S[kg][qg][1]}; s2 += (f32x2){S[kg][qg][2], S[kg][qg][3]};
        }
        float ps = s2[0] + s2[1];
        ps += __shfl_xor(ps, 16); ps += __shfl_xor(ps, 32);
        l[qg] += ps;
#pragma unroll
        for (int ks = 0; ks < 2; ++ks) {
            u32x4 w; w.x = cvtpk(S[2 * ks][qg][0], S[2 * ks][qg][1]); w.y = cvtpk(S[2 * ks][qg][2], S[2 * ks][qg][3]);
            w.z = cvtpk(S[2 * ks + 1][qg][0], S[2 * ks + 1][qg][1]); w.w = cvtpk(S[2 * ks + 1][qg][2], S[2 * ks + 1][qg][3]);
            pa[qg][ks] = *reinterpret_cast<bf16x8*>(&w);
        }
    }
}
struct VF { s16x4 a0, a1, b0, b1; };
template <int HI> __device__ __forceinline__ void vread(VF& f, int a) {
    f.a0 = trr<HI * 256 + 0>(a); f.a1 = trr<HI * 256 + 8192>(a); f.b0 = trr<HI * 256 + 16384>(a); f.b1 = trr<HI * 256 + 24576>(a);
}
__device__ __forceinline__ void vmma(f32x4v& o0, f32x4v& o1, const VF& f, const bf16x8 (&pa)[2][2]) {
#define PKV(L, H) (bf16x8){L[0], L[1], L[2], L[3], H[0], H[1], H[2], H[3]}
    const bf16x8 v0 = PKV(f.a0, f.a1), v1 = PKV(f.b0, f.b1);
    o0 = __builtin_amdgcn_mfma_f32_16x16x32_bf16(pa[0][0], v0, o0, 0, 0, 0);
    o1 = __builtin_amdgcn_mfma_f32_16x16x32_bf16(pa[1][0], v0, o1, 0, 0, 0);
    o0 = __builtin_amdgcn_mfma_f32_16x16x32_bf16(pa[0][1], v1, o0, 0, 0, 0);
    o1 = __builtin_amdgcn_mfma_f32_16x16x32_bf16(pa[1][1], v1, o1, 0, 0, 0);
#undef PKV
}
__device__ __forceinline__ void pv16(f32x4v (&o)[2][16], int vbuf, int lane_, const bf16x8 (&pa)[2][2]) {
    asm volatile("" : "+v"(lane_));
    const int l16 = lane_ & 15, g = lane_ >> 4, q4 = l16 >> 2, p = l16 & 3;
    const int lb = (4 * g + q4) * 512 + ((4 * (g & 1) + q4) << 5) + 8 * p;
    VF fa, fb;
#define VA(vt) (vbuf + (lb ^ (((vt) & 7) << 5)))
    vread<0>(fa, VA(0));
    vread<0>(fb, VA(1)); D5_LW(4); vmma(o[0][0], o[1][0], fa, pa);
    vread<0>(fa, VA(2)); D5_LW(4); vmma(o[0][1], o[1][1], fb, pa);
    vread<0>(fb, VA(3)); D5_LW(4); vmma(o[0][2], o[1][2], fa, pa);
    vread<0>(fa, VA(4)); D5_LW(4); vmma(o[0][3], o[1][3], fb, pa);
    vread<0>(fb, VA(5)); D5_LW(4); vmma(o[0][4], o[1][4], fa, pa);
    vread<0>(fa, VA(6)); D5_LW(4); vmma(o[0][5], o[1][5], fb, pa);
    vread<0>(fb, VA(7)); D5_LW(4); vmma(o[0][6], o[1][6], fa, pa);
    vread<1>(fa, VA(8)); D5_LW(4); vmma(o[0][7], o[1][7], fb, pa);
    vread<1>(fb, VA(9)); D5_LW(4); vmma(o[0][8], o[1][8], fa, pa);
    vread<1>(fa, VA(10)); D5_LW(4); vmma(o[0][9], o[1][9], fb, pa);
    vread<1>(fb, VA(11)); D5_LW(4); vmma(o[0][10], o[1][10], fa, pa);
    vread<1>(fa, VA(12)); D5_LW(4); vmma(o[0][11], o[1][11], fb, pa);
    vread<1>(fb, VA(13)); D5_LW(4); vmma(o[0][12], o[1][12], fa, pa);
    vread<1>(fa, VA(14)); D5_LW(4); vmma(o[0][13], o[1][13], fb, pa);
    vread<1>(fb, VA(15)); D5_LW(4); vmma(o[0][14], o[1][14], fa, pa);
    D5_LW(0); vmma(o[0][15], o[1][15], fb, pa);
#undef VA
}
__device__ __forceinline__ void epilogue(const Params& P, LAS unsigned char* lds, f32x4v (&o)[2][16], const float (&l)[2], int tz, int it) {
    const int wid = __builtin_amdgcn_readfirstlane(tz >> 6), lane = tz & 63, l16 = lane & 15, g = lane >> 4;
    float lam;
    { float a = P.lam_q1[lane] * P.lam_k1[lane] + P.lam_q1[lane + 64] * P.lam_k1[lane + 64];
      float c = P.lam_q2[lane] * P.lam_k2[lane] + P.lam_q2[lane + 64] * P.lam_k2[lane + 64];
      a = wave_sum(a); c = wave_sum(c); lam = expf(a) - expf(c) + 0.2f; }
    const int br = wid >> 2, w4 = wid & 3;
    const int b = it >> 7, h = (it >> 5) & 3, qt = it & 31;
    const size_t row0 = (size_t)b * SEQ; const int q0 = qt * 128;
    LAS float* li_l = (LAS float*)(lds + SCR_OFF) + wid * 32;
    if (g == 0) { li_l[l16] = l[0]; li_l[16 + l16] = l[1]; }
    asm volatile("s_waitcnt lgkmcnt(0)" ::: "memory");
    __syncthreads();
    LAS float* X = (LAS float*)lds + w4 * 8192;
    if (br == 1) {
#pragma unroll
        for (int qg = 0; qg < 2; ++qg)
#pragma unroll
            for (int r = 0; r < 4; ++r) { const float rl = __builtin_amdgcn_rcpf(li_l[16 * qg + 4 * g + r]);
#pragma unroll
                for (int vt = 0; vt < 16; ++vt) X[((qg * 4 + r) * 16 + vt) * 64 + lane] = o[qg][vt][r] * rl; }
    }
    __syncthreads();
    if (br == 0) {
        LAS unsigned char* T = (LAS unsigned char*)X;
        float gw[16];
#pragma unroll
        for (int vt = 0; vt < 16; ++vt) gw[vt] = P.subln_b[16 * vt + l16];
#pragma unroll
        for (int qg = 0; qg < 2; ++qg)
#pragma unroll
            for (int r = 0; r < 4; ++r) {
                const int u = qg * 4 + r;
                const float rl = __builtin_amdgcn_rcpf(li_l[16 * qg + 4 * g + r]);
                float v[16], sq = 0.f;
#pragma unroll
                for (int vt = 0; vt < 16; ++vt) { v[vt] = o[qg][vt][r] * rl - lam * X[(u * 16 + vt) * 64 + lane]; sq += v[vt] * v[vt]; }
                sq += __shfl_xor(sq, 1); sq += __shfl_xor(sq, 2); sq += __shfl_xor(sq, 4); sq += __shfl_xor(sq, 8);
                const float rstd = rsqrtf(sq * (1.0f / 256.0f) + RMS_EPS) * 0.8f;
#pragma unroll
                for (int vt = 0; vt < 16; ++vt) { const unsigned w = cvtpk(v[vt] * rstd * gw[vt], 0.f); *(LAS bf16_t*)(T + (4 * u + g) * 512 + (16 * vt + l16) * 2) = (bf16_t)(w & 0xffffu); }
            }
        asm volatile("s_waitcnt lgkmcnt(0)" ::: "memory");
        char* mixb = (char*)((bf16_t*)(P.ws + WS_MIX) + (row0 + q0 + w4 * 32) * DM + 1024 + h * 256);
#pragma unroll
        for (int i = 0; i < 16; ++i) {
            const int ti = 2 * i + (lane >> 5), u = ti >> 2, gg = ti & 3, q = 16 * (u >> 2) + 4 * gg + (u & 3);
            const u32x4 w = *(const LAS u32x4*)(T + ti * 512 + (lane & 31) * 16);
            *(u32x4*)(mixb + (size_t)q * (DM * 2) + (lane & 31) * 16) = w;
        }
    }
    __syncthreads();
}
__device__ __forceinline__ void item(const Params& P, int it, LAS unsigned char* lds) {
    int tid = threadIdx.x; asm volatile("" : "+v"(tid));
    const int wid = __builtin_amdgcn_readfirstlane(tid >> 6), lane = tid & 63, l16 = lane & 15, g = lane >> 4;
    const int br = wid >> 2, w4 = wid & 3;
    const int b = it >> 7, h = (it >> 5) & 3, qt = it & 31;
    const bf16_t* proj = (const bf16_t*)(P.ws + WS_PROJ);
    const size_t row0 = (size_t)b * SEQ; const int q0 = qt * 128;
    bf16x8 qr[4][2];
    { const bf16_t* Qw = proj + (row0 + q0 + w4 * 32 + l16) * INC + 3072 + br * 512 + h * 128 + 8 * g;
#pragma unroll
      for (int s = 0; s < 4; ++s)
#pragma unroll
          for (int qg = 0; qg < 2; ++qg) qr[s][qg] = *(const bf16x8*)(Qw + (size_t)(16 * qg) * INC + 32 * s); }
    const char* kbase = (const char*)(proj + row0 * INC + 4096 + br * 512 + h * 128);
    const char* vbase = (const char*)(proj + row0 * INC + 5120 + h * 256);
#define D5_LANE() int lz_ = lane; asm volatile("" : "+v"(lz_))
#define D5_ISSUE_K(t, bufi) do { D5_LANE(); const int krow_ = w4 * 16 + (lz_ >> 4); \
        const unsigned voffK0 = (unsigned)(krow_ * INC * 2 + (((lz_ & 15) ^ (lz_ >> 4)) << 4)); \
        const unsigned voffK1 = (unsigned)((krow_ + 4) * INC * 2 + (((lz_ & 15) ^ (4 + (lz_ >> 4))) << 4)); \
        const char* kb_ = kbase + (size_t)(t) * (64 * INC * 2); LAS unsigned char* lb_ = lds + (bufi) * BUFB + br * KB + w4 * 4096; \
        __builtin_amdgcn_global_load_lds((const unsigned*)(kb_ + voffK0), (LAS unsigned*)(lb_), 16, 0, 0); \
        __builtin_amdgcn_global_load_lds((const unsigned*)(kb_ + voffK1), (LAS unsigned*)(lb_ + 1024), 16, 0, 0); \
        __builtin_amdgcn_global_load_lds((const unsigned*)(kb_ + 8 * INC * 2 + voffK0), (LAS unsigned*)(lb_ + 2048), 16, 0, 0); \
        __builtin_amdgcn_global_load_lds((const unsigned*)(kb_ + 8 * INC * 2 + voffK1), (LAS unsigned*)(lb_ + 3072), 16, 0, 0); } while (0)
#define D5_ISSUE_V(t, bufi) do { D5_LANE(); const char* vb_ = vbase + (size_t)(t) * (64 * INC * 2) + (size_t)(wid * 8) * (INC * 2); LAS unsigned char* lb_ = lds + (bufi) * BUFB + 2 * KB + wid * 4096; \
        _Pragma("unroll") for (int i_ = 0; i_ < 4; ++i_) { const int rr_ = 2 * i_ + (lz_ >> 5); \
            const unsigned vo_ = (unsigned)(rr_ * INC * 2 + (((lz_ & 31) ^ (rr_ << 1)) << 4)); \
            __builtin_amdgcn_global_load_lds((const unsigned*)(vb_ + vo_), (LAS unsigned*)(lb_ + i_ * 1024), 16, 0, 0); } } while (0)
#define D5_BAR() do { asm volatile("" ::: "memory"); __builtin_amdgcn_s_barrier(); asm volatile("" ::: "memory"); } while (0)
    const float slope2 = __int_as_float(__builtin_amdgcn_readfirstlane(__float_as_int(exp2f(-2.0f * (float)(h + 1)) * LOG2E)));
    const int qlo = q0 + w4 * 32, jd = qlo >> 6;
    int jlo = 0, jhi = SEQ / 64 - 1;
    { float gq = fmaxf(fabsf(P.qn_b[lane]), fabsf(P.qn_b[lane + 64])), gk = fmaxf(fabsf(P.kn_b[lane]), fabsf(P.kn_b[lane + 64]));
#pragma unroll
      for (int o_ = 32; o_ >= 1; o_ >>= 1) { gq = fmaxf(gq, __shfl_xor(gq, o_)); gk = fmaxf(gk, __shfl_xor(gk, o_)); }
      const float smax = 128.0f * QSCALE * gq * gk, dmax = (160.0f + smax) / slope2;
      const int di = dmax < 8192.0f ? (int)dmax + 1 : 8192;
      const int klo = q0 - di, khi = q0 + 127 + di;
      jlo = __builtin_amdgcn_readfirstlane(klo <= 0 ? 0 : (klo >> 6)); jhi = __builtin_amdgcn_readfirstlane(khi >= SEQ - 1 ? SEQ / 64 - 1 : (khi >> 6)); }
    float dqb = (float)(qlo + l16 - 4 * g - 64 * jlo);
    f32x4v o[2][16];
#pragma unroll
    for (int qg = 0; qg < 2; ++qg)
#pragma unroll
        for (int vt = 0; vt < 16; ++vt) o[qg][vt] = (f32x4v){0.f, 0.f, 0.f, 0.f};
    float l[2] = {0.f, 0.f};
    const int vbuf0 = (int)(uintptr_t)(lds + 2 * KB);
    bf16x8 pa[2][2];
    D5_ISSUE_K(jlo, 0); D5_ISSUE_V(jlo, 0);
    if (br == 0) {
        asm volatile("s_waitcnt vmcnt(4)" ::: "memory");
#pragma unroll 1
        for (int j = jlo; j <= jhi; ++j) {
            const int jn = (j + 1 <= jhi) ? j + 1 : jhi, bc = (j - jlo) & 1, bn = bc ^ 1;
            D5_BAR();
            D5_ISSUE_K(jn, bn);
            qk_softmax(lds + bc * BUFB, qr, lane, dqb, slope2, j - jd, l, pa);
            asm volatile("s_waitcnt vmcnt(4)" ::: "memory");
            D5_BAR();
            D5_ISSUE_V(jn, bn);
            pv16(o, vbuf0 + bc * BUFB, lane, pa);
            asm volatile("s_waitcnt vmcnt(4)" ::: "memory");
            dqb -= 64.0f;
        }
        D5_BAR();
    } else {
        D5_BAR();
        asm volatile("s_waitcnt vmcnt(0)" ::: "memory");
#pragma unroll 1
        for (int j = jlo; j <= jhi; ++j) {
            const int jn = (j + 1 <= jhi) ? j + 1 : jhi, bc = (j - jlo) & 1, bn = bc ^ 1;
            D5_BAR();
            D5_ISSUE_K(jn, bn); D5_ISSUE_V(jn, bn);
            qk_softmax(lds + bc * BUFB + KB, qr, lane, dqb, slope2, j - jd, l, pa);
            D5_BAR();
            pv16(o, vbuf0 + bc * BUFB, lane, pa);
            asm volatile("s_waitcnt vmcnt(0)" ::: "memory");
            dqb -= 64.0f;
        }
    }
#undef D5_ISSUE_K
#undef D5_ISSUE_V
#undef D5_BAR
#undef D5_LANE
    asm volatile("s_waitcnt vmcnt(0)" ::: "memory");
    int tz = threadIdx.x; asm volatile("" : "+v"(tz));
    epilogue(P, lds, o, l, tz, it);
}
#undef D5_LW
}

namespace na2 {
__device__ __forceinline__ void item(const Params& P, int it, LAS unsigned char* lds) {
    int tid = threadIdx.x; asm volatile("" : "+v"(tid));
    const int wid = __builtin_amdgcn_readfirstlane(tid >> 6), lane = tid & 63, r32 = lane & 31, hi = lane >> 5;
    const int b = it >> 7, h = (it >> 4) & 7, r0 = (it & 15) * 4;
    const int r = r0 + (wid >> 1), cq0 = (wid & 1) * 32;
    const bf16_t* proj = (const bf16_t*)(P.ws + WS_PROJ);
    LAS float* tab = (LAS float*)(lds + SCR_OFF);
    LAS float* li_l = (LAS float*)(lds + SCR_OFF + 2048) + wid * 32;
    for (int i = tid; i < 15 * 31; i += NTHR) tab[(i / 31) * 32 + (i % 31)] = P.rpb_a[h * 465 + i] * LOG2E;
    bf16x8 qr[8];
    { const bf16_t* Qw = proj + ((size_t)b * SEQ + r * 64 + cq0 + r32) * INC + h * 128 + hi * 8;
#pragma unroll
      for (int d0 = 0; d0 < 8; ++d0) qr[d0] = *(const bf16x8*)(Qw + d0 * 16); }
    int kr_lo = r0 - 4; kr_lo = kr_lo < 0 ? 0 : (kr_lo > 56 ? 56 : kr_lo);
    int kr_hi = r0 - 1; kr_hi = (kr_hi < 0 ? 0 : (kr_hi > 56 ? 56 : kr_hi)) + 7;
    int rs = r - 4; rs = rs < 0 ? 0 : (rs > 56 ? 56 : rs);
    const int cq = cq0 + r32; int cs = cq - 8; cs = cs < 0 ? 0 : (cs > 48 ? 48 : cs);
    const char* kbase = (const char*)(proj + (size_t)b * SEQ * INC + 1024 + h * 128);
    const char* vbase = (const char*)(proj + (size_t)b * SEQ * INC + 2048 + h * 128);
    const int krow = wid * 8 + (lane >> 4);
    const unsigned voffK0 = (unsigned)(krow * INC * 2 + (((lane & 15) ^ (lane >> 4)) << 4));
    const unsigned voffK1 = (unsigned)((krow + 4) * INC * 2 + (((lane & 15) ^ (4 + (lane >> 4))) << 4));
    const unsigned voffV = (unsigned)(da2::unswap23(wid * 8 + ((lane & 31) >> 2)) * INC * 2 + (lane >> 5) * 64 + (lane & 3) * 16);
#define NA2_ISSUE(kr, bufi) do { const char* kb_ = kbase + (size_t)(kr) * (64 * INC * 2); const char* vb_ = vbase + (size_t)(kr) * (64 * INC * 2); \
        LAS unsigned char* lb_ = lds + (bufi) * 32768; \
        __builtin_amdgcn_global_load_lds((const unsigned*)(kb_ + voffK0), (LAS unsigned*)(lb_ + wid * 2048), 16, 0, 0); \
        __builtin_amdgcn_global_load_lds((const unsigned*)(kb_ + voffK1), (LAS unsigned*)(lb_ + wid * 2048 + 1024), 16, 0, 0); \
        __builtin_amdgcn_global_load_lds((const unsigned*)(vb_ + voffV), (LAS unsigned*)(lb_ + 16384 + wid * 2048), 16, 0, 0); \
        __builtin_amdgcn_global_load_lds((const unsigned*)(vb_ + 128 + voffV), (LAS unsigned*)(lb_ + 16384 + wid * 2048 + 1024), 16, 0, 0); } while (0)
    f32x16 o[4];
#pragma unroll
    for (int d = 0; d < 4; ++d) o[d] = f32x16{};
    float l_reg = 0.f;
    const int vb0 = (int)(uintptr_t)(lds + 16384) + da2::v_rd_base(lane);
    NA2_ISSUE(kr_lo, 0);
#pragma unroll 1
    for (int kr = kr_lo; kr <= kr_hi; ++kr) {
        const int bi = (kr - kr_lo) & 1;
        asm volatile("s_waitcnt vmcnt(0) lgkmcnt(0)" ::: "memory");
        __builtin_amdgcn_s_barrier();
        asm volatile("" ::: "memory");
        if (kr < kr_hi) NA2_ISSUE(kr + 1, bi ^ 1);
        if (kr >= rs && kr < rs + 8) {
            f32x16 p0, p1;
            da2::qkt(p0, p1, lds + bi * 32768, qr, r32, hi);
            const LAS float* trow = tab + (kr - r + 7) * 32;
            float ps = 0.f;
#pragma unroll
            for (int rr = 0; rr < 16; ++rr) {
                const int ck = crow(rr, hi);
                { const int rel = ck - cq + 15; const bool valid = (ck >= cs) && (ck < cs + 16); const int idx = rel < 0 ? 0 : (rel > 30 ? 30 : rel);
                  const float v = valid ? __builtin_amdgcn_exp2f(p0[rr] + trow[idx]) : 0.f; p0[rr] = v; ps += v; }
                { const int ck1 = ck + 32; const int rel = ck1 - cq + 15; const bool valid = (ck1 >= cs) && (ck1 < cs + 16); const int idx = rel < 0 ? 0 : (rel > 30 ? 30 : rel);
                  const float v = valid ? __builtin_amdgcn_exp2f(p1[rr] + trow[idx]) : 0.f; p1[rr] = v; ps += v; }
            }
            l_reg += swap_add(ps);
            bf16x8 pa0, pa1, pa2, pa3;
            PK4(p0, 0, pa0); PK4(p0, 8, pa1); PK4(p1, 0, pa2); PK4(p1, 8, pa3);
            const int vb = vb0 + bi * 32768;
            da2::pv_one<4, 0>(o[0], vb, pa0, pa1, pa2, pa3); da2::pv_one<4, 1>(o[1], vb, pa0, pa1, pa2, pa3);
            da2::pv_one<4, 2>(o[2], vb, pa0, pa1, pa2, pa3); da2::pv_one<4, 3>(o[3], vb, pa0, pa1, pa2, pa3);
        }
    }
#undef NA2_ISSUE
    if (hi == 0) li_l[r32] = l_reg;
    asm volatile("s_waitcnt lgkmcnt(0)" ::: "memory");
    __syncthreads();
    LAS unsigned char* T = lds + wid * 8192;
    float* nassq = (float*)(P.ws + WS_NASSQ);
    const size_t t0 = (size_t)b * SEQ + r * 64 + cq0;
#pragma unroll
    for (int rr = 0; rr < 16; ++rr) {
        const float rl = __builtin_amdgcn_rcpf(li_l[crow(rr, hi)]);
        float sq = 0.f;
#pragma unroll
        for (int d = 0; d < 4; ++d) {
            const unsigned w = cvtpk(o[d][rr] * rl, 0.f); const float vq = __uint_as_float(w << 16);
            sq += vq * vq;
            *(LAS bf16_t*)(T + (2 * rr + hi) * 256 + (d * 32 + r32) * 2) = (bf16_t)(w & 0xffffu);
        }
#pragma unroll
        for (int sh = 16; sh >= 1; sh >>= 1) sq += __shfl_xor(sq, sh);
        if (r32 == 0) nassq[(t0 + crow(rr, hi)) * 8 + h] = sq;
    }
    asm volatile("s_waitcnt lgkmcnt(0)" ::: "memory");
    char* mixb = (char*)((bf16_t*)(P.ws + WS_MIX) + t0 * DM + h * 128);
#pragma unroll
    for (int i = 0; i < 8; ++i) {
        const int tr = i * 4 + (lane >> 4), rr2 = tr >> 1, h2 = tr & 1;
        const u32x4 w = *(const LAS u32x4*)(T + tr * 256 + (lane & 15) * 16);
        *(u32x4*)(mixb + (size_t)crow(rr2, h2) * (DM * 2) + (lane & 15) * 16) = w;
    }
    __syncthreads();
}
}

__device__ __forceinline__ void da_combine(const Params& P) {
    int tid = threadIdx.x; asm volatile("" : "+v"(tid)); const int wid = tid >> 6, lane = tid & 63;
    float a = P.lam_q1[lane] * P.lam_k1[lane] + P.lam_q1[lane + 64] * P.lam_k1[lane + 64];
    float c = P.lam_q2[lane] * P.lam_k2[lane] + P.lam_q2[lane + 64] * P.lam_k2[lane + 64];
    a = wave_sum(a); c = wave_sum(c);
    const float lam = expf(a) - expf(c) + 0.2f;
    const float* op = (const float*)(P.ws + WS_OPART);
    bf16_t* mix = (bf16_t*)(P.ws + WS_MIX);
    const f32x4 g = ((const f32x4*)P.subln_b)[lane];
    for (int it = blockIdx.x * 8 + wid; it < MTOK * 4; it += gridDim.x * 8) {
        const int tok = it >> 2, h = it & 3;
        const float* p = op + (size_t)tok * DM + h * 512;
        const f32x4 o1 = ((const f32x4*)p)[lane], o2 = ((const f32x4*)(p + 256))[lane];
        const f32x4 v = o1 - lam * o2;
        float ss = (v[0] * v[0] + v[1] * v[1]) + (v[2] * v[2] + v[3] * v[3]);
        ss = wave_sum(ss);
        const float rstd = rsqrtf(ss * (1.0f / 256.0f) + RMS_EPS) * 0.8f;
        u32x2 w; w.x = cvtpk(v[0] * rstd * g[0], v[1] * rstd * g[1]); w.y = cvtpk(v[2] * rstd * g[2], v[3] * rstd * g[3]);
        *(u32x2*)(mix + (size_t)tok * DM + 1024 + h * 256 + lane * 4) = w;
    }
}

__device__ __forceinline__ f32x4 ldx1(const bf16_t* p) { const u32x2 w = *(const u32x2*)p; return (f32x4){__uint_as_float(w.x << 16), __uint_as_float(w.x & 0xffff0000u), __uint_as_float(w.y << 16), __uint_as_float(w.y & 0xffff0000u)}; }
__device__ __forceinline__ void router_phase(const Params& P, LAS unsigned char* lds) {
    int tid = threadIdx.x; asm volatile("" : "+v"(tid)); const int wid = tid >> 6, lane = tid & 63;
    { const f32x4* src = (const f32x4*)(P.ws + WS_WRT);
#pragma unroll
      for (int i = 0; i < 16; ++i) *(LAS f32x4*)(lds + (size_t)(i * NTHR + tid) * 16) = src[i * NTHR + tid];
      __syncthreads(); }
    const LAS float* wl = (const LAS float*)lds;
    const bf16_t* x1b = (const bf16_t*)(P.ws + WS_OPART);
    const float* rowss = (const float*)(P.ws + WS_ROWSS);
    unsigned char* H2 = (unsigned char*)(P.ws + WS_H2);
    float* aff = (float*)(P.ws + WS_AFF);
    LAS float* red = (LAS float*)(lds + 131072) + wid * 64;
    for (int g4 = blockIdx.x * 8 + wid; g4 < MTOK / 4; g4 += gridDim.x * 8) {
        const int row0 = g4 * 4;
        f32x4 xa[4], xb[4];
#pragma unroll
        for (int t = 0; t < 4; ++t) { xa[t] = ldx1(x1b + (size_t)(row0 + t) * DM + (0 * 64 + lane) * 4); xb[t] = ldx1(x1b + (size_t)(row0 + t) * DM + (1 * 64 + lane) * 4); }
        float rstd[4];
#pragma unroll
        for (int t = 0; t < 4; ++t) { float s = (lane < 32) ? rowss[(size_t)(row0 + t) * 32 + lane] : 0.f; s = wave_sum(s); rstd[t] = rsqrtf(s * (1.0f / DM) + RMS_EPS); }
        float acc[64];
#pragma unroll
        for (int k = 0; k < 64; ++k) acc[k] = 0.f;
#pragma unroll
        for (int i = 0; i < 8; ++i) {
            const int c0 = (i * 64 + lane) * 4;
            const f32x4 g = *(const f32x4*)(P.ln2_g + c0);
            f32x4 hv[4];
#pragma unroll
            for (int t = 0; t < 4; ++t) {
                const f32x4 xc = (i & 1) ? xb[t] : xa[t];
                if (i + 2 < 8) { const f32x4 nx = ldx1(x1b + (size_t)(row0 + t) * DM + ((i + 2) * 64 + lane) * 4); if (i & 1) xb[t] = nx; else xa[t] = nx; }
                hv[t] = xc * rstd[t] * g;
                *(unsigned*)(H2 + (size_t)(row0 + t) * DM + c0) = cvt4_fp8(hv[t][0] * HSC8, hv[t][1] * HSC8, hv[t][2] * HSC8, hv[t][3] * HSC8);
            }
#pragma unroll
            for (int e = 0; e < 16; ++e) {
                const f32x4 w = *(const LAS f32x4*)(wl + e * DM + c0);
#pragma unroll
                for (int t = 0; t < 4; ++t) acc[t * 16 + e] += (hv[t][0] * w[0] + hv[t][1] * w[1]) + (hv[t][2] * w[2] + hv[t][3] * w[3]);
            }
        }
#pragma unroll
        for (int step = 0; step < 6; ++step) {
            const int m = 32 >> step, half = 32 >> step;
            const bool up = (lane & m) != 0;
#pragma unroll
            for (int k = 0; k < half; ++k) {
                const float keep = up ? acc[k + half] : acc[k], send = up ? acc[k] : acc[k + half];
                acc[k] = keep + __shfl_xor(send, m);
            }
        }
        red[lane] = acc[0];
        asm volatile("s_waitcnt lgkmcnt(0)" ::: "memory");
        if (lane < 4) {
            const int t = lane; float lg[16], mx = -1e30f;
#pragma unroll
            for (int e = 0; e < 16; ++e) { lg[e] = red[t * 16 + e]; mx = fmaxf(mx, lg[e]); }
            float sum = 0.f;
#pragma unroll
            for (int e = 0; e < 16; ++e) { lg[e] = expf(lg[e] - mx); sum += lg[e]; }
            const float inv = 1.0f / sum;
            const int row = row0 + t, bb = row >> 12, sq = row & 4095;
#pragma unroll
            for (int e = 0; e < 16; ++e) aff[((size_t)bb * 16 + e) * SEQ + sq] = lg[e] * inv;
        }
    }
}

__device__ __forceinline__ void topk_phase(const Params& P, LAS unsigned char* lds) {
    int tid = threadIdx.x; asm volatile("" : "+v"(tid)); const int wid = tid >> 6, lane = tid & 63;
    const float* aff = (const float*)(P.ws + WS_AFF);
    int* selidx = (int*)(P.ws + WS_SELIDX); float* selgate = (float*)(P.ws + WS_SELGATE); int* slot = (int*)(P.ws + WS_SLOT);
    LAS unsigned* red = (LAS unsigned*)lds;
    for (int it = blockIdx.x; it < NB * NEXP; it += gridDim.x) {
        const int b = it >> 4, e = it & 15;
        const float* ap = aff + (size_t)it * SEQ + tid * 8;
        const f32x4 a0 = *(const f32x4*)ap, a1 = *(const f32x4*)(ap + 4);
        unsigned v[8];
#pragma unroll
        for (int j = 0; j < 4; ++j) { v[j] = __float_as_uint(a0[j]); v[4 + j] = __float_as_uint(a1[j]); }
        LAS unsigned* hist = red + 64;
        unsigned T = 0u, pmask = 0u, needk = (unsigned)CAP;
#pragma unroll 1
        for (int pass = 0; pass < 4; ++pass) {
            const int shift = 24 - 8 * pass;
            if (tid < 256) hist[tid] = 0u;
            __syncthreads();
#pragma unroll
            for (int j = 0; j < 8; ++j) if ((v[j] & pmask) == T) atomicAdd((unsigned*)(hist + ((v[j] >> shift) & 255u)), 1u);
            __syncthreads();
            unsigned hv = 0, incl = 0;
            if (tid < 256) { hv = hist[255 - tid]; incl = hv;
#pragma unroll
                for (int o = 1; o < 64; o <<= 1) { const unsigned up = __shfl_up(incl, o); if (lane >= o) incl += up; }
                if (lane == 63) hist[260 + wid] = incl; }
            __syncthreads();
            if (tid < 256) {
                for (int w = 0; w < wid; ++w) incl += hist[260 + w];
                const unsigned sfx = incl - hv;
                if (sfx < needk && incl >= needk) { hist[256] = (unsigned)(255 - tid); hist[257] = needk - sfx; }
            }
            __syncthreads();
            T |= hist[256] << shift; pmask |= 255u << shift; needk = hist[257];
            __syncthreads();
        }
        unsigned g[8], q[8], gsum = 0, qsum = 0;
#pragma unroll
        for (int j = 0; j < 8; ++j) { g[j] = v[j] > T ? 1u : 0u; q[j] = v[j] == T ? 1u : 0u; gsum += g[j]; qsum += q[j]; }
        unsigned gi = gsum, qi = qsum;
#pragma unroll
        for (int o = 1; o < 64; o <<= 1) { const unsigned tg = __shfl_up(gi, o), tq = __shfl_up(qi, o); if (lane >= o) { gi += tg; qi += tq; } }
        LAS unsigned* sc = red + 32;
        __syncthreads();
        if (lane == 63) { sc[wid] = gi; sc[8 + wid] = qi; }
        __syncthreads();
        unsigned gbase = 0, qbase = 0, gtot = 0;
#pragma unroll
        for (int w = 0; w < 8; ++w) { const unsigned a = sc[w], c2 = sc[8 + w]; if (w < wid) { gbase += a; qbase += c2; } gtot += a; }
        unsigned G = gbase + gi - gsum, Q = qbase + qi - qsum;
        const unsigned need = (unsigned)CAP - gtot;
#pragma unroll
        for (int j = 0; j < 8; ++j) {
            const int tok = tid * 8 + j;
            const bool sel = g[j] || (q[j] && Q < need);
            const unsigned sl = G + (Q < need ? Q : need);
            if (sel) { selidx[e * EROWS + b * CAP + sl] = b * SEQ + tok; selgate[e * EROWS + b * CAP + sl] = __uint_as_float(v[j]); }
            slot[(size_t)it * SEQ + tok] = sel ? (int)sl : -1;
            G += g[j]; Q += q[j];
        }
        __syncthreads();
    }
}

__device__ __forceinline__ void combine_phase(const Params& P, const float ysc) {
    int tid = threadIdx.x; asm volatile("" : "+v"(tid)); const int wid = tid >> 6, lane = tid & 63;
    const int* slot = (const int*)(P.ws + WS_SLOT);
    const unsigned char* Y = (const unsigned char*)(P.ws + WS_Y);
    for (int row = blockIdx.x * 8 + wid; row < MTOK; row += gridDim.x * 8) {
        const int b = row >> 12, s = row & 4095;
        const int sl = (lane < 16) ? slot[((size_t)b * 16 + lane) * SEQ + s] : -1;
        unsigned long long mask = __ballot(sl >= 0);
        float* op = P.out + (size_t)row * DM;
        const bf16_t* xp = (const bf16_t*)(P.ws + WS_OPART) + (size_t)row * DM;
        f32x4 a[8];
#pragma unroll
        for (int i = 0; i < 4; ++i) { const u32x4 w = *(const u32x4*)(xp + i * 512 + lane * 8);
            a[2 * i] = (f32x4){__uint_as_float(w.x << 16), __uint_as_float(w.x & 0xffff0000u), __uint_as_float(w.y << 16), __uint_as_float(w.y & 0xffff0000u)};
            a[2 * i + 1] = (f32x4){__uint_as_float(w.z << 16), __uint_as_float(w.z & 0xffff0000u), __uint_as_float(w.w << 16), __uint_as_float(w.w & 0xffff0000u)}; }
        while (mask) {
            const int e = __builtin_ctzll(mask); mask &= mask - 1;
            const int se = __shfl(sl, e);
            const unsigned char* yp = Y + ((size_t)e * EROWS + b * CAP + se) * DM + lane * 8;
#pragma unroll
            for (int i = 0; i < 4; ++i) {
                const u32x2 w = *(const u32x2*)(yp + i * 512);
                const f32x2 p0 = __builtin_amdgcn_cvt_pk_f32_fp8((int)w.x, false), p1 = __builtin_amdgcn_cvt_pk_f32_fp8((int)w.x, true);
                const f32x2 p2 = __builtin_amdgcn_cvt_pk_f32_fp8((int)w.y, false), p3 = __builtin_amdgcn_cvt_pk_f32_fp8((int)w.y, true);
                a[2 * i] += (f32x4){p0[0], p0[1], p1[0], p1[1]} * (ysc * (1.0f / YSC8));
                a[2 * i + 1] += (f32x4){p2[0], p2[1], p3[0], p3[1]} * (ysc * (1.0f / YSC8));
            }
        }
#pragma unroll
        for (int i = 0; i < 4; ++i) { *(f32x4*)(op + i * 512 + lane * 8) = a[2 * i]; *(f32x4*)(op + i * 512 + lane * 8 + 4) = a[2 * i + 1]; }
    }
}

#ifndef P1_COMPUTE_WGS
#define P1_COMPUTE_WGS 160
#endif
#ifndef P7_PER_XCD
#define P7_PER_XCD 30
#endif
constexpr int N_PHASES = 10;
__global__ void __launch_bounds__(NTHR, 2) fwd_kernel(Params P) {
    extern __shared__ __attribute__((aligned(16))) unsigned char lds_raw[];
    LAS unsigned char* lds = (LAS unsigned char*)lds_raw;
    const int tid = threadIdx.x;
    volatile LAS unsigned* MISC = (volatile LAS unsigned*)(lds + MISC_OFF);
    if (tid < 16) MISC[tid] = 0u;
    __syncthreads();
    XcdBarrier bar; bar.bar = (unsigned*)(P.ws + WS_CTL); bar.x = 0; bar.st = nullptr;
#if MK_N_LAUNCHES == 1
    bar = xcd_barrier_post((unsigned*)(P.ws + WS_CTL), MISC);
#define GRID_BAR() xcd_barrier(bar)
#else
#define GRID_BAR() do { } while (0)
#endif
    const int lo = P.ph_lo, hi = P.ph_hi;
#ifndef PH_MASK
#define PH_MASK 0x3ff
#endif
#define IN(k) (((PH_MASK >> (k)) & 1) && lo <= (k) && (k) < hi)
#define BOTH(k) (IN(k) && IN((k) + 1))

#ifndef PROBE_DUP
#define PROBE_DUP -1
#endif
#define DUP(k) for (int rep_ = 0; rep_ < ((PROBE_DUP) == (k) ? 2 : 1); ++rep_)
    if (IN(0)) { DUP(0) { p0_prologue(P, lds); __syncthreads(); } if (BOTH(0)) GRID_BAR(); }

    if (IN(1)) {
        { LAS float* gl = (LAS float*)(lds + SCR_OFF + 8192);
          if (tid < 128) { gl[tid] = P.qn_a[tid]; gl[128 + tid] = P.kn_a[tid]; gl[256 + tid] = P.qn_b[tid]; gl[384 + tid] = P.kn_b[tid]; }
          __syncthreads(); }
        DUP(1) {
        pg8::OrderMN S; S.init(P.ws + WS_H, P.ws + WS_WIN, MTOK, INC, DM, P1_COMPUTE_WGS, blockIdx.x);
        EpiInProj E{(bf16_t*)(P.ws + WS_PROJ)};
        pg8::gemm_phase<false, false, false>(lds, DM, S, E, nullptr);
        }
        cvt_queue<2>(P, lds, (unsigned*)(P.ws + WS_CTL) + CW_QG); cvt_queue<3>(P, lds, (unsigned*)(P.ws + WS_CTL) + CW_QU);
        if (BOTH(1)) GRID_BAR();
    }

    if (IN(2)) {
        const bf16_t* proj = (const bf16_t*)(P.ws + WS_PROJ);
        float* opart = (float*)(P.ws + WS_OPART);
        const int da_it = (blockIdx.x & 7) * 32 + (blockIdx.x >> 3);
        DUP(2) {
        if (blockIdx.x < 256) da5::item(P, da_it, lds);
        }
        DUP(12) {
        if (blockIdx.x < 256 && ((da_it >> 5) & 3) == 0) {
            const int r64 = (da_it >> 7) * 32 + (da_it & 31);
#pragma unroll 1
            for (int k = 0; k < 4; ++k) na2::item(P, r64 * 4 + k, lds);
        }
        }
        if (BOTH(2)) GRID_BAR();
    }


    if (IN(4)) {
        DUP(4) {
        pg8::OrderMN S; S.init(P.ws + WS_MIX, P.ws + WS_WOUT, MTOK, DM, DM, gridDim.x, blockIdx.x);
        LAS float* ht = (LAS float*)(lds + SCR_OFF);
        { pg8::Unit u; if (S.next(0, u) && tid < 256) { const float* q = (const float*)(P.ws + WS_NASSQ) + (size_t)(u.pm * 256 + tid) * 8;
            const f32x4 a = *(const f32x4*)q, c = *(const f32x4*)(q + 4);
            ht[tid] = rsqrtf(((a[0] + a[1]) + (a[2] + a[3]) + (c[0] + c[1]) + (c[2] + c[3])) * (1.0f / 1024.0f) + RMS_EPS); } }
        __syncthreads();
        EpiOutProj E{P.x, (bf16_t*)(P.ws + WS_OPART), (float*)(P.ws + WS_ROWSS)};
        pg8::gemm_phase<false, true, false>(lds, DM, S, E, (const LAS unsigned*)ht);
        }
        if (BOTH(4)) GRID_BAR();
    }

    if (IN(5)) { DUP(5) { router_phase(P, lds); __syncthreads(); } if (BOTH(5)) GRID_BAR(); }

    if (IN(6)) { DUP(6) { topk_phase(P, lds); } if (BOTH(6)) GRID_BAR(); }

    if (IN(7)) {
        pg8::OrderExpert S; S.init(P.ws + WS_H2, P.ws + WS_WGU, 2 * FF, DM / 2, 0, (size_t)2 * FF * DM, true, gridDim.x, blockIdx.x, P7_PER_XCD);
        LAS unsigned* gtab = (LAS unsigned*)(lds + SCR_OFF);
        const int* selidx = (const int*)(P.ws + WS_SELIDX);
        { pg8::Unit u; for (int i = 0; i < 12 && S.next(i, u); ++i) { if (tid < 256) gtab[i * 256 + tid] = (unsigned)selidx[u.e * EROWS + u.pm * 256 + tid] * (unsigned)DM; } }
        __syncthreads();
        DUP(7) {
        EpiGateUp E{(unsigned char*)(P.ws + WS_ACT)};
        pg8::gemm_phase<true, false, true>(lds, DM / 2, S, E, gtab);
        }
        cvt_queue<4>(P, lds, (unsigned*)(P.ws + WS_CTL) + CW_QD);
        if (BOTH(7)) GRID_BAR();
    }

    if (IN(8)) {
        DUP(8) {
        pg8::OrderExpert S; S.init(P.ws + WS_ACT, P.ws + WS_WD, DM, FF / 2, (size_t)EROWS * FF, (size_t)DM * FF, false, gridDim.x, blockIdx.x, 32);
        EpiDown E{(unsigned char*)(P.ws + WS_Y), (const float*)(P.ws + WS_SELGATE)};
        pg8::gemm_phase<false, false, true>(lds, FF / 2, S, E, nullptr);
        }
        if (BOTH(8)) GRID_BAR();
    }

    if (IN(9)) { if (PROBE_DUP == 9) { combine_phase(P, 0.5f); __syncthreads(); combine_phase(P, 0.5f); } else combine_phase(P, 1.0f); }
#undef IN
#undef BOTH
}

extern "C" void kernel_launch(void* const* d_in, const int* in_sizes, int n_in, void* d_out, int out_size, void* d_ws, size_t ws_size, hipStream_t stream) {
    static int grid = 0;
    if (grid == 0) {
        if (n_in != 20 || out_size != MTOK * DM || ws_size < WS_END) { fprintf(stderr, "kernel_launch: unexpected shapes (n_in %d out %d ws %zu need %zu)\n", n_in, out_size, ws_size, (size_t)WS_END); grid = -1; return; }
        int dev = 0, cus = 0, per_cu = 0;
        if (hipGetDevice(&dev) != hipSuccess || hipDeviceGetAttribute(&cus, hipDeviceAttributeMultiprocessorCount, dev) != hipSuccess) { grid = -1; return; }
        if (hipFuncSetAttribute((const void*)fwd_kernel, hipFuncAttributeMaxDynamicSharedMemorySize, LDS_BYTES) != hipSuccess) { fprintf(stderr, "kernel_launch: hipFuncSetAttribute failed\n"); grid = -1; return; }
        if (hipOccupancyMaxActiveBlocksPerMultiprocessor(&per_cu, (const void*)fwd_kernel, NTHR, LDS_BYTES) != hipSuccess || per_cu < 1) fprintf(stderr, "kernel_launch: occupancy query reports %d\n", per_cu);
        (void)hipGetLastError();
        if (cus != 256) { fprintf(stderr, "kernel_launch: built for a 256-CU device, found %d\n", cus); grid = -1; return; }
        grid = cus;
    }
    if (grid < 0) return;
    hipMemsetAsync((char*)d_ws + WS_CTL, 0, CTL_BYTES, stream);
    Params p{};
    p.x = (const float*)d_in[0]; p.ln1_g = (const float*)d_in[1]; p.w_in = (const float*)d_in[2]; p.qn_a = (const float*)d_in[3]; p.kn_a = (const float*)d_in[4];
    p.rpb_a = (const float*)d_in[5]; p.on_a = (const float*)d_in[6]; p.qn_b = (const float*)d_in[7]; p.kn_b = (const float*)d_in[8];
    p.lam_q1 = (const float*)d_in[9]; p.lam_k1 = (const float*)d_in[10]; p.lam_q2 = (const float*)d_in[11]; p.lam_k2 = (const float*)d_in[12]; p.subln_b = (const float*)d_in[13];
    p.w_out = (const float*)d_in[14]; p.ln2_g = (const float*)d_in[15]; p.w_router = (const float*)d_in[16]; p.w_gate = (const float*)d_in[17]; p.w_up = (const float*)d_in[18]; p.w_down = (const float*)d_in[19];
    p.out = (float*)d_out; p.ws = (unsigned char*)d_ws;
#if MK_N_LAUNCHES == 1
    p.ph_lo = 0; p.ph_hi = N_PHASES;
    hipLaunchKernelGGL(fwd_kernel, dim3(grid), dim3(NTHR), LDS_BYTES, stream, p);
#else
#ifndef PROBE_LDUP
#define PROBE_LDUP -1
#endif
    for (int ph = 0; ph < N_PHASES; ++ph) { p.ph_lo = ph; p.ph_hi = ph + 1;
        for (int rep = 0; rep < ((ph == PROBE_LDUP && ph != 9) ? 2 : 1); ++rep) hipLaunchKernelGGL(fwd_kernel, dim3(grid), dim3(NTHR), LDS_BYTES, stream, p); }
#endif
    const hipError_t le = hipPeekAtLastError();
    if (le != hipSuccess) fprintf(stderr, "kernel_launch: launch failed: %s\n", hipGetErrorName(le));
}
```

```cpp
#include <hip/hip_runtime.h>
#include <stdint.h>
#include <stdio.h>

#ifndef MK_N_LAUNCHES
#define MK_N_LAUNCHES 1
#endif

#define LAS __attribute__((address_space(3)))
typedef unsigned short bf16_t;
typedef short bf16x8 __attribute__((ext_vector_type(8)));
typedef short s16x4 __attribute__((ext_vector_type(4)));
typedef float f32x4 __attribute__((ext_vector_type(4)));
typedef float f32x2 __attribute__((ext_vector_type(2)));
typedef float f32x16 __attribute__((ext_vector_type(16)));
typedef unsigned u32x4 __attribute__((ext_vector_type(4)));
typedef unsigned u32x2 __attribute__((ext_vector_type(2)));
typedef int i32x8 __attribute__((ext_vector_type(8)));
typedef int i32x4 __attribute__((ext_vector_type(4)));

constexpr int NB = 2, SEQ = 4096, DM = 2048, MTOK = NB * SEQ;
constexpr int INC = 6144;
constexpr int NEXP = 16, CAP = 512, FF = 2816, EROWS = NB * CAP;
constexpr float RMS_EPS = 1e-6f;
constexpr float LOG2E = 1.4426950408889634f;
constexpr float QSCALE = 0.088388347648318440f * LOG2E;
constexpr int NTHR = 512;

constexpr size_t al256(size_t x) { return (x + 255) / 256 * 256; }
constexpr size_t WS_CTL = 0, CTL_BYTES = 65536;
constexpr size_t WS_WIN = WS_CTL + CTL_BYTES;
constexpr size_t WS_WOUT = WS_WIN + (size_t)INC * DM * 2;
constexpr size_t WS_WGU = WS_WOUT + (size_t)DM * DM * 2;
constexpr size_t WS_WD = WS_WGU + (size_t)NEXP * 2 * FF * DM * 2;
constexpr size_t WS_H = WS_WD + (size_t)NEXP * DM * FF * 2;
constexpr size_t WS_PROJ = WS_H + (size_t)MTOK * DM * 2;
constexpr size_t WS_NASSQ = WS_PROJ + (size_t)MTOK * INC * 2;
constexpr size_t WS_MIX = WS_NASSQ + (size_t)MTOK * 1024 * 2;
constexpr size_t WS_OPART = WS_MIX + (size_t)MTOK * DM * 2;
constexpr size_t WS_ROWSS = WS_OPART + (size_t)MTOK * DM * 4;
constexpr size_t WS_AFF = WS_ROWSS + (size_t)MTOK * 32 * 4;
constexpr size_t WS_SELIDX = WS_AFF + (size_t)NB * NEXP * SEQ * 4;
constexpr size_t WS_SELGATE = WS_SELIDX + (size_t)NEXP * EROWS * 4;
constexpr size_t WS_SLOT = WS_SELGATE + (size_t)NEXP * EROWS * 4;
constexpr size_t WS_H2 = WS_SLOT + (size_t)NB * NEXP * SEQ * 4;
constexpr size_t WS_ACT = WS_H2 + (size_t)MTOK * DM * 2;
constexpr size_t WS_Y = WS_ACT + (size_t)NEXP * EROWS * FF * 2;
constexpr size_t WS_WRT = WS_Y + (size_t)NEXP * EROWS * DM * 2;
constexpr size_t WS_END = WS_WRT + (size_t)NEXP * DM * 4;

constexpr int STAGE_BYTES = 131072;
constexpr int SCR_OFF = STAGE_BYTES;
constexpr int SCR_BYTES = 16384;
constexpr int MISC_OFF = SCR_OFF + SCR_BYTES - 64;
constexpr int CVS_OFF = SCR_OFF + SCR_BYTES;
constexpr int LDS_BYTES = CVS_OFF + 16384;

__device__ __forceinline__ unsigned cvtpk(float lo, float hi) { unsigned r; asm volatile("v_cvt_pk_bf16_f32 %0, %1, %2" : "=v"(r) : "v"(lo), "v"(hi)); return r; }
__device__ __forceinline__ float wave_sum(float v) {
#pragma unroll
    for (int o = 32; o >= 1; o >>= 1) v += __shfl_xor(v, o);
    return v;
}
__device__ __forceinline__ unsigned cvt4_fp8(float a, float b, float c, float d) { int w = 0; w = __builtin_amdgcn_cvt_pk_fp8_f32(a, b, w, false); w = __builtin_amdgcn_cvt_pk_fp8_f32(c, d, w, true); return (unsigned)w; }
constexpr float WSC8 = 128.0f, HSC8 = 4.0f, ASC8 = 8.0f, YSC8 = 64.0f;
__device__ __forceinline__ float bf2f(bf16_t b) { return __uint_as_float(((unsigned)b) << 16); }

#define XB_TMO      128
#define XB_XCNT(j)  (256  + 64 * (j))
#define XB_XSUB(j)  (1280 + 64 * (j))
#define XB_XGEN(j)  (2304 + 64 * (j))
#define XB_TOP      3328
#define XB_TOPGEN   3392
#define XCD_BAR_WORDS 3456
#define XB_SPIN_CAP (1u << 18)

__device__ __forceinline__ unsigned xb_ld(unsigned* p)              { return __hip_atomic_load(p, __ATOMIC_RELAXED, __HIP_MEMORY_SCOPE_AGENT); }
__device__ __forceinline__ unsigned xb_add(unsigned* p, unsigned v) { return __hip_atomic_fetch_add(p, v, __ATOMIC_RELAXED, __HIP_MEMORY_SCOPE_AGENT); }
__device__ __forceinline__ unsigned xb_xcc_id() { return (unsigned)__builtin_amdgcn_s_getreg((3 << 11) | 20) & 0xFu; }
#define XB_SPIN(cond, bar) do { unsigned _sp = 0; while (cond) { __builtin_amdgcn_s_sleep(1); \
    if ((++_sp & 255u) == 0u) { if (xb_ld(&(bar)[XB_TMO])) break; if (_sp > XB_SPIN_CAP) { atomicAdd(&(bar)[XB_TMO], 1u); break; } } } } while (0)

struct XcdBarrier { unsigned* bar; unsigned x; volatile LAS unsigned* st; };

__device__ __forceinline__ XcdBarrier xcd_barrier_post(unsigned* bar, volatile LAS unsigned* st) {
    XcdBarrier b; b.bar = bar; b.x = xb_xcc_id(); b.st = st;
    if (threadIdx.x == 0) (void)xb_add(&bar[XB_XCNT(b.x)], 1u);
    return b;
}
__device__ __forceinline__ void xcd_barrier_complete(unsigned* bar, unsigned x, unsigned& nloc, unsigned& nx) {
    const unsigned G = gridDim.x * gridDim.y * gridDim.z;
    unsigned sum, cnt, mine, sp = 0u;
    for (;;) {
        sum = 0u; cnt = 0u; mine = 0u;
#pragma unroll
        for (unsigned j = 0; j < 16; ++j) { const unsigned c = xb_ld(&bar[XB_XCNT(j)]); sum += c; cnt += (c > 0u) ? 1u : 0u; mine = (j == x) ? c : mine; }
        if (sum == G) break;
        __builtin_amdgcn_s_sleep(1);
        if ((++sp & 255u) == 0u) { if (xb_ld(&bar[XB_TMO])) break; if (sp > XB_SPIN_CAP) { atomicAdd(&bar[XB_TMO], 1u); break; } }
    }
    nloc = mine > 0u ? mine : 1u; nx = cnt > 0u ? cnt : 1u;
}
__device__ __forceinline__ void xcd_barrier(const XcdBarrier& b) {
    asm volatile("s_waitcnt vmcnt(0)" ::: "memory");
    __syncthreads();
    if (threadIdx.x == 0) {
        unsigned* bar = b.bar;
        __builtin_amdgcn_s_waitcnt(0);
        unsigned nloc = b.st[0], nx = b.st[1];
        if (nloc == 0u) { xcd_barrier_complete(bar, b.x, nloc, nx); b.st[0] = nloc; b.st[1] = nx; }
        const unsigned old = xb_add(&bar[XB_XSUB(b.x)], 1u);
        const unsigned gen = old / nloc;
        if (old + 1u == (gen + 1u) * nloc) {
            __builtin_amdgcn_fence(__ATOMIC_RELEASE, "agent");
            asm volatile("s_waitcnt vmcnt(0)" ::: "memory");
            const unsigned og = xb_add(&bar[XB_TOP], 1u);
            const unsigned tg = og / nx;
            if (og + 1u == (tg + 1u) * nx) xb_add(&bar[XB_TOPGEN], 1u);
            else XB_SPIN(xb_ld(&bar[XB_TOPGEN]) == tg, bar);
            __builtin_amdgcn_fence(__ATOMIC_ACQUIRE, "agent");
            xb_add(&bar[XB_XGEN(b.x)], 1u);
            asm volatile("s_waitcnt vmcnt(0)" ::: "memory");
        } else {
            XB_SPIN(xb_ld(&bar[XB_XGEN(b.x)]) == gen, bar);
            __builtin_amdgcn_fence(__ATOMIC_ACQUIRE, "agent");
            asm volatile("s_waitcnt vmcnt(0)" ::: "memory");
        }
    }
    __syncthreads();
}

struct Params {
    const float* x; const float* ln1_g; const float* w_in; const float* qn_a; const float* kn_a; const float* rpb_a; const float* on_a;
    const float* qn_b; const float* kn_b; const float* lam_q1; const float* lam_k1; const float* lam_q2; const float* lam_k2; const float* subln_b;
    const float* w_out; const float* ln2_g; const float* w_router; const float* w_gate; const float* w_up; const float* w_down;
    float* out; unsigned char* ws; int ph_lo, ph_hi;
};

__device__ __forceinline__ void cvt_load(const float* __restrict__ src, int N, int k0, int n0, int tid, f32x4 (&v)[8], const float* kscale) {
    const int ln = tid & 63, kq = tid >> 6;
    const float* p = src + (size_t)(k0 + kq * 8) * N + n0 + ln * 4;
#pragma unroll
    for (int i = 0; i < 8; ++i) v[i] = __builtin_nontemporal_load((const f32x4*)(p + (size_t)i * N));
    if (kscale) {
#pragma unroll
        for (int i = 0; i < 8; ++i) v[i] = v[i] * kscale[k0 + kq * 8 + i];
    }
}
__device__ __forceinline__ void cvt_to_lds(LAS unsigned char* buf, int tid, const f32x4 (&v)[8]) {
    const int ln = tid & 63, kq = tid >> 6;
#pragma unroll
    for (int j = 0; j < 4; ++j) {
        u32x4 w; w.x = cvtpk(v[0][j], v[1][j]); w.y = cvtpk(v[2][j], v[3][j]); w.z = cvtpk(v[4][j], v[5][j]); w.w = cvtpk(v[6][j], v[7][j]);
        *(LAS u32x4*)(buf + (ln * 4 + j) * 144 + kq * 16) = w;
    }
}
__device__ __forceinline__ void cvt_store(const LAS unsigned char* buf, bf16_t* __restrict__ dst, int K, int k0, int n0, int blk, int off, int tid) {
#pragma unroll
    for (int q = 0; q < 4; ++q) {
        const int p = tid + q * 512, n = p >> 3, kp = p & 7, ng = n0 + n;
        const u32x4 w = *(const LAS u32x4*)(buf + n * 144 + kp * 16);
        const size_t drow = (size_t)(ng >> 7) * blk + off + (ng & 127);
        *(u32x4*)(dst + drow * K + k0 + kp * 8) = w;
    }
}
__device__ __forceinline__ void cvt_to_lds8(LAS unsigned char* buf, int tid, const f32x4 (&v)[8]) {
    const int ln = tid & 63, kq = tid >> 6, slot = (kq ^ (ln & 7)) * 8;
    f32x4 u[8];
#pragma unroll
    for (int i = 0; i < 8; ++i) u[i] = v[i] * WSC8;
#pragma unroll
    for (int j = 0; j < 4; ++j) {
        u32x2 w; w.x = cvt4_fp8(u[0][j], u[1][j], u[2][j], u[3][j]); w.y = cvt4_fp8(u[4][j], u[5][j], u[6][j], u[7][j]);
        *(LAS u32x2*)(buf + (ln * 4 + j) * 64 + slot) = w;
    }
}
__device__ __forceinline__ void cvt_store8(const LAS unsigned char* buf, unsigned char* __restrict__ dst, int Kb, int k0, int n0, int blk, int off, int tid) {
#pragma unroll
    for (int q = 0; q < 2; ++q) {
        const int p = tid + q * 512, n = p >> 2, kp = p & 3, ng = n0 + n, sw = (n >> 2) & 7;
        const u32x2 lo = *(const LAS u32x2*)(buf + n * 64 + ((2 * kp) ^ sw) * 8), hi = *(const LAS u32x2*)(buf + n * 64 + ((2 * kp + 1) ^ sw) * 8);
        const u32x4 w = {lo.x, lo.y, hi.x, hi.y};
        const size_t drow = (size_t)(ng >> 7) * blk + off + (ng & 127);
        __builtin_nontemporal_store(w, (u32x4*)(dst + drow * Kb + k0 + kp * 16));
    }
}
struct CvtTile { const float* src; bf16_t* dst; int K, N, k0, n0, blk, off; const float* kscale; int fp8; };
__device__ __forceinline__ void cvt_to_lds_any(LAS unsigned char* buf, int tid, const f32x4 (&v)[8], int fp8) { if (fp8) cvt_to_lds8(buf, tid, v); else cvt_to_lds(buf, tid, v); }
__device__ __forceinline__ void cvt_store_any(const LAS unsigned char* buf, const CvtTile& t, int tid) {
    if (t.fp8) cvt_store8(buf, (unsigned char*)t.dst, t.K, t.k0, t.n0, t.blk, t.off, tid); else cvt_store(buf, t.dst, t.K, t.k0, t.n0, t.blk, t.off, tid); }
template <int KIND> __device__ __forceinline__ constexpr int cvt_count() { return KIND == 0 ? 768 : KIND == 1 ? 256 : 16 * 352; }
template <int KIND> __device__ __forceinline__ CvtTile cvt_decode(const Params& P, int r) {
    CvtTile t; t.kscale = nullptr; t.fp8 = 0;
    if (KIND == 0) { t.src = P.w_in; t.dst = (bf16_t*)(P.ws + WS_WIN); t.K = DM; t.N = INC; t.k0 = (r / 24) * 64; t.n0 = (r % 24) * 256; t.blk = 128; t.off = 0; }
    else if (KIND == 1) { t.src = P.w_out; t.dst = (bf16_t*)(P.ws + WS_WOUT); t.K = DM; t.N = DM; t.k0 = (r / 8) * 64; t.n0 = (r % 8) * 256; t.blk = 128; t.off = 0; t.kscale = (t.k0 < 1024) ? P.on_a : nullptr; }
    else if (KIND == 2 || KIND == 3) { const int e = r / 352, q = r % 352;
        t.src = (KIND == 3 ? P.w_up : P.w_gate) + (size_t)e * DM * FF; t.dst = (bf16_t*)(P.ws + WS_WGU + (size_t)e * 2 * FF * DM);
        t.K = DM; t.N = FF; t.k0 = (q / 11) * 64; t.n0 = (q % 11) * 256; t.blk = 256; t.off = (KIND == 3) ? 128 : 0; t.fp8 = 1; }
    else { const int e = r / 352, q = r % 352;
        t.src = P.w_down + (size_t)e * FF * DM; t.dst = (bf16_t*)(P.ws + WS_WD + (size_t)e * DM * FF);
        t.K = FF; t.N = DM; t.k0 = (q / 8) * 64; t.n0 = (q % 8) * 256; t.blk = 128; t.off = 0; t.fp8 = 1; }
    return t;
}
constexpr int CW_QG = 4096, CW_QU = 4160, CW_QD = 4224;

template <int KIND> __device__ __forceinline__ void cvt_static(const Params& P, LAS unsigned char* lds) {
    const int tid = threadIdx.x, G = gridDim.x; constexpr int NT = cvt_count<KIND>();
    int idA = blockIdx.x, idB = blockIdx.x + G;
    f32x4 vA[8], vB[8];
    CvtTile tA = cvt_decode<KIND>(P, idA < NT ? idA : 0), tB = cvt_decode<KIND>(P, idB < NT ? idB : 0);
    if (idA < NT) cvt_load(tA.src, tA.N, tA.k0, tA.n0, tid, vA, tA.kscale);
    if (idB < NT) cvt_load(tB.src, tB.N, tB.k0, tB.n0, tid, vB, tB.kscale);
    for (;;) {
        if (idA >= NT) break;
        cvt_to_lds_any(lds, tid, vA, tA.fp8);
        { const int nid = idA + 2 * G; CvtTile tn = cvt_decode<KIND>(P, nid < NT ? nid : 0);
          if (nid < NT) cvt_load(tn.src, tn.N, tn.k0, tn.n0, tid, vA, tn.kscale);
          asm volatile("s_waitcnt lgkmcnt(0)" ::: "memory"); __builtin_amdgcn_s_barrier(); asm volatile("" ::: "memory");
          cvt_store_any(lds, tA, tid);
          tA = tn; idA = nid; }
        if (idB >= NT) break;
        cvt_to_lds_any(lds + 36864, tid, vB, tB.fp8);
        { const int nid = idB + 2 * G; CvtTile tn = cvt_decode<KIND>(P, nid < NT ? nid : 0);
          if (nid < NT) cvt_load(tn.src, tn.N, tn.k0, tn.n0, tid, vB, tn.kscale);
          asm volatile("s_waitcnt lgkmcnt(0)" ::: "memory"); __builtin_amdgcn_s_barrier(); asm volatile("" ::: "memory");
          cvt_store_any(lds + 36864, tB, tid);
          tB = tn; idB = nid; }
    }
}
__device__ __forceinline__ void p0_prologue(const Params& P, LAS unsigned char* lds) {
    int tid = threadIdx.x; asm volatile("" : "+v"(tid)); const int lane = tid & 63, wid = tid >> 6;
    {
        bf16_t* H = (bf16_t*)(P.ws + WS_H);
        for (int row = blockIdx.x * 8 + wid; row < MTOK; row += gridDim.x * 8) {
            const f32x4* xp = (const f32x4*)(P.x + (size_t)row * DM);
            f32x4 v[8]; float ss = 0.f;
#pragma unroll
            for (int i = 0; i < 8; ++i) { v[i] = xp[i * 64 + lane]; ss += v[i][0] * v[i][0] + v[i][1] * v[i][1] + v[i][2] * v[i][2] + v[i][3] * v[i][3]; }
            ss = wave_sum(ss);
            const float rstd = rsqrtf(ss * (1.0f / DM) + RMS_EPS);
#pragma unroll
            for (int i = 0; i < 8; ++i) {
                const f32x4 g = ((const f32x4*)P.ln1_g)[i * 64 + lane];
                u32x2 w; w.x = cvtpk(v[i][0] * rstd * g[0], v[i][1] * rstd * g[1]); w.y = cvtpk(v[i][2] * rstd * g[2], v[i][3] * rstd * g[3]);
                *(u32x2*)(H + (size_t)row * DM + (i * 64 + lane) * 4) = w;
            }
        }
    }
    cvt_static<0>(P, lds); __syncthreads(); cvt_static<1>(P, lds);
    { float* wrt = (float*)(P.ws + WS_WRT);
      for (int i = blockIdx.x * NTHR + tid; i < NEXP * DM; i += gridDim.x * NTHR) { const int e = i >> 11, c = i & 2047; wrt[i] = P.w_router[c * 16 + e]; } }
}
__device__ __forceinline__ void cvt_load_asm(const float* __restrict__ src, int N, int k0, int n0, int tid, f32x4 (&v)[8]) {
    const int ln = tid & 63, kq = tid >> 6;
    const float* p = src + (size_t)(k0 + kq * 8) * N + n0 + ln * 4;
#pragma unroll
    for (int i = 0; i < 8; ++i) { const float* q = p + (size_t)i * N; asm volatile("global_load_dwordx4 %0, %1, off nt" : "=v"(v[i]) : "v"(q) : "memory"); }
}
__device__ __forceinline__ void cvt_load_asm_s(const float* tile  , int N, unsigned voff, f32x4 (&v)[8]) {
#pragma unroll
    for (int i = 0; i < 8; ++i) { const float* q = tile + (size_t)i * N; asm volatile("global_load_dwordx4 %0, %1, %2 nt" : "=v"(v[i]) : "v"(voff), "s"(q) : "memory"); }
}
#define CVT_WAIT_SET(v, N) asm volatile("s_waitcnt vmcnt(" #N ")" : "+v"(v[0]), "+v"(v[1]), "+v"(v[2]), "+v"(v[3]), "+v"(v[4]), "+v"(v[5]), "+v"(v[6]), "+v"(v[7]) :: "memory")
struct CvtT { const float* src; unsigned char* dst; int N, Kb, k0, drow0; };
template <int KIND> __device__ __forceinline__ CvtT cvt_decode8(const Params& P, int r) {
    CvtT t; const int e = r / 352, q = r % 352;
    if (KIND == 2 || KIND == 3) { const int kt = q / 22, nt = q % 22;
        t.N = FF; t.Kb = DM; t.k0 = kt * 128; t.src = (KIND == 3 ? P.w_up : P.w_gate) + (size_t)e * DM * FF + (size_t)t.k0 * FF + nt * 128;
        t.dst = P.ws + WS_WGU + (size_t)e * 2 * FF * DM; t.drow0 = nt * 256 + (KIND == 3 ? 128 : 0); }
    else { const int kt = q / 16, nt = q % 16;
        t.N = DM; t.Kb = FF; t.k0 = kt * 128; t.src = P.w_down + (size_t)e * FF * DM + (size_t)t.k0 * DM + nt * 128;
        t.dst = P.ws + WS_WD + (size_t)e * DM * FF; t.drow0 = nt * 128; }
    return t;
}
template <int KIND> __device__ __forceinline__ void cvt_queue(const Params& P, LAS unsigned char* lds, unsigned* qhead) {
    int tid = threadIdx.x; asm volatile("" : "+v"(tid));
    const int wid = __builtin_amdgcn_readfirstlane(tid >> 6), lane = tid & 63, ln32 = lane & 31, kq = tid >> 5;
    constexpr unsigned n = (unsigned)cvt_count<KIND>(); constexpr unsigned CH = 8;
    LAS unsigned* slot = (LAS unsigned*)(lds + SCR_OFF + 12288);
    LAS unsigned char* stg = lds + CVS_OFF;
#define QCLAIM() __hip_atomic_fetch_add(qhead, CH, __ATOMIC_RELAXED, __HIP_MEMORY_SCOPE_AGENT)
    __syncthreads();
    if (tid == 0) { const unsigned s0 = QCLAIM(), s1 = QCLAIM(); slot[0] = s0; slot[1] = s1; }
    __syncthreads();
    unsigned cbase = slot[0], pos = 0, par = 1;
#define QGEN(dst) do { dst = cbase + pos; if (++pos == CH) { pos = 0; cbase = slot[par]; \
        if (tid == 0) { const unsigned nb_ = (cbase < n) ? QCLAIM() : 0xffffff00u; slot[par ^ 1] = nb_; } par ^= 1; } } while (0)
#define CVT_DMA(t, sl) do { const char* gb_ = (const char*)(t).src + (size_t)(wid * 16 + (lane >> 5)) * ((t).N * 4) + ln32 * 16; LAS unsigned char* lb_ = lds + (sl) * 65536 + wid * 8192; \
        _Pragma("unroll") for (int i_ = 0; i_ < 8; ++i_) __builtin_amdgcn_global_load_lds((const unsigned*)(gb_ + (size_t)(2 * i_) * ((t).N * 4)), (LAS unsigned*)(lb_ + i_ * 1024), 16, 0, 2); } while (0)
    unsigned id0, id1; QGEN(id0); QGEN(id1);
    id0 = __builtin_amdgcn_readfirstlane(id0); id1 = __builtin_amdgcn_readfirstlane(id1);
    CvtT tc = cvt_decode8<KIND>(P, id0 < n ? (int)id0 : 0), tn = cvt_decode8<KIND>(P, id1 < n ? (int)id1 : 0);
    CVT_DMA(tc, 0); CVT_DMA(tn, 1);
    unsigned idc = id0, idn = id1; int k = 0;
    while (idc < n) {
        const int sl = k & 1;
        if (k < 2) asm volatile("s_waitcnt vmcnt(0)" ::: "memory"); else asm volatile("s_waitcnt vmcnt(12)" ::: "memory");
        f32x4 v[8];
        { const LAS unsigned char* rb = lds + sl * 65536 + wid * 8192 + (lane >> 5) * 4096 + ln32 * 16;
#pragma unroll
          for (int i = 0; i < 8; ++i) v[i] = *(const LAS f32x4*)(rb + i * 512) * WSC8; }
        unsigned w8[4][2];
#pragma unroll
        for (int j = 0; j < 4; ++j) { w8[j][0] = cvt4_fp8(v[0][j], v[1][j], v[2][j], v[3][j]); w8[j][1] = cvt4_fp8(v[4][j], v[5][j], v[6][j], v[7][j]); }
        unsigned idx; QGEN(idx); idx = __builtin_amdgcn_readfirstlane(idx);
        const CvtT tx = cvt_decode8<KIND>(P, idx < n ? (int)idx : 0);
        asm volatile("s_waitcnt lgkmcnt(0)" ::: "memory");
        CVT_DMA(tx, sl);
        __builtin_amdgcn_s_barrier(); asm volatile("" ::: "memory");
#pragma unroll
        for (int j = 0; j < 4; ++j) { u32x2 w; w.x = w8[j][0]; w.y = w8[j][1]; *(LAS u32x2*)(stg + (ln32 * 4 + j) * 128 + ((kq ^ (ln32 & 15)) << 3)) = w; }
        asm volatile("s_waitcnt lgkmcnt(0)" ::: "memory"); __builtin_amdgcn_s_barrier(); asm volatile("" ::: "memory");
#pragma unroll
        for (int q = 0; q < 2; ++q) {
            const int p = tid + q * 512, nn = p >> 3, kp = p & 7, sw = (nn >> 2) & 15;
            const u32x2 lo = *(const LAS u32x2*)(stg + nn * 128 + (((2 * kp) ^ sw) << 3)), hi = *(const LAS u32x2*)(stg + nn * 128 + (((2 * kp + 1) ^ sw) << 3));
            const u32x4 w = {lo.x, lo.y, hi.x, hi.y};
            __builtin_nontemporal_store(w, (u32x4*)(tc.dst + (size_t)(tc.drow0 + nn) * tc.Kb + tc.k0 + kp * 16));
        }
        tc = tn; tn = tx; idc = idn; idn = idx; ++k;
    }
    asm volatile("s_waitcnt vmcnt(0)" ::: "memory");
#undef QCLAIM
#undef QGEN
#undef CVT_DMA
    __syncthreads();
}

namespace pg8 {
constexpr int BM = 256, BK = 64, HALF = 128, HTB = HALF * BK * 2, NXCD = 8, WGM = 8;
__device__ __forceinline__ int lds_byte(int r, int c) { const int st = (r >> 4) * 2 + (c >> 5), rr = r & 15, cc = c & 31, ob = rr * 64 + cc * 2; return st * 1024 + (ob ^ (((ob >> 9) & 1) << 5)); }
__device__ __forceinline__ void stage_rc(int b, int& R, int& C) { const int st = b / 1024, sb = b % 1024, swz = sb ^ (((sb >> 9) & 1) << 5); R = (st >> 1) * 16 + swz / 64; C = (st & 1) * 32 + (swz % 64) / 2; }
__device__ __forceinline__ int perm32(int rho) { const int n = rho >> 4, i = rho & 15; return 8 * (i >> 2) + 4 * n + (i & 3); }

struct Unit { int pm, pn, e; };

template <bool GATHER, bool HOOK, bool FP8, class Epi, class Sched>
__device__ __forceinline__ void gemm_phase(LAS unsigned char* lds, const int K, const Sched& S, const Epi& E, const LAS unsigned* gtab) {
    int tid = threadIdx.x; asm volatile("" : "+v"(tid));
    const int wid = __builtin_amdgcn_readfirstlane(tid >> 6), lane = tid & 63, wr = wid >> 2, wc = wid & 3, fr = lane & 15, fq = lane >> 4;
    const int nt = K / BK;
    unsigned voffA[2], voffB[2]; int RA[2], CA2[2];
#pragma unroll
    for (int i = 0; i < 2; ++i) { int R, C; stage_rc(tid * 16 + i * 8192, R, C); const int Rb = (R & ~31) + perm32(R & 31);
        voffA[i] = (unsigned)(R * K + C) * 2u; voffB[i] = (unsigned)(Rb * K + C) * 2u; RA[i] = R; CA2[i] = C * 2; }
    const size_t kstep = (size_t)(BK * 2);
    const size_t hstep = (size_t)HALF * K * 2;
    const unsigned ldsw = (unsigned)wid * 1024u;
    const int aoff = lds_byte(wr * 64 + fr, fq * 8), boff = lds_byte(wc * 32 + fr, fq * 8);
#define PG8_SA(b, h) (((b) * 2 + (h)) * HTB)
#define PG8_SB(b, h) ((4 + (b) * 2 + (h)) * HTB)
#define PG8_STAGE(bufoff, gbase, voff) do { _Pragma("unroll") for (int _i = 0; _i < 2; ++_i) \
        __builtin_amdgcn_global_load_lds((const unsigned*)((const char*)(gbase) + (voff)[_i]), (LAS unsigned*)(lds + (bufoff) + ldsw + _i * 8192), 16, 0, 0); } while (0)
#define PG8_STAGE_A(bufoff, ubase, kbytes, h, gv) do { if (GATHER) { PG8_STAGE(bufoff, (ubase) + (kbytes), (gv)[h]); } else { PG8_STAGE(bufoff, (ubase) + (kbytes) + (h) * hstep, voffA); } } while (0)
#define PG8_LD2(addr) __builtin_shufflevector(*(const LAS i32x4*)(addr), *(const LAS i32x4*)((addr) + 1024), 0, 1, 2, 3, 4, 5, 6, 7)
#define PG8_LDA(dst, b, h) do { if (FP8) { _Pragma("unroll") for (int m = 0; m < 4; ++m) dst##_f8[m] = PG8_LD2(lds + PG8_SA(b, h) + aoff + m * 2048); } \
        else { _Pragma("unroll") for (int m = 0; m < 4; ++m) _Pragma("unroll") for (int k = 0; k < 2; ++k) dst##_bf[m][k] = *(const LAS bf16x8*)(lds + PG8_SA(b, h) + aoff + m * 2048 + k * 1024); } } while (0)
#define PG8_LDB(dst, b, h) do { if (FP8) { _Pragma("unroll") for (int n = 0; n < 2; ++n) dst##_f8[n] = PG8_LD2(lds + PG8_SB(b, h) + boff + n * 2048); } \
        else { _Pragma("unroll") for (int n = 0; n < 2; ++n) _Pragma("unroll") for (int k = 0; k < 2; ++k) dst##_bf[n][k] = *(const LAS bf16x8*)(lds + PG8_SB(b, h) + boff + n * 2048 + k * 1024); } } while (0)
#define PG8_MMA(ai, bj, At, Bt) do { __builtin_amdgcn_s_setprio(1); \
        if (FP8) { _Pragma("unroll") for (int m = 0; m < 4; ++m) _Pragma("unroll") for (int n = 0; n < 2; ++n) \
            asm volatile("v_mfma_scale_f32_16x16x128_f8f6f4 %0, %1, %2, %0, %3, %3 op_sel_hi:[0,0,0]" : "+v"(acc[ai][bj][m][n]) : "v"(Bt##_f8[n]), "v"(At##_f8[m]), "v"(sc1)); } \
        else { _Pragma("unroll") for (int m = 0; m < 4; ++m) _Pragma("unroll") for (int n = 0; n < 2; ++n) _Pragma("unroll") for (int k = 0; k < 2; ++k) \
            acc[ai][bj][m][n] = __builtin_amdgcn_mfma_f32_16x16x32_bf16(Bt##_bf[n][k], At##_bf[m][k], acc[ai][bj][m][n], 0, 0, 0); } \
        __builtin_amdgcn_s_setprio(0); } while (0)
#define PG8_WAIT_V(n) asm volatile("s_waitcnt vmcnt(" #n ")" ::: "memory")
#define PG8_WAIT_L(n) asm volatile("s_waitcnt lgkmcnt(" #n ")" ::: "memory")
#define PG8_BAR __builtin_amdgcn_s_barrier()
#define PG8_SCHED __builtin_amdgcn_sched_barrier(0)
#define PG8_GLOAD(gv, i) do { if (GATHER) { _Pragma("unroll") for (int _h = 0; _h < 2; ++_h) _Pragma("unroll") for (int _i = 0; _i < 2; ++_i) (gv)[_h][_i] = gtab[(i) * 256 + _h * 128 + RA[_i]] + (unsigned)CA2[_i]; } } while (0)
    Unit cur, nxt; int ui = 0;
    if (!S.next(0, cur)) return;
    f32x4 acc[2][2][4][2];
    if constexpr (Epi::INIT) E.init(acc, cur, wr, wc, fr, fq, gtab);
    else {
#pragma unroll
    for (int a = 0; a < 2; ++a)
#pragma unroll
        for (int b = 0; b < 2; ++b)
#pragma unroll
            for (int m = 0; m < 4; ++m)
#pragma unroll
                for (int n = 0; n < 2; ++n) acc[a][b][m][n] = (f32x4){0.f, 0.f, 0.f, 0.f};
    }
    i32x8 At_f8[4], B0_f8[2], B1_f8[2]; bf16x8 At_bf[4][2], B0_bf[2][2], B1_bf[2][2];
    int sc1 = 0x7F7F7F7F; asm volatile("" : "+v"(sc1));
    unsigned gc[2][2] = {{0u, 0u}, {0u, 0u}}, gn[2][2] = {{0u, 0u}, {0u, 0u}};
    PG8_GLOAD(gc, 0);
    const char* cA = S.abase(cur); const char* cB = S.bbase(cur);
    PG8_STAGE(PG8_SB(0, 0), cB, voffB); PG8_STAGE_A(PG8_SA(0, 0), cA, 0, 0, gc); PG8_STAGE(PG8_SB(0, 1), cB + hstep, voffB); PG8_STAGE_A(PG8_SA(0, 1), cA, 0, 1, gc);
    if (wr == 1) PG8_BAR;
    PG8_WAIT_V(4); PG8_BAR;
    PG8_STAGE(PG8_SB(1, 0), cB + kstep, voffB); PG8_STAGE_A(PG8_SA(1, 0), cA, kstep, 0, gc); PG8_STAGE(PG8_SB(1, 1), cB + hstep + kstep, voffB);
    PG8_WAIT_V(6); PG8_BAR;
    for (;;) {
        const bool has_next = S.next(ui + 1, nxt);
        const char* nA = has_next ? S.abase(nxt) : cA; const char* nB = has_next ? S.bbase(nxt) : cB;
        if (GATHER) { if (has_next) { PG8_GLOAD(gn, ui + 1); } else {
#pragma unroll
            for (int _h = 0; _h < 2; ++_h)
#pragma unroll
                for (int _i = 0; _i < 2; ++_i) gn[_h][_i] = gc[_h][_i]; } }
        for (int t = 0; t < nt; t += 2) {
            const bool last = (t == nt - 2);
            const size_t k1 = (size_t)(t + 1) * kstep;
            const char* a2 = last ? nA : cA + (size_t)(t + 2) * kstep; const char* b2 = last ? nB : cB + (size_t)(t + 2) * kstep;
            const char* a3 = a2 + kstep; const char* b3 = b2 + kstep;
            unsigned g2[2][2];
#pragma unroll
            for (int _h = 0; _h < 2; ++_h)
#pragma unroll
                for (int _i = 0; _i < 2; ++_i) g2[_h][_i] = last ? gn[_h][_i] : gc[_h][_i];
            if (HOOK && t == 16) {
                const LAS float* ht = (const LAS float*)gtab;
#pragma unroll
                for (int a = 0; a < 2; ++a)
#pragma unroll
                    for (int m = 0; m < 4; ++m) { const float sc = ht[a * 128 + wr * 64 + m * 16 + fr];
#pragma unroll
                        for (int b = 0; b < 2; ++b)
#pragma unroll
                            for (int n = 0; n < 2; ++n) acc[a][b][m][n] = acc[a][b][m][n] * sc; }
            }
            PG8_LDB(B0, 0, 0); PG8_SCHED; PG8_LDA(At, 0, 0); PG8_STAGE_A(PG8_SA(1, 1), cA, k1, 1, gc);
            PG8_WAIT_L(8); PG8_BAR; PG8_WAIT_L(0); PG8_MMA(0, 0, At, B0); PG8_BAR; PG8_SCHED;
            PG8_LDB(B1, 0, 1); PG8_STAGE(PG8_SB(0, 0), b2, voffB);
            PG8_BAR; PG8_WAIT_L(0); PG8_MMA(0, 1, At, B1); PG8_BAR;
            PG8_LDA(At, 0, 1); PG8_STAGE_A(PG8_SA(0, 0), a2, 0, 0, g2);
            PG8_BAR; PG8_WAIT_L(0); PG8_MMA(1, 0, At, B0); PG8_BAR; PG8_SCHED;
            PG8_STAGE(PG8_SB(0, 1), b2 + hstep, voffB);
            PG8_WAIT_V(6); PG8_BAR; PG8_MMA(1, 1, At, B1); PG8_BAR;
            PG8_LDB(B0, 1, 0); PG8_SCHED; PG8_LDA(At, 1, 0); PG8_STAGE_A(PG8_SA(0, 1), a2, 0, 1, g2);
            PG8_WAIT_L(8); PG8_BAR; PG8_WAIT_L(0); PG8_MMA(0, 0, At, B0); PG8_BAR; PG8_SCHED;
            PG8_LDB(B1, 1, 1); PG8_STAGE(PG8_SB(1, 0), b3, voffB);
            PG8_BAR; PG8_WAIT_L(0); PG8_MMA(0, 1, At, B1); PG8_BAR;
            PG8_LDA(At, 1, 1); PG8_STAGE_A(PG8_SA(1, 0), a3, 0, 0, g2);
            PG8_BAR; PG8_WAIT_L(0); PG8_MMA(1, 0, At, B0); PG8_BAR; PG8_SCHED;
            PG8_STAGE(PG8_SB(1, 1), b3 + hstep, voffB);
            PG8_WAIT_V(6); PG8_BAR; PG8_MMA(1, 1, At, B1); PG8_BAR;
        }
        E(acc, cur, wr, wc, fr, fq, lds);
        if (!has_next) break;
#pragma unroll
        for (int a = 0; a < 2; ++a)
#pragma unroll
            for (int b = 0; b < 2; ++b)
#pragma unroll
                for (int m = 0; m < 4; ++m)
#pragma unroll
                    for (int n = 0; n < 2; ++n) acc[a][b][m][n] = (f32x4){0.f, 0.f, 0.f, 0.f};
        cur = nxt; cA = nA; cB = nB; ++ui;
#pragma unroll
        for (int _h = 0; _h < 2; ++_h)
#pragma unroll
            for (int _i = 0; _i < 2; ++_i) gc[_h][_i] = gn[_h][_i];
    }
    PG8_WAIT_V(0);
    if (wr == 0) PG8_BAR;
    PG8_BAR;
#undef PG8_SA
#undef PG8_SB
#undef PG8_STAGE
#undef PG8_STAGE_A
#undef PG8_LDA
#undef PG8_LDB
#undef PG8_MMA
#undef PG8_LD2
#undef PG8_WAIT_V
#undef PG8_WAIT_L
#undef PG8_BAR
#undef PG8_SCHED
#undef PG8_GLOAD
}

struct OrderMN {
    int nM, nN, nwg, G, c; const char* A; const char* Bt; size_t tstep;
    __device__ __forceinline__ void init(const void* A_, const void* Bt_, int M, int N, int K, int G_, int c_) { nM = M / BM; nN = N / BM; nwg = nM * nN; G = G_; c = c_; A = (const char*)A_; Bt = (const char*)Bt_; tstep = (size_t)BM * K * 2; }
    __device__ __forceinline__ bool next(int i, Unit& u) const {
        if (c >= G) return false;
        const long L = (long)i * G + c; if (L >= nwg) return false;
        int wgid = (int)L; { const int q = nwg / NXCD, r = nwg % NXCD, xcd = wgid % NXCD, off = wgid / NXCD; wgid = (xcd < r ? xcd * (q + 1) : r * (q + 1) + (xcd - r) * q) + off; }
        const int nig = WGM * nN, gid = wgid / nig, fm = gid * WGM, gsz = (nM - fm) < WGM ? (nM - fm) : WGM;
        u.pm = fm + ((wgid % nig) % gsz); u.pn = (wgid % nig) / gsz; u.e = 0; return true;
    }
    __device__ __forceinline__ const char* abase(const Unit& u) const { return A + (size_t)u.pm * tstep; }
    __device__ __forceinline__ const char* bbase(const Unit& u) const { return Bt + (size_t)u.pn * tstep; }
};
struct OrderExpert {
    int nN, ntile, G, c, per; const char* A; const char* Bt; size_t a_estride, b_estride, tstepA, tstepB; bool gather;
    __device__ __forceinline__ void init(const void* A_, const void* Bt_, int N, int K, size_t a_es, size_t b_es, bool gather_, int G_, int c_, int per_) {
        nN = N / BM; ntile = NEXP * nN; G = G_; c = c_; per = per_; A = (const char*)A_; Bt = (const char*)Bt_; a_estride = a_es; b_estride = b_es; tstepA = (size_t)BM * K * 2; tstepB = tstepA; gather = gather_; }
    __device__ __forceinline__ bool next(int i, Unit& u) const {
        int T, pm;
        if ((G & 7) == 0) {
            const int x = c & 7, j = c >> 3; if (j >= per) return false;
            const int q = i * per + j, U = 4 * nN; if (q >= 2 * U) return false;
            const int el = q >= U ? 1 : 0, r = q - el * U, chunk = r >> 5, w = r & 31;
            pm = w & 3; const int pn = chunk * 8 + (w >> 2);
            T = (2 * x + el) * nN + pn;
            if (pn >= nN) return false;
        }
        else { const int q = i * G + c; T = q >> 2; pm = q & 3; }
        if (T >= ntile) return false;
        u.e = T / nN; u.pn = T % nN; u.pm = pm; return true;
    }
    __device__ __forceinline__ const char* abase(const Unit& u) const { return gather ? A : A + (size_t)u.e * a_estride + (size_t)u.pm * tstepA; }
    __device__ __forceinline__ const char* bbase(const Unit& u) const { return Bt + (size_t)u.e * b_estride + (size_t)u.pn * tstepB; }
};
}

struct EpiInProj {
    static constexpr bool INIT = false;
    bf16_t* proj;
    __device__ __forceinline__ void operator()(const f32x4 (&acc)[2][2][4][2], const pg8::Unit& u, int wr, int wc, int fr, int fq, LAS unsigned char* lds) const {
        const int pn = u.pn, grp = pn >> 2;
        const int row0 = u.pm * 256 + wr * 64 + fr;
        if (grp == 5 || grp == 2) {
#pragma unroll
            for (int ai = 0; ai < 2; ++ai)
#pragma unroll
                for (int m = 0; m < 4; ++m) {
                    bf16_t* rowp = proj + (size_t)(row0 + ai * 128 + m * 16) * INC + pn * 256 + wc * 32 + 8 * fq;
#pragma unroll
                    for (int bj = 0; bj < 2; ++bj) { const f32x4 v0 = acc[ai][bj][m][0], v1 = acc[ai][bj][m][1];
                        u32x4 w; w.x = cvtpk(v0[0], v0[1]); w.y = cvtpk(v0[2], v0[3]); w.z = cvtpk(v1[0], v1[1]); w.w = cvtpk(v1[2], v1[3]);
                        *(u32x4*)(rowp + bj * 128) = w; }
                }
            return;
        }
        const int gsel = (grp == 0) ? 0 : (grp == 1) ? 1 : (grp == 3) ? 2 : 3;
        const LAS float* gain = (const LAS float*)(lds + SCR_OFF + 8192) + gsel * 128;
        const float osc = (grp == 0 || grp == 3) ? QSCALE : 1.0f;
        LAS float* Pt = (LAS float*)(lds + SCR_OFF);
#pragma unroll
        for (int ai = 0; ai < 2; ++ai)
#pragma unroll
            for (int m = 0; m < 4; ++m)
#pragma unroll
                for (int bj = 0; bj < 2; ++bj) {
                    const f32x4 v0 = acc[ai][bj][m][0], v1 = acc[ai][bj][m][1];
                    float s = (v0[0] * v0[0] + v0[1] * v0[1]) + (v0[2] * v0[2] + v0[3] * v0[3]) + (v1[0] * v1[0] + v1[1] * v1[1]) + (v1[2] * v1[2] + v1[3] * v1[3]);
                    s += __shfl_xor(s, 16); s += __shfl_xor(s, 32);
                    if (fq == 0) Pt[((ai * 128 + wr * 64 + m * 16 + fr) * 2 + bj) * 4 + wc] = s;
                }
        asm volatile("s_waitcnt lgkmcnt(0)" ::: "memory"); __builtin_amdgcn_s_barrier(); asm volatile("" ::: "memory");
        const f32x4 g0 = *(const LAS f32x4*)(gain + wc * 32 + 8 * fq), g1 = *(const LAS f32x4*)(gain + wc * 32 + 8 * fq + 4);
#pragma unroll
        for (int ai = 0; ai < 2; ++ai)
#pragma unroll
            for (int m = 0; m < 4; ++m) {
                bf16_t* rowp = proj + (size_t)(row0 + ai * 128 + m * 16) * INC + pn * 256 + wc * 32 + 8 * fq;
#pragma unroll
                for (int bj = 0; bj < 2; ++bj) {
                    const f32x4 ps = *(const LAS f32x4*)(Pt + ((ai * 128 + wr * 64 + m * 16 + fr) * 2 + bj) * 4);
                    const float rstd = rsqrtf(((ps[0] + ps[1]) + (ps[2] + ps[3])) * (1.0f / 128.0f) + RMS_EPS) * osc;
                    const f32x4 v0 = acc[ai][bj][m][0] * rstd * g0, v1 = acc[ai][bj][m][1] * rstd * g1;
                    u32x4 w; w.x = cvtpk(v0[0], v0[1]); w.y = cvtpk(v0[2], v0[3]); w.z = cvtpk(v1[0], v1[1]); w.w = cvtpk(v1[2], v1[3]);
                    *(u32x4*)(rowp + bj * 128) = w;
                }
            }
    }
};
struct EpiOutProj {
    static constexpr bool INIT = true;
    const float* x; bf16_t* x1b; float* rowss;
    __device__ __forceinline__ void init(f32x4 (&acc)[2][2][4][2], const pg8::Unit& u, int wr, int wc, int fr, int fq, const LAS unsigned* gtab) const {
        const LAS float* ht = (const LAS float*)gtab;
        const int row0 = u.pm * 256 + wr * 64 + fr, col0 = u.pn * 256 + wc * 32 + 8 * fq;
#pragma unroll
        for (int ai = 0; ai < 2; ++ai)
#pragma unroll
            for (int m = 0; m < 4; ++m) {
                const float isc = __builtin_amdgcn_rcpf(ht[ai * 128 + wr * 64 + m * 16 + fr]);
                const float* xp = x + (size_t)(row0 + ai * 128 + m * 16) * DM + col0;
#pragma unroll
                for (int bj = 0; bj < 2; ++bj)
#pragma unroll
                    for (int n = 0; n < 2; ++n) acc[ai][bj][m][n] = *(const f32x4*)(xp + bj * 128 + 4 * n) * isc;
            }
    }
    __device__ __forceinline__ void operator()(const f32x4 (&acc)[2][2][4][2], const pg8::Unit& u, int wr, int wc, int fr, int fq, LAS unsigned char* lds) const {
        const int row0 = u.pm * 256 + wr * 64 + fr, col0 = u.pn * 256 + wc * 32 + 8 * fq;
#pragma unroll
        for (int ai = 0; ai < 2; ++ai)
#pragma unroll
            for (int m = 0; m < 4; ++m) {
                const int row = row0 + ai * 128 + m * 16;
                bf16_t* op = x1b + (size_t)row * DM + col0;
                float s = 0.f;
#pragma unroll
                for (int bj = 0; bj < 2; ++bj) {
                    const f32x4 v0 = acc[ai][bj][m][0], v1 = acc[ai][bj][m][1];
                    u32x4 w; w.x = cvtpk(v0[0], v0[1]); w.y = cvtpk(v0[2], v0[3]); w.z = cvtpk(v1[0], v1[1]); w.w = cvtpk(v1[2], v1[3]);
                    *(u32x4*)(op + bj * 128) = w;
                    s += (v0[0] * v0[0] + v0[1] * v0[1]) + (v0[2] * v0[2] + v0[3] * v0[3]) + (v1[0] * v1[0] + v1[1] * v1[1]) + (v1[2] * v1[2] + v1[3] * v1[3]);
                }
                s += __shfl_xor(s, 16); s += __shfl_xor(s, 32);
                if (fq == 0) rowss[(size_t)row * 32 + u.pn * 4 + wc] = s;
            }
    }
};
struct EpiGateUp {
    static constexpr bool INIT = false;
    unsigned char* act;
    __device__ __forceinline__ void operator()(const f32x4 (&acc)[2][2][4][2], const pg8::Unit& u, int wr, int wc, int fr, int fq, LAS unsigned char* lds) const {
        const int row0 = u.pm * 256 + wr * 64 + fr;
        unsigned char* base = act + (size_t)u.e * EROWS * FF + u.pn * 128 + wc * 32 + 8 * fq;
        constexpr float DS = 1.0f / (WSC8 * HSC8);
#pragma unroll
        for (int ai = 0; ai < 2; ++ai)
#pragma unroll
            for (int m = 0; m < 4; ++m) {
                float r[8];
#pragma unroll
                for (int n = 0; n < 2; ++n)
#pragma unroll
                    for (int j = 0; j < 4; ++j) { const float g = acc[ai][0][m][n][j] * DS, uu = acc[ai][1][m][n][j] * DS;
                        const float a = g * __builtin_amdgcn_rcpf(1.0f + __builtin_amdgcn_exp2f(-g * LOG2E)) * uu * ASC8;
                        r[n * 4 + j] = fminf(fmaxf(a, -448.0f), 448.0f); }
                u32x2 w; w.x = cvt4_fp8(r[0], r[1], r[2], r[3]); w.y = cvt4_fp8(r[4], r[5], r[6], r[7]);
                *(u32x2*)(base + (size_t)(row0 + ai * 128 + m * 16) * FF) = w;
            }
    }
};
struct EpiDown {
    static constexpr bool INIT = false;
    unsigned char* y; const float* selgate;
    __device__ __forceinline__ void operator()(const f32x4 (&acc)[2][2][4][2], const pg8::Unit& u, int wr, int wc, int fr, int fq, LAS unsigned char* lds) const {
        const int row0 = u.pm * 256 + wr * 64 + fr;
        unsigned char* base = y + (size_t)u.e * EROWS * DM + u.pn * 256 + wc * 32 + 8 * fq;
#pragma unroll
        for (int ai = 0; ai < 2; ++ai)
#pragma unroll
            for (int m = 0; m < 4; ++m) {
                const int row = row0 + ai * 128 + m * 16;
                const float gt = selgate[u.e * EROWS + row] * (YSC8 / (WSC8 * ASC8));
#pragma unroll
                for (int bj = 0; bj < 2; ++bj) { const f32x4 v0 = acc[ai][bj][m][0] * gt, v1 = acc[ai][bj][m][1] * gt;
                    u32x2 w; w.x = cvt4_fp8(fminf(fmaxf(v0[0], -448.f), 448.f), fminf(fmaxf(v0[1], -448.f), 448.f), fminf(fmaxf(v0[2], -448.f), 448.f), fminf(fmaxf(v0[3], -448.f), 448.f));
                    w.y = cvt4_fp8(fminf(fmaxf(v1[0], -448.f), 448.f), fminf(fmaxf(v1[1], -448.f), 448.f), fminf(fmaxf(v1[2], -448.f), 448.f), fminf(fmaxf(v1[3], -448.f), 448.f));
                    *(u32x2*)(base + (size_t)row * DM + bj * 128) = w; }
            }
    }
};

#define KSWZ(row, colB) ((row) * 256 + ((colB) ^ (((row) & 7) << 4)))
#define SBAR() __builtin_amdgcn_sched_barrier(0)
__device__ __forceinline__ int crow(int r, int hi) { return (r & 3) + 8 * (r >> 2) + 4 * hi; }
#define PK4(P, BASE, OUT) do { unsigned a0 = cvtpk(P[BASE + 0], P[BASE + 1]), a1 = cvtpk(P[BASE + 2], P[BASE + 3]);   \
    unsigned b0 = cvtpk(P[BASE + 4], P[BASE + 5]), b1 = cvtpk(P[BASE + 6], P[BASE + 7]);                              \
    auto r0 = __builtin_amdgcn_permlane32_swap(a0, b0, false, false); auto r1 = __builtin_amdgcn_permlane32_swap(a1, b1, false, false); \
    u32x4 w = {r0[0], r1[0], r0[1], r1[1]}; OUT = *reinterpret_cast<bf16x8*>(&w); } while (0)
__device__ __forceinline__ float swap_add(float v) { auto rr = __builtin_amdgcn_permlane32_swap(__float_as_uint(v), __float_as_uint(v), false, false); return __uint_as_float(rr[0]) + __uint_as_float(rr[1]); }

namespace da {
constexpr int D = 128, NW = 8, QBLK = 32, KVBLK = 64;
constexpr int SHM_V = KVBLK * D * 2, SHM_K = KVBLK * D * 2, SHM_ATTN = 2 * SHM_V + 2 * SHM_K + NW * 64 * 4;
constexpr int LDP = INC;

__device__ __forceinline__ void qkt(f32x16& p0, f32x16& p1, const LAS unsigned char* Ks, const bf16x8* qr, int r32, int hi) {
    p0 = f32x16{}; p1 = f32x16{};
#pragma unroll
    for (int d0 = 0; d0 < 8; ++d0) { const int cb = (d0 * 16 + hi * 8) * 2;
        const bf16x8 b0 = *(const LAS bf16x8*)(Ks + KSWZ(r32, cb));
        const bf16x8 b1 = *(const LAS bf16x8*)(Ks + KSWZ(32 + r32, cb));
        p0 = __builtin_amdgcn_mfma_f32_32x32x16_bf16(b0, qr[d0], p0, 0, 0, 0);
        p1 = __builtin_amdgcn_mfma_f32_32x32x16_bf16(b1, qr[d0], p1, 0, 0, 0); }
}
__device__ __forceinline__ int v_st(int k, int c) { const int kk = (k & ~0xC) | ((k & 4) << 1) | ((k & 8) >> 1); return ((kk >> 3) * 4 + (c >> 5)) * 512 + ((kk & 7) * 32 + (c & 31)) * 2; }
__device__ __forceinline__ int v_rd_base(int lane) { return ((lane & 3) << 3) | (((lane >> 2) & 3) << 6) | (((lane >> 4) & 1) << 5) | (((lane >> 5) & 1) << 8); }
constexpr int v_rd_off(int d0, int ks, int half) { return d0 * 512 + ks * 4096 + half * 2048; }
template <int OFF> __device__ __forceinline__ s16x4 tr_read(int vb) {
    s16x4 r; asm volatile("ds_read_b64_tr_b16 %0, %1 offset:%2" : "=&v"(r) : "v"(vb), "i"(OFF) : "memory"); return r;
}
template <int D0> __device__ __forceinline__ void pv_one(f32x16& od, int vb, bf16x8 pa0, bf16x8 pa1, bf16x8 pa2, bf16x8 pa3) {
    const s16x4 l0 = tr_read<v_rd_off(D0, 0, 0)>(vb), h0 = tr_read<v_rd_off(D0, 0, 1)>(vb), l1 = tr_read<v_rd_off(D0, 1, 0)>(vb), h1 = tr_read<v_rd_off(D0, 1, 1)>(vb);
    const s16x4 l2 = tr_read<v_rd_off(D0, 2, 0)>(vb), h2 = tr_read<v_rd_off(D0, 2, 1)>(vb), l3 = tr_read<v_rd_off(D0, 3, 0)>(vb), h3 = tr_read<v_rd_off(D0, 3, 1)>(vb);
    asm volatile("s_waitcnt lgkmcnt(0)" ::: "memory"); SBAR();
#define PKV(L, H) (bf16x8){L[0], L[1], L[2], L[3], H[0], H[1], H[2], H[3]}
    od = __builtin_amdgcn_mfma_f32_32x32x16_bf16(pa0, PKV(l0, h0), od, 0, 0, 0);
    od = __builtin_amdgcn_mfma_f32_32x32x16_bf16(pa1, PKV(l1, h1), od, 0, 0, 0);
    od = __builtin_amdgcn_mfma_f32_32x32x16_bf16(pa2, PKV(l2, h2), od, 0, 0, 0);
    od = __builtin_amdgcn_mfma_f32_32x32x16_bf16(pa3, PKV(l3, h3), od, 0, 0, 0);
#undef PKV
}
__device__ __forceinline__ void pv_d0(f32x16* o, int vb, bf16x8 pa0, bf16x8 pa1, bf16x8 pa2, bf16x8 pa3) {
    pv_one<0>(o[0], vb, pa0, pa1, pa2, pa3); pv_one<1>(o[1], vb, pa0, pa1, pa2, pa3); pv_one<2>(o[2], vb, pa0, pa1, pa2, pa3); pv_one<3>(o[3], vb, pa0, pa1, pa2, pa3);
}
__device__ __forceinline__ void sm_a(f32x16& p0, f32x16& p1, float dq, float slope2) {
#pragma unroll
    for (int r = 0; r < 16; ++r) { const float c = (float)((r & 3) + 8 * (r >> 2)); p0[r] = __builtin_amdgcn_exp2f(p0[r] - slope2 * fabsf(dq - c)); }
#pragma unroll
    for (int r = 0; r < 16; ++r) { const float c = (float)((r & 3) + 8 * (r >> 2) + 32); p1[r] = p1[r] - slope2 * fabsf(dq - c); }
}
__device__ __forceinline__ void sm_b(f32x16& p0, f32x16& p1, float& l_reg, bf16x8& pa0, bf16x8& pa1, bf16x8& pa2, bf16x8& pa3) {
#pragma unroll
    for (int r = 0; r < 16; ++r) p1[r] = __builtin_amdgcn_exp2f(p1[r]);
    float ps = 0;
#pragma unroll
    for (int r = 0; r < 16; ++r) ps += p0[r];
#pragma unroll
    for (int r = 0; r < 16; ++r) ps += p1[r];
    l_reg += swap_add(ps);
    PK4(p0, 0, pa0); PK4(p0, 8, pa1); PK4(p1, 0, pa2); PK4(p1, 8, pa3);
}
__device__ __forceinline__ void attn_body(const bf16_t* __restrict__ Qb, const bf16_t* __restrict__ Kh, const bf16_t* __restrict__ Vh, float* __restrict__ Ob, int q0, float slope2, LAS unsigned char* lds) {
    const int tid = threadIdx.x, wid = tid >> 6, lane = tid & 63, r32 = lane & 31, hi = lane >> 5;
    LAS unsigned char* V_lds = lds; LAS unsigned char* K_lds = lds + 2 * SHM_V;
    LAS float* li_l = (LAS float*)(lds + 2 * SHM_V + 2 * SHM_K) + wid * 64;
    float l_reg = 0; f32x16 o[4] = {}; bf16x8 qr[8];
    const bf16_t* Qw = Qb + (size_t)(wid * QBLK + r32) * LDP + hi * 8;
#pragma unroll
    for (int d0 = 0; d0 < 8; ++d0) qr[d0] = *(const bf16x8*)(Qw + d0 * 16);
    const int sr = tid >> 4, sc = (tid & 15) * 8, vst0 = v_st(sr, sc), vst1 = v_st(32 + sr, sc);
    const int vb0 = (int)(uintptr_t)V_lds + v_rd_base(lane);
    const float dqbase = (float)(q0 + wid * QBLK + r32 - 4 * hi);
    struct { bf16x8 vs0, vs1, ks0, ks1; } sr_[1];
    const unsigned so0 = (unsigned)(sr * LDP + sc) * 2u, so1 = (unsigned)((32 + sr) * LDP + sc) * 2u;
#define SLOAD(i, k0) do { const char* vb_ = (const char*)Vh + (size_t)(k0) * (LDP * 2); const char* kb_ = (const char*)Kh + (size_t)(k0) * (LDP * 2); \
    sr_[i].vs0 = *(const bf16x8*)(vb_ + so0); sr_[i].vs1 = *(const bf16x8*)(vb_ + so1); \
    sr_[i].ks0 = *(const bf16x8*)(kb_ + so0); sr_[i].ks1 = *(const bf16x8*)(kb_ + so1); } while (0)
#define SWRITE(b, i) do { *(LAS bf16x8*)(V_lds + (b) * SHM_V + vst0) = sr_[i].vs0;          \
    *(LAS bf16x8*)(V_lds + (b) * SHM_V + vst1) = sr_[i].vs1; const int kc = sc * 2;               \
    *(LAS bf16x8*)(K_lds + (b) * SHM_K + KSWZ(sr, kc)) = sr_[i].ks0;                       \
    *(LAS bf16x8*)(K_lds + (b) * SHM_K + KSWZ(32 + sr, kc)) = sr_[i].ks1; } while (0)
#define SWAIT() asm volatile("s_waitcnt vmcnt(0)" ::: "memory")
    f32x16 pA0, pA1, pB0, pB1; bf16x8 pa0, pa1, pa2, pa3; constexpr int NT = SEQ / KVBLK;
    SLOAD(0, 0); SWAIT(); SWRITE(0, 0); __syncthreads();
    qkt(pA0, pA1, K_lds, qr, r32, hi); sm_a(pA0, pA1, dqbase, slope2);
    SLOAD(0, KVBLK);
    SWAIT(); SWRITE(1, 0); __syncthreads();
    for (int j = 1; j + 1 < NT; j += 2) {
        SBAR(); qkt(pB0, pB1, K_lds + SHM_K, qr, r32, hi);
        sm_b(pA0, pA1, l_reg, pa0, pa1, pa2, pa3); SBAR();
        SLOAD(0, (j + 1) * KVBLK); SBAR();
        pv_d0(o, vb0, pa0, pa1, pa2, pa3); sm_a(pB0, pB1, dqbase - (float)(j * KVBLK), slope2);
        __syncthreads(); SWAIT(); SWRITE(0, 0);
        __syncthreads();
        SBAR(); qkt(pA0, pA1, K_lds, qr, r32, hi);
        sm_b(pB0, pB1, l_reg, pa0, pa1, pa2, pa3); SBAR();
        SLOAD(0, (j + 2) * KVBLK); SBAR();
        pv_d0(o, vb0 + SHM_V, pa0, pa1, pa2, pa3); sm_a(pA0, pA1, dqbase - (float)((j + 1) * KVBLK), slope2);
        __syncthreads(); SWAIT(); SWRITE(1, 0);
        __syncthreads();
    }
    SBAR(); qkt(pB0, pB1, K_lds + SHM_K, qr, r32, hi);
    sm_b(pA0, pA1, l_reg, pa0, pa1, pa2, pa3); SBAR();
    pv_d0(o, vb0, pa0, pa1, pa2, pa3); sm_a(pB0, pB1, dqbase - (float)((NT - 1) * KVBLK), slope2);
    __syncthreads();
    sm_b(pB0, pB1, l_reg, pa0, pa1, pa2, pa3); SBAR();
    pv_d0(o, vb0 + SHM_V, pa0, pa1, pa2, pa3);
    if (hi == 0) li_l[r32] = l_reg; asm volatile("s_waitcnt lgkmcnt(0)" ::: "memory");
    float rli[16];
#pragma unroll
    for (int r = 0; r < 16; ++r) rli[r] = __builtin_amdgcn_rcpf(li_l[crow(r, hi)]);
    float* Ow = Ob + (size_t)(wid * QBLK) * DM;
#pragma unroll
    for (int r = 0; r < 16; ++r) { const int orow = crow(r, hi);
#pragma unroll
        for (int d0 = 0; d0 < 4; ++d0) Ow[(size_t)orow * DM + d0 * 32 + r32] = o[d0][r] * rli[r]; }
    __syncthreads();
#undef SLOAD
#undef SWRITE
#undef SWAIT
}
}

namespace da2 {
constexpr int BUFB = 65536, KB = 16384;
__device__ __forceinline__ int v_rd_base(int lane) { return ((lane & 3) << 3) | (((lane >> 2) & 3) << 6) | (((lane >> 4) & 1) << 5) | (((lane >> 5) & 1) << 8); }
template <int OFF> __device__ __forceinline__ s16x4 tr_read(int vb) {
    s16x4 r; asm volatile("ds_read_b64_tr_b16 %0, %1 offset:%2" : "=&v"(r) : "v"(vb), "i"(OFF) : "memory"); return r;
}
template <int NCB, int CB> __device__ __forceinline__ void pv_one(f32x16& od, int vb, bf16x8 pa0, bf16x8 pa1, bf16x8 pa2, bf16x8 pa3) {
    constexpr int S = NCB * 512;
    const s16x4 l0 = tr_read<CB * 512 + 0 * S>(vb), h0 = tr_read<CB * 512 + 1 * S>(vb), l1 = tr_read<CB * 512 + 2 * S>(vb), h1 = tr_read<CB * 512 + 3 * S>(vb);
    const s16x4 l2 = tr_read<CB * 512 + 4 * S>(vb), h2 = tr_read<CB * 512 + 5 * S>(vb), l3 = tr_read<CB * 512 + 6 * S>(vb), h3 = tr_read<CB * 512 + 7 * S>(vb);
    asm volatile("s_waitcnt lgkmcnt(0)" ::: "memory"); SBAR();
#define PKV(L, H) (bf16x8){L[0], L[1], L[2], L[3], H[0], H[1], H[2], H[3]}
    od = __builtin_amdgcn_mfma_f32_32x32x16_bf16(pa0, PKV(l0, h0), od, 0, 0, 0);
    od = __builtin_amdgcn_mfma_f32_32x32x16_bf16(pa1, PKV(l1, h1), od, 0, 0, 0);
    od = __builtin_amdgcn_mfma_f32_32x32x16_bf16(pa2, PKV(l2, h2), od, 0, 0, 0);
    od = __builtin_amdgcn_mfma_f32_32x32x16_bf16(pa3, PKV(l3, h3), od, 0, 0, 0);
#undef PKV
}
__device__ __forceinline__ void qkt(f32x16& p0, f32x16& p1, const LAS unsigned char* Ks, const bf16x8* qr, int r32, int hi) {
    p0 = f32x16{}; p1 = f32x16{};
#pragma unroll
    for (int d0 = 0; d0 < 8; ++d0) { const int cb = (d0 * 16 + hi * 8) * 2;
        const bf16x8 b0 = *(const LAS bf16x8*)(Ks + KSWZ(r32, cb));
        const bf16x8 b1 = *(const LAS bf16x8*)(Ks + KSWZ(32 + r32, cb));
        p0 = __builtin_amdgcn_mfma_f32_32x32x16_bf16(b0, qr[d0], p0, 0, 0, 0);
        p1 = __builtin_amdgcn_mfma_f32_32x32x16_bf16(b1, qr[d0], p1, 0, 0, 0); }
}
__device__ __forceinline__ int unswap23(int kk) { return (kk & ~0xC) | ((kk & 4) << 1) | ((kk & 8) >> 1); }

__device__ __forceinline__ void epilogue(const Params& P, LAS unsigned char* lds, f32x16 (&o)[8], float l_reg, int tz, int it) {
    const int wid = __builtin_amdgcn_readfirstlane(tz >> 6), lane = tz & 63, r32 = lane & 31, hi = lane >> 5;
    float lam;
    { float a = P.lam_q1[lane] * P.lam_k1[lane] + P.lam_q1[lane + 64] * P.lam_k1[lane + 64];
      float c = P.lam_q2[lane] * P.lam_k2[lane] + P.lam_q2[lane + 64] * P.lam_k2[lane + 64];
      a = wave_sum(a); c = wave_sum(c); lam = expf(a) - expf(c) + 0.2f; }
    const int br = wid >> 2, w4 = wid & 3;
    const int b = it >> 7, h = (it >> 5) & 3, qt = it & 31;
    const size_t row0 = (size_t)b * SEQ; const int q0 = qt * 128;
    LAS float* li_l = (LAS float*)(lds + SCR_OFF) + wid * 32;
    if (hi == 0) li_l[r32] = l_reg;
    asm volatile("s_waitcnt lgkmcnt(0)" ::: "memory");
    __syncthreads();
    LAS float* X = (LAS float*)lds + w4 * 8192;
    if (br == 1) {
#pragma unroll
        for (int r = 0; r < 16; ++r) { const float rl = __builtin_amdgcn_rcpf(li_l[crow(r, hi)]);
#pragma unroll
            for (int d = 0; d < 8; ++d) X[(r * 8 + d) * 64 + lane] = o[d][r] * rl; }
    }
    __syncthreads();
    if (br == 0) {
        LAS unsigned char* T = (LAS unsigned char*)X;
        float g[8];
#pragma unroll
        for (int d = 0; d < 8; ++d) g[d] = P.subln_b[d * 32 + r32];
#pragma unroll
        for (int r = 0; r < 16; ++r) {
            const float rl = __builtin_amdgcn_rcpf(li_l[crow(r, hi)]);
            float v[8], sq = 0.f;
#pragma unroll
            for (int d = 0; d < 8; ++d) { v[d] = o[d][r] * rl - lam * X[(r * 8 + d) * 64 + lane]; sq += v[d] * v[d]; }
#pragma unroll
            for (int sh = 16; sh >= 1; sh >>= 1) sq += __shfl_xor(sq, sh);
            const float rstd = rsqrtf(sq * (1.0f / 256.0f) + RMS_EPS) * 0.8f;
#pragma unroll
            for (int d = 0; d < 8; ++d) { const unsigned w = cvtpk(v[d] * rstd * g[d], 0.f); *(LAS bf16_t*)(T + (2 * r + hi) * 512 + (d * 32 + r32) * 2) = (bf16_t)(w & 0xffffu); }
        }
        asm volatile("s_waitcnt lgkmcnt(0)" ::: "memory");
        char* mixb = (char*)((bf16_t*)(P.ws + WS_MIX) + (row0 + q0 + w4 * 32) * DM + 1024 + h * 256);
        const unsigned loff = (unsigned)(hi * 4 * DM * 2 + r32 * 16);
#pragma unroll
        for (int i = 0; i < 16; ++i) {
            const u32x4 w = *(const LAS u32x4*)(T + (2 * i + hi) * 512 + r32 * 16);
            *(u32x4*)(mixb + (size_t)((i & 3) + 8 * (i >> 2)) * (DM * 2) + loff) = w;
        }
    }
    __syncthreads();
}
__device__ __forceinline__ void item(const Params& P, int it, LAS unsigned char* lds) {
    int tid = threadIdx.x; asm volatile("" : "+v"(tid));
    const int wid = __builtin_amdgcn_readfirstlane(tid >> 6), lane = tid & 63, r32 = lane & 31, hi = lane >> 5;
    const int br = wid >> 2, w4 = wid & 3;
    const int b = it >> 7, h = (it >> 5) & 3, qt = it & 31;
    const bf16_t* proj = (const bf16_t*)(P.ws + WS_PROJ);
    const size_t row0 = (size_t)b * SEQ; const int q0 = qt * 128;
    bf16x8 qr[8];
    { const bf16_t* Qw = proj + (row0 + q0 + w4 * 32 + r32) * INC + 3072 + br * 512 + h * 128 + hi * 8;
#pragma unroll
      for (int d0 = 0; d0 < 8; ++d0) qr[d0] = *(const bf16x8*)(Qw + d0 * 16); }
    const char* kbase = (const char*)(proj + row0 * INC + 4096 + h * 128);
    const char* vbase = (const char*)(proj + row0 * INC + 5120 + h * 256);
    const int krow = wid * 8 + (lane >> 4);
    const unsigned voffK0 = (unsigned)(krow * INC * 2 + (((lane & 15) ^ (lane >> 4)) << 4));
    const unsigned voffK1 = (unsigned)((krow + 4) * INC * 2 + (((lane & 15) ^ (4 + (lane >> 4))) << 4));
    const unsigned voffV = (unsigned)(unswap23(wid * 8 + ((lane & 31) >> 2)) * INC * 2 + (lane >> 5) * 64 + (lane & 3) * 16);
#define DA2_ISSUE(t, bufi) do { const char* kb_ = kbase + (size_t)(t) * (64 * INC * 2); const char* vb_ = vbase + (size_t)(t) * (64 * INC * 2); \
        LAS unsigned char* lb_ = lds + (bufi) * BUFB; \
        __builtin_amdgcn_global_load_lds((const unsigned*)(kb_ + voffK0), (LAS unsigned*)(lb_ + wid * 2048), 16, 0, 0); \
        __builtin_amdgcn_global_load_lds((const unsigned*)(kb_ + voffK1), (LAS unsigned*)(lb_ + wid * 2048 + 1024), 16, 0, 0); \
        __builtin_amdgcn_global_load_lds((const unsigned*)(kb_ + 1024 + voffK0), (LAS unsigned*)(lb_ + KB + wid * 2048), 16, 0, 0); \
        __builtin_amdgcn_global_load_lds((const unsigned*)(kb_ + 1024 + voffK1), (LAS unsigned*)(lb_ + KB + wid * 2048 + 1024), 16, 0, 0); \
        _Pragma("unroll") for (int i_ = 0; i_ < 4; ++i_) \
            __builtin_amdgcn_global_load_lds((const unsigned*)(vb_ + i_ * 128 + voffV), (LAS unsigned*)(lb_ + 2 * KB + wid * 4096 + i_ * 1024), 16, 0, 0); } while (0)
    const float slope2 = exp2f(-2.0f * (float)(h + 1)) * LOG2E;
    float dq = (float)(q0 + w4 * 32 + r32 - 4 * hi);
    f32x16 o[8];
#pragma unroll
    for (int d = 0; d < 8; ++d) o[d] = f32x16{};
    float l_reg = 0.f;
    const int vb0 = (int)(uintptr_t)(lds + 2 * KB) + v_rd_base(lane);
    DA2_ISSUE(0, 0);
#pragma unroll 1
    for (int j = 0; j < SEQ / 64; ++j) {
        asm volatile("s_waitcnt vmcnt(0)" ::: "memory");
        __builtin_amdgcn_s_barrier();
        asm volatile("" ::: "memory");
        if (j + 1 < SEQ / 64) DA2_ISSUE(j + 1, (j + 1) & 1);
        const LAS unsigned char* Kb = lds + (j & 1) * BUFB + br * KB;
        f32x16 p0, p1;
        qkt(p0, p1, Kb, qr, r32, hi);
        float ps = 0.f;
#pragma unroll
        for (int r = 0; r < 16; ++r) { const float c = (float)((r & 3) + 8 * (r >> 2)); p0[r] = __builtin_amdgcn_exp2f(p0[r] - slope2 * fabsf(dq - c)); ps += p0[r]; }
#pragma unroll
        for (int r = 0; r < 16; ++r) { const float c = (float)((r & 3) + 8 * (r >> 2) + 32); p1[r] = __builtin_amdgcn_exp2f(p1[r] - slope2 * fabsf(dq - c)); ps += p1[r]; }
        l_reg += swap_add(ps);
        bf16x8 pa0, pa1, pa2, pa3;
        PK4(p0, 0, pa0); PK4(p0, 8, pa1); PK4(p1, 0, pa2); PK4(p1, 8, pa3);
        const int vb = vb0 + (j & 1) * BUFB;
        pv_one<8, 0>(o[0], vb, pa0, pa1, pa2, pa3); pv_one<8, 1>(o[1], vb, pa0, pa1, pa2, pa3); pv_one<8, 2>(o[2], vb, pa0, pa1, pa2, pa3); pv_one<8, 3>(o[3], vb, pa0, pa1, pa2, pa3);
        pv_one<8, 4>(o[4], vb, pa0, pa1, pa2, pa3); pv_one<8, 5>(o[5], vb, pa0, pa1, pa2, pa3); pv_one<8, 6>(o[6], vb, pa0, pa1, pa2, pa3); pv_one<8, 7>(o[7], vb, pa0, pa1, pa2, pa3);
        dq -= 64.0f;
    }
#undef DA2_ISSUE
    int tz = threadIdx.x; asm volatile("" : "+v"(tz));
    epilogue(P, lds, o, l_reg, tz, it);
}
}

namespace da3 {
constexpr int BUFB = 65536, KB = 16384;
__device__ __forceinline__ void qk_softmax(const LAS unsigned char* Kb, const bf16x8* qr, int r32, int hi, float dq, float slope2, int rel  ,
                                           float& l_reg, bf16x8& pa0, bf16x8& pa1, bf16x8& pa2, bf16x8& pa3) {
    f32x16 p0, p1;
    if (rel != 0) {
        const float ss = rel < 0 ? slope2 : -slope2, A = -ss * dq;
#pragma unroll
        for (int r = 0; r < 16; ++r) { const float c = (float)((r & 3) + 8 * (r >> 2)); p0[r] = fmaf(ss, c, A); p1[r] = fmaf(ss, c + 32.0f, A); }
    } else {
#pragma unroll
        for (int r = 0; r < 16; ++r) { const float c = (float)((r & 3) + 8 * (r >> 2)); p0[r] = -slope2 * fabsf(dq - c); p1[r] = -slope2 * fabsf(dq - c - 32.0f); }
    }
#pragma unroll
    for (int d0 = 0; d0 < 8; ++d0) { const int cb = (d0 * 16 + hi * 8) * 2;
        const bf16x8 b0 = *(const LAS bf16x8*)(Kb + KSWZ(r32, cb));
        const bf16x8 b1 = *(const LAS bf16x8*)(Kb + KSWZ(32 + r32, cb));
        p0 = __builtin_amdgcn_mfma_f32_32x32x16_bf16(b0, qr[d0], p0, 0, 0, 0);
        p1 = __builtin_amdgcn_mfma_f32_32x32x16_bf16(b1, qr[d0], p1, 0, 0, 0); }
    f32x2 s2 = {0.f, 0.f};
#pragma unroll
    for (int r = 0; r < 16; r += 2) { p0[r] = __builtin_amdgcn_exp2f(p0[r]); p0[r + 1] = __builtin_amdgcn_exp2f(p0[r + 1]); s2 += (f32x2){p0[r], p0[r + 1]}; }
#pragma unroll
    for (int r = 0; r < 16; r += 2) { p1[r] = __builtin_amdgcn_exp2f(p1[r]); p1[r + 1] = __builtin_amdgcn_exp2f(p1[r + 1]); s2 += (f32x2){p1[r], p1[r + 1]}; }
    l_reg += swap_add(s2[0] + s2[1]);
    PK4(p0, 0, pa0); PK4(p0, 8, pa1); PK4(p1, 0, pa2); PK4(p1, 8, pa3);
}
struct VFrag { s16x4 l0, h0, l1, h1, l2, h2, l3, h3; };
template <int CB> __device__ __forceinline__ void vread(VFrag& f, int vb) {
    constexpr int S = 8 * 512;
    f.l0 = da2::tr_read<CB * 512 + 0 * S>(vb); f.h0 = da2::tr_read<CB * 512 + 1 * S>(vb); f.l1 = da2::tr_read<CB * 512 + 2 * S>(vb); f.h1 = da2::tr_read<CB * 512 + 3 * S>(vb);
    f.l2 = da2::tr_read<CB * 512 + 4 * S>(vb); f.h2 = da2::tr_read<CB * 512 + 5 * S>(vb); f.l3 = da2::tr_read<CB * 512 + 6 * S>(vb); f.h3 = da2::tr_read<CB * 512 + 7 * S>(vb);
}
__device__ __forceinline__ void vmma(f32x16& od, const VFrag& f, bf16x8 pa0, bf16x8 pa1, bf16x8 pa2, bf16x8 pa3) {
#define PKV(L, H) (bf16x8){L[0], L[1], L[2], L[3], H[0], H[1], H[2], H[3]}
    od = __builtin_amdgcn_mfma_f32_32x32x16_bf16(pa0, PKV(f.l0, f.h0), od, 0, 0, 0);
    od = __builtin_amdgcn_mfma_f32_32x32x16_bf16(pa1, PKV(f.l1, f.h1), od, 0, 0, 0);
    od = __builtin_amdgcn_mfma_f32_32x32x16_bf16(pa2, PKV(f.l2, f.h2), od, 0, 0, 0);
    od = __builtin_amdgcn_mfma_f32_32x32x16_bf16(pa3, PKV(f.l3, f.h3), od, 0, 0, 0);
#undef PKV
}
#define DA3_LW(n) do { asm volatile("s_waitcnt lgkmcnt(" #n ")" ::: "memory"); SBAR(); } while (0)
__device__ __forceinline__ void pv8(f32x16 (&o)[8], int vb, bf16x8 pa0, bf16x8 pa1, bf16x8 pa2, bf16x8 pa3) {
    VFrag fa, fb;
    vread<0>(fa, vb);
    vread<1>(fb, vb); DA3_LW(8); vmma(o[0], fa, pa0, pa1, pa2, pa3);
    vread<2>(fa, vb); DA3_LW(8); vmma(o[1], fb, pa0, pa1, pa2, pa3);
    vread<3>(fb, vb); DA3_LW(8); vmma(o[2], fa, pa0, pa1, pa2, pa3);
    vread<4>(fa, vb); DA3_LW(8); vmma(o[3], fb, pa0, pa1, pa2, pa3);
    vread<5>(fb, vb); DA3_LW(8); vmma(o[4], fa, pa0, pa1, pa2, pa3);
    vread<6>(fa, vb); DA3_LW(8); vmma(o[5], fb, pa0, pa1, pa2, pa3);
    vread<7>(fb, vb); DA3_LW(8); vmma(o[6], fa, pa0, pa1, pa2, pa3);
    DA3_LW(0); vmma(o[7], fb, pa0, pa1, pa2, pa3);
}
__device__ __forceinline__ void item(const Params& P, int it, LAS unsigned char* lds) {
    int tid = threadIdx.x; asm volatile("" : "+v"(tid));
    const int wid = __builtin_amdgcn_readfirstlane(tid >> 6), lane = tid & 63, r32 = lane & 31, hi = lane >> 5;
    const int br = wid >> 2, w4 = wid & 3;
    const int b = it >> 7, h = (it >> 5) & 3, qt = it & 31;
    const bf16_t* proj = (const bf16_t*)(P.ws + WS_PROJ);
    const size_t row0 = (size_t)b * SEQ; const int q0 = qt * 128;
    bf16x8 qr[8];
    { const bf16_t* Qw = proj + (row0 + q0 + w4 * 32 + r32) * INC + 3072 + br * 512 + h * 128 + hi * 8;
#pragma unroll
      for (int d0 = 0; d0 < 8; ++d0) qr[d0] = *(const bf16x8*)(Qw + d0 * 16); }
    const char* kbase = (const char*)(proj + row0 * INC + 4096 + br * 512 + h * 128);
    const char* vbase = (const char*)(proj + row0 * INC + 5120 + h * 256);
#define DA3_LANE() int lz_ = lane; asm volatile("" : "+v"(lz_)); const int krow_ = w4 * 16 + (lz_ >> 4)
#define DA3_ISSUE_K(t, bufi) do { DA3_LANE(); \
        const unsigned voffK0 = (unsigned)(krow_ * INC * 2 + (((lz_ & 15) ^ (lz_ >> 4)) << 4)); \
        const unsigned voffK1 = (unsigned)((krow_ + 4) * INC * 2 + (((lz_ & 15) ^ (4 + (lz_ >> 4))) << 4)); \
        const char* kb_ = kbase + (size_t)(t) * (64 * INC * 2); LAS unsigned char* lb_ = lds + (bufi) * BUFB + br * KB + w4 * 4096; \
        __builtin_amdgcn_global_load_lds((const unsigned*)(kb_ + voffK0), (LAS unsigned*)(lb_), 16, 0, 0); \
        __builtin_amdgcn_global_load_lds((const unsigned*)(kb_ + voffK1), (LAS unsigned*)(lb_ + 1024), 16, 0, 0); \
        __builtin_amdgcn_global_load_lds((const unsigned*)(kb_ + 8 * INC * 2 + voffK0), (LAS unsigned*)(lb_ + 2048), 16, 0, 0); \
        __builtin_amdgcn_global_load_lds((const unsigned*)(kb_ + 8 * INC * 2 + voffK1), (LAS unsigned*)(lb_ + 3072), 16, 0, 0); } while (0)
#define DA3_ISSUE_V(t, bufi) do { DA3_LANE(); (void)krow_; \
        const unsigned voffV = (unsigned)(da2::unswap23(wid * 8 + ((lz_ & 31) >> 2)) * INC * 2 + (lz_ >> 5) * 64 + (lz_ & 3) * 16); \
        const char* vb_ = vbase + (size_t)(t) * (64 * INC * 2); LAS unsigned char* lb_ = lds + (bufi) * BUFB + 2 * KB + wid * 4096; \
        _Pragma("unroll") for (int i_ = 0; i_ < 4; ++i_) \
            __builtin_amdgcn_global_load_lds((const unsigned*)(vb_ + i_ * 128 + voffV), (LAS unsigned*)(lb_ + i_ * 1024), 16, 0, 0); } while (0)
#define DA3_BAR() do { asm volatile("" ::: "memory"); __builtin_amdgcn_s_barrier(); asm volatile("" ::: "memory"); } while (0)
    const float slope2 = exp2f(-2.0f * (float)(h + 1)) * LOG2E;
    const int qlo = q0 + w4 * 32, jd = qlo >> 6;
    int jlo = 0, jhi = SEQ / 64 - 1;
    { float gq = fmaxf(fabsf(P.qn_b[lane]), fabsf(P.qn_b[lane + 64])), gk = fmaxf(fabsf(P.kn_b[lane]), fabsf(P.kn_b[lane + 64]));
#pragma unroll
      for (int o_ = 32; o_ >= 1; o_ >>= 1) { gq = fmaxf(gq, __shfl_xor(gq, o_)); gk = fmaxf(gk, __shfl_xor(gk, o_)); }
      const float smax = 128.0f * QSCALE * gq * gk, dmax = (160.0f + smax) / slope2;
      const int di = dmax < 8192.0f ? (int)dmax + 1 : 8192;
      const int klo = q0 - di, khi = q0 + 127 + di;
      jlo = __builtin_amdgcn_readfirstlane(klo <= 0 ? 0 : (klo >> 6)); jhi = __builtin_amdgcn_readfirstlane(khi >= SEQ - 1 ? SEQ / 64 - 1 : (khi >> 6)); }
    float dq = (float)(qlo + r32 - 4 * hi - 64 * jlo);
    f32x16 o[8];
#pragma unroll
    for (int d = 0; d < 8; ++d) o[d] = f32x16{};
    float l_reg = 0.f;
    const int vb0 = (int)(uintptr_t)(lds + 2 * KB) + da2::v_rd_base(lane);
    bf16x8 pa0, pa1, pa2, pa3;
    DA3_ISSUE_K(jlo, 0); DA3_ISSUE_V(jlo, 0);
    if (br == 0) {
        asm volatile("s_waitcnt vmcnt(4)" ::: "memory");
#pragma unroll 1
        for (int j = jlo; j <= jhi; ++j) {
            const int jn = (j + 1 <= jhi) ? j + 1 : jhi, bc = (j - jlo) & 1, bn = bc ^ 1;
            DA3_BAR();
            DA3_ISSUE_K(jn, bn);
            qk_softmax(lds + bc * BUFB, qr, r32, hi, dq, slope2, j - jd, l_reg, pa0, pa1, pa2, pa3);
            asm volatile("s_waitcnt vmcnt(4)" ::: "memory");
            DA3_BAR();
            DA3_ISSUE_V(jn, bn);
            pv8(o, vb0 + bc * BUFB, pa0, pa1, pa2, pa3);
            asm volatile("s_waitcnt vmcnt(4)" ::: "memory");
            dq -= 64.0f;
        }
        DA3_BAR();
    } else {
        DA3_BAR();
        asm volatile("s_waitcnt vmcnt(0)" ::: "memory");
#pragma unroll 1
        for (int j = jlo; j <= jhi; ++j) {
            const int jn = (j + 1 <= jhi) ? j + 1 : jhi, bc = (j - jlo) & 1, bn = bc ^ 1;
            DA3_BAR();
            DA3_ISSUE_K(jn, bn); DA3_ISSUE_V(jn, bn);
            qk_softmax(lds + bc * BUFB + KB, qr, r32, hi, dq, slope2, j - jd, l_reg, pa0, pa1, pa2, pa3);
            DA3_BAR();
            pv8(o, vb0 + bc * BUFB, pa0, pa1, pa2, pa3);
            asm volatile("s_waitcnt vmcnt(0)" ::: "memory");
            dq -= 64.0f;
        }
    }
#undef DA3_ISSUE_K
#undef DA3_LANE
#undef DA3_ISSUE_V
#undef DA3_BAR
    asm volatile("s_waitcnt vmcnt(0)" ::: "memory");
    int tz = threadIdx.x; asm volatile("" : "+v"(tz));
    da2::epilogue(P, lds, o, l_reg, tz, it);
}
}

namespace da5 {
constexpr int BUFB = 65536, KB = 16384;
typedef float f32x4v __attribute__((ext_vector_type(4)));
template <int OFF> __device__ __forceinline__ s16x4 trr(int a) { s16x4 r; asm volatile("ds_read_b64_tr_b16 %0, %1 offset:%2" : "=&v"(r) : "v"(a), "i"(OFF) : "memory"); return r; }
#define D5_LW(n) do { asm volatile("s_waitcnt lgkmcnt(" #n ")" ::: "memory"); SBAR(); } while (0)

__device__ __forceinline__ void qk_softmax(const LAS unsigned char* Kb, const bf16x8 (&qr)[4][2], int lane_, float dqb, float slope2, int rel, float (&l)[2], bf16x8 (&pa)[2][2]) {
    asm volatile("" : "+v"(lane_));
    const int l16 = lane_ & 15, g = lane_ >> 4;
    f32x4v S[4][2];
    if (rel != 0) {
        const float ss = rel < 0 ? slope2 : -slope2, A = -ss * dqb;
#pragma unroll
        for (int kg = 0; kg < 4; ++kg)
#pragma unroll
            for (int qg = 0; qg < 2; ++qg)
#pragma unroll
                for (int r = 0; r < 4; ++r) S[kg][qg][r] = fmaf(ss, (float)(16 * kg + r - 16 * qg), A);
    } else {
#pragma unroll
        for (int kg = 0; kg < 4; ++kg)
#pragma unroll
            for (int qg = 0; qg < 2; ++qg)
#pragma unroll
                for (int r = 0; r < 4; ++r) S[kg][qg][r] = -slope2 * fabsf(dqb - (float)(16 * kg + r - 16 * qg));
    }
    const int krow = l16 * 256, kx = (l16 & 7) << 4;
#pragma unroll
    for (int s = 0; s < 4; ++s) {
        const int ka = krow + ((64 * s + 16 * g) ^ kx);
        const bf16x8 k0 = *(const LAS bf16x8*)(Kb + ka), k1 = *(const LAS bf16x8*)(Kb + ka + 4096), k2 = *(const LAS bf16x8*)(Kb + ka + 8192), k3 = *(const LAS bf16x8*)(Kb + ka + 12288);
#pragma unroll
        for (int qg = 0; qg < 2; ++qg) {
            S[0][qg] = __builtin_amdgcn_mfma_f32_16x16x32_bf16(k0, qr[s][qg], S[0][qg], 0, 0, 0);
            S[1][qg] = __builtin_amdgcn_mfma_f32_16x16x32_bf16(k1, qr[s][qg], S[1][qg], 0, 0, 0);
            S[2][qg] = __builtin_amdgcn_mfma_f32_16x16x32_bf16(k2, qr[s][qg], S[2][qg], 0, 0, 0);
            S[3][qg] = __builtin_amdgcn_mfma_f32_16x16x32_bf16(k3, qr[s][qg], S[3][qg], 0, 0, 0);
        }
    }
#pragma unroll
    for (int qg = 0; qg < 2; ++qg) {
        f32x2 s2 = {0.f, 0.f};
#pragma unroll
        for (int kg = 0; kg < 4; ++kg) {
#pragma unroll
            for (int r = 0; r < 4; ++r) S[kg][qg][r] = __builtin_amdgcn_exp2f(S[kg][qg][r]);
            s2 += (f32x2){S[kg][qg][0], S[kg][qg][1]}; s2 += (f32x2){S[kg][qg][2], S[kg][qg][3]};
        }
        float ps = s2[0] + s2[1];
        ps += __shfl_xor(ps, 16); ps += __shfl_xor(ps, 32);
        l[qg] += ps;
#pragma unroll
        for (int ks = 0; ks < 2; ++ks) {
            u32x4 w; w.x = cvtpk(S[2 * ks][qg][0], S[2 * ks][qg][1]); w.y = cvtpk(S[2 * ks][qg][2], S[2 * ks][qg][3]);
            w.z = cvtpk(S[2 * ks + 1][qg][0], S[2 * ks + 1][qg][1]); w.w = cvtpk(S[2 * ks + 1][qg][2], S[2 * ks + 1][qg][3]);
            pa[qg][ks] = *reinterpret_cast<bf16x8*>(&w);
        }
    }
}
struct VF { s16x4 a0, a1, b0, b1; };
template <int HI> __device__ __forceinline__ void vread(VF& f, int a) {
    f.a0 = trr<HI * 256 + 0>(a); f.a1 = trr<HI * 256 + 8192>(a); f.b0 = trr<HI * 256 + 16384>(a); f.b1 = trr<HI * 256 + 24576>(a);
}
__device__ __forceinline__ void vmma(f32x4v& o0, f32x4v& o1, const VF& f, const bf16x8 (&pa)[2][2]) {
#define PKV(L, H) (bf16x8){L[0], L[1], L[2], L[3], H[0], H[1], H[2], H[3]}
    const bf16x8 v0 = PKV(f.a0, f.a1), v1 = PKV(f.b0, f.b1);
    o0 = __builtin_amdgcn_mfma_f32_16x16x32_bf16(pa[0][0], v0, o0, 0, 0, 0);
    o1 = __builtin_amdgcn_mfma_f32_16x16x32_bf16(pa[1][0], v0, o1, 0, 0, 0);
    o0 = __builtin_amdgcn_mfma_f32_16x16x32_bf16(pa[0][1], v1, o0, 0, 0, 0);
    o1 = __builtin_amdgcn_mfma_f32_16x16x32_bf16(pa[1][1], v1, o1, 0, 0, 0);
#undef PKV
}
__device__ __forceinline__ void pv16(f32x4v (&o)[2][16], int vbuf, int lane_, const bf16x8 (&pa)[2][2]) {
    asm volatile("" : "+v"(lane_));
    const int l16 = lane_ & 15, g = lane_ >> 4, q4 = l16 >> 2, p = l16 & 3;
    const int lb = (4 * g + q4) * 512 + ((4 * (g & 1) + q4) << 5) + 8 * p;
    VF fa, fb;
#define VA(vt) (vbuf + (lb ^ (((vt) & 7) << 5)))
    vread<0>(fa, VA(0));
    vread<0>(fb, VA(1)); D5_LW(4); vmma(o[0][0], o[1][0], fa, pa);
    vread<0>(fa, VA(2)); D5_LW(4); vmma(o[0][1], o[1][1], fb, pa);
    vread<0>(fb, VA(3)); D5_LW(4); vmma(o[0][2], o[1][2], fa, pa);
    vread<0>(fa, VA(4)); D5_LW(4); vmma(o[0][3], o[1][3], fb, pa);
    vread<0>(fb, VA(5)); D5_LW(4); vmma(o[0][4], o[1][4], fa, pa);
    vread<0>(fa, VA(6)); D5_LW(4); vmma(o[0][5], o[1][5], fb, pa);
    vread<0>(fb, VA(7)); D5_LW(4); vmma(o[0][6], o[1][6], fa, pa);
    vread<1>(fa, VA(8)); D5_LW(4); vmma(o[0][7], o[1][7], fb, pa);
    vread<1>(fb, VA(9)); D5_LW(4); vmma(o[0][8], o[1][8], fa, pa);
    vread<1>(fa, VA(10)); D5_LW(4); vmma(o[0][9], o[1][9], fb, pa);
    vread<1>(fb, VA(11)); D5_LW(4); vmma(o[0][10], o[1][10], fa, pa);
    vread<1>(fa, VA(12)); D5_LW(4); vmma(o[0][11], o[1][11], fb, pa);
    vread<1>(fb, VA(13)); D5_LW(4); vmma(o[0][12], o[1][12], fa, pa);
    vread<1>(fa, VA(14)); D5_LW(4); vmma(o[0][13], o[1][13], fb, pa);
    vread<1>(fb, VA(15)); D5_LW(4); vmma(o[0][14], o[1][14], fa, pa);
    D5_LW(0); vmma(o[0][15], o[1][15], fb, pa);
#undef VA
}
__device__ __forceinline__ void epilogue(const Params& P, LAS unsigned char* lds, f32x4v (&o)[2][16], const float (&l)[2], int tz, int it) {
    const int wid = __builtin_amdgcn_readfirstlane(tz >> 6), lane = tz & 63, l16 = lane & 15, g = lane >> 4;
    float lam;
    { float a = P.lam_q1[lane] * P.lam_k1[lane] + P.lam_q1[lane + 64] * P.lam_k1[lane + 64];
      float c = P.lam_q2[lane] * P.lam_k2[lane] + P.lam_q2[lane + 64] * P.lam_k2[lane + 64];
      a = wave_sum(a); c = wave_sum(c); lam = expf(a) - expf(c) + 0.2f; }
    const int br = wid >> 2, w4 = wid & 3;
    const int b = it >> 7, h = (it >> 5) & 3, qt = it & 31;
    const size_t row0 = (size_t)b * SEQ; const int q0 = qt * 128;
    LAS float* li_l = (LAS float*)(lds + SCR_OFF) + wid * 32;
    if (g == 0) { li_l[l16] = l[0]; li_l[16 + l16] = l[1]; }
    asm volatile("s_waitcnt lgkmcnt(0)" ::: "memory");
    __syncthreads();
    LAS float* X = (LAS float*)lds + w4 * 8192;
    if (br == 1) {
#pragma unroll
        for (int qg = 0; qg < 2; ++qg)
#pragma unroll
            for (int r = 0; r < 4; ++r) { const float rl = __builtin_amdgcn_rcpf(li_l[16 * qg + 4 * g + r]);
#pragma unroll
                for (int vt = 0; vt < 16; ++vt) X[((qg * 4 + r) * 16 + vt) * 64 + lane] = o[qg][vt][r] * rl; }
    }
    __syncthreads();
    if (br == 0) {
        LAS unsigned char* T = (LAS unsigned char*)X;
        float gw[16];
#pragma unroll
        for (int vt = 0; vt < 16; ++vt) gw[vt] = P.subln_b[16 * vt + l16];
#pragma unroll
        for (int qg = 0; qg < 2; ++qg)
#pragma unroll
            for (int r = 0; r < 4; ++r) {
                const int u = qg * 4 + r;
                const float rl = __builtin_amdgcn_rcpf(li_l[16 * qg + 4 * g + r]);
                float v[16], sq = 0.f;
#pragma unroll
                for (int vt = 0; vt < 16; ++vt) { v[vt] = o[qg][vt][r] * rl - lam * X[(u * 16 + vt) * 64 + lane]; sq += v[vt] * v[vt]; }
                sq += __shfl_xor(sq, 1); sq += __shfl_xor(sq, 2); sq += __shfl_xor(sq, 4); sq += __shfl_xor(sq, 8);
                const float rstd = rsqrtf(sq * (1.0f / 256.0f) + RMS_EPS) * 0.8f;
#pragma unroll
                for (int vt = 0; vt < 16; ++vt) { const unsigned w = cvtpk(v[vt] * rstd * gw[vt], 0.f); *(LAS bf16_t*)(T + (4 * u + g) * 512 + (16 * vt + l16) * 2) = (bf16_t)(w & 0xffffu); }
            }
        asm volatile("s_waitcnt lgkmcnt(0)" ::: "memory");
        char* mixb = (char*)((bf16_t*)(P.ws + WS_MIX) + (row0 + q0 + w4 * 32) * DM + 1024 + h * 256);
#pragma unroll
        for (int i = 0; i < 16; ++i) {
            const int ti = 2 * i + (lane >> 5), u = ti >> 2, gg = ti & 3, q = 16 * (u >> 2) + 4 * gg + (u & 3);
            const u32x4 w = *(const LAS u32x4*)(T + ti * 512 + (lane & 31) * 16);
            *(u32x4*)(mixb + (size_t)q * (DM * 2) + (lane & 31) * 16) = w;
        }
    }
    __syncthreads();
}
__device__ __forceinline__ void item(const Params& P, int it, LAS unsigned char* lds) {
    int tid = threadIdx.x; asm volatile("" : "+v"(tid));
    const int wid = __builtin_amdgcn_readfirstlane(tid >> 6), lane = tid & 63, l16 = lane & 15, g = lane >> 4;
    const int br = wid >> 2, w4 = wid & 3;
    const int b = it >> 7, h = (it >> 5) & 3, qt = it & 31;
    const bf16_t* proj = (const bf16_t*)(P.ws + WS_PROJ);
    const size_t row0 = (size_t)b * SEQ; const int q0 = qt * 128;
    bf16x8 qr[4][2];
    { const bf16_t* Qw = proj + (row0 + q0 + w4 * 32 + l16) * INC + 3072 + br * 512 + h * 128 + 8 * g;
#pragma unroll
      for (int s = 0; s < 4; ++s)
#pragma unroll
          for (int qg = 0; qg < 2; ++qg) qr[s][qg] = *(const bf16x8*)(Qw + (size_t)(16 * qg) * INC + 32 * s); }
    const char* kbase = (const char*)(proj + row0 * INC + 4096 + br * 512 + h * 128);
    const char* vbase = (const char*)(proj + row0 * INC + 5120 + h * 256);
#define D5_LANE() int lz_ = lane; asm volatile("" : "+v"(lz_))
#define D5_ISSUE_K(t, bufi) do { D5_LANE(); const int krow_ = w4 * 16 + (lz_ >> 4); \
        const unsigned voffK0 = (unsigned)(krow_ * INC * 2 + (((lz_ & 15) ^ (lz_ >> 4)) << 4)); \
        const unsigned voffK1 = (unsigned)((krow_ + 4) * INC * 2 + (((lz_ & 15) ^ (4 + (lz_ >> 4))) << 4)); \
        const char* kb_ = kbase + (size_t)(t) * (64 * INC * 2); LAS unsigned char* lb_ = lds + (bufi) * BUFB + br * KB + w4 * 4096; \
        __builtin_amdgcn_global_load_lds((const unsigned*)(kb_ + voffK0), (LAS unsigned*)(lb_), 16, 0, 0); \
        __builtin_amdgcn_global_load_lds((const unsigned*)(kb_ + voffK1), (LAS unsigned*)(lb_ + 1024), 16, 0, 0); \
        __builtin_amdgcn_global_load_lds((const unsigned*)(kb_ + 8 * INC * 2 + voffK0), (LAS unsigned*)(lb_ + 2048), 16, 0, 0); \
        __builtin_amdgcn_global_load_lds((const unsigned*)(kb_ + 8 * INC * 2 + voffK1), (LAS unsigned*)(lb_ + 3072), 16, 0, 0); } while (0)
#define D5_ISSUE_V(t, bufi) do { D5_LANE(); const char* vb_ = vbase + (size_t)(t) * (64 * INC * 2) + (size_t)(wid * 8) * (INC * 2); LAS unsigned char* lb_ = lds + (bufi) * BUFB + 2 * KB + wid * 4096; \
        _Pragma("unroll") for (int i_ = 0; i_ < 4; ++i_) { const int rr_ = 2 * i_ + (lz_ >> 5); \
            const unsigned vo_ = (unsigned)(rr_ * INC * 2 + (((lz_ & 31) ^ (rr_ << 1)) << 4)); \
            __builtin_amdgcn_global_load_lds((const unsigned*)(vb_ + vo_), (LAS unsigned*)(lb_ + i_ * 1024), 16, 0, 0); } } while (0)
#define D5_BAR() do { asm volatile("" ::: "memory"); __builtin_amdgcn_s_barrier(); asm volatile("" ::: "memory"); } while (0)
    const float slope2 = __int_as_float(__builtin_amdgcn_readfirstlane(__float_as_int(exp2f(-2.0f * (float)(h + 1)) * LOG2E)));
    const int qlo = q0 + w4 * 32, jd = qlo >> 6;
    int jlo = 0, jhi = SEQ / 64 - 1;
    { float gq = fmaxf(fabsf(P.qn_b[lane]), fabsf(P.qn_b[lane + 64])), gk = fmaxf(fabsf(P.kn_b[lane]), fabsf(P.kn_b[lane + 64]));
#pragma unroll
      for (int o_ = 32; o_ >= 1; o_ >>= 1) { gq = fmaxf(gq, __shfl_xor(gq, o_)); gk = fmaxf(gk, __shfl_xor(gk, o_)); }
      const float smax = 128.0f * QSCALE * gq * gk, dmax = (160.0f + smax) / slope2;
      const int di = dmax < 8192.0f ? (int)dmax + 1 : 8192;
      const int klo = q0 - di, khi = q0 + 127 + di;
      jlo = __builtin_amdgcn_readfirstlane(klo <= 0 ? 0 : (klo >> 6)); jhi = __builtin_amdgcn_readfirstlane(khi >= SEQ - 1 ? SEQ / 64 - 1 : (khi >> 6)); }
    float dqb = (float)(qlo + l16 - 4 * g - 64 * jlo);
    f32x4v o[2][16];
#pragma unroll
    for (int qg = 0; qg < 2; ++qg)
#pragma unroll
        for (int vt = 0; vt < 16; ++vt) o[qg][vt] = (f32x4v){0.f, 0.f, 0.f, 0.f};
    float l[2] = {0.f, 0.f};
    const int vbuf0 = (int)(uintptr_t)(lds + 2 * KB);
    bf16x8 pa[2][2];
    D5_ISSUE_K(jlo, 0); D5_ISSUE_V(jlo, 0);
    if (br == 0) {
        asm volatile("s_waitcnt vmcnt(4)" ::: "memory");
#pragma unroll 1
        for (int j = jlo; j <= jhi; ++j) {
            const int jn = (j + 1 <= jhi) ? j + 1 : jhi, bc = (j - jlo) & 1, bn = bc ^ 1;
            D5_BAR();
            D5_ISSUE_K(jn, bn);
            qk_softmax(lds + bc * BUFB, qr, lane, dqb, slope2, j - jd, l, pa);
            asm volatile("s_waitcnt vmcnt(4)" ::: "memory");
            D5_BAR();
            D5_ISSUE_V(jn, bn);
            pv16(o, vbuf0 + bc * BUFB, lane, pa);
            asm volatile("s_waitcnt vmcnt(4)" ::: "memory");
            dqb -= 64.0f;
        }
        D5_BAR();
    } else {
        D5_BAR();
        asm volatile("s_waitcnt vmcnt(0)" ::: "memory");
#pragma unroll 1
        for (int j = jlo; j <= jhi; ++j) {
            const int jn = (j + 1 <= jhi) ? j + 1 : jhi, bc = (j - jlo) & 1, bn = bc ^ 1;
            D5_BAR();
            D5_ISSUE_K(jn, bn); D5_ISSUE_V(jn, bn);
            qk_softmax(lds + bc * BUFB + KB, qr, lane, dqb, slope2, j - jd, l, pa);
            D5_BAR();
            pv16(o, vbuf0 + bc * BUFB, lane, pa);
            asm volatile("s_waitcnt vmcnt(0)" ::: "memory");
            dqb -= 64.0f;
        }
    }
#undef D5_ISSUE_K
#undef D5_ISSUE_V
#undef D5_BAR
#undef D5_LANE
    asm volatile("s_waitcnt vmcnt(0)" ::: "memory");
    int tz = threadIdx.x; asm volatile("" : "+v"(tz));
    epilogue(P, lds, o, l, tz, it);
}
#undef D5_LW
}

namespace na2 {
__device__ __forceinline__ void item(const Params& P, int it, LAS unsigned char* lds) {
    int tid = threadIdx.x; asm volatile("" : "+v"(tid));
    const int wid = __builtin_amdgcn_readfirstlane(tid >> 6), lane = tid & 63, r32 = lane & 31, hi = lane >> 5;
    const int b = it >> 7, h = (it >> 4) & 7, r0 = (it & 15) * 4;
    const int r = r0 + (wid >> 1), cq0 = (wid & 1) * 32;
    const bf16_t* proj = (const bf16_t*)(P.ws + WS_PROJ);
    LAS float* tab = (LAS float*)(lds + SCR_OFF);
    LAS float* li_l = (LAS float*)(lds + SCR_OFF + 2048) + wid * 32;
    for (int i = tid; i < 15 * 31; i += NTHR) tab[(i / 31) * 32 + (i % 31)] = P.rpb_a[h * 465 + i] * LOG2E;
    bf16x8 qr[8];
    { const bf16_t* Qw = proj + ((size_t)b * SEQ + r * 64 + cq0 + r32) * INC + h * 128 + hi * 8;
#pragma unroll
      for (int d0 = 0; d0 < 8; ++d0) qr[d0] = *(const bf16x8*)(Qw + d0 * 16); }
    int kr_lo = r0 - 4; kr_lo = kr_lo < 0 ? 0 : (kr_lo > 56 ? 56 : kr_lo);
    int kr_hi = r0 - 1; kr_hi = (kr_hi < 0 ? 0 : (kr_hi > 56 ? 56 : kr_hi)) + 7;
    int rs = r - 4; rs = rs < 0 ? 0 : (rs > 56 ? 56 : rs);
    const int cq = cq0 + r32; int cs = cq - 8; cs = cs < 0 ? 0 : (cs > 48 ? 48 : cs);
    const char* kbase = (const char*)(proj + (size_t)b * SEQ * INC + 1024 + h * 128);
    const char* vbase = (const char*)(proj + (size_t)b * SEQ * INC + 2048 + h * 128);
    const int krow = wid * 8 + (lane >> 4);
    const unsigned voffK0 = (unsigned)(krow * INC * 2 + (((lane & 15) ^ (lane >> 4)) << 4));
    const unsigned voffK1 = (unsigned)((krow + 4) * INC * 2 + (((lane & 15) ^ (4 + (lane >> 4))) << 4));
    const unsigned voffV = (unsigned)(da2::unswap23(wid * 8 + ((lane & 31) >> 2)) * INC * 2 + (lane >> 5) * 64 + (lane & 3) * 16);
#define NA2_ISSUE(kr, bufi) do { const char* kb_ = kbase + (size_t)(kr) * (64 * INC * 2); const char* vb_ = vbase + (size_t)(kr) * (64 * INC * 2); \
        LAS unsigned char* lb_ = lds + (bufi) * 32768; \
        __builtin_amdgcn_global_load_lds((const unsigned*)(kb_ + voffK0), (LAS unsigned*)(lb_ + wid * 2048), 16, 0, 0); \
        __builtin_amdgcn_global_load_lds((const unsigned*)(kb_ + voffK1), (LAS unsigned*)(lb_ + wid * 2048 + 1024), 16, 0, 0); \
        __builtin_amdgcn_global_load_lds((const unsigned*)(vb_ + voffV), (LAS unsigned*)(lb_ + 16384 + wid * 2048), 16, 0, 0); \
        __builtin_amdgcn_global_load_lds((const unsigned*)(vb_ + 128 + voffV), (LAS unsigned*)(lb_ + 16384 + wid * 2048 + 1024), 16, 0, 0); } while (0)
    f32x16 o[4];
#pragma unroll
    for (int d = 0; d < 4; ++d) o[d] = f32x16{};
    float l_reg = 0.f;
    const int vb0 = (int)(uintptr_t)(lds + 16384) + da2::v_rd_base(lane);
    NA2_ISSUE(kr_lo, 0);
#pragma unroll 1
    for (int kr = kr_lo; kr <= kr_hi; ++kr) {
        const int bi = (kr - kr_lo) & 1;
        asm volatile("s_waitcnt vmcnt(0) lgkmcnt(0)" ::: "memory");
        __builtin_amdgcn_s_barrier();
        asm volatile("" ::: "memory");
        if (kr < kr_hi) NA2_ISSUE(kr + 1, bi ^ 1);
        if (kr >= rs && kr < rs + 8) {
            f32x16 p0, p1;
            da2::qkt(p0, p1, lds + bi * 32768, qr, r32, hi);
            const LAS float* trow = tab + (kr - r + 7) * 32;
            float ps = 0.f;
#pragma unroll
            for (int rr = 0; rr < 16; ++rr) {
                const int ck = crow(rr, hi);
                { const int rel = ck - cq + 15; const bool valid = (ck >= cs) && (ck < cs + 16); const int idx = rel < 0 ? 0 : (rel > 30 ? 30 : rel);
                  const float v = valid ? __builtin_amdgcn_exp2f(p0[rr] + trow[idx]) : 0.f; p0[rr] = v; ps += v; }
                { const int ck1 = ck + 32; const int rel = ck1 - cq + 15; const bool valid = (ck1 >= cs) && (ck1 < cs + 16); const int idx = rel < 0 ? 0 : (rel > 30 ? 30 : rel);
                  const float v = valid ? __builtin_amdgcn_exp2f(p1[rr] + trow[idx]) : 0.f; p1[rr] = v; ps += v; }
            }
            l_reg += swap_add(ps);
            bf16x8 pa0, pa1, pa2, pa3;
            PK4(p0, 0, pa0); PK4(p0, 8, pa1); PK4(p1, 0, pa2); PK4(p1, 8, pa3);
            const int vb = vb0 + bi * 32768;
            da2::pv_one<4, 0>(o[0], vb, pa0, pa1, pa2, pa3); da2::pv_one<4, 1>(o[1], vb, pa0, pa1, pa2, pa3);
            da2::pv_one<4, 2>(o[2], vb, pa0, pa1, pa2, pa3); da2::pv_one<4, 3>(o[3], vb, pa0, pa1, pa2, pa3);
        }
    }
#undef NA2_ISSUE
    if (hi == 0) li_l[r32] = l_reg;
    asm volatile("s_waitcnt lgkmcnt(0)" ::: "memory");
    __syncthreads();
    LAS unsigned char* T = lds + wid * 8192;
    float* nassq = (float*)(P.ws + WS_NASSQ);
    const size_t t0 = (size_t)b * SEQ + r * 64 + cq0;
#pragma unroll
    for (int rr = 0; rr < 16; ++rr) {
        const float rl = __builtin_amdgcn_rcpf(li_l[crow(rr, hi)]);
        float sq = 0.f;
#pragma unroll
        for (int d = 0; d < 4; ++d) {
            const unsigned w = cvtpk(o[d][rr] * rl, 0.f); const float vq = __uint_as_float(w << 16);
            sq += vq * vq;
            *(LAS bf16_t*)(T + (2 * rr + hi) * 256 + (d * 32 + r32) * 2) = (bf16_t)(w & 0xffffu);
        }
#pragma unroll
        for (int sh = 16; sh >= 1; sh >>= 1) sq += __shfl_xor(sq, sh);
        if (r32 == 0) nassq[(t0 + crow(rr, hi)) * 8 + h] = sq;
    }
    asm volatile("s_waitcnt lgkmcnt(0)" ::: "memory");
    char* mixb = (char*)((bf16_t*)(P.ws + WS_MIX) + t0 * DM + h * 128);
#pragma unroll
    for (int i = 0; i < 8; ++i) {
        const int tr = i * 4 + (lane >> 4), rr2 = tr >> 1, h2 = tr & 1;
        const u32x4 w = *(const LAS u32x4*)(T + tr * 256 + (lane & 15) * 16);
        *(u32x4*)(mixb + (size_t)crow(rr2, h2) * (DM * 2) + (lane & 15) * 16) = w;
    }
    __syncthreads();
}
}

__device__ __forceinline__ void da_combine(const Params& P) {
    int tid = threadIdx.x; asm volatile("" : "+v"(tid)); const int wid = tid >> 6, lane = tid & 63;
    float a = P.lam_q1[lane] * P.lam_k1[lane] + P.lam_q1[lane + 64] * P.lam_k1[lane + 64];
    float c = P.lam_q2[lane] * P.lam_k2[lane] + P.lam_q2[lane + 64] * P.lam_k2[lane + 64];
    a = wave_sum(a); c = wave_sum(c);
    const float lam = expf(a) - expf(c) + 0.2f;
    const float* op = (const float*)(P.ws + WS_OPART);
    bf16_t* mix = (bf16_t*)(P.ws + WS_MIX);
    const f32x4 g = ((const f32x4*)P.subln_b)[lane];
    for (int it = blockIdx.x * 8 + wid; it < MTOK * 4; it += gridDim.x * 8) {
        const int tok = it >> 2, h = it & 3;
        const float* p = op + (size_t)tok * DM + h * 512;
        const f32x4 o1 = ((const f32x4*)p)[lane], o2 = ((const f32x4*)(p + 256))[lane];
        const f32x4 v = o1 - lam * o2;
        float ss = (v[0] * v[0] + v[1] * v[1]) + (v[2] * v[2] + v[3] * v[3]);
        ss = wave_sum(ss);
        const float rstd = rsqrtf(ss * (1.0f / 256.0f) + RMS_EPS) * 0.8f;
        u32x2 w; w.x = cvtpk(v[0] * rstd * g[0], v[1] * rstd * g[1]); w.y = cvtpk(v[2] * rstd * g[2], v[3] * rstd * g[3]);
        *(u32x2*)(mix + (size_t)tok * DM + 1024 + h * 256 + lane * 4) = w;
    }
}

__device__ __forceinline__ f32x4 ldx1(const bf16_t* p) { const u32x2 w = *(const u32x2*)p; return (f32x4){__uint_as_float(w.x << 16), __uint_as_float(w.x & 0xffff0000u), __uint_as_float(w.y << 16), __uint_as_float(w.y & 0xffff0000u)}; }
__device__ __forceinline__ void router_phase(const Params& P, LAS unsigned char* lds) {
    int tid = threadIdx.x; asm volatile("" : "+v"(tid)); const int wid = tid >> 6, lane = tid & 63;
    { const f32x4* src = (const f32x4*)(P.ws + WS_WRT);
#pragma unroll
      for (int i = 0; i < 16; ++i) *(LAS f32x4*)(lds + (size_t)(i * NTHR + tid) * 16) = src[i * NTHR + tid];
      __syncthreads(); }
    const LAS float* wl = (const LAS float*)lds;
    const bf16_t* x1b = (const bf16_t*)(P.ws + WS_OPART);
    const float* rowss = (const float*)(P.ws + WS_ROWSS);
    unsigned char* H2 = (unsigned char*)(P.ws + WS_H2);
    float* aff = (float*)(P.ws + WS_AFF);
    LAS float* red = (LAS float*)(lds + 131072) + wid * 64;
    for (int g4 = blockIdx.x * 8 + wid; g4 < MTOK / 4; g4 += gridDim.x * 8) {
        const int row0 = g4 * 4;
        f32x4 xa[4], xb[4];
#pragma unroll
        for (int t = 0; t < 4; ++t) { xa[t] = ldx1(x1b + (size_t)(row0 + t) * DM + (0 * 64 + lane) * 4); xb[t] = ldx1(x1b + (size_t)(row0 + t) * DM + (1 * 64 + lane) * 4); }
        float rstd[4];
#pragma unroll
        for (int t = 0; t < 4; ++t) { float s = (lane < 32) ? rowss[(size_t)(row0 + t) * 32 + lane] : 0.f; s = wave_sum(s); rstd[t] = rsqrtf(s * (1.0f / DM) + RMS_EPS); }
        float acc[64];
#pragma unroll
        for (int k = 0; k < 64; ++k) acc[k] = 0.f;
#pragma unroll
        for (int i = 0; i < 8; ++i) {
            const int c0 = (i * 64 + lane) * 4;
            const f32x4 g = *(const f32x4*)(P.ln2_g + c0);
            f32x4 hv[4];
#pragma unroll
            for (int t = 0; t < 4; ++t) {
                const f32x4 xc = (i & 1) ? xb[t] : xa[t];
                if (i + 2 < 8) { const f32x4 nx = ldx1(x1b + (size_t)(row0 + t) * DM + ((i + 2) * 64 + lane) * 4); if (i & 1) xb[t] = nx; else xa[t] = nx; }
                hv[t] = xc * rstd[t] * g;
                *(unsigned*)(H2 + (size_t)(row0 + t) * DM + c0) = cvt4_fp8(hv[t][0] * HSC8, hv[t][1] * HSC8, hv[t][2] * HSC8, hv[t][3] * HSC8);
            }
#pragma unroll
            for (int e = 0; e < 16; ++e) {
                const f32x4 w = *(const LAS f32x4*)(wl + e * DM + c0);
#pragma unroll
                for (int t = 0; t < 4; ++t) acc[t * 16 + e] += (hv[t][0] * w[0] + hv[t][1] * w[1]) + (hv[t][2] * w[2] + hv[t][3] * w[3]);
            }
        }
#pragma unroll
        for (int step = 0; step < 6; ++step) {
            const int m = 32 >> step, half = 32 >> step;
            const bool up = (lane & m) != 0;
#pragma unroll
            for (int k = 0; k < half; ++k) {
                const float keep = up ? acc[k + half] : acc[k], send = up ? acc[k] : acc[k + half];
                acc[k] = keep + __shfl_xor(send, m);
            }
        }
        red[lane] = acc[0];
        asm volatile("s_waitcnt lgkmcnt(0)" ::: "memory");
        if (lane < 4) {
            const int t = lane; float lg[16], mx = -1e30f;
#pragma unroll
            for (int e = 0; e < 16; ++e) { lg[e] = red[t * 16 + e]; mx = fmaxf(mx, lg[e]); }
            float sum = 0.f;
#pragma unroll
            for (int e = 0; e < 16; ++e) { lg[e] = expf(lg[e] - mx); sum += lg[e]; }
            const float inv = 1.0f / sum;
            const int row = row0 + t, bb = row >> 12, sq = row & 4095;
#pragma unroll
            for (int e = 0; e < 16; ++e) aff[((size_t)bb * 16 + e) * SEQ + sq] = lg[e] * inv;
        }
    }
}

__device__ __forceinline__ void topk_phase(const Params& P, LAS unsigned char* lds) {
    int tid = threadIdx.x; asm volatile("" : "+v"(tid)); const int wid = tid >> 6, lane = tid & 63;
    const float* aff = (const float*)(P.ws + WS_AFF);
    int* selidx = (int*)(P.ws + WS_SELIDX); float* selgate = (float*)(P.ws + WS_SELGATE); int* slot = (int*)(P.ws + WS_SLOT);
    LAS unsigned* red = (LAS unsigned*)lds;
    for (int it = blockIdx.x; it < NB * NEXP; it += gridDim.x) {
        const int b = it >> 4, e = it & 15;
        const float* ap = aff + (size_t)it * SEQ + tid * 8;
        const f32x4 a0 = *(const f32x4*)ap, a1 = *(const f32x4*)(ap + 4);
        unsigned v[8];
#pragma unroll
        for (int j = 0; j < 4; ++j) { v[j] = __float_as_uint(a0[j]); v[4 + j] = __float_as_uint(a1[j]); }
        LAS unsigned* hist = red + 64;
        unsigned T = 0u, pmask = 0u, needk = (unsigned)CAP;
#pragma unroll 1
        for (int pass = 0; pass < 4; ++pass) {
            const int shift = 24 - 8 * pass;
            if (tid < 256) hist[tid] = 0u;
            __syncthreads();
#pragma unroll
            for (int j = 0; j < 8; ++j) if ((v[j] & pmask) == T) atomicAdd((unsigned*)(hist + ((v[j] >> shift) & 255u)), 1u);
            __syncthreads();
            unsigned hv = 0, incl = 0;
            if (tid < 256) { hv = hist[255 - tid]; incl = hv;
#pragma unroll
                for (int o = 1; o < 64; o <<= 1) { const unsigned up = __shfl_up(incl, o); if (lane >= o) incl += up; }
                if (lane == 63) hist[260 + wid] = incl; }
            __syncthreads();
            if (tid < 256) {
                for (int w = 0; w < wid; ++w) incl += hist[260 + w];
                const unsigned sfx = incl - hv;
                if (sfx < needk && incl >= needk) { hist[256] = (unsigned)(255 - tid); hist[257] = needk - sfx; }
            }
            __syncthreads();
            T |= hist[256] << shift; pmask |= 255u << shift; needk = hist[257];
            __syncthreads();
        }
        unsigned g[8], q[8], gsum = 0, qsum = 0;
#pragma unroll
        for (int j = 0; j < 8; ++j) { g[j] = v[j] > T ? 1u : 0u; q[j] = v[j] == T ? 1u : 0u; gsum += g[j]; qsum += q[j]; }
        unsigned gi = gsum, qi = qsum;
#pragma unroll
        for (int o = 1; o < 64; o <<= 1) { const unsigned tg = __shfl_up(gi, o), tq = __shfl_up(qi, o); if (lane >= o) { gi += tg; qi += tq; } }
        LAS unsigned* sc = red + 32;
        __syncthreads();
        if (lane == 63) { sc[wid] = gi; sc[8 + wid] = qi; }
        __syncthreads();
        unsigned gbase = 0, qbase = 0, gtot = 0;
#pragma unroll
        for (int w = 0; w < 8; ++w) { const unsigned a = sc[w], c2 = sc[8 + w]; if (w < wid) { gbase += a; qbase += c2; } gtot += a; }
        unsigned G = gbase + gi - gsum, Q = qbase + qi - qsum;
        const unsigned need = (unsigned)CAP - gtot;
#pragma unroll
        for (int j = 0; j < 8; ++j) {
            const int tok = tid * 8 + j;
            const bool sel = g[j] || (q[j] && Q < need);
            const unsigned sl = G + (Q < need ? Q : need);
            if (sel) { selidx[e * EROWS + b * CAP + sl] = b * SEQ + tok; selgate[e * EROWS + b * CAP + sl] = __uint_as_float(v[j]); }
            slot[(size_t)it * SEQ + tok] = sel ? (int)sl : -1;
            G += g[j]; Q += q[j];
        }
        __syncthreads();
    }
}

__device__ __forceinline__ void combine_phase(const Params& P, const float ysc) {
    int tid = threadIdx.x; asm volatile("" : "+v"(tid)); const int wid = tid >> 6, lane = tid & 63;
    const int* slot = (const int*)(P.ws + WS_SLOT);
    const unsigned char* Y = (const unsigned char*)(P.ws + WS_Y);
    for (int row = blockIdx.x * 8 + wid; row < MTOK; row += gridDim.x * 8) {
        const int b = row >> 12, s = row & 4095;
        const int sl = (lane < 16) ? slot[((size_t)b * 16 + lane) * SEQ + s] : -1;
        unsigned long long mask = __ballot(sl >= 0);
        float* op = P.out + (size_t)row * DM;
        const bf16_t* xp = (const bf16_t*)(P.ws + WS_OPART) + (size_t)row * DM;
        f32x4 a[8];
#pragma unroll
        for (int i = 0; i < 4; ++i) { const u32x4 w = *(const u32x4*)(xp + i * 512 + lane * 8);
            a[2 * i] = (f32x4){__uint_as_float(w.x << 16), __uint_as_float(w.x & 0xffff0000u), __uint_as_float(w.y << 16), __uint_as_float(w.y & 0xffff0000u)};
            a[2 * i + 1] = (f32x4){__uint_as_float(w.z << 16), __uint_as_float(w.z & 0xffff0000u), __uint_as_float(w.w << 16), __uint_as_float(w.w & 0xffff0000u)}; }
        while (mask) {
            const int e = __builtin_ctzll(mask); mask &= mask - 1;
            const int se = __shfl(sl, e);
            const unsigned char* yp = Y + ((size_t)e * EROWS + b * CAP + se) * DM + lane * 8;
#pragma unroll
            for (int i = 0; i < 4; ++i) {
                const u32x2 w = *(const u32x2*)(yp + i * 512);
                const f32x2 p0 = __builtin_amdgcn_cvt_pk_f32_fp8((int)w.x, false), p1 = __builtin_amdgcn_cvt_pk_f32_fp8((int)w.x, true);
                const f32x2 p2 = __builtin_amdgcn_cvt_pk_f32_fp8((int)w.y, false), p3 = __builtin_amdgcn_cvt_pk_f32_fp8((int)w.y, true);
                a[2 * i] += (f32x4){p0[0], p0[1], p1[0], p1[1]} * (ysc * (1.0f / YSC8));
                a[2 * i + 1] += (f32x4){p2[0], p2[1], p3[0], p3[1]} * (ysc * (1.0f / YSC8));
            }
        }
#pragma unroll
        for (int i = 0; i < 4; ++i) { *(f32x4*)(op + i * 512 + lane * 8) = a[2 * i]; *(f32x4*)(op + i * 512 + lane * 8 + 4) = a[2 * i + 1]; }
    }
}

#ifndef P1_COMPUTE_WGS
#define P1_COMPUTE_WGS 160
#endif
#ifndef P7_PER_XCD
#define P7_PER_XCD 26
#endif
constexpr int N_PHASES = 10;
__global__ void __launch_bounds__(NTHR, 2) fwd_kernel(Params P) {
    extern __shared__ __attribute__((aligned(16))) unsigned char lds_raw[];
    LAS unsigned char* lds = (LAS unsigned char*)lds_raw;
    const int tid = threadIdx.x;
    volatile LAS unsigned* MISC = (volatile LAS unsigned*)(lds + MISC_OFF);
    if (tid < 16) MISC[tid] = 0u;
    __syncthreads();
    XcdBarrier bar; bar.bar = (unsigned*)(P.ws + WS_CTL); bar.x = 0; bar.st = nullptr;
#if MK_N_LAUNCHES == 1
    bar = xcd_barrier_post((unsigned*)(P.ws + WS_CTL), MISC);
#define GRID_BAR() xcd_barrier(bar)
#else
#define GRID_BAR() do { } while (0)
#endif
    const int lo = P.ph_lo, hi = P.ph_hi;
#ifndef PH_MASK
#define PH_MASK 0x3ff
#endif
#define IN(k) (((PH_MASK >> (k)) & 1) && lo <= (k) && (k) < hi)
#define BOTH(k) (IN(k) && IN((k) + 1))

#ifndef PROBE_DUP
#define PROBE_DUP -1
#endif
#define DUP(k) for (int rep_ = 0; rep_ < ((PROBE_DUP) == (k) ? 2 : 1); ++rep_)
    if (IN(0)) { DUP(0) { p0_prologue(P, lds); __syncthreads(); } if (BOTH(0)) GRID_BAR(); }

    if (IN(1)) {
        { LAS float* gl = (LAS float*)(lds + SCR_OFF + 8192);
          if (tid < 128) { gl[tid] = P.qn_a[tid]; gl[128 + tid] = P.kn_a[tid]; gl[256 + tid] = P.qn_b[tid]; gl[384 + tid] = P.kn_b[tid]; }
          __syncthreads(); }
        DUP(1) {
        pg8::OrderMN S; S.init(P.ws + WS_H, P.ws + WS_WIN, MTOK, INC, DM, P1_COMPUTE_WGS, blockIdx.x);
        EpiInProj E{(bf16_t*)(P.ws + WS_PROJ)};
        pg8::gemm_phase<false, false, false>(lds, DM, S, E, nullptr);
        }
        cvt_queue<2>(P, lds, (unsigned*)(P.ws + WS_CTL) + CW_QG); cvt_queue<3>(P, lds, (unsigned*)(P.ws + WS_CTL) + CW_QU);
        if (BOTH(1)) GRID_BAR();
    }

    if (IN(2)) {
        const bf16_t* proj = (const bf16_t*)(P.ws + WS_PROJ);
        float* opart = (float*)(P.ws + WS_OPART);
        const int da_it = (blockIdx.x & 7) * 32 + (blockIdx.x >> 3);
        DUP(2) {
        if (blockIdx.x < 256) da5::item(P, da_it, lds);
        }
        DUP(12) {
        if (blockIdx.x < 256 && ((da_it >> 5) & 3) == 0) {
            const int r64 = (da_it >> 7) * 32 + (da_it & 31);
#pragma unroll 1
            for (int k = 0; k < 4; ++k) na2::item(P, r64 * 4 + k, lds);
        }
        }
        if (BOTH(2)) GRID_BAR();
    }


    if (IN(4)) {
        DUP(4) {
        pg8::OrderMN S; S.init(P.ws + WS_MIX, P.ws + WS_WOUT, MTOK, DM, DM, gridDim.x, blockIdx.x);
        LAS float* ht = (LAS float*)(lds + SCR_OFF);
        { pg8::Unit u; if (S.next(0, u) && tid < 256) { const float* q = (const float*)(P.ws + WS_NASSQ) + (size_t)(u.pm * 256 + tid) * 8;
            const f32x4 a = *(const f32x4*)q, c = *(const f32x4*)(q + 4);
            ht[tid] = rsqrtf(((a[0] + a[1]) + (a[2] + a[3]) + (c[0] + c[1]) + (c[2] + c[3])) * (1.0f / 1024.0f) + RMS_EPS); } }
        __syncthreads();
        EpiOutProj E{P.x, (bf16_t*)(P.ws + WS_OPART), (float*)(P.ws + WS_ROWSS)};
        pg8::gemm_phase<false, true, false>(lds, DM, S, E, (const LAS unsigned*)ht);
        }
        if (BOTH(4)) GRID_BAR();
    }

    if (IN(5)) { DUP(5) { router_phase(P, lds); __syncthreads(); } if (BOTH(5)) GRID_BAR(); }

    if (IN(6)) { DUP(6) { topk_phase(P, lds); } if (BOTH(6)) GRID_BAR(); }

    if (IN(7)) {
        pg8::OrderExpert S; S.init(P.ws + WS_H2, P.ws + WS_WGU, 2 * FF, DM / 2, 0, (size_t)2 * FF * DM, true, gridDim.x, blockIdx.x, P7_PER_XCD);
        LAS unsigned* gtab = (LAS unsigned*)(lds + SCR_OFF);
        const int* selidx = (const int*)(P.ws + WS_SELIDX);
        { pg8::Unit u; for (int i = 0; i < 12 && S.next(i, u); ++i) { if (tid < 256) gtab[i * 256 + tid] = (unsigned)selidx[u.e * EROWS + u.pm * 256 + tid] * (unsigned)DM; } }
        __syncthreads();
        DUP(7) {
        EpiGateUp E{(unsigned char*)(P.ws + WS_ACT)};
        pg8::gemm_phase<true, false, true>(lds, DM / 2, S, E, gtab);
        }
        cvt_queue<4>(P, lds, (unsigned*)(P.ws + WS_CTL) + CW_QD);
        if (BOTH(7)) GRID_BAR();
    }

    if (IN(8)) {
        DUP(8) {
        pg8::OrderExpert S; S.init(P.ws + WS_ACT, P.ws + WS_WD, DM, FF / 2, (size_t)EROWS * FF, (size_t)DM * FF, false, gridDim.x, blockIdx.x, 32);
        EpiDown E{(unsigned char*)(P.ws + WS_Y), (const float*)(P.ws + WS_SELGATE)};
        pg8::gemm_phase<false, false, true>(lds, FF / 2, S, E, nullptr);
        }
        if (BOTH(8)) GRID_BAR();
    }

    if (IN(9)) { if (PROBE_DUP == 9) { combine_phase(P, 0.5f); __syncthreads(); combine_phase(P, 0.5f); } else combine_phase(P, 1.0f); }
#undef IN
#undef BOTH
}

extern "C" void kernel_launch(void* const* d_in, const int* in_sizes, int n_in, void* d_out, int out_size, void* d_ws, size_t ws_size, hipStream_t stream) {
    static int grid = 0;
    if (grid == 0) {
        if (n_in != 20 || out_size != MTOK * DM || ws_size < WS_END) { fprintf(stderr, "kernel_launch: unexpected shapes (n_in %d out %d ws %zu need %zu)\n", n_in, out_size, ws_size, (size_t)WS_END); grid = -1; return; }
        int dev = 0, cus = 0, per_cu = 0;
        if (hipGetDevice(&dev) != hipSuccess || hipDeviceGetAttribute(&cus, hipDeviceAttributeMultiprocessorCount, dev) != hipSuccess) { grid = -1; return; }
        if (hipFuncSetAttribute((const void*)fwd_kernel, hipFuncAttributeMaxDynamicSharedMemorySize, LDS_BYTES) != hipSuccess) { fprintf(stderr, "kernel_launch: hipFuncSetAttribute failed\n"); grid = -1; return; }
        if (hipOccupancyMaxActiveBlocksPerMultiprocessor(&per_cu, (const void*)fwd_kernel, NTHR, LDS_BYTES) != hipSuccess || per_cu < 1) fprintf(stderr, "kernel_launch: occupancy query reports %d\n", per_cu);
        (void)hipGetLastError();
        if (cus != 256) { fprintf(stderr, "kernel_launch: built for a 256-CU device, found %d\n", cus); grid = -1; return; }
        grid = cus;
    }
    if (grid < 0) return;
    hipMemsetAsync((char*)d_ws + WS_CTL, 0, CTL_BYTES, stream);
    Params p{};
    p.x = (const float*)d_in[0]; p.ln1_g = (const float*)d_in[1]; p.w_in = (const float*)d_in[2]; p.qn_a = (const float*)d_in[3]; p.kn_a = (const float*)d_in[4];
    p.rpb_a = (const float*)d_in[5]; p.on_a = (const float*)d_in[6]; p.qn_b = (const float*)d_in[7]; p.kn_b = (const float*)d_in[8];
    p.lam_q1 = (const float*)d_in[9]; p.lam_k1 = (const float*)d_in[10]; p.lam_q2 = (const float*)d_in[11]; p.lam_k2 = (const float*)d_in[12]; p.subln_b = (const float*)d_in[13];
    p.w_out = (const float*)d_in[14]; p.ln2_g = (const float*)d_in[15]; p.w_router = (const float*)d_in[16]; p.w_gate = (const float*)d_in[17]; p.w_up = (const float*)d_in[18]; p.w_down = (const float*)d_in[19];
    p.out = (float*)d_out; p.ws = (unsigned char*)d_ws;
#if MK_N_LAUNCHES == 1
    p.ph_lo = 0; p.ph_hi = N_PHASES;
    hipLaunchKernelGGL(fwd_kernel, dim3(grid), dim3(NTHR), LDS_BYTES, stream, p);
#else
#ifndef PROBE_LDUP
#define PROBE_LDUP -1
#endif
    for (int ph = 0; ph < N_PHASES; ++ph) { p.ph_lo = ph; p.ph_hi = ph + 1;
        for (int rep = 0; rep < ((ph == PROBE_LDUP && ph != 9) ? 2 : 1); ++rep) hipLaunchKernelGGL(fwd_kernel, dim3(grid), dim3(NTHR), LDS_BYTES, stream, p); }
#endif
    const hipError_t le = hipPeekAtLastError();
    if (le != hipSuccess) fprintf(stderr, "kernel_launch: launch failed: %s\n", hipGetErrorName(le));
}
```

```cpp
#include <hip/hip_runtime.h>
#include <stdint.h>
#include <stdio.h>

#ifndef MK_N_LAUNCHES
#define MK_N_LAUNCHES 1
#endif

#define LAS __attribute__((address_space(3)))
typedef unsigned short bf16_t;
typedef short bf16x8 __attribute__((ext_vector_type(8)));
typedef short s16x4 __attribute__((ext_vector_type(4)));
typedef float f32x4 __attribute__((ext_vector_type(4)));
typedef float f32x2 __attribute__((ext_vector_type(2)));
typedef float f32x16 __attribute__((ext_vector_type(16)));
typedef unsigned u32x4 __attribute__((ext_vector_type(4)));
typedef unsigned u32x2 __attribute__((ext_vector_type(2)));
typedef int i32x8 __attribute__((ext_vector_type(8)));
typedef int i32x4 __attribute__((ext_vector_type(4)));

constexpr int NB = 2, SEQ = 4096, DM = 2048, MTOK = NB * SEQ;
constexpr int INC = 6144;
constexpr int NEXP = 16, CAP = 512, FF = 2816, EROWS = NB * CAP;
constexpr float RMS_EPS = 1e-6f;
constexpr float LOG2E = 1.4426950408889634f;
constexpr float QSCALE = 0.088388347648318440f * LOG2E;
constexpr int NTHR = 512;

constexpr size_t al256(size_t x) { return (x + 255) / 256 * 256; }
constexpr size_t WS_CTL = 0, CTL_BYTES = 65536;
constexpr size_t WS_WIN = WS_CTL + CTL_BYTES;
constexpr size_t WS_WOUT = WS_WIN + (size_t)INC * DM * 2;
constexpr size_t WS_WGU = WS_WOUT + (size_t)DM * DM * 2;
constexpr size_t WS_WD = WS_WGU + (size_t)NEXP * 2 * FF * DM * 2;
constexpr size_t WS_H = WS_WD + (size_t)NEXP * DM * FF * 2;
constexpr size_t WS_PROJ = WS_H + (size_t)MTOK * DM * 2;
constexpr size_t WS_NASSQ = WS_PROJ + (size_t)MTOK * INC * 2;
constexpr size_t WS_MIX = WS_NASSQ + (size_t)MTOK * 1024 * 2;
constexpr size_t WS_OPART = WS_MIX + (size_t)MTOK * DM * 2;
constexpr size_t WS_ROWSS = WS_OPART + (size_t)MTOK * DM * 4;
constexpr size_t WS_AFF = WS_ROWSS + (size_t)MTOK * 32 * 4;
constexpr size_t WS_SELIDX = WS_AFF + (size_t)NB * NEXP * SEQ * 4;
constexpr size_t WS_SELGATE = WS_SELIDX + (size_t)NEXP * EROWS * 4;
constexpr size_t WS_SLOT = WS_SELGATE + (size_t)NEXP * EROWS * 4;
constexpr size_t WS_H2 = WS_SLOT + (size_t)NB * NEXP * SEQ * 4;
constexpr size_t WS_ACT = WS_H2 + (size_t)MTOK * DM * 2;
constexpr size_t WS_Y = WS_ACT + (size_t)NEXP * EROWS * FF * 2;
constexpr size_t WS_WRT = WS_Y + (size_t)NEXP * EROWS * DM * 2;
constexpr size_t WS_END = WS_WRT + (size_t)NEXP * DM * 4;

constexpr int STAGE_BYTES = 131072;
constexpr int SCR_OFF = STAGE_BYTES;
constexpr int SCR_BYTES = 16384;
constexpr int MISC_OFF = SCR_OFF + SCR_BYTES - 64;
constexpr int CVS_OFF = SCR_OFF + SCR_BYTES;
constexpr int LDS_BYTES = CVS_OFF + 16384;

__device__ __forceinline__ unsigned cvtpk(float lo, float hi) { unsigned r; asm volatile("v_cvt_pk_bf16_f32 %0, %1, %2" : "=v"(r) : "v"(lo), "v"(hi)); return r; }
__device__ __forceinline__ float wave_sum(float v) {
#pragma unroll
    for (int o = 32; o >= 1; o >>= 1) v += __shfl_xor(v, o);
    return v;
}
__device__ __forceinline__ unsigned cvt4_fp8(float a, float b, float c, float d) { int w = 0; w = __builtin_amdgcn_cvt_pk_fp8_f32(a, b, w, false); w = __builtin_amdgcn_cvt_pk_fp8_f32(c, d, w, true); return (unsigned)w; }
constexpr float WSC8 = 128.0f, HSC8 = 4.0f, ASC8 = 8.0f, YSC8 = 64.0f;
__device__ __forceinline__ float bf2f(bf16_t b) { return __uint_as_float(((unsigned)b) << 16); }

#define XB_TMO      128
#define XB_XCNT(j)  (256  + 64 * (j))
#define XB_XSUB(j)  (1280 + 64 * (j))
#define XB_XGEN(j)  (2304 + 64 * (j))
#define XB_TOP      3328
#define XB_TOPGEN   3392
#define XCD_BAR_WORDS 3456
#define XB_SPIN_CAP (1u << 18)

__device__ __forceinline__ unsigned xb_ld(unsigned* p)              { return __hip_atomic_load(p, __ATOMIC_RELAXED, __HIP_MEMORY_SCOPE_AGENT); }
__device__ __forceinline__ unsigned xb_add(unsigned* p, unsigned v) { return __hip_atomic_fetch_add(p, v, __ATOMIC_RELAXED, __HIP_MEMORY_SCOPE_AGENT); }
__device__ __forceinline__ unsigned xb_xcc_id() { return (unsigned)__builtin_amdgcn_s_getreg((3 << 11) | 20) & 0xFu; }
#define XB_SPIN(cond, bar) do { unsigned _sp = 0; while (cond) { __builtin_amdgcn_s_sleep(1); \
    if ((++_sp & 255u) == 0u) { if (xb_ld(&(bar)[XB_TMO])) break; if (_sp > XB_SPIN_CAP) { atomicAdd(&(bar)[XB_TMO], 1u); break; } } } } while (0)

struct XcdBarrier { unsigned* bar; unsigned x; volatile LAS unsigned* st; };

__device__ __forceinline__ XcdBarrier xcd_barrier_post(unsigned* bar, volatile LAS unsigned* st) {
    XcdBarrier b; b.bar = bar; b.x = xb_xcc_id(); b.st = st;
    if (threadIdx.x == 0) (void)xb_add(&bar[XB_XCNT(b.x)], 1u);
    return b;
}
__device__ __forceinline__ void xcd_barrier_complete(unsigned* bar, unsigned x, unsigned& nloc, unsigned& nx) {
    const unsigned G = gridDim.x * gridDim.y * gridDim.z;
    unsigned sum, cnt, mine, sp = 0u;
    for (;;) {
        sum = 0u; cnt = 0u; mine = 0u;
#pragma unroll
        for (unsigned j = 0; j < 16; ++j) { const unsigned c = xb_ld(&bar[XB_XCNT(j)]); sum += c; cnt += (c > 0u) ? 1u : 0u; mine = (j == x) ? c : mine; }
        if (sum == G) break;
        __builtin_amdgcn_s_sleep(1);
        if ((++sp & 255u) == 0u) { if (xb_ld(&bar[XB_TMO])) break; if (sp > XB_SPIN_CAP) { atomicAdd(&bar[XB_TMO], 1u); break; } }
    }
    nloc = mine > 0u ? mine : 1u; nx = cnt > 0u ? cnt : 1u;
}
__device__ __forceinline__ void xcd_barrier(const XcdBarrier& b) {
    asm volatile("s_waitcnt vmcnt(0)" ::: "memory");
    __syncthreads();
    if (threadIdx.x == 0) {
        unsigned* bar = b.bar;
        __builtin_amdgcn_s_waitcnt(0);
        unsigned nloc = b.st[0], nx = b.st[1];
        if (nloc == 0u) { xcd_barrier_complete(bar, b.x, nloc, nx); b.st[0] = nloc; b.st[1] = nx; }
        const unsigned old = xb_add(&bar[XB_XSUB(b.x)], 1u);
        const unsigned gen = old / nloc;
        if (old + 1u == (gen + 1u) * nloc) {
            __builtin_amdgcn_fence(__ATOMIC_RELEASE, "agent");
            asm volatile("s_waitcnt vmcnt(0)" ::: "memory");
            const unsigned og = xb_add(&bar[XB_TOP], 1u);
            const unsigned tg = og / nx;
            if (og + 1u == (tg + 1u) * nx) xb_add(&bar[XB_TOPGEN], 1u);
            else XB_SPIN(xb_ld(&bar[XB_TOPGEN]) == tg, bar);
            __builtin_amdgcn_fence(__ATOMIC_ACQUIRE, "agent");
            xb_add(&bar[XB_XGEN(b.x)], 1u);
            asm volatile("s_waitcnt vmcnt(0)" ::: "memory");
        } else {
            XB_SPIN(xb_ld(&bar[XB_XGEN(b.x)]) == gen, bar);
            __builtin_amdgcn_fence(__ATOMIC_ACQUIRE, "agent");
            asm volatile("s_waitcnt vmcnt(0)" ::: "memory");
        }
    }
    __syncthreads();
}

struct Params {
    const float* x; const float* ln1_g; const float* w_in; const float* qn_a; const float* kn_a; const float* rpb_a; const float* on_a;
    const float* qn_b; const float* kn_b; const float* lam_q1; const float* lam_k1; const float* lam_q2; const float* lam_k2; const float* subln_b;
    const float* w_out; const float* ln2_g; const float* w_router; const float* w_gate; const float* w_up; const float* w_down;
    float* out; unsigned char* ws; int ph_lo, ph_hi;
};

__device__ __forceinline__ void cvt_load(const float* __restrict__ src, int N, int k0, int n0, int tid, f32x4 (&v)[8], const float* kscale) {
    const int ln = tid & 63, kq = tid >> 6;
    const float* p = src + (size_t)(k0 + kq * 8) * N + n0 + ln * 4;
#pragma unroll
    for (int i = 0; i < 8; ++i) v[i] = __builtin_nontemporal_load((const f32x4*)(p + (size_t)i * N));
    if (kscale) {
#pragma unroll
        for (int i = 0; i < 8; ++i) v[i] = v[i] * kscale[k0 + kq * 8 + i];
    }
}
__device__ __forceinline__ void cvt_to_lds(LAS unsigned char* buf, int tid, const f32x4 (&v)[8]) {
    const int ln = tid & 63, kq = tid >> 6;
#pragma unroll
    for (int j = 0; j < 4; ++j) {
        u32x4 w; w.x = cvtpk(v[0][j], v[1][j]); w.y = cvtpk(v[2][j], v[3][j]); w.z = cvtpk(v[4][j], v[5][j]); w.w = cvtpk(v[6][j], v[7][j]);
        *(LAS u32x4*)(buf + (ln * 4 + j) * 144 + kq * 16) = w;
    }
}
__device__ __forceinline__ void cvt_store(const LAS unsigned char* buf, bf16_t* __restrict__ dst, int K, int k0, int n0, int blk, int off, int tid) {
#pragma unroll
    for (int q = 0; q < 4; ++q) {
        const int p = tid + q * 512, n = p >> 3, kp = p & 7, ng = n0 + n;
        const u32x4 w = *(const LAS u32x4*)(buf + n * 144 + kp * 16);
        const size_t drow = (size_t)(ng >> 7) * blk + off + (ng & 127);
        *(u32x4*)(dst + drow * K + k0 + kp * 8) = w;
    }
}
__device__ __forceinline__ void cvt_to_lds8(LAS unsigned char* buf, int tid, const f32x4 (&v)[8]) {
    const int ln = tid & 63, kq = tid >> 6, slot = (kq ^ (ln & 7)) * 8;
    f32x4 u[8];
#pragma unroll
    for (int i = 0; i < 8; ++i) u[i] = v[i] * WSC8;
#pragma unroll
    for (int j = 0; j < 4; ++j) {
        u32x2 w; w.x = cvt4_fp8(u[0][j], u[1][j], u[2][j], u[3][j]); w.y = cvt4_fp8(u[4][j], u[5][j], u[6][j], u[7][j]);
        *(LAS u32x2*)(buf + (ln * 4 + j) * 64 + slot) = w;
    }
}
__device__ __forceinline__ void cvt_store8(const LAS unsigned char* buf, unsigned char* __restrict__ dst, int Kb, int k0, int n0, int blk, int off, int tid) {
#pragma unroll
    for (int q = 0; q < 2; ++q) {
        const int p = tid + q * 512, n = p >> 2, kp = p & 3, ng = n0 + n, sw = (n >> 2) & 7;
        const u32x2 lo = *(const LAS u32x2*)(buf + n * 64 + ((2 * kp) ^ sw) * 8), hi = *(const LAS u32x2*)(buf + n * 64 + ((2 * kp + 1) ^ sw) * 8);
        const u32x4 w = {lo.x, lo.y, hi.x, hi.y};
        const size_t drow = (size_t)(ng >> 7) * blk + off + (ng & 127);
        __builtin_nontemporal_store(w, (u32x4*)(dst + drow * Kb + k0 + kp * 16));
    }
}
struct CvtTile { const float* src; bf16_t* dst; int K, N, k0, n0, blk, off; const float* kscale; int fp8; };
__device__ __forceinline__ void cvt_to_lds_any(LAS unsigned char* buf, int tid, const f32x4 (&v)[8], int fp8) { if (fp8) cvt_to_lds8(buf, tid, v); else cvt_to_lds(buf, tid, v); }
__device__ __forceinline__ void cvt_store_any(const LAS unsigned char* buf, const CvtTile& t, int tid) {
    if (t.fp8) cvt_store8(buf, (unsigned char*)t.dst, t.K, t.k0, t.n0, t.blk, t.off, tid); else cvt_store(buf, t.dst, t.K, t.k0, t.n0, t.blk, t.off, tid); }
template <int KIND> __device__ __forceinline__ constexpr int cvt_count() { return KIND == 0 ? 768 : KIND == 1 ? 256 : 16 * 352; }
template <int KIND> __device__ __forceinline__ CvtTile cvt_decode(const Params& P, int r) {
    CvtTile t; t.kscale = nullptr; t.fp8 = 0;
    if (KIND == 0) { t.src = P.w_in; t.dst = (bf16_t*)(P.ws + WS_WIN); t.K = DM; t.N = INC; t.k0 = (r / 24) * 64; t.n0 = (r % 24) * 256; t.blk = 128; t.off = 0; }
    else if (KIND == 1) { t.src = P.w_out; t.dst = (bf16_t*)(P.ws + WS_WOUT); t.K = DM; t.N = DM; t.k0 = (r / 8) * 64; t.n0 = (r % 8) * 256; t.blk = 128; t.off = 0; t.kscale = (t.k0 < 1024) ? P.on_a : nullptr; }
    else if (KIND == 2 || KIND == 3) { const int e = r / 352, q = r % 352;
        t.src = (KIND == 3 ? P.w_up : P.w_gate) + (size_t)e * DM * FF; t.dst = (bf16_t*)(P.ws + WS_WGU + (size_t)e * 2 * FF * DM);
        t.K = DM; t.N = FF; t.k0 = (q / 11) * 64; t.n0 = (q % 11) * 256; t.blk = 256; t.off = (KIND == 3) ? 128 : 0; t.fp8 = 1; }
    else { const int e = r / 352, q = r % 352;
        t.src = P.w_down + (size_t)e * FF * DM; t.dst = (bf16_t*)(P.ws + WS_WD + (size_t)e * DM * FF);
        t.K = FF; t.N = DM; t.k0 = (q / 8) * 64; t.n0 = (q % 8) * 256; t.blk = 128; t.off = 0; t.fp8 = 1; }
    return t;
}
constexpr int CW_QG = 4096, CW_QU = 4160, CW_QD = 4224;

template <int KIND> __device__ __forceinline__ void cvt_static(const Params& P, LAS unsigned char* lds) {
    const int tid = threadIdx.x, G = gridDim.x; constexpr int NT = cvt_count<KIND>();
    int idA = blockIdx.x, idB = blockIdx.x + G;
    f32x4 vA[8], vB[8];
    CvtTile tA = cvt_decode<KIND>(P, idA < NT ? idA : 0), tB = cvt_decode<KIND>(P, idB < NT ? idB : 0);
    if (idA < NT) cvt_load(tA.src, tA.N, tA.k0, tA.n0, tid, vA, tA.kscale);
    if (idB < NT) cvt_load(tB.src, tB.N, tB.k0, tB.n0, tid, vB, tB.kscale);
    for (;;) {
        if (idA >= NT) break;
        cvt_to_lds_any(lds, tid, vA, tA.fp8);
        { const int nid = idA + 2 * G; CvtTile tn = cvt_decode<KIND>(P, nid < NT ? nid : 0);
          if (nid < NT) cvt_load(tn.src, tn.N, tn.k0, tn.n0, tid, vA, tn.kscale);
          asm volatile("s_waitcnt lgkmcnt(0)" ::: "memory"); __builtin_amdgcn_s_barrier(); asm volatile("" ::: "memory");
          cvt_store_any(lds, tA, tid);
          tA = tn; idA = nid; }
        if (idB >= NT) break;
        cvt_to_lds_any(lds + 36864, tid, vB, tB.fp8);
        { const int nid = idB + 2 * G; CvtTile tn = cvt_decode<KIND>(P, nid < NT ? nid : 0);
          if (nid < NT) cvt_load(tn.src, tn.N, tn.k0, tn.n0, tid, vB, tn.kscale);
          asm volatile("s_waitcnt lgkmcnt(0)" ::: "memory"); __builtin_amdgcn_s_barrier(); asm volatile("" ::: "memory");
          cvt_store_any(lds + 36864, tB, tid);
          tB = tn; idB = nid; }
    }
}
__device__ __forceinline__ void p0_prologue(const Params& P, LAS unsigned char* lds) {
    int tid = threadIdx.x; asm volatile("" : "+v"(tid)); const int lane = tid & 63, wid = tid >> 6;
    {
        bf16_t* H = (bf16_t*)(P.ws + WS_H);
        for (int row = blockIdx.x * 8 + wid; row < MTOK; row += gridDim.x * 8) {
            const f32x4* xp = (const f32x4*)(P.x + (size_t)row * DM);
            f32x4 v[8]; float ss = 0.f;
#pragma unroll
            for (int i = 0; i < 8; ++i) { v[i] = xp[i * 64 + lane]; ss += v[i][0] * v[i][0] + v[i][1] * v[i][1] + v[i][2] * v[i][2] + v[i][3] * v[i][3]; }
            ss = wave_sum(ss);
            const float rstd = rsqrtf(ss * (1.0f / DM) + RMS_EPS);
#pragma unroll
            for (int i = 0; i < 8; ++i) {
                const f32x4 g = ((const f32x4*)P.ln1_g)[i * 64 + lane];
                u32x2 w; w.x = cvtpk(v[i][0] * rstd * g[0], v[i][1] * rstd * g[1]); w.y = cvtpk(v[i][2] * rstd * g[2], v[i][3] * rstd * g[3]);
                *(u32x2*)(H + (size_t)row * DM + (i * 64 + lane) * 4) = w;
            }
        }
    }
    cvt_static<0>(P, lds); __syncthreads(); cvt_static<1>(P, lds);
    { float* wrt = (float*)(P.ws + WS_WRT);
      for (int i = blockIdx.x * NTHR + tid; i < NEXP * DM; i += gridDim.x * NTHR) { const int e = i >> 11, c = i & 2047; wrt[i] = P.w_router[c * 16 + e]; } }
}
__device__ __forceinline__ void cvt_load_asm(const float* __restrict__ src, int N, int k0, int n0, int tid, f32x4 (&v)[8]) {
    const int ln = tid & 63, kq = tid >> 6;
    const float* p = src + (size_t)(k0 + kq * 8) * N + n0 + ln * 4;
#pragma unroll
    for (int i = 0; i < 8; ++i) { const float* q = p + (size_t)i * N; asm volatile("global_load_dwordx4 %0, %1, off nt" : "=v"(v[i]) : "v"(q) : "memory"); }
}
__device__ __forceinline__ void cvt_load_asm_s(const float* tile  , int N, unsigned voff, f32x4 (&v)[8]) {
#pragma unroll
    for (int i = 0; i < 8; ++i) { const float* q = tile + (size_t)i * N; asm volatile("global_load_dwordx4 %0, %1, %2 nt" : "=v"(v[i]) : "v"(voff), "s"(q) : "memory"); }
}
#define CVT_WAIT_SET(v, N) asm volatile("s_waitcnt vmcnt(" #N ")" : "+v"(v[0]), "+v"(v[1]), "+v"(v[2]), "+v"(v[3]), "+v"(v[4]), "+v"(v[5]), "+v"(v[6]), "+v"(v[7]) :: "memory")
struct CvtT { const float* src; unsigned char* dst; int N, Kb, k0, drow0; };
template <int KIND> __device__ __forceinline__ CvtT cvt_decode8(const Params& P, int r) {
    CvtT t; const int e = r / 352, q = r % 352;
    if (KIND == 2 || KIND == 3) { const int kt = q / 22, nt = q % 22;
        t.N = FF; t.Kb = DM; t.k0 = kt * 128; t.src = (KIND == 3 ? P.w_up : P.w_gate) + (size_t)e * DM * FF + (size_t)t.k0 * FF + nt * 128;
        t.dst = P.ws + WS_WGU + (size_t)e * 2 * FF * DM; t.drow0 = nt * 256 + (KIND == 3 ? 128 : 0); }
    else { const int kt = q / 16, nt = q % 16;
        t.N = DM; t.Kb = FF; t.k0 = kt * 128; t.src = P.w_down + (size_t)e * FF * DM + (size_t)t.k0 * DM + nt * 128;
        t.dst = P.ws + WS_WD + (size_t)e * DM * FF; t.drow0 = nt * 128; }
    return t;
}
template <int KIND> __device__ __forceinline__ void cvt_queue(const Params& P, LAS unsigned char* lds, unsigned* qhead) {
    int tid = threadIdx.x; asm volatile("" : "+v"(tid));
    const int wid = __builtin_amdgcn_readfirstlane(tid >> 6), lane = tid & 63, ln32 = lane & 31, kq = tid >> 5;
    constexpr unsigned n = (unsigned)cvt_count<KIND>(); constexpr unsigned CH = 4;
    LAS unsigned* slot = (LAS unsigned*)(lds + SCR_OFF + 12288);
    LAS unsigned char* stg = lds + CVS_OFF;
#define QCLAIM() __hip_atomic_fetch_add(qhead, CH, __ATOMIC_RELAXED, __HIP_MEMORY_SCOPE_AGENT)
    __syncthreads();
    if (tid == 0) { const unsigned s0 = QCLAIM(), s1 = QCLAIM(); slot[0] = s0; slot[1] = s1; }
    __syncthreads();
    unsigned cbase = slot[0], pos = 0, par = 1;
#define QGEN(dst) do { dst = cbase + pos; if (++pos == CH) { pos = 0; cbase = slot[par]; \
        if (tid == 0) { const unsigned nb_ = (cbase < n) ? QCLAIM() : 0xffffff00u; slot[par ^ 1] = nb_; } par ^= 1; } } while (0)
#define CVT_DMA(t, sl) do { const char* gb_ = (const char*)(t).src + (size_t)(wid * 16 + (lane >> 5)) * ((t).N * 4) + ln32 * 16; LAS unsigned char* lb_ = lds + (sl) * 65536 + wid * 8192; \
        _Pragma("unroll") for (int i_ = 0; i_ < 8; ++i_) __builtin_amdgcn_global_load_lds((const unsigned*)(gb_ + (size_t)(2 * i_) * ((t).N * 4)), (LAS unsigned*)(lb_ + i_ * 1024), 16, 0, 2); } while (0)
    unsigned id0, id1; QGEN(id0); QGEN(id1);
    id0 = __builtin_amdgcn_readfirstlane(id0); id1 = __builtin_amdgcn_readfirstlane(id1);
    CvtT tc = cvt_decode8<KIND>(P, id0 < n ? (int)id0 : 0), tn = cvt_decode8<KIND>(P, id1 < n ? (int)id1 : 0);
    CVT_DMA(tc, 0); CVT_DMA(tn, 1);
    unsigned idc = id0, idn = id1; int k = 0;
    while (idc < n) {
        const int sl = k & 1;
        if (k < 2) asm volatile("s_waitcnt vmcnt(0)" ::: "memory"); else asm volatile("s_waitcnt vmcnt(12)" ::: "memory");
        f32x4 v[8];
        { const LAS unsigned char* rb = lds + sl * 65536 + wid * 8192 + (lane >> 5) * 4096 + ln32 * 16;
#pragma unroll
          for (int i = 0; i < 8; ++i) v[i] = *(const LAS f32x4*)(rb + i * 512) * WSC8; }
        unsigned w8[4][2];
#pragma unroll
        for (int j = 0; j < 4; ++j) { w8[j][0] = cvt4_fp8(v[0][j], v[1][j], v[2][j], v[3][j]); w8[j][1] = cvt4_fp8(v[4][j], v[5][j], v[6][j], v[7][j]); }
        unsigned idx; QGEN(idx); idx = __builtin_amdgcn_readfirstlane(idx);
        const CvtT tx = cvt_decode8<KIND>(P, idx < n ? (int)idx : 0);
        asm volatile("s_waitcnt lgkmcnt(0)" ::: "memory");
        CVT_DMA(tx, sl);
        __builtin_amdgcn_s_barrier(); asm volatile("" ::: "memory");
#pragma unroll
        for (int j = 0; j < 4; ++j) { u32x2 w; w.x = w8[j][0]; w.y = w8[j][1]; *(LAS u32x2*)(stg + (ln32 * 4 + j) * 128 + ((kq ^ (ln32 & 15)) << 3)) = w; }
        asm volatile("s_waitcnt lgkmcnt(0)" ::: "memory"); __builtin_amdgcn_s_barrier(); asm volatile("" ::: "memory");
#pragma unroll
        for (int q = 0; q < 2; ++q) {
            const int p = tid + q * 512, nn = p >> 3, kp = p & 7, sw = (nn >> 2) & 15;
            const u32x2 lo = *(const LAS u32x2*)(stg + nn * 128 + (((2 * kp) ^ sw) << 3)), hi = *(const LAS u32x2*)(stg + nn * 128 + (((2 * kp + 1) ^ sw) << 3));
            const u32x4 w = {lo.x, lo.y, hi.x, hi.y};
            __builtin_nontemporal_store(w, (u32x4*)(tc.dst + (size_t)(tc.drow0 + nn) * tc.Kb + tc.k0 + kp * 16));
        }
        tc = tn; tn = tx; idc = idn; idn = idx; ++k;
    }
    asm volatile("s_waitcnt vmcnt(0)" ::: "memory");
#undef QCLAIM
#undef QGEN
#undef CVT_DMA
    __syncthreads();
}

namespace pg8 {
constexpr int BM = 256, BK = 64, HALF = 128, HTB = HALF * BK * 2, NXCD = 8, WGM = 8;
__device__ __forceinline__ int lds_byte(int r, int c) { const int st = (r >> 4) * 2 + (c >> 5), rr = r & 15, cc = c & 31, ob = rr * 64 + cc * 2; return st * 1024 + (ob ^ (((ob >> 9) & 1) << 5)); }
__device__ __forceinline__ void stage_rc(int b, int& R, int& C) { const int st = b / 1024, sb = b % 1024, swz = sb ^ (((sb >> 9) & 1) << 5); R = (st >> 1) * 16 + swz / 64; C = (st & 1) * 32 + (swz % 64) / 2; }
__device__ __forceinline__ int perm32(int rho) { const int n = rho >> 4, i = rho & 15; return 8 * (i >> 2) + 4 * n + (i & 3); }

struct Unit { int pm, pn, e; };

template <bool GATHER, bool HOOK, bool FP8, class Epi, class Sched>
__device__ __forceinline__ void gemm_phase(LAS unsigned char* lds, const int K, const Sched& S, const Epi& E, const LAS unsigned* gtab) {
    int tid = threadIdx.x; asm volatile("" : "+v"(tid));
    const int wid = __builtin_amdgcn_readfirstlane(tid >> 6), lane = tid & 63, wr = wid >> 2, wc = wid & 3, fr = lane & 15, fq = lane >> 4;
    const int nt = K / BK;
    unsigned voffA[2], voffB[2]; int RA[2], CA2[2];
#pragma unroll
    for (int i = 0; i < 2; ++i) { int R, C; stage_rc(tid * 16 + i * 8192, R, C); const int Rb = (R & ~31) + perm32(R & 31);
        voffA[i] = (unsigned)(R * K + C) * 2u; voffB[i] = (unsigned)(Rb * K + C) * 2u; RA[i] = R; CA2[i] = C * 2; }
    const size_t kstep = (size_t)(BK * 2);
    const size_t hstep = (size_t)HALF * K * 2;
    const unsigned ldsw = (unsigned)wid * 1024u;
    const int aoff = lds_byte(wr * 64 + fr, fq * 8), boff = lds_byte(wc * 32 + fr, fq * 8);
#define PG8_SA(b, h) (((b) * 2 + (h)) * HTB)
#define PG8_SB(b, h) ((4 + (b) * 2 + (h)) * HTB)
#define PG8_STAGE(bufoff, gbase, voff) do { _Pragma("unroll") for (int _i = 0; _i < 2; ++_i) \
        __builtin_amdgcn_global_load_lds((const unsigned*)((const char*)(gbase) + (voff)[_i]), (LAS unsigned*)(lds + (bufoff) + ldsw + _i * 8192), 16, 0, 0); } while (0)
#define PG8_STAGE_A(bufoff, ubase, kbytes, h, gv) do { if (GATHER) { PG8_STAGE(bufoff, (ubase) + (kbytes), (gv)[h]); } else { PG8_STAGE(bufoff, (ubase) + (kbytes) + (h) * hstep, voffA); } } while (0)
#define PG8_LD2(addr) __builtin_shufflevector(*(const LAS i32x4*)(addr), *(const LAS i32x4*)((addr) + 1024), 0, 1, 2, 3, 4, 5, 6, 7)
#define PG8_LDA(dst, b, h) do { if (FP8) { _Pragma("unroll") for (int m = 0; m < 4; ++m) dst##_f8[m] = PG8_LD2(lds + PG8_SA(b, h) + aoff + m * 2048); } \
        else { _Pragma("unroll") for (int m = 0; m < 4; ++m) _Pragma("unroll") for (int k = 0; k < 2; ++k) dst##_bf[m][k] = *(const LAS bf16x8*)(lds + PG8_SA(b, h) + aoff + m * 2048 + k * 1024); } } while (0)
#define PG8_LDB(dst, b, h) do { if (FP8) { _Pragma("unroll") for (int n = 0; n < 2; ++n) dst##_f8[n] = PG8_LD2(lds + PG8_SB(b, h) + boff + n * 2048); } \
        else { _Pragma("unroll") for (int n = 0; n < 2; ++n) _Pragma("unroll") for (int k = 0; k < 2; ++k) dst##_bf[n][k] = *(const LAS bf16x8*)(lds + PG8_SB(b, h) + boff + n * 2048 + k * 1024); } } while (0)
#define PG8_MMA(ai, bj, At, Bt) do { __builtin_amdgcn_s_setprio(1); \
        if (FP8) { _Pragma("unroll") for (int m = 0; m < 4; ++m) _Pragma("unroll") for (int n = 0; n < 2; ++n) \
            asm volatile("v_mfma_scale_f32_16x16x128_f8f6f4 %0, %1, %2, %0, %3, %3 op_sel_hi:[0,0,0]" : "+v"(acc[ai][bj][m][n]) : "v"(Bt##_f8[n]), "v"(At##_f8[m]), "v"(sc1)); } \
        else { _Pragma("unroll") for (int m = 0; m < 4; ++m) _Pragma("unroll") for (int n = 0; n < 2; ++n) _Pragma("unroll") for (int k = 0; k < 2; ++k) \
            acc[ai][bj][m][n] = __builtin_amdgcn_mfma_f32_16x16x32_bf16(Bt##_bf[n][k], At##_bf[m][k], acc[ai][bj][m][n], 0, 0, 0); } \
        __builtin_amdgcn_s_setprio(0); } while (0)
#define PG8_WAIT_V(n) asm volatile("s_waitcnt vmcnt(" #n ")" ::: "memory")
#define PG8_WAIT_L(n) asm volatile("s_waitcnt lgkmcnt(" #n ")" ::: "memory")
#define PG8_BAR __builtin_amdgcn_s_barrier()
#define PG8_SCHED __builtin_amdgcn_sched_barrier(0)
#define PG8_GLOAD(gv, i) do { if (GATHER) { _Pragma("unroll") for (int _h = 0; _h < 2; ++_h) _Pragma("unroll") for (int _i = 0; _i < 2; ++_i) (gv)[_h][_i] = gtab[(i) * 256 + _h * 128 + RA[_i]] + (unsigned)CA2[_i]; } } while (0)
    Unit cur, nxt; int ui = 0;
    if (!S.next(0, cur)) return;
    f32x4 acc[2][2][4][2];
    if constexpr (Epi::INIT) E.init(acc, cur, wr, wc, fr, fq, gtab);
    else {
#pragma unroll
    for (int a = 0; a < 2; ++a)
#pragma unroll
        for (int b = 0; b < 2; ++b)
#pragma unroll
            for (int m = 0; m < 4; ++m)
#pragma unroll
                for (int n = 0; n < 2; ++n) acc[a][b][m][n] = (f32x4){0.f, 0.f, 0.f, 0.f};
    }
    i32x8 At_f8[4], B0_f8[2], B1_f8[2]; bf16x8 At_bf[4][2], B0_bf[2][2], B1_bf[2][2];
    int sc1 = 0x7F7F7F7F; asm volatile("" : "+v"(sc1));
    unsigned gc[2][2] = {{0u, 0u}, {0u, 0u}}, gn[2][2] = {{0u, 0u}, {0u, 0u}};
    PG8_GLOAD(gc, 0);
    const char* cA = S.abase(cur); const char* cB = S.bbase(cur);
    PG8_STAGE(PG8_SB(0, 0), cB, voffB); PG8_STAGE_A(PG8_SA(0, 0), cA, 0, 0, gc); PG8_STAGE(PG8_SB(0, 1), cB + hstep, voffB); PG8_STAGE_A(PG8_SA(0, 1), cA, 0, 1, gc);
    if (wr == 1) PG8_BAR;
    PG8_WAIT_V(4); PG8_BAR;
    PG8_STAGE(PG8_SB(1, 0), cB + kstep, voffB); PG8_STAGE_A(PG8_SA(1, 0), cA, kstep, 0, gc); PG8_STAGE(PG8_SB(1, 1), cB + hstep + kstep, voffB);
    PG8_WAIT_V(6); PG8_BAR;
    for (;;) {
        const bool has_next = S.next(ui + 1, nxt);
        const char* nA = has_next ? S.abase(nxt) : cA; const char* nB = has_next ? S.bbase(nxt) : cB;
        if (GATHER) { if (has_next) { PG8_GLOAD(gn, ui + 1); } else {
#pragma unroll
            for (int _h = 0; _h < 2; ++_h)
#pragma unroll
                for (int _i = 0; _i < 2; ++_i) gn[_h][_i] = gc[_h][_i]; } }
        for (int t = 0; t < nt; t += 2) {
            const bool last = (t == nt - 2);
            const size_t k1 = (size_t)(t + 1) * kstep;
            const char* a2 = last ? nA : cA + (size_t)(t + 2) * kstep; const char* b2 = last ? nB : cB + (size_t)(t + 2) * kstep;
            const char* a3 = a2 + kstep; const char* b3 = b2 + kstep;
            unsigned g2[2][2];
#pragma unroll
            for (int _h = 0; _h < 2; ++_h)
#pragma unroll
                for (int _i = 0; _i < 2; ++_i) g2[_h][_i] = last ? gn[_h][_i] : gc[_h][_i];
            if (HOOK && t == 16) {
                const LAS float* ht = (const LAS float*)gtab;
#pragma unroll
                for (int a = 0; a < 2; ++a)
#pragma unroll
                    for (int m = 0; m < 4; ++m) { const float sc = ht[a * 128 + wr * 64 + m * 16 + fr];
#pragma unroll
                        for (int b = 0; b < 2; ++b)
#pragma unroll
                            for (int n = 0; n < 2; ++n) acc[a][b][m][n] = acc[a][b][m][n] * sc; }
            }
            PG8_LDB(B0, 0, 0); PG8_SCHED; PG8_LDA(At, 0, 0); PG8_STAGE_A(PG8_SA(1, 1), cA, k1, 1, gc);
            PG8_WAIT_L(8); PG8_BAR; PG8_WAIT_L(0); PG8_MMA(0, 0, At, B0); PG8_BAR; PG8_SCHED;
            PG8_LDB(B1, 0, 1); PG8_STAGE(PG8_SB(0, 0), b2, voffB);
            PG8_BAR; PG8_WAIT_L(0); PG8_MMA(0, 1, At, B1); PG8_BAR;
            PG8_LDA(At, 0, 1); PG8_STAGE_A(PG8_SA(0, 0), a2, 0, 0, g2);
            PG8_BAR; PG8_WAIT_L(0); PG8_MMA(1, 0, At, B0); PG8_BAR; PG8_SCHED;
            PG8_STAGE(PG8_SB(0, 1), b2 + hstep, voffB);
            PG8_WAIT_V(6); PG8_BAR; PG8_MMA(1, 1, At, B1); PG8_BAR;
            PG8_LDB(B0, 1, 0); PG8_SCHED; PG8_LDA(At, 1, 0); PG8_STAGE_A(PG8_SA(0, 1), a2, 0, 1, g2);
            PG8_WAIT_L(8); PG8_BAR; PG8_WAIT_L(0); PG8_MMA(0, 0, At, B0); PG8_BAR; PG8_SCHED;
            PG8_LDB(B1, 1, 1); PG8_STAGE(PG8_SB(1, 0), b3, voffB);
            PG8_BAR; PG8_WAIT_L(0); PG8_MMA(0, 1, At, B1); PG8_BAR;
            PG8_LDA(At, 1, 1); PG8_STAGE_A(PG8_SA(1, 0), a3, 0, 0, g2);
            PG8_BAR; PG8_WAIT_L(0); PG8_MMA(1, 0, At, B0); PG8_BAR; PG8_SCHED;
            PG8_STAGE(PG8_SB(1, 1), b3 + hstep, voffB);
            PG8_WAIT_V(6); PG8_BAR; PG8_MMA(1, 1, At, B1); PG8_BAR;
        }
        E(acc, cur, wr, wc, fr, fq, lds);
        if (!has_next) break;
#pragma unroll
        for (int a = 0; a < 2; ++a)
#pragma unroll
            for (int b = 0; b < 2; ++b)
#pragma unroll
                for (int m = 0; m < 4; ++m)
#pragma unroll
                    for (int n = 0; n < 2; ++n) acc[a][b][m][n] = (f32x4){0.f, 0.f, 0.f, 0.f};
        cur = nxt; cA = nA; cB = nB; ++ui;
#pragma unroll
        for (int _h = 0; _h < 2; ++_h)
#pragma unroll
            for (int _i = 0; _i < 2; ++_i) gc[_h][_i] = gn[_h][_i];
    }
    PG8_WAIT_V(0);
    if (wr == 0) PG8_BAR;
    PG8_BAR;
#undef PG8_SA
#undef PG8_SB
#undef PG8_STAGE
#undef PG8_STAGE_A
#undef PG8_LDA
#undef PG8_LDB
#undef PG8_MMA
#undef PG8_LD2
#undef PG8_WAIT_V
#undef PG8_WAIT_L
#undef PG8_BAR
#undef PG8_SCHED
#undef PG8_GLOAD
}

struct OrderMN {
    int nM, nN, nwg, G, c; const char* A; const char* Bt; size_t tstep;
    __device__ __forceinline__ void init(const void* A_, const void* Bt_, int M, int N, int K, int G_, int c_) { nM = M / BM; nN = N / BM; nwg = nM * nN; G = G_; c = c_; A = (const char*)A_; Bt = (const char*)Bt_; tstep = (size_t)BM * K * 2; }
    __device__ __forceinline__ bool next(int i, Unit& u) const {
        if (c >= G) return false;
        const long L = (long)i * G + c; if (L >= nwg) return false;
        int wgid = (int)L; { const int q = nwg / NXCD, r = nwg % NXCD, xcd = wgid % NXCD, off = wgid / NXCD; wgid = (xcd < r ? xcd * (q + 1) : r * (q + 1) + (xcd - r) * q) + off; }
        const int nig = WGM * nN, gid = wgid / nig, fm = gid * WGM, gsz = (nM - fm) < WGM ? (nM - fm) : WGM;
        u.pm = fm + ((wgid % nig) % gsz); u.pn = (wgid % nig) / gsz; u.e = 0; return true;
    }
    __device__ __forceinline__ const char* abase(const Unit& u) const { return A + (size_t)u.pm * tstep; }
    __device__ __forceinline__ const char* bbase(const Unit& u) const { return Bt + (size_t)u.pn * tstep; }
};
struct OrderExpert {
    int nN, ntile, G, c, per; const char* A; const char* Bt; size_t a_estride, b_estride, tstepA, tstepB; bool gather;
    __device__ __forceinline__ void init(const void* A_, const void* Bt_, int N, int K, size_t a_es, size_t b_es, bool gather_, int G_, int c_, int per_) {
        nN = N / BM; ntile = NEXP * nN; G = G_; c = c_; per = per_; A = (const char*)A_; Bt = (const char*)Bt_; a_estride = a_es; b_estride = b_es; tstepA = (size_t)BM * K * 2; tstepB = tstepA; gather = gather_; }
    __device__ __forceinline__ bool next(int i, Unit& u) const {
        int T, pm;
        if ((G & 7) == 0) {
            const int x = c & 7, j = c >> 3; if (j >= per) return false;
            const int q = i * per + j, U = 4 * nN; if (q >= 2 * U) return false;
            const int el = q >= U ? 1 : 0, r = q - el * U, chunk = r >> 5, w = r & 31;
            pm = w & 3; const int pn = chunk * 8 + (w >> 2);
            T = (2 * x + el) * nN + pn;
            if (pn >= nN) return false;
        }
        else { const int q = i * G + c; T = q >> 2; pm = q & 3; }
        if (T >= ntile) return false;
        u.e = T / nN; u.pn = T % nN; u.pm = pm; return true;
    }
    __device__ __forceinline__ const char* abase(const Unit& u) const { return gather ? A : A + (size_t)u.e * a_estride + (size_t)u.pm * tstepA; }
    __device__ __forceinline__ const char* bbase(const Unit& u) const { return Bt + (size_t)u.e * b_estride + (size_t)u.pn * tstepB; }
};
}

struct EpiInProj {
    static constexpr bool INIT = false;
    bf16_t* proj;
    __device__ __forceinline__ void operator()(const f32x4 (&acc)[2][2][4][2], const pg8::Unit& u, int wr, int wc, int fr, int fq, LAS unsigned char* lds) const {
        const int pn = u.pn, grp = pn >> 2;
        const int row0 = u.pm * 256 + wr * 64 + fr;
        if (grp == 5 || grp == 2) {
#pragma unroll
            for (int ai = 0; ai < 2; ++ai)
#pragma unroll
                for (int m = 0; m < 4; ++m) {
                    bf16_t* rowp = proj + (size_t)(row0 + ai * 128 + m * 16) * INC + pn * 256 + wc * 32 + 8 * fq;
#pragma unroll
                    for (int bj = 0; bj < 2; ++bj) { const f32x4 v0 = acc[ai][bj][m][0], v1 = acc[ai][bj][m][1];
                        u32x4 w; w.x = cvtpk(v0[0], v0[1]); w.y = cvtpk(v0[2], v0[3]); w.z = cvtpk(v1[0], v1[1]); w.w = cvtpk(v1[2], v1[3]);
                        *(u32x4*)(rowp + bj * 128) = w; }
                }
            return;
        }
        const int gsel = (grp == 0) ? 0 : (grp == 1) ? 1 : (grp == 3) ? 2 : 3;
        const LAS float* gain = (const LAS float*)(lds + SCR_OFF + 8192) + gsel * 128;
        const float osc = (grp == 0 || grp == 3) ? QSCALE : 1.0f;
        LAS float* Pt = (LAS float*)(lds + SCR_OFF);
#pragma unroll
        for (int ai = 0; ai < 2; ++ai)
#pragma unroll
            for (int m = 0; m < 4; ++m)
#pragma unroll
                for (int bj = 0; bj < 2; ++bj) {
                    const f32x4 v0 = acc[ai][bj][m][0], v1 = acc[ai][bj][m][1];
                    float s = (v0[0] * v0[0] + v0[1] * v0[1]) + (v0[2] * v0[2] + v0[3] * v0[3]) + (v1[0] * v1[0] + v1[1] * v1[1]) + (v1[2] * v1[2] + v1[3] * v1[3]);
                    s += __shfl_xor(s, 16); s += __shfl_xor(s, 32);
                    if (fq == 0) Pt[((ai * 128 + wr * 64 + m * 16 + fr) * 2 + bj) * 4 + wc] = s;
                }
        asm volatile("s_waitcnt lgkmcnt(0)" ::: "memory"); __builtin_amdgcn_s_barrier(); asm volatile("" ::: "memory");
        const f32x4 g0 = *(const LAS f32x4*)(gain + wc * 32 + 8 * fq), g1 = *(const LAS f32x4*)(gain + wc * 32 + 8 * fq + 4);
#pragma unroll
        for (int ai = 0; ai < 2; ++ai)
#pragma unroll
            for (int m = 0; m < 4; ++m) {
                bf16_t* rowp = proj + (size_t)(row0 + ai * 128 + m * 16) * INC + pn * 256 + wc * 32 + 8 * fq;
#pragma unroll
                for (int bj = 0; bj < 2; ++bj) {
                    const f32x4 ps = *(const LAS f32x4*)(Pt + ((ai * 128 + wr * 64 + m * 16 + fr) * 2 + bj) * 4);
                    const float rstd = rsqrtf(((ps[0] + ps[1]) + (ps[2] + ps[3])) * (1.0f / 128.0f) + RMS_EPS) * osc;
                    const f32x4 v0 = acc[ai][bj][m][0] * rstd * g0, v1 = acc[ai][bj][m][1] * rstd * g1;
                    u32x4 w; w.x = cvtpk(v0[0], v0[1]); w.y = cvtpk(v0[2], v0[3]); w.z = cvtpk(v1[0], v1[1]); w.w = cvtpk(v1[2], v1[3]);
                    *(u32x4*)(rowp + bj * 128) = w;
                }
            }
    }
};
struct EpiOutProj {
    static constexpr bool INIT = true;
    const float* x; bf16_t* x1b; float* rowss;
    __device__ __forceinline__ void init(f32x4 (&acc)[2][2][4][2], const pg8::Unit& u, int wr, int wc, int fr, int fq, const LAS unsigned* gtab) const {
        const LAS float* ht = (const LAS float*)gtab;
        const int row0 = u.pm * 256 + wr * 64 + fr, col0 = u.pn * 256 + wc * 32 + 8 * fq;
#pragma unroll
        for (int ai = 0; ai < 2; ++ai)
#pragma unroll
            for (int m = 0; m < 4; ++m) {
                const float isc = __builtin_amdgcn_rcpf(ht[ai * 128 + wr * 64 + m * 16 + fr]);
                const float* xp = x + (size_t)(row0 + ai * 128 + m * 16) * DM + col0;
#pragma unroll
                for (int bj = 0; bj < 2; ++bj)
#pragma unroll
                    for (int n = 0; n < 2; ++n) acc[ai][bj][m][n] = *(const f32x4*)(xp + bj * 128 + 4 * n) * isc;
            }
    }
    __device__ __forceinline__ void operator()(const f32x4 (&acc)[2][2][4][2], const pg8::Unit& u, int wr, int wc, int fr, int fq, LAS unsigned char* lds) const {
        const int row0 = u.pm * 256 + wr * 64 + fr, col0 = u.pn * 256 + wc * 32 + 8 * fq;
#pragma unroll
        for (int ai = 0; ai < 2; ++ai)
#pragma unroll
            for (int m = 0; m < 4; ++m) {
                const int row = row0 + ai * 128 + m * 16;
                bf16_t* op = x1b + (size_t)row * DM + col0;
                float s = 0.f;
#pragma unroll
                for (int bj = 0; bj < 2; ++bj) {
                    const f32x4 v0 = acc[ai][bj][m][0], v1 = acc[ai][bj][m][1];
                    u32x4 w; w.x = cvtpk(v0[0], v0[1]); w.y = cvtpk(v0[2], v0[3]); w.z = cvtpk(v1[0], v1[1]); w.w = cvtpk(v1[2], v1[3]);
                    *(u32x4*)(op + bj * 128) = w;
                    s += (v0[0] * v0[0] + v0[1] * v0[1]) + (v0[2] * v0[2] + v0[3] * v0[3]) + (v1[0] * v1[0] + v1[1] * v1[1]) + (v1[2] * v1[2] + v1[3] * v1[3]);
                }
                s += __shfl_xor(s, 16); s += __shfl_xor(s, 32);
                if (fq == 0) rowss[(size_t)row * 32 + u.pn * 4 + wc] = s;
            }
    }
};
struct EpiGateUp {
    static constexpr bool INIT = false;
    unsigned char* act;
    __device__ __forceinline__ void operator()(const f32x4 (&acc)[2][2][4][2], const pg8::Unit& u, int wr, int wc, int fr, int fq, LAS unsigned char* lds) const {
        const int row0 = u.pm * 256 + wr * 64 + fr;
        unsigned char* base = act + (size_t)u.e * EROWS * FF + u.pn * 128 + wc * 32 + 8 * fq;
        constexpr float DS = 1.0f / (WSC8 * HSC8);
#pragma unroll
        for (int ai = 0; ai < 2; ++ai)
#pragma unroll
            for (int m = 0; m < 4; ++m) {
                float r[8];
#pragma unroll
                for (int n = 0; n < 2; ++n)
#pragma unroll
                    for (int j = 0; j < 4; ++j) { const float g = acc[ai][0][m][n][j] * DS, uu = acc[ai][1][m][n][j] * DS;
                        const float a = g * __builtin_amdgcn_rcpf(1.0f + __builtin_amdgcn_exp2f(-g * LOG2E)) * uu * ASC8;
                        r[n * 4 + j] = fminf(fmaxf(a, -448.0f), 448.0f); }
                u32x2 w; w.x = cvt4_fp8(r[0], r[1], r[2], r[3]); w.y = cvt4_fp8(r[4], r[5], r[6], r[7]);
                *(u32x2*)(base + (size_t)(row0 + ai * 128 + m * 16) * FF) = w;
            }
    }
};
struct EpiDown {
    static constexpr bool INIT = false;
    unsigned char* y; const float* selgate;
    __device__ __forceinline__ void operator()(const f32x4 (&acc)[2][2][4][2], const pg8::Unit& u, int wr, int wc, int fr, int fq, LAS unsigned char* lds) const {
        const int row0 = u.pm * 256 + wr * 64 + fr;
        unsigned char* base = y + (size_t)u.e * EROWS * DM + u.pn * 256 + wc * 32 + 8 * fq;
#pragma unroll
        for (int ai = 0; ai < 2; ++ai)
#pragma unroll
            for (int m = 0; m < 4; ++m) {
                const int row = row0 + ai * 128 + m * 16;
                const float gt = selgate[u.e * EROWS + row] * (YSC8 / (WSC8 * ASC8));
#pragma unroll
                for (int bj = 0; bj < 2; ++bj) { const f32x4 v0 = acc[ai][bj][m][0] * gt, v1 = acc[ai][bj][m][1] * gt;
                    u32x2 w; w.x = cvt4_fp8(fminf(fmaxf(v0[0], -448.f), 448.f), fminf(fmaxf(v0[1], -448.f), 448.f), fminf(fmaxf(v0[2], -448.f), 448.f), fminf(fmaxf(v0[3], -448.f), 448.f));
                    w.y = cvt4_fp8(fminf(fmaxf(v1[0], -448.f), 448.f), fminf(fmaxf(v1[1], -448.f), 448.f), fminf(fmaxf(v1[2], -448.f), 448.f), fminf(fmaxf(v1[3], -448.f), 448.f));
                    *(u32x2*)(base + (size_t)row * DM + bj * 128) = w; }
            }
    }
};

#define KSWZ(row, colB) ((row) * 256 + ((colB) ^ (((row) & 7) << 4)))
#define SBAR() __builtin_amdgcn_sched_barrier(0)
__device__ __forceinline__ int crow(int r, int hi) { return (r & 3) + 8 * (r >> 2) + 4 * hi; }
#define PK4(P, BASE, OUT) do { unsigned a0 = cvtpk(P[BASE + 0], P[BASE + 1]), a1 = cvtpk(P[BASE + 2], P[BASE + 3]);   \
    unsigned b0 = cvtpk(P[BASE + 4], P[BASE + 5]), b1 = cvtpk(P[BASE + 6], P[BASE + 7]);                              \
    auto r0 = __builtin_amdgcn_permlane32_swap(a0, b0, false, false); auto r1 = __builtin_amdgcn_permlane32_swap(a1, b1, false, false); \
    u32x4 w = {r0[0], r1[0], r0[1], r1[1]}; OUT = *reinterpret_cast<bf16x8*>(&w); } while (0)
__device__ __forceinline__ float swap_add(float v) { auto rr = __builtin_amdgcn_permlane32_swap(__float_as_uint(v), __float_as_uint(v), false, false); return __uint_as_float(rr[0]) + __uint_as_float(rr[1]); }

namespace da {
constexpr int D = 128, NW = 8, QBLK = 32, KVBLK = 64;
constexpr int SHM_V = KVBLK * D * 2, SHM_K = KVBLK * D * 2, SHM_ATTN = 2 * SHM_V + 2 * SHM_K + NW * 64 * 4;
constexpr int LDP = INC;

__device__ __forceinline__ void qkt(f32x16& p0, f32x16& p1, const LAS unsigned char* Ks, const bf16x8* qr, int r32, int hi) {
    p0 = f32x16{}; p1 = f32x16{};
#pragma unroll
    for (int d0 = 0; d0 < 8; ++d0) { const int cb = (d0 * 16 + hi * 8) * 2;
        const bf16x8 b0 = *(const LAS bf16x8*)(Ks + KSWZ(r32, cb));
        const bf16x8 b1 = *(const LAS bf16x8*)(Ks + KSWZ(32 + r32, cb));
        p0 = __builtin_amdgcn_mfma_f32_32x32x16_bf16(b0, qr[d0], p0, 0, 0, 0);
        p1 = __builtin_amdgcn_mfma_f32_32x32x16_bf16(b1, qr[d0], p1, 0, 0, 0); }
}
__device__ __forceinline__ int v_st(int k, int c) { const int kk = (k & ~0xC) | ((k & 4) << 1) | ((k & 8) >> 1); return ((kk >> 3) * 4 + (c >> 5)) * 512 + ((kk & 7) * 32 + (c & 31)) * 2; }
__device__ __forceinline__ int v_rd_base(int lane) { return ((lane & 3) << 3) | (((lane >> 2) & 3) << 6) | (((lane >> 4) & 1) << 5) | (((lane >> 5) & 1) << 8); }
constexpr int v_rd_off(int d0, int ks, int half) { return d0 * 512 + ks * 4096 + half * 2048; }
template <int OFF> __device__ __forceinline__ s16x4 tr_read(int vb) {
    s16x4 r; asm volatile("ds_read_b64_tr_b16 %0, %1 offset:%2" : "=&v"(r) : "v"(vb), "i"(OFF) : "memory"); return r;
}
template <int D0> __device__ __forceinline__ void pv_one(f32x16& od, int vb, bf16x8 pa0, bf16x8 pa1, bf16x8 pa2, bf16x8 pa3) {
    const s16x4 l0 = tr_read<v_rd_off(D0, 0, 0)>(vb), h0 = tr_read<v_rd_off(D0, 0, 1)>(vb), l1 = tr_read<v_rd_off(D0, 1, 0)>(vb), h1 = tr_read<v_rd_off(D0, 1, 1)>(vb);
    const s16x4 l2 = tr_read<v_rd_off(D0, 2, 0)>(vb), h2 = tr_read<v_rd_off(D0, 2, 1)>(vb), l3 = tr_read<v_rd_off(D0, 3, 0)>(vb), h3 = tr_read<v_rd_off(D0, 3, 1)>(vb);
    asm volatile("s_waitcnt lgkmcnt(0)" ::: "memory"); SBAR();
#define PKV(L, H) (bf16x8){L[0], L[1], L[2], L[3], H[0], H[1], H[2], H[3]}
    od = __builtin_amdgcn_mfma_f32_32x32x16_bf16(pa0, PKV(l0, h0), od, 0, 0, 0);
    od = __builtin_amdgcn_mfma_f32_32x32x16_bf16(pa1, PKV(l1, h1), od, 0, 0, 0);
    od = __builtin_amdgcn_mfma_f32_32x32x16_bf16(pa2, PKV(l2, h2), od, 0, 0, 0);
    od = __builtin_amdgcn_mfma_f32_32x32x16_bf16(pa3, PKV(l3, h3), od, 0, 0, 0);
#undef PKV
}
__device__ __forceinline__ void pv_d0(f32x16* o, int vb, bf16x8 pa0, bf16x8 pa1, bf16x8 pa2, bf16x8 pa3) {
    pv_one<0>(o[0], vb, pa0, pa1, pa2, pa3); pv_one<1>(o[1], vb, pa0, pa1, pa2, pa3); pv_one<2>(o[2], vb, pa0, pa1, pa2, pa3); pv_one<3>(o[3], vb, pa0, pa1, pa2, pa3);
}
__device__ __forceinline__ void sm_a(f32x16& p0, f32x16& p1, float dq, float slope2) {
#pragma unroll
    for (int r = 0; r < 16; ++r) { const float c = (float)((r & 3) + 8 * (r >> 2)); p0[r] = __builtin_amdgcn_exp2f(p0[r] - slope2 * fabsf(dq - c)); }
#pragma unroll
    for (int r = 0; r < 16; ++r) { const float c = (float)((r & 3) + 8 * (r >> 2) + 32); p1[r] = p1[r] - slope2 * fabsf(dq - c); }
}
__device__ __forceinline__ void sm_b(f32x16& p0, f32x16& p1, float& l_reg, bf16x8& pa0, bf16x8& pa1, bf16x8& pa2, bf16x8& pa3) {
#pragma unroll
    for (int r = 0; r < 16; ++r) p1[r] = __builtin_amdgcn_exp2f(p1[r]);
    float ps = 0;
#pragma unroll
    for (int r = 0; r < 16; ++r) ps += p0[r];
#pragma unroll
    for (int r = 0; r < 16; ++r) ps += p1[r];
    l_reg += swap_add(ps);
    PK4(p0, 0, pa0); PK4(p0, 8, pa1); PK4(p1, 0, pa2); PK4(p1, 8, pa3);
}
__device__ __forceinline__ void attn_body(const bf16_t* __restrict__ Qb, const bf16_t* __restrict__ Kh, const bf16_t* __restrict__ Vh, float* __restrict__ Ob, int q0, float slope2, LAS unsigned char* lds) {
    const int tid = threadIdx.x, wid = tid >> 6, lane = tid & 63, r32 = lane & 31, hi = lane >> 5;
    LAS unsigned char* V_lds = lds; LAS unsigned char* K_lds = lds + 2 * SHM_V;
    LAS float* li_l = (LAS float*)(lds + 2 * SHM_V + 2 * SHM_K) + wid * 64;
    float l_reg = 0; f32x16 o[4] = {}; bf16x8 qr[8];
    const bf16_t* Qw = Qb + (size_t)(wid * QBLK + r32) * LDP + hi * 8;
#pragma unroll
    for (int d0 = 0; d0 < 8; ++d0) qr[d0] = *(const bf16x8*)(Qw + d0 * 16);
    const int sr = tid >> 4, sc = (tid & 15) * 8, vst0 = v_st(sr, sc), vst1 = v_st(32 + sr, sc);
    const int vb0 = (int)(uintptr_t)V_lds + v_rd_base(lane);
    const float dqbase = (float)(q0 + wid * QBLK + r32 - 4 * hi);
    struct { bf16x8 vs0, vs1, ks0, ks1; } sr_[1];
    const unsigned so0 = (unsigned)(sr * LDP + sc) * 2u, so1 = (unsigned)((32 + sr) * LDP + sc) * 2u;
#define SLOAD(i, k0) do { const char* vb_ = (const char*)Vh + (size_t)(k0) * (LDP * 2); const char* kb_ = (const char*)Kh + (size_t)(k0) * (LDP * 2); \
    sr_[i].vs0 = *(const bf16x8*)(vb_ + so0); sr_[i].vs1 = *(const bf16x8*)(vb_ + so1); \
    sr_[i].ks0 = *(const bf16x8*)(kb_ + so0); sr_[i].ks1 = *(const bf16x8*)(kb_ + so1); } while (0)
#define SWRITE(b, i) do { *(LAS bf16x8*)(V_lds + (b) * SHM_V + vst0) = sr_[i].vs0;          \
    *(LAS bf16x8*)(V_lds + (b) * SHM_V + vst1) = sr_[i].vs1; const int kc = sc * 2;               \
    *(LAS bf16x8*)(K_lds + (b) * SHM_K + KSWZ(sr, kc)) = sr_[i].ks0;                       \
    *(LAS bf16x8*)(K_lds + (b) * SHM_K + KSWZ(32 + sr, kc)) = sr_[i].ks1; } while (0)
#define SWAIT() asm volatile("s_waitcnt vmcnt(0)" ::: "memory")
    f32x16 pA0, pA1, pB0, pB1; bf16x8 pa0, pa1, pa2, pa3; constexpr int NT = SEQ / KVBLK;
    SLOAD(0, 0); SWAIT(); SWRITE(0, 0); __syncthreads();
    qkt(pA0, pA1, K_lds, qr, r32, hi); sm_a(pA0, pA1, dqbase, slope2);
    SLOAD(0, KVBLK);
    SWAIT(); SWRITE(1, 0); __syncthreads();
    for (int j = 1; j + 1 < NT; j += 2) {
        SBAR(); qkt(pB0, pB1, K_lds + SHM_K, qr, r32, hi);
        sm_b(pA0, pA1, l_reg, pa0, pa1, pa2, pa3); SBAR();
        SLOAD(0, (j + 1) * KVBLK); SBAR();
        pv_d0(o, vb0, pa0, pa1, pa2, pa3); sm_a(pB0, pB1, dqbase - (float)(j * KVBLK), slope2);
        __syncthreads(); SWAIT(); SWRITE(0, 0);
        __syncthreads();
        SBAR(); qkt(pA0, pA1, K_lds, qr, r32, hi);
        sm_b(pB0, pB1, l_reg, pa0, pa1, pa2, pa3); SBAR();
        SLOAD(0, (j + 2) * KVBLK); SBAR();
        pv_d0(o, vb0 + SHM_V, pa0, pa1, pa2, pa3); sm_a(pA0, pA1, dqbase - (float)((j + 1) * KVBLK), slope2);
        __syncthreads(); SWAIT(); SWRITE(1, 0);
        __syncthreads();
    }
    SBAR(); qkt(pB0, pB1, K_lds + SHM_K, qr, r32, hi);
    sm_b(pA0, pA1, l_reg, pa0, pa1, pa2, pa3); SBAR();
    pv_d0(o, vb0, pa0, pa1, pa2, pa3); sm_a(pB0, pB1, dqbase - (float)((NT - 1) * KVBLK), slope2);
    __syncthreads();
    sm_b(pB0, pB1, l_reg, pa0, pa1, pa2, pa3); SBAR();
    pv_d0(o, vb0 + SHM_V, pa0, pa1, pa2, pa3);
    if (hi == 0) li_l[r32] = l_reg; asm volatile("s_waitcnt lgkmcnt(0)" ::: "memory");
    float rli[16];
#pragma unroll
    for (int r = 0; r < 16; ++r) rli[r] = __builtin_amdgcn_rcpf(li_l[crow(r, hi)]);
    float* Ow = Ob + (size_t)(wid * QBLK) * DM;
#pragma unroll
    for (int r = 0; r < 16; ++r) { const int orow = crow(r, hi);
#pragma unroll
        for (int d0 = 0; d0 < 4; ++d0) Ow[(size_t)orow * DM + d0 * 32 + r32] = o[d0][r] * rli[r]; }
    __syncthreads();
#undef SLOAD
#undef SWRITE
#undef SWAIT
}
}

namespace da2 {
constexpr int BUFB = 65536, KB = 16384;
__device__ __forceinline__ int v_rd_base(int lane) { return ((lane & 3) << 3) | (((lane >> 2) & 3) << 6) | (((lane >> 4) & 1) << 5) | (((lane >> 5) & 1) << 8); }
template <int OFF> __device__ __forceinline__ s16x4 tr_read(int vb) {
    s16x4 r; asm volatile("ds_read_b64_tr_b16 %0, %1 offset:%2" : "=&v"(r) : "v"(vb), "i"(OFF) : "memory"); return r;
}
template <int NCB, int CB> __device__ __forceinline__ void pv_one(f32x16& od, int vb, bf16x8 pa0, bf16x8 pa1, bf16x8 pa2, bf16x8 pa3) {
    constexpr int S = NCB * 512;
    const s16x4 l0 = tr_read<CB * 512 + 0 * S>(vb), h0 = tr_read<CB * 512 + 1 * S>(vb), l1 = tr_read<CB * 512 + 2 * S>(vb), h1 = tr_read<CB * 512 + 3 * S>(vb);
    const s16x4 l2 = tr_read<CB * 512 + 4 * S>(vb), h2 = tr_read<CB * 512 + 5 * S>(vb), l3 = tr_read<CB * 512 + 6 * S>(vb), h3 = tr_read<CB * 512 + 7 * S>(vb);
    asm volatile("s_waitcnt lgkmcnt(0)" ::: "memory"); SBAR();
#define PKV(L, H) (bf16x8){L[0], L[1], L[2], L[3], H[0], H[1], H[2], H[3]}
    od = __builtin_amdgcn_mfma_f32_32x32x16_bf16(pa0, PKV(l0, h0), od, 0, 0, 0);
    od = __builtin_amdgcn_mfma_f32_32x32x16_bf16(pa1, PKV(l1, h1), od, 0, 0, 0);
    od = __builtin_amdgcn_mfma_f32_32x32x16_bf16(pa2, PKV(l2, h2), od, 0, 0, 0);
    od = __builtin_amdgcn_mfma_f32_32x32x16_bf16(pa3, PKV(l3, h3), od, 0, 0, 0);
#undef PKV
}
__device__ __forceinline__ void qkt(f32x16& p0, f32x16& p1, const LAS unsigned char* Ks, const bf16x8* qr, int r32, int hi) {
    p0 = f32x16{}; p1 = f32x16{};
#pragma unroll
    for (int d0 = 0; d0 < 8; ++d0) { const int cb = (d0 * 16 + hi * 8) * 2;
        const bf16x8 b0 = *(const LAS bf16x8*)(Ks + KSWZ(r32, cb));
        const bf16x8 b1 = *(const LAS bf16x8*)(Ks + KSWZ(32 + r32, cb));
        p0 = __builtin_amdgcn_mfma_f32_32x32x16_bf16(b0, qr[d0], p0, 0, 0, 0);
        p1 = __builtin_amdgcn_mfma_f32_32x32x16_bf16(b1, qr[d0], p1, 0, 0, 0); }
}
__device__ __forceinline__ int unswap23(int kk) { return (kk & ~0xC) | ((kk & 4) << 1) | ((kk & 8) >> 1); }

__device__ __forceinline__ void epilogue(const Params& P, LAS unsigned char* lds, f32x16 (&o)[8], float l_reg, int tz, int it) {
    const int wid = __builtin_amdgcn_readfirstlane(tz >> 6), lane = tz & 63, r32 = lane & 31, hi = lane >> 5;
    float lam;
    { float a = P.lam_q1[lane] * P.lam_k1[lane] + P.lam_q1[lane + 64] * P.lam_k1[lane + 64];
      float c = P.lam_q2[lane] * P.lam_k2[lane] + P.lam_q2[lane + 64] * P.lam_k2[lane + 64];
      a = wave_sum(a); c = wave_sum(c); lam = expf(a) - expf(c) + 0.2f; }
    const int br = wid >> 2, w4 = wid & 3;
    const int b = it >> 7, h = (it >> 5) & 3, qt = it & 31;
    const size_t row0 = (size_t)b * SEQ; const int q0 = qt * 128;
    LAS float* li_l = (LAS float*)(lds + SCR_OFF) + wid * 32;
    if (hi == 0) li_l[r32] = l_reg;
    asm volatile("s_waitcnt lgkmcnt(0)" ::: "memory");
    __syncthreads();
    LAS float* X = (LAS float*)lds + w4 * 8192;
    if (br == 1) {
#pragma unroll
        for (int r = 0; r < 16; ++r) { const float rl = __builtin_amdgcn_rcpf(li_l[crow(r, hi)]);
#pragma unroll
            for (int d = 0; d < 8; ++d) X[(r * 8 + d) * 64 + lane] = o[d][r] * rl; }
    }
    __syncthreads();
    if (br == 0) {
        LAS unsigned char* T = (LAS unsigned char*)X;
        float g[8];
#pragma unroll
        for (int d = 0; d < 8; ++d) g[d] = P.subln_b[d * 32 + r32];
#pragma unroll
        for (int r = 0; r < 16; ++r) {
            const float rl = __builtin_amdgcn_rcpf(li_l[crow(r, hi)]);
            float v[8], sq = 0.f;
#pragma unroll
            for (int d = 0; d < 8; ++d) { v[d] = o[d][r] * rl - lam * X[(r * 8 + d) * 64 + lane]; sq += v[d] * v[d]; }
#pragma unroll
            for (int sh = 16; sh >= 1; sh >>= 1) sq += __shfl_xor(sq, sh);
            const float rstd = rsqrtf(sq * (1.0f / 256.0f) + RMS_EPS) * 0.8f;
#pragma unroll
            for (int d = 0; d < 8; ++d) { const unsigned w = cvtpk(v[d] * rstd * g[d], 0.f); *(LAS bf16_t*)(T + (2 * r + hi) * 512 + (d * 32 + r32) * 2) = (bf16_t)(w & 0xffffu); }
        }
        asm volatile("s_waitcnt lgkmcnt(0)" ::: "memory");
        char* mixb = (char*)((bf16_t*)(P.ws + WS_MIX) + (row0 + q0 + w4 * 32) * DM + 1024 + h * 256);
        const unsigned loff = (unsigned)(hi * 4 * DM * 2 + r32 * 16);
#pragma unroll
        for (int i = 0; i < 16; ++i) {
            const u32x4 w = *(const LAS u32x4*)(T + (2 * i + hi) * 512 + r32 * 16);
            *(u32x4*)(mixb + (size_t)((i & 3) + 8 * (i >> 2)) * (DM * 2) + loff) = w;
        }
    }
    __syncthreads();
}
__device__ __forceinline__ void item(const Params& P, int it, LAS unsigned char* lds) {
    int tid = threadIdx.x; asm volatile("" : "+v"(tid));
    const int wid = __builtin_amdgcn_readfirstlane(tid >> 6), lane = tid & 63, r32 = lane & 31, hi = lane >> 5;
    const int br = wid >> 2, w4 = wid & 3;
    const int b = it >> 7, h = (it >> 5) & 3, qt = it & 31;
    const bf16_t* proj = (const bf16_t*)(P.ws + WS_PROJ);
    const size_t row0 = (size_t)b * SEQ; const int q0 = qt * 128;
    bf16x8 qr[8];
    { const bf16_t* Qw = proj + (row0 + q0 + w4 * 32 + r32) * INC + 3072 + br * 512 + h * 128 + hi * 8;
#pragma unroll
      for (int d0 = 0; d0 < 8; ++d0) qr[d0] = *(const bf16x8*)(Qw + d0 * 16); }
    const char* kbase = (const char*)(proj + row0 * INC + 4096 + h * 128);
    const char* vbase = (const char*)(proj + row0 * INC + 5120 + h * 256);
    const int krow = wid * 8 + (lane >> 4);
    const unsigned voffK0 = (unsigned)(krow * INC * 2 + (((lane & 15) ^ (lane >> 4)) << 4));
    const unsigned voffK1 = (unsigned)((krow + 4) * INC * 2 + (((lane & 15) ^ (4 + (lane >> 4))) << 4));
    const unsigned voffV = (unsigned)(unswap23(wid * 8 + ((lane & 31) >> 2)) * INC * 2 + (lane >> 5) * 64 + (lane & 3) * 16);
#define DA2_ISSUE(t, bufi) do { const char* kb_ = kbase + (size_t)(t) * (64 * INC * 2); const char* vb_ = vbase + (size_t)(t) * (64 * INC * 2); \
        LAS unsigned char* lb_ = lds + (bufi) * BUFB; \
        __builtin_amdgcn_global_load_lds((const unsigned*)(kb_ + voffK0), (LAS unsigned*)(lb_ + wid * 2048), 16, 0, 0); \
        __builtin_amdgcn_global_load_lds((const unsigned*)(kb_ + voffK1), (LAS unsigned*)(lb_ + wid * 2048 + 1024), 16, 0, 0); \
        __builtin_amdgcn_global_load_lds((const unsigned*)(kb_ + 1024 + voffK0), (LAS unsigned*)(lb_ + KB + wid * 2048), 16, 0, 0); \
        __builtin_amdgcn_global_load_lds((const unsigned*)(kb_ + 1024 + voffK1), (LAS unsigned*)(lb_ + KB + wid * 2048 + 1024), 16, 0, 0); \
        _Pragma("unroll") for (int i_ = 0; i_ < 4; ++i_) \
            __builtin_amdgcn_global_load_lds((const unsigned*)(vb_ + i_ * 128 + voffV), (LAS unsigned*)(lb_ + 2 * KB + wid * 4096 + i_ * 1024), 16, 0, 0); } while (0)
    const float slope2 = exp2f(-2.0f * (float)(h + 1)) * LOG2E;
    float dq = (float)(q0 + w4 * 32 + r32 - 4 * hi);
    f32x16 o[8];
#pragma unroll
    for (int d = 0; d < 8; ++d) o[d] = f32x16{};
    float l_reg = 0.f;
    const int vb0 = (int)(uintptr_t)(lds + 2 * KB) + v_rd_base(lane);
    DA2_ISSUE(0, 0);
#pragma unroll 1
    for (int j = 0; j < SEQ / 64; ++j) {
        asm volatile("s_waitcnt vmcnt(0)" ::: "memory");
        __builtin_amdgcn_s_barrier();
        asm volatile("" ::: "memory");
        if (j + 1 < SEQ / 64) DA2_ISSUE(j + 1, (j + 1) & 1);
        const LAS unsigned char* Kb = lds + (j & 1) * BUFB + br * KB;
        f32x16 p0, p1;
        qkt(p0, p1, Kb, qr, r32, hi);
        float ps = 0.f;
#pragma unroll
        for (int r = 0; r < 16; ++r) { const float c = (float)((r & 3) + 8 * (r >> 2)); p0[r] = __builtin_amdgcn_exp2f(p0[r] - slope2 * fabsf(dq - c)); ps += p0[r]; }
#pragma unroll
        for (int r = 0; r < 16; ++r) { const float c = (float)((r & 3) + 8 * (r >> 2) + 32); p1[r] = __builtin_amdgcn_exp2f(p1[r] - slope2 * fabsf(dq - c)); ps += p1[r]; }
        l_reg += swap_add(ps);
        bf16x8 pa0, pa1, pa2, pa3;
        PK4(p0, 0, pa0); PK4(p0, 8, pa1); PK4(p1, 0, pa2); PK4(p1, 8, pa3);
        const int vb = vb0 + (j & 1) * BUFB;
        pv_one<8, 0>(o[0], vb, pa0, pa1, pa2, pa3); pv_one<8, 1>(o[1], vb, pa0, pa1, pa2, pa3); pv_one<8, 2>(o[2], vb, pa0, pa1, pa2, pa3); pv_one<8, 3>(o[3], vb, pa0, pa1, pa2, pa3);
        pv_one<8, 4>(o[4], vb, pa0, pa1, pa2, pa3); pv_one<8, 5>(o[5], vb, pa0, pa1, pa2, pa3); pv_one<8, 6>(o[6], vb, pa0, pa1, pa2, pa3); pv_one<8, 7>(o[7], vb, pa0, pa1, pa2, pa3);
        dq -= 64.0f;
    }
#undef DA2_ISSUE
    int tz = threadIdx.x; asm volatile("" : "+v"(tz));
    epilogue(P, lds, o, l_reg, tz, it);
}
}

namespace da3 {
constexpr int BUFB = 65536, KB = 16384;
__device__ __forceinline__ void qk_softmax(const LAS unsigned char* Kb, const bf16x8* qr, int r32, int hi, float dq, float slope2, int rel  ,
                                           float& l_reg, bf16x8& pa0, bf16x8& pa1, bf16x8& pa2, bf16x8& pa3) {
    f32x16 p0, p1;
    if (rel != 0) {
        const float ss = rel < 0 ? slope2 : -slope2, A = -ss * dq;
#pragma unroll
        for (int r = 0; r < 16; ++r) { const float c = (float)((r & 3) + 8 * (r >> 2)); p0[r] = fmaf(ss, c, A); p1[r] = fmaf(ss, c + 32.0f, A); }
    } else {
#pragma unroll
        for (int r = 0; r < 16; ++r) { const float c = (float)((r & 3) + 8 * (r >> 2)); p0[r] = -slope2 * fabsf(dq - c); p1[r] = -slope2 * fabsf(dq - c - 32.0f); }
    }
#pragma unroll
    for (int d0 = 0; d0 < 8; ++d0) { const int cb = (d0 * 16 + hi * 8) * 2;
        const bf16x8 b0 = *(const LAS bf16x8*)(Kb + KSWZ(r32, cb));
        const bf16x8 b1 = *(const LAS bf16x8*)(Kb + KSWZ(32 + r32, cb));
        p0 = __builtin_amdgcn_mfma_f32_32x32x16_bf16(b0, qr[d0], p0, 0, 0, 0);
        p1 = __builtin_amdgcn_mfma_f32_32x32x16_bf16(b1, qr[d0], p1, 0, 0, 0); }
    f32x2 s2 = {0.f, 0.f};
#pragma unroll
    for (int r = 0; r < 16; r += 2) { p0[r] = __builtin_amdgcn_exp2f(p0[r]); p0[r + 1] = __builtin_amdgcn_exp2f(p0[r + 1]); s2 += (f32x2){p0[r], p0[r + 1]}; }
#pragma unroll
    for (int r = 0; r < 16; r += 2) { p1[r] = __builtin_amdgcn_exp2f(p1[r]); p1[r + 1] = __builtin_amdgcn_exp2f(p1[r + 1]); s2 += (f32x2){p1[r], p1[r + 1]}; }
    l_reg += swap_add(s2[0] + s2[1]);
    PK4(p0, 0, pa0); PK4(p0, 8, pa1); PK4(p1, 0, pa2); PK4(p1, 8, pa3);
}
struct VFrag { s16x4 l0, h0, l1, h1, l2, h2, l3, h3; };
template <int CB> __device__ __forceinline__ void vread(VFrag& f, int vb) {
    constexpr int S = 8 * 512;
    f.l0 = da2::tr_read<CB * 512 + 0 * S>(vb); f.h0 = da2::tr_read<CB * 512 + 1 * S>(vb); f.l1 = da2::tr_read<CB * 512 + 2 * S>(vb); f.h1 = da2::tr_read<CB * 512 + 3 * S>(vb);
    f.l2 = da2::tr_read<CB * 512 + 4 * S>(vb); f.h2 = da2::tr_read<CB * 512 + 5 * S>(vb); f.l3 = da2::tr_read<CB * 512 + 6 * S>(vb); f.h3 = da2::tr_read<CB * 512 + 7 * S>(vb);
}
__device__ __forceinline__ void vmma(f32x16& od, const VFrag& f, bf16x8 pa0, bf16x8 pa1, bf16x8 pa2, bf16x8 pa3) {
#define PKV(L, H) (bf16x8){L[0], L[1], L[2], L[3], H[0], H[1], H[2], H[3]}
    od = __builtin_amdgcn_mfma_f32_32x32x16_bf16(pa0, PKV(f.l0, f.h0), od, 0, 0, 0);
    od = __builtin_amdgcn_mfma_f32_32x32x16_bf16(pa1, PKV(f.l1, f.h1), od, 0, 0, 0);
    od = __builtin_amdgcn_mfma_f32_32x32x16_bf16(pa2, PKV(f.l2, f.h2), od, 0, 0, 0);
    od = __builtin_amdgcn_mfma_f32_32x32x16_bf16(pa3, PKV(f.l3, f.h3), od, 0, 0, 0);
#undef PKV
}
#define DA3_LW(n) do { asm volatile("s_waitcnt lgkmcnt(" #n ")" ::: "memory"); SBAR(); } while (0)
__device__ __forceinline__ void pv8(f32x16 (&o)[8], int vb, bf16x8 pa0, bf16x8 pa1, bf16x8 pa2, bf16x8 pa3) {
    VFrag fa, fb;
    vread<0>(fa, vb);
    vread<1>(fb, vb); DA3_LW(8); vmma(o[0], fa, pa0, pa1, pa2, pa3);
    vread<2>(fa, vb); DA3_LW(8); vmma(o[1], fb, pa0, pa1, pa2, pa3);
    vread<3>(fb, vb); DA3_LW(8); vmma(o[2], fa, pa0, pa1, pa2, pa3);
    vread<4>(fa, vb); DA3_LW(8); vmma(o[3], fb, pa0, pa1, pa2, pa3);
    vread<5>(fb, vb); DA3_LW(8); vmma(o[4], fa, pa0, pa1, pa2, pa3);
    vread<6>(fa, vb); DA3_LW(8); vmma(o[5], fb, pa0, pa1, pa2, pa3);
    vread<7>(fb, vb); DA3_LW(8); vmma(o[6], fa, pa0, pa1, pa2, pa3);
    DA3_LW(0); vmma(o[7], fb, pa0, pa1, pa2, pa3);
}
__device__ __forceinline__ void item(const Params& P, int it, LAS unsigned char* lds) {
    int tid = threadIdx.x; asm volatile("" : "+v"(tid));
    const int wid = __builtin_amdgcn_readfirstlane(tid >> 6), lane = tid & 63, r32 = lane & 31, hi = lane >> 5;
    const int br = wid >> 2, w4 = wid & 3;
    const int b = it >> 7, h = (it >> 5) & 3, qt = it & 31;
    const bf16_t* proj = (const bf16_t*)(P.ws + WS_PROJ);
    const size_t row0 = (size_t)b * SEQ; const int q0 = qt * 128;
    bf16x8 qr[8];
    { const bf16_t* Qw = proj + (row0 + q0 + w4 * 32 + r32) * INC + 3072 + br * 512 + h * 128 + hi * 8;
#pragma unroll
      for (int d0 = 0; d0 < 8; ++d0) qr[d0] = *(const bf16x8*)(Qw + d0 * 16); }
    const char* kbase = (const char*)(proj + row0 * INC + 4096 + br * 512 + h * 128);
    const char* vbase = (const char*)(proj + row0 * INC + 5120 + h * 256);
#define DA3_LANE() int lz_ = lane; asm volatile("" : "+v"(lz_)); const int krow_ = w4 * 16 + (lz_ >> 4)
#define DA3_ISSUE_K(t, bufi) do { DA3_LANE(); \
        const unsigned voffK0 = (unsigned)(krow_ * INC * 2 + (((lz_ & 15) ^ (lz_ >> 4)) << 4)); \
        const unsigned voffK1 = (unsigned)((krow_ + 4) * INC * 2 + (((lz_ & 15) ^ (4 + (lz_ >> 4))) << 4)); \
        const char* kb_ = kbase + (size_t)(t) * (64 * INC * 2); LAS unsigned char* lb_ = lds + (bufi) * BUFB + br * KB + w4 * 4096; \
        __builtin_amdgcn_global_load_lds((const unsigned*)(kb_ + voffK0), (LAS unsigned*)(lb_), 16, 0, 0); \
        __builtin_amdgcn_global_load_lds((const unsigned*)(kb_ + voffK1), (LAS unsigned*)(lb_ + 1024), 16, 0, 0); \
        __builtin_amdgcn_global_load_lds((const unsigned*)(kb_ + 8 * INC * 2 + voffK0), (LAS unsigned*)(lb_ + 2048), 16, 0, 0); \
        __builtin_amdgcn_global_load_lds((const unsigned*)(kb_ + 8 * INC * 2 + voffK1), (LAS unsigned*)(lb_ + 3072), 16, 0, 0); } while (0)
#define DA3_ISSUE_V(t, bufi) do { DA3_LANE(); (void)krow_; \
        const unsigned voffV = (unsigned)(da2::unswap23(wid * 8 + ((lz_ & 31) >> 2)) * INC * 2 + (lz_ >> 5) * 64 + (lz_ & 3) * 16); \
        const char* vb_ = vbase + (size_t)(t) * (64 * INC * 2); LAS unsigned char* lb_ = lds + (bufi) * BUFB + 2 * KB + wid * 4096; \
        _Pragma("unroll") for (int i_ = 0; i_ < 4; ++i_) \
            __builtin_amdgcn_global_load_lds((const unsigned*)(vb_ + i_ * 128 + voffV), (LAS unsigned*)(lb_ + i_ * 1024), 16, 0, 0); } while (0)
#define DA3_BAR() do { asm volatile("" ::: "memory"); __builtin_amdgcn_s_barrier(); asm volatile("" ::: "memory"); } while (0)
    const float slope2 = exp2f(-2.0f * (float)(h + 1)) * LOG2E;
    const int qlo = q0 + w4 * 32, jd = qlo >> 6;
    int jlo = 0, jhi = SEQ / 64 - 1;
    { float gq = fmaxf(fabsf(P.qn_b[lane]), fabsf(P.qn_b[lane + 64])), gk = fmaxf(fabsf(P.kn_b[lane]), fabsf(P.kn_b[lane + 64]));
#pragma unroll
      for (int o_ = 32; o_ >= 1; o_ >>= 1) { gq = fmaxf(gq, __shfl_xor(gq, o_)); gk = fmaxf(gk, __shfl_xor(gk, o_)); }
      const float smax = 128.0f * QSCALE * gq * gk, dmax = (160.0f + smax) / slope2;
      const int di = dmax < 8192.0f ? (int)dmax + 1 : 8192;
      const int klo = q0 - di, khi = q0 + 127 + di;
      jlo = __builtin_amdgcn_readfirstlane(klo <= 0 ? 0 : (klo >> 6)); jhi = __builtin_amdgcn_readfirstlane(khi >= SEQ - 1 ? SEQ / 64 - 1 : (khi >> 6)); }
    float dq = (float)(qlo + r32 - 4 * hi - 64 * jlo);
    f32x16 o[8];
#pragma unroll
    for (int d = 0; d < 8; ++d) o[d] = f32x16{};
    float l_reg = 0.f;
    const int vb0 = (int)(uintptr_t)(lds + 2 * KB) + da2::v_rd_base(lane);
    bf16x8 pa0, pa1, pa2, pa3;
    DA3_ISSUE_K(jlo, 0); DA3_ISSUE_V(jlo, 0);
    if (br == 0) {
        asm volatile("s_waitcnt vmcnt(4)" ::: "memory");
#pragma unroll 1
        for (int j = jlo; j <= jhi; ++j) {
            const int jn = (j + 1 <= jhi) ? j + 1 : jhi, bc = (j - jlo) & 1, bn = bc ^ 1;
            DA3_BAR();
            DA3_ISSUE_K(jn, bn);
            qk_softmax(lds + bc * BUFB, qr, r32, hi, dq, slope2, j - jd, l_reg, pa0, pa1, pa2, pa3);
            asm volatile("s_waitcnt vmcnt(4)" ::: "memory");
            DA3_BAR();
            DA3_ISSUE_V(jn, bn);
            pv8(o, vb0 + bc * BUFB, pa0, pa1, pa2, pa3);
            asm volatile("s_waitcnt vmcnt(4)" ::: "memory");
            dq -= 64.0f;
        }
        DA3_BAR();
    } else {
        DA3_BAR();
        asm volatile("s_waitcnt vmcnt(0)" ::: "memory");
#pragma unroll 1
        for (int j = jlo; j <= jhi; ++j) {
            const int jn = (j + 1 <= jhi) ? j + 1 : jhi, bc = (j - jlo) & 1, bn = bc ^ 1;
            DA3_BAR();
            DA3_ISSUE_K(jn, bn); DA3_ISSUE_V(jn, bn);
            qk_softmax(lds + bc * BUFB + KB, qr, r32, hi, dq, slope2, j - jd, l_reg, pa0, pa1, pa2, pa3);
            DA3_BAR();
            pv8(o, vb0 + bc * BUFB, pa0, pa1, pa2, pa3);
            asm volatile("s_waitcnt vmcnt(0)" ::: "memory");
            dq -= 64.0f;
        }
    }
#undef DA3_ISSUE_K
#undef DA3_LANE
#undef DA3_ISSUE_V
#undef DA3_BAR
    asm volatile("s_waitcnt vmcnt(0)" ::: "memory");
    int tz = threadIdx.x; asm volatile("" : "+v"(tz));
    da2::epilogue(P, lds, o, l_reg, tz, it);
}
}

namespace da5 {
constexpr int BUFB = 65536, KB = 16384;
typedef float f32x4v __attribute__((ext_vector_type(4)));
template <int OFF> __device__ __forceinline__ s16x4 trr(int a) { s16x4 r; asm volatile("ds_read_b64_tr_b16 %0, %1 offset:%2" : "=&v"(r) : "v"(a), "i"(OFF) : "memory"); return r; }
#define D5_LW(n) do { asm volatile("s_waitcnt lgkmcnt(" #n ")" ::: "memory"); SBAR(); } while (0)

__device__ __forceinline__ void qk_softmax(const LAS unsigned char* Kb, const bf16x8 (&qr)[4][2], int lane_, float dqb, float slope2, int rel, float (&l)[2], bf16x8 (&pa)[2][2]) {
    asm volatile("" : "+v"(lane_));
    const int l16 = lane_ & 15, g = lane_ >> 4;
    f32x4v S[4][2];
    if (rel != 0) {
        const float ss = rel < 0 ? slope2 : -slope2, A = -ss * dqb;
#pragma unroll
        for (int kg = 0; kg < 4; ++kg)
#pragma unroll
            for (int qg = 0; qg < 2; ++qg)
#pragma unroll
                for (int r = 0; r < 4; ++r) S[kg][qg][r] = fmaf(ss, (float)(16 * kg + r - 16 * qg), A);
    } else {
#pragma unroll
        for (int kg = 0; kg < 4; ++kg)
#pragma unroll
            for (int qg = 0; qg < 2; ++qg)
#pragma unroll
                for (int r = 0; r < 4; ++r) S[kg][qg][r] = -slope2 * fabsf(dqb - (float)(16 * kg + r - 16 * qg));
    }
    const int krow = l16 * 256, kx = (l16 & 7) << 4;
#pragma unroll
    for (int s = 0; s < 4; ++s) {
        const int ka = krow + ((64 * s + 16 * g) ^ kx);
        const bf16x8 k0 = *(const LAS bf16x8*)(Kb + ka), k1 = *(const LAS bf16x8*)(Kb + ka + 4096), k2 = *(const LAS bf16x8*)(Kb + ka + 8192), k3 = *(const LAS bf16x8*)(Kb + ka + 12288);
#pragma unroll
        for (int qg = 0; qg < 2; ++qg) {
            S[0][qg] = __builtin_amdgcn_mfma_f32_16x16x32_bf16(k0, qr[s][qg], S[0][qg], 0, 0, 0);
            S[1][qg] = __builtin_amdgcn_mfma_f32_16x16x32_bf16(k1, qr[s][qg], S[1][qg], 0, 0, 0);
            S[2][qg] = __builtin_amdgcn_mfma_f32_16x16x32_bf16(k2, qr[s][qg], S[2][qg], 0, 0, 0);
            S[3][qg] = __builtin_amdgcn_mfma_f32_16x16x32_bf16(k3, qr[s][qg], S[3][qg], 0, 0, 0);
        }
    }
#pragma unroll
    for (int qg = 0; qg < 2; ++qg) {
        f32x2 s2 = {0.f, 0.f};
#pragma unroll
        for (int kg = 0; kg < 4; ++kg) {
#pragma unroll
            for (int r = 0; r < 4; ++r) S[kg][qg][r] = __builtin_amdgcn_exp2f(S[kg][qg][r]);
            s2 += (f32x2){S[kg][qg][0], S[kg][qg][1]}; s2 += (f32x2){S[kg][qg][2], S[kg][qg][3]};
        }
        float ps = s2[0] + s2[1];
        ps += __shfl_xor(ps, 16); ps += __shfl_xor(ps, 32);
        l[qg] += ps;
#pragma unroll
        for (int ks = 0; ks < 2; ++ks) {
            u32x4 w; w.x = cvtpk(S[2 * ks][qg][0], S[2 * ks][qg][1]); w.y = cvtpk(S[2 * ks][qg][2], S[2 * ks][qg][3]);
            w.z = cvtpk(S[2 * ks + 1][qg][0], S[2 * ks + 1][qg][1]); w.w = cvtpk(S[2 * ks + 1][qg][2], S[2 * ks + 1][qg][3]);
            pa[qg][ks] = *reinterpret_cast<bf16x8*>(&w);
        }
    }
}
struct VF { s16x4 a0, a1, b0, b1; };
template <int HI> __device__ __forceinline__ void vread(VF& f, int a) {
    f.a0 = trr<HI * 256 + 0>(a); f.a1 = trr<HI * 256 + 8192>(a); f.b0 = trr<HI * 256 + 16384>(a); f.b1 = trr<HI * 256 + 24576>(a);
}
__device__ __forceinline__ void vmma(f32x4v& o0, f32x4v& o1, const VF& f, const bf16x8 (&pa)[2][2]) {
#define PKV(L, H) (bf16x8){L[0], L[1], L[2], L[3], H[0], H[1], H[2], H[3]}
    const bf16x8 v0 = PKV(f.a0, f.a1), v1 = PKV(f.b0, f.b1);
    o0 = __builtin_amdgcn_mfma_f32_16x16x32_bf16(pa[0][0], v0, o0, 0, 0, 0);
    o1 = __builtin_amdgcn_mfma_f32_16x16x32_bf16(pa[1][0], v0, o1, 0, 0, 0);
    o0 = __builtin_amdgcn_mfma_f32_16x16x32_bf16(pa[0][1], v1, o0, 0, 0, 0);
    o1 = __builtin_amdgcn_mfma_f32_16x16x32_bf16(pa[1][1], v1, o1, 0, 0, 0);
#undef PKV
}
__device__ __forceinline__ void pv16(f32x4v (&o)[2][16], int vbuf, int lane_, const bf16x8 (&pa)[2][2]) {
    asm volatile("" : "+v"(lane_));
    const int l16 = lane_ & 15, g = lane_ >> 4, q4 = l16 >> 2, p = l16 & 3;
    const int lb = (4 * g + q4) * 512 + ((4 * (g & 1) + q4) << 5) + 8 * p;
    VF fa, fb;
#define VA(vt) (vbuf + (lb ^ (((vt) & 7) << 5)))
    vread<0>(fa, VA(0));
    vread<0>(fb, VA(1)); D5_LW(4); vmma(o[0][0], o[1][0], fa, pa);
    vread<0>(fa, VA(2)); D5_LW(4); vmma(o[0][1], o[1][1], fb, pa);
    vread<0>(fb, VA(3)); D5_LW(4); vmma(o[0][2], o[1][2], fa, pa);
    vread<0>(fa, VA(4)); D5_LW(4); vmma(o[0][3], o[1][3], fb, pa);
    vread<0>(fb, VA(5)); D5_LW(4); vmma(o[0][4], o[1][4], fa, pa);
    vread<0>(fa, VA(6)); D5_LW(4); vmma(o[0][5], o[1][5], fb, pa);
    vread<0>(fb, VA(7)); D5_LW(4); vmma(o[0][6], o[1][6], fa, pa);
    vread<1>(fa, VA(8)); D5_LW(4); vmma(o[0][7], o[1][7], fb, pa);
    vread<1>(fb, VA(9)); D5_LW(4); vmma(o[0][8], o[1][8], fa, pa);
    vread<1>(fa, VA(10)); D5_LW(4); vmma(o[0][9], o[1][9], fb, pa);
    vread<1>(fb, VA(11)); D5_LW(4); vmma(o[0][10], o[1][10], fa, pa);
    vread<1>(fa, VA(12)); D5_LW(4); vmma(o[0][11], o[1][11], fb, pa);
    vread<1>(fb, VA(13)); D5_LW(4); vmma(o[0][12], o[1][12], fa, pa);
    vread<1>(fa, VA(14)); D5_LW(4); vmma(o[0][13], o[1][13], fb, pa);
    vread<1>(fb, VA(15)); D5_LW(4); vmma(o[0][14], o[1][14], fa, pa);
    D5_LW(0); vmma(o[0][15], o[1][15], fb, pa);
#undef VA
}
__device__ __forceinline__ void epilogue(const Params& P, LAS unsigned char* lds, f32x4v (&o)[2][16], const float (&l)[2], int tz, int it) {
    const int wid = __builtin_amdgcn_readfirstlane(tz >> 6), lane = tz & 63, l16 = lane & 15, g = lane >> 4;
    float lam;
    { float a = P.lam_q1[lane] * P.lam_k1[lane] + P.lam_q1[lane + 64] * P.lam_k1[lane + 64];
      float c = P.lam_q2[lane] * P.lam_k2[lane] + P.lam_q2[lane + 64] * P.lam_k2[lane + 64];
      a = wave_sum(a); c = wave_sum(c); lam = expf(a) - expf(c) + 0.2f; }
    const int br = wid >> 2, w4 = wid & 3;
    const int b = it >> 7, h = (it >> 5) & 3, qt = it & 31;
    const size_t row0 = (size_t)b * SEQ; const int q0 = qt * 128;
    LAS float* li_l = (LAS float*)(lds + SCR_OFF) + wid * 32;
    if (g == 0) { li_l[l16] = l[0]; li_l[16 + l16] = l[1]; }
    asm volatile("s_waitcnt lgkmcnt(0)" ::: "memory");
    __syncthreads();
    LAS float* X = (LAS float*)lds + w4 * 8192;
    if (br == 1) {
#pragma unroll
        for (int qg = 0; qg < 2; ++qg)
#pragma unroll
            for (int r = 0; r < 4; ++r) { const float rl = __builtin_amdgcn_rcpf(li_l[16 * qg + 4 * g + r]);
#pragma unroll
                for (int vt = 0; vt < 16; ++vt) X[((qg * 4 + r) * 16 + vt) * 64 + lane] = o[qg][vt][r] * rl; }
    }
    __syncthreads();
    if (br == 0) {
        LAS unsigned char* T = (LAS unsigned char*)X;
        float gw[16];
#pragma unroll
        for (int vt = 0; vt < 16; ++vt) gw[vt] = P.subln_b[16 * vt + l16];
#pragma unroll
        for (int qg = 0; qg < 2; ++qg)
#pragma unroll
            for (int r = 0; r < 4; ++r) {
                const int u = qg * 4 + r;
                const float rl = __builtin_amdgcn_rcpf(li_l[16 * qg + 4 * g + r]);
                float v[16], sq = 0.f;
#pragma unroll
                for (int vt = 0; vt < 16; ++vt) { v[vt] = o[qg][vt][r] * rl - lam * X[(u * 16 + vt) * 64 + lane]; sq += v[vt] * v[vt]; }
                sq += __shfl_xor(sq, 1); sq += __shfl_xor(sq, 2); sq += __shfl_xor(sq, 4); sq += __shfl_xor(sq, 8);
                const float rstd = rsqrtf(sq * (1.0f / 256.0f) + RMS_EPS) * 0.8f;
#pragma unroll
                for (int vt = 0; vt < 16; ++vt) { const unsigned w = cvtpk(v[vt] * rstd * gw[vt], 0.f); *(LAS bf16_t*)(T + (4 * u + g) * 512 + (16 * vt + l16) * 2) = (bf16_t)(w & 0xffffu); }
            }
        asm volatile("s_waitcnt lgkmcnt(0)" ::: "memory");
        char* mixb = (char*)((bf16_t*)(P.ws + WS_MIX) + (row0 + q0 + w4 * 32) * DM + 1024 + h * 256);
#pragma unroll
        for (int i = 0; i < 16; ++i) {
            const int ti = 2 * i + (lane >> 5), u = ti >> 2, gg = ti & 3, q = 16 * (u >> 2) + 4 * gg + (u & 3);
            const u32x4 w = *(const LAS u32x4*)(T + ti * 512 + (lane & 31) * 16);
            *(u32x4*)(mixb + (size_t)q * (DM * 2) + (lane & 31) * 16) = w;
        }
    }
    __syncthreads();
}
__device__ __forceinline__ void item(const Params& P, int it, LAS unsigned char* lds) {
    int tid = threadIdx.x; asm volatile("" : "+v"(tid));
    const int wid = __builtin_amdgcn_readfirstlane(tid >> 6), lane = tid & 63, l16 = lane & 15, g = lane >> 4;
    const int br = wid >> 2, w4 = wid & 3;
    const int b = it >> 7, h = (it >> 5) & 3, qt = it & 31;
    const bf16_t* proj = (const bf16_t*)(P.ws + WS_PROJ);
    const size_t row0 = (size_t)b * SEQ; const int q0 = qt * 128;
    bf16x8 qr[4][2];
    { const bf16_t* Qw = proj + (row0 + q0 + w4 * 32 + l16) * INC + 3072 + br * 512 + h * 128 + 8 * g;
#pragma unroll
      for (int s = 0; s < 4; ++s)
#pragma unroll
          for (int qg = 0; qg < 2; ++qg) qr[s][qg] = *(const bf16x8*)(Qw + (size_t)(16 * qg) * INC + 32 * s); }
    const char* kbase = (const char*)(proj + row0 * INC + 4096 + br * 512 + h * 128);
    const char* vbase = (const char*)(proj + row0 * INC + 5120 + h * 256);
#define D5_LANE() int lz_ = lane; asm volatile("" : "+v"(lz_))
#define D5_ISSUE_K(t, bufi) do { D5_LANE(); const int krow_ = w4 * 16 + (lz_ >> 4); \
        const unsigned voffK0 = (unsigned)(krow_ * INC * 2 + (((lz_ & 15) ^ (lz_ >> 4)) << 4)); \
        const unsigned voffK1 = (unsigned)((krow_ + 4) * INC * 2 + (((lz_ & 15) ^ (4 + (lz_ >> 4))) << 4)); \
        const char* kb_ = kbase + (size_t)(t) * (64 * INC * 2); LAS unsigned char* lb_ = lds + (bufi) * BUFB + br * KB + w4 * 4096; \
        __builtin_amdgcn_global_load_lds((const unsigned*)(kb_ + voffK0), (LAS unsigned*)(lb_), 16, 0, 0); \
        __builtin_amdgcn_global_load_lds((const unsigned*)(kb_ + voffK1), (LAS unsigned*)(lb_ + 1024), 16, 0, 0); \
        __builtin_amdgcn_global_load_lds((const unsigned*)(kb_ + 8 * INC * 2 + voffK0), (LAS unsigned*)(lb_ + 2048), 16, 0, 0); \
        __builtin_amdgcn_global_load_lds((const unsigned*)(kb_ + 8 * INC * 2 + voffK1), (LAS unsigned*)(lb_ + 3072), 16, 0, 0); } while (0)
#define D5_ISSUE_V(t, bufi) do { D5_LANE(); const char* vb_ = vbase + (size_t)(t) * (64 * INC * 2) + (size_t)(wid * 8) * (INC * 2); LAS unsigned char* lb_ = lds + (bufi) * BUFB + 2 * KB + wid * 4096; \
        _Pragma("unroll") for (int i_ = 0; i_ < 4; ++i_) { const int rr_ = 2 * i_ + (lz_ >> 5); \
            const unsigned vo_ = (unsigned)(rr_ * INC * 2 + (((lz_ & 31) ^ (rr_ << 1)) << 4)); \
            __builtin_amdgcn_global_load_lds((const unsigned*)(vb_ + vo_), (LAS unsigned*)(lb_ + i_ * 1024), 16, 0, 0); } } while (0)
#define D5_BAR() do { asm volatile("" ::: "memory"); __builtin_amdgcn_s_barrier(); asm volatile("" ::: "memory"); } while (0)
    const float slope2 = __int_as_float(__builtin_amdgcn_readfirstlane(__float_as_int(exp2f(-2.0f * (float)(h + 1)) * LOG2E)));
    const int qlo = q0 + w4 * 32, jd = qlo >> 6;
    int jlo = 0, jhi = SEQ / 64 - 1;
    { float gq = fmaxf(fabsf(P.qn_b[lane]), fabsf(P.qn_b[lane + 64])), gk = fmaxf(fabsf(P.kn_b[lane]), fabsf(P.kn_b[lane + 64]));
#pragma unroll
      for (int o_ = 32; o_ >= 1; o_ >>= 1) { gq = fmaxf(gq, __shfl_xor(gq, o_)); gk = fmaxf(gk, __shfl_xor(gk, o_)); }
      const float smax = 128.0f * QSCALE * gq * gk, dmax = (160.0f + smax) / slope2;
      const int di = dmax < 8192.0f ? (int)dmax + 1 : 8192;
      const int klo = q0 - di, khi = q0 + 127 + di;
      jlo = __builtin_amdgcn_readfirstlane(klo <= 0 ? 0 : (klo >> 6)); jhi = __builtin_amdgcn_readfirstlane(khi >= SEQ - 1 ? SEQ / 64 - 1 : (khi >> 6)); }
    float dqb = (float)(qlo + l16 - 4 * g - 64 * jlo);
    f32x4v o[2][16];
#pragma unroll
    for (int qg = 0; qg < 2; ++qg)
#pragma unroll
        for (int vt = 0; vt < 16; ++vt) o[qg][vt] = (f32x4v){0.f, 0.f, 0.f, 0.f};
    float l[2] = {0.f, 0.f};
    const int vbuf0 = (int)(uintptr_t)(lds + 2 * KB);
    bf16x8 pa[2][2];
    D5_ISSUE_K(jlo, 0); D5_ISSUE_V(jlo, 0);
    if (br == 0) {
        asm volatile("s_waitcnt vmcnt(4)" ::: "memory");
#pragma unroll 1
        for (int j = jlo; j <= jhi; ++j) {
            const int jn = (j + 1 <= jhi) ? j + 1 : jhi, bc = (j - jlo) & 1, bn = bc ^ 1;
            D5_BAR();
            D5_ISSUE_K(jn, bn);
            qk_softmax(lds + bc * BUFB, qr, lane, dqb, slope2, j - jd, l, pa);
            asm volatile("s_waitcnt vmcnt(4)" ::: "memory");
            D5_BAR();
            D5_ISSUE_V(jn, bn);
            pv16(o, vbuf0 + bc * BUFB, lane, pa);
            asm volatile("s_waitcnt vmcnt(4)" ::: "memory");
            dqb -= 64.0f;
        }
        D5_BAR();
    } else {
        D5_BAR();
        asm volatile("s_waitcnt vmcnt(0)" ::: "memory");
#pragma unroll 1
        for (int j = jlo; j <= jhi; ++j) {
            const int jn = (j + 1 <= jhi) ? j + 1 : jhi, bc = (j - jlo) & 1, bn = bc ^ 1;
            D5_BAR();
            D5_ISSUE_K(jn, bn); D5_ISSUE_V(jn, bn);
            qk_softmax(lds + bc * BUFB + KB, qr, lane, dqb, slope2, j - jd, l, pa);
            D5_BAR();
            pv16(o, vbuf0 + bc * BUFB, lane, pa);
            asm volatile("s_waitcnt vmcnt(0)" ::: "memory");
            dqb -= 64.0f;
        }
    }
#undef D5_ISSUE_K
#undef D5_ISSUE_V
#undef D5_BAR
#undef D5_LANE
    asm volatile("s_waitcnt vmcnt(0)" ::: "memory");
    int tz = threadIdx.x; asm volatile("" : "+v"(tz));
    epilogue(P, lds, o, l, tz, it);
}
#undef D5_LW
}

namespace na2 {
__device__ __forceinline__ void item(const Params& P, int it, LAS unsigned char* lds) {
    int tid = threadIdx.x; asm volatile("" : "+v"(tid));
    const int wid = __builtin_amdgcn_readfirstlane(tid >> 6), lane = tid & 63, r32 = lane & 31, hi = lane >> 5;
    const int b = it >> 7, h = (it >> 4) & 7, r0 = (it & 15) * 4;
    const int r = r0 + (wid >> 1), cq0 = (wid & 1) * 32;
    const bf16_t* proj = (const bf16_t*)(P.ws + WS_PROJ);
    LAS float* tab = (LAS float*)(lds + SCR_OFF);
    LAS float* li_l = (LAS float*)(lds + SCR_OFF + 2048) + wid * 32;
    for (int i = tid; i < 15 * 31; i += NTHR) tab[(i / 31) * 32 + (i % 31)] = P.rpb_a[h * 465 + i] * LOG2E;
    bf16x8 qr[8];
    { const bf16_t* Qw = proj + ((size_t)b * SEQ + r * 64 + cq0 + r32) * INC + h * 128 + hi * 8;
#pragma unroll
      for (int d0 = 0; d0 < 8; ++d0) qr[d0] = *(const bf16x8*)(Qw + d0 * 16); }
    int kr_lo = r0 - 4; kr_lo = kr_lo < 0 ? 0 : (kr_lo > 56 ? 56 : kr_lo);
    int kr_hi = r0 - 1; kr_hi = (kr_hi < 0 ? 0 : (kr_hi > 56 ? 56 : kr_hi)) + 7;
    int rs = r - 4; rs = rs < 0 ? 0 : (rs > 56 ? 56 : rs);
    const int cq = cq0 + r32; int cs = cq - 8; cs = cs < 0 ? 0 : (cs > 48 ? 48 : cs);
    const char* kbase = (const char*)(proj + (size_t)b * SEQ * INC + 1024 + h * 128);
    const char* vbase = (const char*)(proj + (size_t)b * SEQ * INC + 2048 + h * 128);
    const int krow = wid * 8 + (lane >> 4);
    const unsigned voffK0 = (unsigned)(krow * INC * 2 + (((lane & 15) ^ (lane >> 4)) << 4));
    const unsigned voffK1 = (unsigned)((krow + 4) * INC * 2 + (((lane & 15) ^ (4 + (lane >> 4))) << 4));
    const unsigned voffV = (unsigned)(da2::unswap23(wid * 8 + ((lane & 31) >> 2)) * INC * 2 + (lane >> 5) * 64 + (lane & 3) * 16);
#define NA2_ISSUE(kr, bufi) do { const char* kb_ = kbase + (size_t)(kr) * (64 * INC * 2); const char* vb_ = vbase + (size_t)(kr) * (64 * INC * 2); \
        LAS unsigned char* lb_ = lds + (bufi) * 32768; \
        __builtin_amdgcn_global_load_lds((const unsigned*)(kb_ + voffK0), (LAS unsigned*)(lb_ + wid * 2048), 16, 0, 0); \
        __builtin_amdgcn_global_load_lds((const unsigned*)(kb_ + voffK1), (LAS unsigned*)(lb_ + wid * 2048 + 1024), 16, 0, 0); \
        __builtin_amdgcn_global_load_lds((const unsigned*)(vb_ + voffV), (LAS unsigned*)(lb_ + 16384 + wid * 2048), 16, 0, 0); \
        __builtin_amdgcn_global_load_lds((const unsigned*)(vb_ + 128 + voffV), (LAS unsigned*)(lb_ + 16384 + wid * 2048 + 1024), 16, 0, 0); } while (0)
    f32x16 o[4];
#pragma unroll
    for (int d = 0; d < 4; ++d) o[d] = f32x16{};
    float l_reg = 0.f;
    const int vb0 = (int)(uintptr_t)(lds + 16384) + da2::v_rd_base(lane);
    NA2_ISSUE(kr_lo, 0);
#pragma unroll 1
    for (int kr = kr_lo; kr <= kr_hi; ++kr) {
        const int bi = (kr - kr_lo) & 1;
        asm volatile("s_waitcnt vmcnt(0) lgkmcnt(0)" ::: "memory");
        __builtin_amdgcn_s_barrier();
        asm volatile("" ::: "memory");
        if (kr < kr_hi) NA2_ISSUE(kr + 1, bi ^ 1);
        if (kr >= rs && kr < rs + 8) {
            f32x16 p0, p1;
            da2::qkt(p0, p1, lds + bi * 32768, qr, r32, hi);
            const LAS float* trow = tab + (kr - r + 7) * 32;
            float ps = 0.f;
#pragma unroll
            for (int rr = 0; rr < 16; ++rr) {
                const int ck = crow(rr, hi);
                { const int rel = ck - cq + 15; const bool valid = (ck >= cs) && (ck < cs + 16); const int idx = rel < 0 ? 0 : (rel > 30 ? 30 : rel);
                  const float v = valid ? __builtin_amdgcn_exp2f(p0[rr] + trow[idx]) : 0.f; p0[rr] = v; ps += v; }
                { const int ck1 = ck + 32; const int rel = ck1 - cq + 15; const bool valid = (ck1 >= cs) && (ck1 < cs + 16); const int idx = rel < 0 ? 0 : (rel > 30 ? 30 : rel);
                  const float v = valid ? __builtin_amdgcn_exp2f(p1[rr] + trow[idx]) : 0.f; p1[rr] = v; ps += v; }
            }
            l_reg += swap_add(ps);
            bf16x8 pa0, pa1, pa2, pa3;
            PK4(p0, 0, pa0); PK4(p0, 8, pa1); PK4(p1, 0, pa2); PK4(p1, 8, pa3);
            const int vb = vb0 + bi * 32768;
            da2::pv_one<4, 0>(o[0], vb, pa0, pa1, pa2, pa3); da2::pv_one<4, 1>(o[1], vb, pa0, pa1, pa2, pa3);
            da2::pv_one<4, 2>(o[2], vb, pa0, pa1, pa2, pa3); da2::pv_one<4, 3>(o[3], vb, pa0, pa1, pa2, pa3);
        }
    }
#undef NA2_ISSUE
    if (hi == 0) li_l[r32] = l_reg;
    asm volatile("s_waitcnt lgkmcnt(0)" ::: "memory");
    __syncthreads();
    LAS unsigned char* T = lds + wid * 8192;
    float* nassq = (float*)(P.ws + WS_NASSQ);
    const size_t t0 = (size_t)b * SEQ + r * 64 + cq0;
#pragma unroll
    for (int rr = 0; rr < 16; ++rr) {
        const float rl = __builtin_amdgcn_rcpf(li_l[crow(rr, hi)]);
        float sq = 0.f;
#pragma unroll
        for (int d = 0; d < 4; ++d) {
            const unsigned w = cvtpk(o[d][rr] * rl, 0.f); const float vq = __uint_as_float(w << 16);
            sq += vq * vq;
            *(LAS bf16_t*)(T + (2 * rr + hi) * 256 + (d * 32 + r32) * 2) = (bf16_t)(w & 0xffffu);
        }
#pragma unroll
        for (int sh = 16; sh >= 1; sh >>= 1) sq += __shfl_xor(sq, sh);
        if (r32 == 0) nassq[(t0 + crow(rr, hi)) * 8 + h] = sq;
    }
    asm volatile("s_waitcnt lgkmcnt(0)" ::: "memory");
    char* mixb = (char*)((bf16_t*)(P.ws + WS_MIX) + t0 * DM + h * 128);
#pragma unroll
    for (int i = 0; i < 8; ++i) {
        const int tr = i * 4 + (lane >> 4), rr2 = tr >> 1, h2 = tr & 1;
        const u32x4 w = *(const LAS u32x4*)(T + tr * 256 + (lane & 15) * 16);
        *(u32x4*)(mixb + (size_t)crow(rr2, h2) * (DM * 2) + (lane & 15) * 16) = w;
    }
    __syncthreads();
}
}

__device__ __forceinline__ void da_combine(const Params& P) {
    int tid = threadIdx.x; asm volatile("" : "+v"(tid)); const int wid = tid >> 6, lane = tid & 63;
    float a = P.lam_q1[lane] * P.lam_k1[lane] + P.lam_q1[lane + 64] * P.lam_k1[lane + 64];
    float c = P.lam_q2[lane] * P.lam_k2[lane] + P.lam_q2[lane + 64] * P.lam_k2[lane + 64];
    a = wave_sum(a); c = wave_sum(c);
    const float lam = expf(a) - expf(c) + 0.2f;
    const float* op = (const float*)(P.ws + WS_OPART);
    bf16_t* mix = (bf16_t*)(P.ws + WS_MIX);
    const f32x4 g = ((const f32x4*)P.subln_b)[lane];
    for (int it = blockIdx.x * 8 + wid; it < MTOK * 4; it += gridDim.x * 8) {
        const int tok = it >> 2, h = it & 3;
        const float* p = op + (size_t)tok * DM + h * 512;
        const f32x4 o1 = ((const f32x4*)p)[lane], o2 = ((const f32x4*)(p + 256))[lane];
        const f32x4 v = o1 - lam * o2;
        float ss = (v[0] * v[0] + v[1] * v[1]) + (v[2] * v[2] + v[3] * v[3]);
        ss = wave_sum(ss);
        const float rstd = rsqrtf(ss * (1.0f / 256.0f) + RMS_EPS) * 0.8f;
        u32x2 w; w.x = cvtpk(v[0] * rstd * g[0], v[1] * rstd * g[1]); w.y = cvtpk(v[2] * rstd * g[2], v[3] * rstd * g[3]);
        *(u32x2*)(mix + (size_t)tok * DM + 1024 + h * 256 + lane * 4) = w;
    }
}

__device__ __forceinline__ f32x4 ldx1(const bf16_t* p) { const u32x2 w = *(const u32x2*)p; return (f32x4){__uint_as_float(w.x << 16), __uint_as_float(w.x & 0xffff0000u), __uint_as_float(w.y << 16), __uint_as_float(w.y & 0xffff0000u)}; }
__device__ __forceinline__ void router_phase(const Params& P, LAS unsigned char* lds) {
    int tid = threadIdx.x; asm volatile("" : "+v"(tid)); const int wid = tid >> 6, lane = tid & 63;
    { const f32x4* src = (const f32x4*)(P.ws + WS_WRT);
#pragma unroll
      for (int i = 0; i < 16; ++i) *(LAS f32x4*)(lds + (size_t)(i * NTHR + tid) * 16) = src[i * NTHR + tid];
      __syncthreads(); }
    const LAS float* wl = (const LAS float*)lds;
    const bf16_t* x1b = (const bf16_t*)(P.ws + WS_OPART);
    const float* rowss = (const float*)(P.ws + WS_ROWSS);
    unsigned char* H2 = (unsigned char*)(P.ws + WS_H2);
    float* aff = (float*)(P.ws + WS_AFF);
    LAS float* red = (LAS float*)(lds + 131072) + wid * 64;
    for (int g4 = blockIdx.x * 8 + wid; g4 < MTOK / 4; g4 += gridDim.x * 8) {
        const int row0 = g4 * 4;
        f32x4 xa[4], xb[4];
#pragma unroll
        for (int t = 0; t < 4; ++t) { xa[t] = ldx1(x1b + (size_t)(row0 + t) * DM + (0 * 64 + lane) * 4); xb[t] = ldx1(x1b + (size_t)(row0 + t) * DM + (1 * 64 + lane) * 4); }
        float rstd[4];
#pragma unroll
        for (int t = 0; t < 4; ++t) { float s = (lane < 32) ? rowss[(size_t)(row0 + t) * 32 + lane] : 0.f; s = wave_sum(s); rstd[t] = rsqrtf(s * (1.0f / DM) + RMS_EPS); }
        float acc[64];
#pragma unroll
        for (int k = 0; k < 64; ++k) acc[k] = 0.f;
#pragma unroll
        for (int i = 0; i < 8; ++i) {
            const int c0 = (i * 64 + lane) * 4;
            const f32x4 g = *(const f32x4*)(P.ln2_g + c0);
            f32x4 hv[4];
#pragma unroll
            for (int t = 0; t < 4; ++t) {
                const f32x4 xc = (i & 1) ? xb[t] : xa[t];
                if (i + 2 < 8) { const f32x4 nx = ldx1(x1b + (size_t)(row0 + t) * DM + ((i + 2) * 64 + lane) * 4); if (i & 1) xb[t] = nx; else xa[t] = nx; }
                hv[t] = xc * rstd[t] * g;
                *(unsigned*)(H2 + (size_t)(row0 + t) * DM + c0) = cvt4_fp8(hv[t][0] * HSC8, hv[t][1] * HSC8, hv[t][2] * HSC8, hv[t][3] * HSC8);
            }
#pragma unroll
            for (int e = 0; e < 16; ++e) {
                const f32x4 w = *(const LAS f32x4*)(wl + e * DM + c0);
#pragma unroll
                for (int t = 0; t < 4; ++t) acc[t * 16 + e] += (hv[t][0] * w[0] + hv[t][1] * w[1]) + (hv[t][2] * w[2] + hv[t][3] * w[3]);
            }
        }
#pragma unroll
        for (int step = 0; step < 6; ++step) {
            const int m = 32 >> step, half = 32 >> step;
            const bool up = (lane & m) != 0;
#pragma unroll
            for (int k = 0; k < half; ++k) {
                const float keep = up ? acc[k + half] : acc[k], send = up ? acc[k] : acc[k + half];
                acc[k] = keep + __shfl_xor(send, m);
            }
        }
        red[lane] = acc[0];
        asm volatile("s_waitcnt lgkmcnt(0)" ::: "memory");
        if (lane < 4) {
            const int t = lane; float lg[16], mx = -1e30f;
#pragma unroll
            for (int e = 0; e < 16; ++e) { lg[e] = red[t * 16 + e]; mx = fmaxf(mx, lg[e]); }
            float sum = 0.f;
#pragma unroll
            for (int e = 0; e < 16; ++e) { lg[e] = expf(lg[e] - mx); sum += lg[e]; }
            const float inv = 1.0f / sum;
            const int row = row0 + t, bb = row >> 12, sq = row & 4095;
#pragma unroll
            for (int e = 0; e < 16; ++e) aff[((size_t)bb * 16 + e) * SEQ + sq] = lg[e] * inv;
        }
    }
}

__device__ __forceinline__ void topk_phase(const Params& P, LAS unsigned char* lds) {
    int tid = threadIdx.x; asm volatile("" : "+v"(tid)); const int wid = tid >> 6, lane = tid & 63;
    const float* aff = (const float*)(P.ws + WS_AFF);
    int* selidx = (int*)(P.ws + WS_SELIDX); float* selgate = (float*)(P.ws + WS_SELGATE); int* slot = (int*)(P.ws + WS_SLOT);
    LAS unsigned* red = (LAS unsigned*)lds;
    for (int it = blockIdx.x; it < NB * NEXP; it += gridDim.x) {
        const int b = it >> 4, e = it & 15;
        const float* ap = aff + (size_t)it * SEQ + tid * 8;
        const f32x4 a0 = *(const f32x4*)ap, a1 = *(const f32x4*)(ap + 4);
        unsigned v[8];
#pragma unroll
        for (int j = 0; j < 4; ++j) { v[j] = __float_as_uint(a0[j]); v[4 + j] = __float_as_uint(a1[j]); }
        LAS unsigned* hist = red + 64;
        unsigned T = 0u, pmask = 0u, needk = (unsigned)CAP;
#pragma unroll 1
        for (int pass = 0; pass < 4; ++pass) {
            const int shift = 24 - 8 * pass;
            if (tid < 256) hist[tid] = 0u;
            __syncthreads();
#pragma unroll
            for (int j = 0; j < 8; ++j) if ((v[j] & pmask) == T) atomicAdd((unsigned*)(hist + ((v[j] >> shift) & 255u)), 1u);
            __syncthreads();
            unsigned hv = 0, incl = 0;
            if (tid < 256) { hv = hist[255 - tid]; incl = hv;
#pragma unroll
                for (int o = 1; o < 64; o <<= 1) { const unsigned up = __shfl_up(incl, o); if (lane >= o) incl += up; }
                if (lane == 63) hist[260 + wid] = incl; }
            __syncthreads();
            if (tid < 256) {
                for (int w = 0; w < wid; ++w) incl += hist[260 + w];
                const unsigned sfx = incl - hv;
                if (sfx < needk && incl >= needk) { hist[256] = (unsigned)(255 - tid); hist[257] = needk - sfx; }
            }
            __syncthreads();
            T |= hist[256] << shift; pmask |= 255u << shift; needk = hist[257];
            __syncthreads();
        }
        unsigned g[8], q[8], gsum = 0, qsum = 0;
#pragma unroll
        for (int j = 0; j < 8; ++j) { g[j] = v[j] > T ? 1u : 0u; q[j] = v[j] == T ? 1u : 0u; gsum += g[j]; qsum += q[j]; }
        unsigned gi = gsum, qi = qsum;
#pragma unroll
        for (int o = 1; o < 64; o <<= 1) { const unsigned tg = __shfl_up(gi, o), tq = __shfl_up(qi, o); if (lane >= o) { gi += tg; qi += tq; } }
        LAS unsigned* sc = red + 32;
        __syncthreads();
        if (lane == 63) { sc[wid] = gi; sc[8 + wid] = qi; }
        __syncthreads();
        unsigned gbase = 0, qbase = 0, gtot = 0;
#pragma unroll
        for (int w = 0; w < 8; ++w) { const unsigned a = sc[w], c2 = sc[8 + w]; if (w < wid) { gbase += a; qbase += c2; } gtot += a; }
        unsigned G = gbase + gi - gsum, Q = qbase + qi - qsum;
        const unsigned need = (unsigned)CAP - gtot;
#pragma unroll
        for (int j = 0; j < 8; ++j) {
            const int tok = tid * 8 + j;
            const bool sel = g[j] || (q[j] && Q < need);
            const unsigned sl = G + (Q < need ? Q : need);
            if (sel) { selidx[e * EROWS + b * CAP + sl] = b * SEQ + tok; selgate[e * EROWS + b * CAP + sl] = __uint_as_float(v[j]); }
            slot[(size_t)it * SEQ + tok] = sel ? (int)sl : -1;
            G += g[j]; Q += q[j];
        }
        __syncthreads();
    }
}

__device__ __forceinline__ void combine_phase(const Params& P, const float ysc) {
    int tid = threadIdx.x; asm volatile("" : "+v"(tid)); const int wid = tid >> 6, lane = tid & 63;
    const int* slot = (const int*)(P.ws + WS_SLOT);
    const unsigned char* Y = (const unsigned char*)(P.ws + WS_Y);
    for (int row = blockIdx.x * 8 + wid; row < MTOK; row += gridDim.x * 8) {
        const int b = row >> 12, s = row & 4095;
        const int sl = (lane < 16) ? slot[((size_t)b * 16 + lane) * SEQ + s] : -1;
        unsigned long long mask = __ballot(sl >= 0);
        float* op = P.out + (size_t)row * DM;
        const bf16_t* xp = (const bf16_t*)(P.ws + WS_OPART) + (size_t)row * DM;
        f32x4 a[8];
#pragma unroll
        for (int i = 0; i < 4; ++i) { const u32x4 w = *(const u32x4*)(xp + i * 512 + lane * 8);
            a[2 * i] = (f32x4){__uint_as_float(w.x << 16), __uint_as_float(w.x & 0xffff0000u), __uint_as_float(w.y << 16), __uint_as_float(w.y & 0xffff0000u)};
            a[2 * i + 1] = (f32x4){__uint_as_float(w.z << 16), __uint_as_float(w.z & 0xffff0000u), __uint_as_float(w.w << 16), __uint_as_float(w.w & 0xffff0000u)}; }
        while (mask) {
            const int e = __builtin_ctzll(mask); mask &= mask - 1;
            const int se = __shfl(sl, e);
            const unsigned char* yp = Y + ((size_t)e * EROWS + b * CAP + se) * DM + lane * 8;
#pragma unroll
            for (int i = 0; i < 4; ++i) {
                const u32x2 w = *(const u32x2*)(yp + i * 512);
                const f32x2 p0 = __builtin_amdgcn_cvt_pk_f32_fp8((int)w.x, false), p1 = __builtin_amdgcn_cvt_pk_f32_fp8((int)w.x, true);
                const f32x2 p2 = __builtin_amdgcn_cvt_pk_f32_fp8((int)w.y, false), p3 = __builtin_amdgcn_cvt_pk_f32_fp8((int)w.y, true);
                a[2 * i] += (f32x4){p0[0], p0[1], p1[0], p1[1]} * (ysc * (1.0f / YSC8));
                a[2 * i + 1] += (f32x4){p2[0], p2[1], p3[0], p3[1]} * (ysc * (1.0f / YSC8));
            }
        }
#pragma unroll
        for (int i = 0; i < 4; ++i) { *(f32x4*)(op + i * 512 + lane * 8) = a[2 * i]; *(f32x4*)(op + i * 512 + lane * 8 + 4) = a[2 * i + 1]; }
    }
}

#ifndef P1_COMPUTE_WGS
#define P1_COMPUTE_WGS 160
#endif
#ifndef P7_PER_XCD
#define P7_PER_XCD 26
#endif
constexpr int N_PHASES = 10;
__global__ void __launch_bounds__(NTHR, 2) fwd_kernel(Params P) {
    extern __shared__ __attribute__((aligned(16))) unsigned char lds_raw[];
    LAS unsigned char* lds = (LAS unsigned char*)lds_raw;
    const int tid = threadIdx.x;
    volatile LAS unsigned* MISC = (volatile LAS unsigned*)(lds + MISC_OFF);
    if (tid < 16) MISC[tid] = 0u;
    __syncthreads();
    XcdBarrier bar; bar.bar = (unsigned*)(P.ws + WS_CTL); bar.x = 0; bar.st = nullptr;
#if MK_N_LAUNCHES == 1
    bar = xcd_barrier_post((unsigned*)(P.ws + WS_CTL), MISC);
#define GRID_BAR() xcd_barrier(bar)
#else
#define GRID_BAR() do { } while (0)
#endif
    const int lo = P.ph_lo, hi = P.ph_hi;
#ifndef PH_MASK
#define PH_MASK 0x3ff
#endif
#define IN(k) (((PH_MASK >> (k)) & 1) && lo <= (k) && (k) < hi)
#define BOTH(k) (IN(k) && IN((k) + 1))

#ifndef PROBE_DUP
#define PROBE_DUP -1
#endif
#define DUP(k) for (int rep_ = 0; rep_ < ((PROBE_DUP) == (k) ? 2 : 1); ++rep_)
    if (IN(0)) { DUP(0) { p0_prologue(P, lds); __syncthreads(); } if (BOTH(0)) GRID_BAR(); }

    if (IN(1)) {
        { LAS float* gl = (LAS float*)(lds + SCR_OFF + 8192);
          if (tid < 128) { gl[tid] = P.qn_a[tid]; gl[128 + tid] = P.kn_a[tid]; gl[256 + tid] = P.qn_b[tid]; gl[384 + tid] = P.kn_b[tid]; }
          __syncthreads(); }
        DUP(1) {
        pg8::OrderMN S; S.init(P.ws + WS_H, P.ws + WS_WIN, MTOK, INC, DM, P1_COMPUTE_WGS, blockIdx.x);
        EpiInProj E{(bf16_t*)(P.ws + WS_PROJ)};
        pg8::gemm_phase<false, false, false>(lds, DM, S, E, nullptr);
        }
        cvt_queue<2>(P, lds, (unsigned*)(P.ws + WS_CTL) + CW_QG); cvt_queue<3>(P, lds, (unsigned*)(P.ws + WS_CTL) + CW_QU);
        if (BOTH(1)) GRID_BAR();
    }

    if (IN(2)) {
        const bf16_t* proj = (const bf16_t*)(P.ws + WS_PROJ);
        float* opart = (float*)(P.ws + WS_OPART);
        const int da_it = (blockIdx.x & 7) * 32 + (blockIdx.x >> 3);
        DUP(2) {
        if (blockIdx.x < 256) da5::item(P, da_it, lds);
        }
        DUP(12) {
        if (blockIdx.x < 256 && ((da_it >> 5) & 3) == 0) {
            const int r64 = (da_it >> 7) * 32 + (da_it & 31);
#pragma unroll 1
            for (int k = 0; k < 4; ++k) na2::item(P, r64 * 4 + k, lds);
        }
        }
        if (BOTH(2)) GRID_BAR();
    }


    if (IN(4)) {
        DUP(4) {
        pg8::OrderMN S; S.init(P.ws + WS_MIX, P.ws + WS_WOUT, MTOK, DM, DM, gridDim.x, blockIdx.x);
        LAS float* ht = (LAS float*)(lds + SCR_OFF);
        { pg8::Unit u; if (S.next(0, u) && tid < 256) { const float* q = (const float*)(P.ws + WS_NASSQ) + (size_t)(u.pm * 256 + tid) * 8;
            const f32x4 a = *(const f32x4*)q, c = *(const f32x4*)(q + 4);
            ht[tid] = rsqrtf(((a[0] + a[1]) + (a[2] + a[3]) + (c[0] + c[1]) + (c[2] + c[3])) * (1.0f / 1024.0f) + RMS_EPS); } }
        __syncthreads();
        EpiOutProj E{P.x, (bf16_t*)(P.ws + WS_OPART), (float*)(P.ws + WS_ROWSS)};
        pg8::gemm_phase<false, true, false>(lds, DM, S, E, (const LAS unsigned*)ht);
        }
        if (BOTH(4)) GRID_BAR();
    }

    if (IN(5)) { DUP(5) { router_phase(P, lds); __syncthreads(); } if (BOTH(5)) GRID_BAR(); }

    if (IN(6)) { DUP(6) { topk_phase(P, lds); } if (BOTH(6)) GRID_BAR(); }

    if (IN(7)) {
        pg8::OrderExpert S; S.init(P.ws + WS_H2, P.ws + WS_WGU, 2 * FF, DM / 2, 0, (size_t)2 * FF * DM, true, gridDim.x, blockIdx.x, P7_PER_XCD);
        LAS unsigned* gtab = (LAS unsigned*)(lds + SCR_OFF);
        const int* selidx = (const int*)(P.ws + WS_SELIDX);
        { pg8::Unit u; for (int i = 0; i < 12 && S.next(i, u); ++i) { if (tid < 256) gtab[i * 256 + tid] = (unsigned)selidx[u.e * EROWS + u.pm * 256 + tid] * (unsigned)DM; } }
        __syncthreads();
        DUP(7) {
        EpiGateUp E{(unsigned char*)(P.ws + WS_ACT)};
        pg8::gemm_phase<true, false, true>(lds, DM / 2, S, E, gtab);
        }
        cvt_queue<4>(P, lds, (unsigned*)(P.ws + WS_CTL) + CW_QD);
        if (BOTH(7)) GRID_BAR();
    }

    if (IN(8)) {
        DUP(8) {
        pg8::OrderExpert S; S.init(P.ws + WS_ACT, P.ws + WS_WD, DM, FF / 2, (size_t)EROWS * FF, (size_t)DM * FF, false, gridDim.x, blockIdx.x, 32);
        EpiDown E{(unsigned char*)(P.ws + WS_Y), (const float*)(P.ws + WS_SELGATE)};
        pg8::gemm_phase<false, false, true>(lds, FF / 2, S, E, nullptr);
        }
        if (BOTH(8)) GRID_BAR();
    }

    if (IN(9)) { if (PROBE_DUP == 9) { combine_phase(P, 0.5f); __syncthreads(); combine_phase(P, 0.5f); } else combine_phase(P, 1.0f); }
#undef IN
#undef BOTH
}

extern "C" void kernel_launch(void* const* d_in, const int* in_sizes, int n_in, void* d_out, int out_size, void* d_ws, size_t ws_size, hipStream_t stream) {
    static int grid = 0;
    if (grid == 0) {
        if (n_in != 20 || out_size != MTOK * DM || ws_size < WS_END) { fprintf(stderr, "kernel_launch: unexpected shapes (n_in %d out %d ws %zu need %zu)\n", n_in, out_size, ws_size, (size_t)WS_END); grid = -1; return; }
        int dev = 0, cus = 0, per_cu = 0;
        if (hipGetDevice(&dev) != hipSuccess || hipDeviceGetAttribute(&cus, hipDeviceAttributeMultiprocessorCount, dev) != hipSuccess) { grid = -1; return; }
        if (hipFuncSetAttribute((const void*)fwd_kernel, hipFuncAttributeMaxDynamicSharedMemorySize, LDS_BYTES) != hipSuccess) { fprintf(stderr, "kernel_launch: hipFuncSetAttribute failed\n"); grid = -1; return; }
        if (hipOccupancyMaxActiveBlocksPerMultiprocessor(&per_cu, (const void*)fwd_kernel, NTHR, LDS_BYTES) != hipSuccess || per_cu < 1) fprintf(stderr, "kernel_launch: occupancy query reports %d\n", per_cu);
        (void)hipGetLastError();
        if (cus != 256) { fprintf(stderr, "kernel_launch: built for a 256-CU device, found %d\n", cus); grid = -1; return; }
        grid = cus;
    }
    if (grid < 0) return;
    hipMemsetAsync((char*)d_ws + WS_CTL, 0, CTL_BYTES, stream);
    Params p{};
    p.x = (const float*)d_in[0]; p.ln1_g = (const float*)d_in[1]; p.w_in = (const float*)d_in[2]; p.qn_a = (const float*)d_in[3]; p.kn_a = (const float*)d_in[4];
    p.rpb_a = (const float*)d_in[5]; p.on_a = (const float*)d_in[6]; p.qn_b = (const float*)d_in[7]; p.kn_b = (const float*)d_in[8];
    p.lam_q1 = (const float*)d_in[9]; p.lam_k1 = (const float*)d_in[10]; p.lam_q2 = (const float*)d_in[11]; p.lam_k2 = (const float*)d_in[12]; p.subln_b = (const float*)d_in[13];
    p.w_out = (const float*)d_in[14]; p.ln2_g = (const float*)d_in[15]; p.w_router = (const float*)d_in[16]; p.w_gate = (const float*)d_in[17]; p.w_up = (const float*)d_in[18]; p.w_down = (const float*)d_in[19];
    p.out = (float*)d_out; p.ws = (unsigned char*)d_ws;
#if MK_N_LAUNCHES == 1
    p.ph_lo = 0; p.ph_hi = N_PHASES;
    hipLaunchKernelGGL(fwd_kernel, dim3(grid), dim3(NTHR), LDS_BYTES, stream, p);
#else
#ifndef PROBE_LDUP
#define PROBE_LDUP -1
#endif
    for (int ph = 0; ph < N_PHASES; ++ph) { p.ph_lo = ph; p.ph_hi = ph + 1;
        for (int rep = 0; rep < ((ph == PROBE_LDUP && ph != 9) ? 2 : 1); ++rep) hipLaunchKernelGGL(fwd_kernel, dim3(grid), dim3(NTHR), LDS_BYTES, stream, p); }
#endif
    const hipError_t le = hipPeekAtLastError();
    if (le != hipSuccess) fprintf(stderr, "kernel_launch: launch failed: %s\n", hipGetErrorName(le));
}
```

```cpp
#include <hip/hip_runtime.h>
#include <stdint.h>
#include <stdio.h>

#ifndef MK_N_LAUNCHES
#define MK_N_LAUNCHES 1
#endif

#define LAS __attribute__((address_space(3)))
typedef unsigned short bf16_t;
typedef short bf16x8 __attribute__((ext_vector_type(8)));
typedef short s16x4 __attribute__((ext_vector_type(4)));
typedef float f32x4 __attribute__((ext_vector_type(4)));
typedef float f32x2 __attribute__((ext_vector_type(2)));
typedef float f32x16 __attribute__((ext_vector_type(16)));
typedef unsigned u32x4 __attribute__((ext_vector_type(4)));
typedef unsigned u32x2 __attribute__((ext_vector_type(2)));
typedef int i32x8 __attribute__((ext_vector_type(8)));
typedef int i32x4 __attribute__((ext_vector_type(4)));

constexpr int NB = 2, SEQ = 4096, DM = 2048, MTOK = NB * SEQ;
constexpr int INC = 6144;
constexpr int NEXP = 16, CAP = 512, FF = 2816, EROWS = NB * CAP;
constexpr float RMS_EPS = 1e-6f;
constexpr float LOG2E = 1.4426950408889634f;
constexpr float QSCALE = 0.088388347648318440f * LOG2E;
constexpr int NTHR = 512;

constexpr size_t al256(size_t x) { return (x + 255) / 256 * 256; }
constexpr size_t WS_CTL = 0, CTL_BYTES = 65536;
constexpr size_t WS_WIN = WS_CTL + CTL_BYTES;
constexpr size_t WS_WOUT = WS_WIN + (size_t)INC * DM * 2;
constexpr size_t WS_WGU = WS_WOUT + (size_t)DM * DM * 2;
constexpr size_t WS_WD = WS_WGU + (size_t)NEXP * 2 * FF * DM * 2;
constexpr size_t WS_H = WS_WD + (size_t)NEXP * DM * FF * 2;
constexpr size_t WS_PROJ = WS_H + (size_t)MTOK * DM * 2;
constexpr size_t WS_NASSQ = WS_PROJ + (size_t)MTOK * INC * 2;
constexpr size_t WS_MIX = WS_NASSQ + (size_t)MTOK * 1024 * 2;
constexpr size_t WS_OPART = WS_MIX + (size_t)MTOK * DM * 2;
constexpr size_t WS_ROWSS = WS_OPART + (size_t)MTOK * DM * 4;
constexpr size_t WS_AFF = WS_ROWSS + (size_t)MTOK * 32 * 4;
constexpr size_t WS_SELIDX = WS_AFF + (size_t)NB * NEXP * SEQ * 4;
constexpr size_t WS_SELGATE = WS_SELIDX + (size_t)NEXP * EROWS * 4;
constexpr size_t WS_SLOT = WS_SELGATE + (size_t)NEXP * EROWS * 4;
constexpr size_t WS_H2 = WS_SLOT + (size_t)NB * NEXP * SEQ * 4;
constexpr size_t WS_ACT = WS_H2 + (size_t)MTOK * DM * 2;
constexpr size_t WS_Y = WS_ACT + (size_t)NEXP * EROWS * FF * 2;
constexpr size_t WS_WRT = WS_Y + (size_t)NEXP * EROWS * DM * 2;
constexpr size_t WS_END = WS_WRT + (size_t)NEXP * DM * 4;

constexpr int STAGE_BYTES = 131072;
constexpr int SCR_OFF = STAGE_BYTES;
constexpr int SCR_BYTES = 16384;
constexpr int MISC_OFF = SCR_OFF + SCR_BYTES - 64;
constexpr int CVS_OFF = SCR_OFF + SCR_BYTES;
constexpr int LDS_BYTES = CVS_OFF + 16384;

__device__ __forceinline__ unsigned cvtpk(float lo, float hi) { unsigned r; asm volatile("v_cvt_pk_bf16_f32 %0, %1, %2" : "=v"(r) : "v"(lo), "v"(hi)); return r; }
__device__ __forceinline__ float wave_sum(float v) {
#pragma unroll
    for (int o = 32; o >= 1; o >>= 1) v += __shfl_xor(v, o);
    return v;
}
__device__ __forceinline__ unsigned cvt4_fp8(float a, float b, float c, float d) { int w = 0; w = __builtin_amdgcn_cvt_pk_fp8_f32(a, b, w, false); w = __builtin_amdgcn_cvt_pk_fp8_f32(c, d, w, true); return (unsigned)w; }
constexpr float WSC8 = 128.0f, HSC8 = 4.0f, ASC8 = 8.0f, YSC8 = 64.0f;
__device__ __forceinline__ float bf2f(bf16_t b) { return __uint_as_float(((unsigned)b) << 16); }

#define XB_TMO      128
#define XB_XCNT(j)  (256  + 64 * (j))
#define XB_XSUB(j)  (1280 + 64 * (j))
#define XB_XGEN(j)  (2304 + 64 * (j))
#define XB_TOP      3328
#define XB_TOPGEN   3392
#define XCD_BAR_WORDS 3456
#define XB_SPIN_CAP (1u << 18)

__device__ __forceinline__ unsigned xb_ld(unsigned* p)              { return __hip_atomic_load(p, __ATOMIC_RELAXED, __HIP_MEMORY_SCOPE_AGENT); }
__device__ __forceinline__ unsigned xb_add(unsigned* p, unsigned v) { return __hip_atomic_fetch_add(p, v, __ATOMIC_RELAXED, __HIP_MEMORY_SCOPE_AGENT); }
__device__ __forceinline__ unsigned xb_xcc_id() { return (unsigned)__builtin_amdgcn_s_getreg((3 << 11) | 20) & 0xFu; }
#define XB_SPIN(cond, bar) do { unsigned _sp = 0; while (cond) { __builtin_amdgcn_s_sleep(1); \
    if ((++_sp & 255u) == 0u) { if (xb_ld(&(bar)[XB_TMO])) break; if (_sp > XB_SPIN_CAP) { atomicAdd(&(bar)[XB_TMO], 1u); break; } } } } while (0)

struct XcdBarrier { unsigned* bar; unsigned x; volatile LAS unsigned* st; };

__device__ __forceinline__ XcdBarrier xcd_barrier_post(unsigned* bar, volatile LAS unsigned* st) {
    XcdBarrier b; b.bar = bar; b.x = xb_xcc_id(); b.st = st;
    if (threadIdx.x == 0) (void)xb_add(&bar[XB_XCNT(b.x)], 1u);
    return b;
}
__device__ __forceinline__ void xcd_barrier_complete(unsigned* bar, unsigned x, unsigned& nloc, unsigned& nx) {
    const unsigned G = gridDim.x * gridDim.y * gridDim.z;
    unsigned sum, cnt, mine, sp = 0u;
    for (;;) {
        sum = 0u; cnt = 0u; mine = 0u;
#pragma unroll
        for (unsigned j = 0; j < 16; ++j) { const unsigned c = xb_ld(&bar[XB_XCNT(j)]); sum += c; cnt += (c > 0u) ? 1u : 0u; mine = (j == x) ? c : mine; }
        if (sum == G) break;
        __builtin_amdgcn_s_sleep(1);
        if ((++sp & 255u) == 0u) { if (xb_ld(&bar[XB_TMO])) break; if (sp > XB_SPIN_CAP) { atomicAdd(&bar[XB_TMO], 1u); break; } }
    }
    nloc = mine > 0u ? mine : 1u; nx = cnt > 0u ? cnt : 1u;
}
__device__ __forceinline__ void xcd_barrier(const XcdBarrier& b) {
    asm volatile("s_waitcnt vmcnt(0)" ::: "memory");
    __syncthreads();
    if (threadIdx.x == 0) {
        unsigned* bar = b.bar;
        __builtin_amdgcn_s_waitcnt(0);
        unsigned nloc = b.st[0], nx = b.st[1];
        if (nloc == 0u) { xcd_barrier_complete(bar, b.x, nloc, nx); b.st[0] = nloc; b.st[1] = nx; }
        const unsigned old = xb_add(&bar[XB_XSUB(b.x)], 1u);
        const unsigned gen = old / nloc;
        if (old + 1u == (gen + 1u) * nloc) {
            __builtin_amdgcn_fence(__ATOMIC_RELEASE, "agent");
            asm volatile("s_waitcnt vmcnt(0)" ::: "memory");
            const unsigned og = xb_add(&bar[XB_TOP], 1u);
            const unsigned tg = og / nx;
            if (og + 1u == (tg + 1u) * nx) xb_add(&bar[XB_TOPGEN], 1u);
            else XB_SPIN(xb_ld(&bar[XB_TOPGEN]) == tg, bar);
            __builtin_amdgcn_fence(__ATOMIC_ACQUIRE, "agent");
            xb_add(&bar[XB_XGEN(b.x)], 1u);
            asm volatile("s_waitcnt vmcnt(0)" ::: "memory");
        } else {
            XB_SPIN(xb_ld(&bar[XB_XGEN(b.x)]) == gen, bar);
            __builtin_amdgcn_fence(__ATOMIC_ACQUIRE, "agent");
            asm volatile("s_waitcnt vmcnt(0)" ::: "memory");
        }
    }
    __syncthreads();
}

struct Params {
    const float* x; const float* ln1_g; const float* w_in; const float* qn_a; const float* kn_a; const float* rpb_a; const float* on_a;
    const float* qn_b; const float* kn_b; const float* lam_q1; const float* lam_k1; const float* lam_q2; const float* lam_k2; const float* subln_b;
    const float* w_out; const float* ln2_g; const float* w_router; const float* w_gate; const float* w_up; const float* w_down;
    float* out; unsigned char* ws; int ph_lo, ph_hi;
};

__device__ __forceinline__ void cvt_load(const float* __restrict__ src, int N, int k0, int n0, int tid, f32x4 (&v)[8], const float* kscale) {
    const int ln = tid & 63, kq = tid >> 6;
    const float* p = src + (size_t)(k0 + kq * 8) * N + n0 + ln * 4;
#pragma unroll
    for (int i = 0; i < 8; ++i) v[i] = __builtin_nontemporal_load((const f32x4*)(p + (size_t)i * N));
    if (kscale) {
#pragma unroll
        for (int i = 0; i < 8; ++i) v[i] = v[i] * kscale[k0 + kq * 8 + i];
    }
}
__device__ __forceinline__ void cvt_to_lds(LAS unsigned char* buf, int tid, const f32x4 (&v)[8]) {
    const int ln = tid & 63, kq = tid >> 6;
#pragma unroll
    for (int j = 0; j < 4; ++j) {
        u32x4 w; w.x = cvtpk(v[0][j], v[1][j]); w.y = cvtpk(v[2][j], v[3][j]); w.z = cvtpk(v[4][j], v[5][j]); w.w = cvtpk(v[6][j], v[7][j]);
        *(LAS u32x4*)(buf + (ln * 4 + j) * 144 + kq * 16) = w;
    }
}
__device__ __forceinline__ void cvt_store(const LAS unsigned char* buf, bf16_t* __restrict__ dst, int K, int k0, int n0, int blk, int off, int tid) {
#pragma unroll
    for (int q = 0; q < 4; ++q) {
        const int p = tid + q * 512, n = p >> 3, kp = p & 7, ng = n0 + n;
        const u32x4 w = *(const LAS u32x4*)(buf + n * 144 + kp * 16);
        const size_t drow = (size_t)(ng >> 7) * blk + off + (ng & 127);
        *(u32x4*)(dst + drow * K + k0 + kp * 8) = w;
    }
}
__device__ __forceinline__ void cvt_to_lds8(LAS unsigned char* buf, int tid, const f32x4 (&v)[8]) {
    const int ln = tid & 63, kq = tid >> 6, slot = (kq ^ (ln & 7)) * 8;
    f32x4 u[8];
#pragma unroll
    for (int i = 0; i < 8; ++i) u[i] = v[i] * WSC8;
#pragma unroll
    for (int j = 0; j < 4; ++j) {
        u32x2 w; w.x = cvt4_fp8(u[0][j], u[1][j], u[2][j], u[3][j]); w.y = cvt4_fp8(u[4][j], u[5][j], u[6][j], u[7][j]);
        *(LAS u32x2*)(buf + (ln * 4 + j) * 64 + slot) = w;
    }
}
__device__ __forceinline__ void cvt_store8(const LAS unsigned char* buf, unsigned char* __restrict__ dst, int Kb, int k0, int n0, int blk, int off, int tid) {
#pragma unroll
    for (int q = 0; q < 2; ++q) {
        const int p = tid + q * 512, n = p >> 2, kp = p & 3, ng = n0 + n, sw = (n >> 2) & 7;
        const u32x2 lo = *(const LAS u32x2*)(buf + n * 64 + ((2 * kp) ^ sw) * 8), hi = *(const LAS u32x2*)(buf + n * 64 + ((2 * kp + 1) ^ sw) * 8);
        const u32x4 w = {lo.x, lo.y, hi.x, hi.y};
        const size_t drow = (size_t)(ng >> 7) * blk + off + (ng & 127);
        __builtin_nontemporal_store(w, (u32x4*)(dst + drow * Kb + k0 + kp * 16));
    }
}
struct CvtTile { const float* src; bf16_t* dst; int K, N, k0, n0, blk, off; const float* kscale; int fp8; };
__device__ __forceinline__ void cvt_to_lds_any(LAS unsigned char* buf, int tid, const f32x4 (&v)[8], int fp8) { if (fp8) cvt_to_lds8(buf, tid, v); else cvt_to_lds(buf, tid, v); }
__device__ __forceinline__ void cvt_store_any(const LAS unsigned char* buf, const CvtTile& t, int tid) {
    if (t.fp8) cvt_store8(buf, (unsigned char*)t.dst, t.K, t.k0, t.n0, t.blk, t.off, tid); else cvt_store(buf, t.dst, t.K, t.k0, t.n0, t.blk, t.off, tid); }
template <int KIND> __device__ __forceinline__ constexpr int cvt_count() { return KIND == 0 ? 768 : KIND == 1 ? 256 : 16 * 352; }
template <int KIND> __device__ __forceinline__ CvtTile cvt_decode(const Params& P, int r) {
    CvtTile t; t.kscale = nullptr; t.fp8 = 0;
    if (KIND == 0) { t.src = P.w_in; t.dst = (bf16_t*)(P.ws + WS_WIN); t.K = DM; t.N = INC; t.k0 = (r / 24) * 64; t.n0 = (r % 24) * 256; t.blk = 128; t.off = 0; }
    else if (KIND == 1) { t.src = P.w_out; t.dst = (bf16_t*)(P.ws + WS_WOUT); t.K = DM; t.N = DM; t.k0 = (r / 8) * 64; t.n0 = (r % 8) * 256; t.blk = 128; t.off = 0; t.kscale = (t.k0 < 1024) ? P.on_a : nullptr; }
    else if (KIND == 2 || KIND == 3) { const int e = r / 352, q = r % 352;
        t.src = (KIND == 3 ? P.w_up : P.w_gate) + (size_t)e * DM * FF; t.dst = (bf16_t*)(P.ws + WS_WGU + (size_t)e * 2 * FF * DM);
        t.K = DM; t.N = FF; t.k0 = (q / 11) * 64; t.n0 = (q % 11) * 256; t.blk = 256; t.off = (KIND == 3) ? 128 : 0; t.fp8 = 1; }
    else { const int e = r / 352, q = r % 352;
        t.src = P.w_down + (size_t)e * FF * DM; t.dst = (bf16_t*)(P.ws + WS_WD + (size_t)e * DM * FF);
        t.K = FF; t.N = DM; t.k0 = (q / 8) * 64; t.n0 = (q % 8) * 256; t.blk = 128; t.off = 0; t.fp8 = 1; }
    return t;
}
constexpr int CW_QG = 4096, CW_QU = 4160, CW_QD = 4224;

template <int KIND> __device__ __forceinline__ void cvt_static(const Params& P, LAS unsigned char* lds) {
    const int tid = threadIdx.x, G = gridDim.x; constexpr int NT = cvt_count<KIND>();
    int idA = blockIdx.x, idB = blockIdx.x + G;
    f32x4 vA[8], vB[8];
    CvtTile tA = cvt_decode<KIND>(P, idA < NT ? idA : 0), tB = cvt_decode<KIND>(P, idB < NT ? idB : 0);
    if (idA < NT) cvt_load(tA.src, tA.N, tA.k0, tA.n0, tid, vA, tA.kscale);
    if (idB < NT) cvt_load(tB.src, tB.N, tB.k0, tB.n0, tid, vB, tB.kscale);
    for (;;) {
        if (idA >= NT) break;
        cvt_to_lds_any(lds, tid, vA, tA.fp8);
        { const int nid = idA + 2 * G; CvtTile tn = cvt_decode<KIND>(P, nid < NT ? nid : 0);
          if (nid < NT) cvt_load(tn.src, tn.N, tn.k0, tn.n0, tid, vA, tn.kscale);
          asm volatile("s_waitcnt lgkmcnt(0)" ::: "memory"); __builtin_amdgcn_s_barrier(); asm volatile("" ::: "memory");
          cvt_store_any(lds, tA, tid);
          tA = tn; idA = nid; }
        if (idB >= NT) break;
        cvt_to_lds_any(lds + 36864, tid, vB, tB.fp8);
        { const int nid = idB + 2 * G; CvtTile tn = cvt_decode<KIND>(P, nid < NT ? nid : 0);
          if (nid < NT) cvt_load(tn.src, tn.N, tn.k0, tn.n0, tid, vB, tn.kscale);
          asm volatile("s_waitcnt lgkmcnt(0)" ::: "memory"); __builtin_amdgcn_s_barrier(); asm volatile("" ::: "memory");
          cvt_store_any(lds + 36864, tB, tid);
          tB = tn; idB = nid; }
    }
}
__device__ __forceinline__ void p0_prologue(const Params& P, LAS unsigned char* lds) {
    int tid = threadIdx.x; asm volatile("" : "+v"(tid)); const int lane = tid & 63, wid = tid >> 6;
    {
        bf16_t* H = (bf16_t*)(P.ws + WS_H);
        for (int row = blockIdx.x * 8 + wid; row < MTOK; row += gridDim.x * 8) {
            const f32x4* xp = (const f32x4*)(P.x + (size_t)row * DM);
            f32x4 v[8]; float ss = 0.f;
#pragma unroll
            for (int i = 0; i < 8; ++i) { v[i] = xp[i * 64 + lane]; ss += v[i][0] * v[i][0] + v[i][1] * v[i][1] + v[i][2] * v[i][2] + v[i][3] * v[i][3]; }
            ss = wave_sum(ss);
            const float rstd = rsqrtf(ss * (1.0f / DM) + RMS_EPS);
#pragma unroll
            for (int i = 0; i < 8; ++i) {
                const f32x4 g = ((const f32x4*)P.ln1_g)[i * 64 + lane];
                u32x2 w; w.x = cvtpk(v[i][0] * rstd * g[0], v[i][1] * rstd * g[1]); w.y = cvtpk(v[i][2] * rstd * g[2], v[i][3] * rstd * g[3]);
                *(u32x2*)(H + (size_t)row * DM + (i * 64 + lane) * 4) = w;
            }
        }
    }
    cvt_static<0>(P, lds); __syncthreads(); cvt_static<1>(P, lds);
    { float* wrt = (float*)(P.ws + WS_WRT);
      for (int i = blockIdx.x * NTHR + tid; i < NEXP * DM; i += gridDim.x * NTHR) { const int e = i >> 11, c = i & 2047; wrt[i] = P.w_router[c * 16 + e]; } }
}
__device__ __forceinline__ void cvt_load_asm(const float* __restrict__ src, int N, int k0, int n0, int tid, f32x4 (&v)[8]) {
    const int ln = tid & 63, kq = tid >> 6;
    const float* p = src + (size_t)(k0 + kq * 8) * N + n0 + ln * 4;
#pragma unroll
    for (int i = 0; i < 8; ++i) { const float* q = p + (size_t)i * N; asm volatile("global_load_dwordx4 %0, %1, off nt" : "=v"(v[i]) : "v"(q) : "memory"); }
}
__device__ __forceinline__ void cvt_load_asm_s(const float* tile  , int N, unsigned voff, f32x4 (&v)[8]) {
#pragma unroll
    for (int i = 0; i < 8; ++i) { const float* q = tile + (size_t)i * N; asm volatile("global_load_dwordx4 %0, %1, %2 nt" : "=v"(v[i]) : "v"(voff), "s"(q) : "memory"); }
}
#define CVT_WAIT_SET(v, N) asm volatile("s_waitcnt vmcnt(" #N ")" : "+v"(v[0]), "+v"(v[1]), "+v"(v[2]), "+v"(v[3]), "+v"(v[4]), "+v"(v[5]), "+v"(v[6]), "+v"(v[7]) :: "memory")
struct CvtT { const float* src; unsigned char* dst; int N, Kb, k0, drow0; };
template <int KIND> __device__ __forceinline__ CvtT cvt_decode8(const Params& P, int r) {
    CvtT t; const int e = r / 352, q = r % 352;
    if (KIND == 2 || KIND == 3) { const int kt = q / 22, nt = q % 22;
        t.N = FF; t.Kb = DM; t.k0 = kt * 128; t.src = (KIND == 3 ? P.w_up : P.w_gate) + (size_t)e * DM * FF + (size_t)t.k0 * FF + nt * 128;
        t.dst = P.ws + WS_WGU + (size_t)e * 2 * FF * DM; t.drow0 = nt * 256 + (KIND == 3 ? 128 : 0); }
    else { const int kt = q / 16, nt = q % 16;
        t.N = DM; t.Kb = FF; t.k0 = kt * 128; t.src = P.w_down + (size_t)e * FF * DM + (size_t)t.k0 * DM + nt * 128;
        t.dst = P.ws + WS_WD + (size_t)e * DM * FF; t.drow0 = nt * 128; }
    return t;
}
template <int KIND> __device__ __forceinline__ void cvt_queue(const Params& P, LAS unsigned char* lds, unsigned* qhead) {
    int tid = threadIdx.x; asm volatile("" : "+v"(tid));
    const int wid = __builtin_amdgcn_readfirstlane(tid >> 6), lane = tid & 63, ln32 = lane & 31, kq = tid >> 5;
    constexpr unsigned n = (unsigned)cvt_count<KIND>(); constexpr unsigned CH = 4;
    LAS unsigned* slot = (LAS unsigned*)(lds + SCR_OFF + 12288);
    LAS unsigned char* stg = lds + CVS_OFF;
#define QCLAIM() __hip_atomic_fetch_add(qhead, CH, __ATOMIC_RELAXED, __HIP_MEMORY_SCOPE_AGENT)
    __syncthreads();
    if (tid == 0) { const unsigned s0 = QCLAIM(), s1 = QCLAIM(); slot[0] = s0; slot[1] = s1; }
    __syncthreads();
    unsigned cbase = slot[0], pos = 0, par = 1;
#define QGEN(dst) do { dst = cbase + pos; if (++pos == CH) { pos = 0; cbase = slot[par]; \
        if (tid == 0) { const unsigned nb_ = (cbase < n) ? QCLAIM() : 0xffffff00u; slot[par ^ 1] = nb_; } par ^= 1; } } while (0)
#define CVT_DMA(t, sl) do { const char* gb_ = (const char*)(t).src + (size_t)(wid * 16 + (lane >> 5)) * ((t).N * 4) + ln32 * 16; LAS unsigned char* lb_ = lds + (sl) * 65536 + wid * 8192; \
        _Pragma("unroll") for (int i_ = 0; i_ < 8; ++i_) __builtin_amdgcn_global_load_lds((const unsigned*)(gb_ + (size_t)(2 * i_) * ((t).N * 4)), (LAS unsigned*)(lb_ + i_ * 1024), 16, 0, 2); } while (0)
    unsigned id0, id1; QGEN(id0); QGEN(id1);
    id0 = __builtin_amdgcn_readfirstlane(id0); id1 = __builtin_amdgcn_readfirstlane(id1);
    CvtT tc = cvt_decode8<KIND>(P, id0 < n ? (int)id0 : 0), tn = cvt_decode8<KIND>(P, id1 < n ? (int)id1 : 0);
    CVT_DMA(tc, 0); CVT_DMA(tn, 1);
    unsigned idc = id0, idn = id1; int k = 0;
    while (idc < n) {
        const int sl = k & 1;
        if (k < 2) asm volatile("s_waitcnt vmcnt(0)" ::: "memory"); else asm volatile("s_waitcnt vmcnt(12)" ::: "memory");
        f32x4 v[8];
        { const LAS unsigned char* rb = lds + sl * 65536 + wid * 8192 + (lane >> 5) * 4096 + ln32 * 16;
#pragma unroll
          for (int i = 0; i < 8; ++i) v[i] = *(const LAS f32x4*)(rb + i * 512) * WSC8; }
        unsigned w8[4][2];
#pragma unroll
        for (int j = 0; j < 4; ++j) { w8[j][0] = cvt4_fp8(v[0][j], v[1][j], v[2][j], v[3][j]); w8[j][1] = cvt4_fp8(v[4][j], v[5][j], v[6][j], v[7][j]); }
        unsigned idx; QGEN(idx); idx = __builtin_amdgcn_readfirstlane(idx);
        const CvtT tx = cvt_decode8<KIND>(P, idx < n ? (int)idx : 0);
        asm volatile("s_waitcnt lgkmcnt(0)" ::: "memory");
        CVT_DMA(tx, sl);
        __builtin_amdgcn_s_barrier(); asm volatile("" ::: "memory");
#pragma unroll
        for (int j = 0; j < 4; ++j) { u32x2 w; w.x = w8[j][0]; w.y = w8[j][1]; *(LAS u32x2*)(stg + (ln32 * 4 + j) * 128 + ((kq ^ (ln32 & 15)) << 3)) = w; }
        asm volatile("s_waitcnt lgkmcnt(0)" ::: "memory"); __builtin_amdgcn_s_barrier(); asm volatile("" ::: "memory");
#pragma unroll
        for (int q = 0; q < 2; ++q) {
            const int p = tid + q * 512, nn = p >> 3, kp = p & 7, sw = (nn >> 2) & 15;
            const u32x2 lo = *(const LAS u32x2*)(stg + nn * 128 + (((2 * kp) ^ sw) << 3)), hi = *(const LAS u32x2*)(stg + nn * 128 + (((2 * kp + 1) ^ sw) << 3));
            const u32x4 w = {lo.x, lo.y, hi.x, hi.y};
            __builtin_nontemporal_store(w, (u32x4*)(tc.dst + (size_t)(tc.drow0 + nn) * tc.Kb + tc.k0 + kp * 16));
        }
        tc = tn; tn = tx; idc = idn; idn = idx; ++k;
    }
    asm volatile("s_waitcnt vmcnt(0)" ::: "memory");
#undef QCLAIM
#undef QGEN
#undef CVT_DMA
    __syncthreads();
}

namespace pg8 {
constexpr int BM = 256, BK = 64, HALF = 128, HTB = HALF * BK * 2, NXCD = 8, WGM = 8;
__device__ __forceinline__ int lds_byte(int r, int c) { const int st = (r >> 4) * 2 + (c >> 5), rr = r & 15, cc = c & 31, ob = rr * 64 + cc * 2; return st * 1024 + (ob ^ (((ob >> 9) & 1) << 5)); }
__device__ __forceinline__ void stage_rc(int b, int& R, int& C) { const int st = b / 1024, sb = b % 1024, swz = sb ^ (((sb >> 9) & 1) << 5); R = (st >> 1) * 16 + swz / 64; C = (st & 1) * 32 + (swz % 64) / 2; }
__device__ __forceinline__ int perm32(int rho) { const int n = rho >> 4, i = rho & 15; return 8 * (i >> 2) + 4 * n + (i & 3); }

struct Unit { int pm, pn, e; };

template <bool GATHER, bool HOOK, bool FP8, class Epi, class Sched>
__device__ __forceinline__ void gemm_phase(LAS unsigned char* lds, const int K, const Sched& S, const Epi& E, const LAS unsigned* gtab) {
    int tid = threadIdx.x; asm volatile("" : "+v"(tid));
    const int wid = __builtin_amdgcn_readfirstlane(tid >> 6), lane = tid & 63, wr = wid >> 2, wc = wid & 3, fr = lane & 15, fq = lane >> 4;
    const int nt = K / BK;
    unsigned voffA[2], voffB[2]; int RA[2], CA2[2];
#pragma unroll
    for (int i = 0; i < 2; ++i) { int R, C; stage_rc(tid * 16 + i * 8192, R, C); const int Rb = (R & ~31) + perm32(R & 31);
        voffA[i] = (unsigned)(R * K + C) * 2u; voffB[i] = (unsigned)(Rb * K + C) * 2u; RA[i] = R; CA2[i] = C * 2; }
    const size_t kstep = (size_t)(BK * 2);
    const size_t hstep = (size_t)HALF * K * 2;
    const unsigned ldsw = (unsigned)wid * 1024u;
    const int aoff = lds_byte(wr * 64 + fr, fq * 8), boff = lds_byte(wc * 32 + fr, fq * 8);
#define PG8_SA(b, h) (((b) * 2 + (h)) * HTB)
#define PG8_SB(b, h) ((4 + (b) * 2 + (h)) * HTB)
#define PG8_STAGE(bufoff, gbase, voff) do { _Pragma("unroll") for (int _i = 0; _i < 2; ++_i) \
        __builtin_amdgcn_global_load_lds((const unsigned*)((const char*)(gbase) + (voff)[_i]), (LAS unsigned*)(lds + (bufoff) + ldsw + _i * 8192), 16, 0, 0); } while (0)
#define PG8_STAGE_A(bufoff, ubase, kbytes, h, gv) do { if (GATHER) { PG8_STAGE(bufoff, (ubase) + (kbytes), (gv)[h]); } else { PG8_STAGE(bufoff, (ubase) + (kbytes) + (h) * hstep, voffA); } } while (0)
#define PG8_LD2(addr) __builtin_shufflevector(*(const LAS i32x4*)(addr), *(const LAS i32x4*)((addr) + 1024), 0, 1, 2, 3, 4, 5, 6, 7)
#define PG8_LDA(dst, b, h) do { if (FP8) { _Pragma("unroll") for (int m = 0; m < 4; ++m) dst##_f8[m] = PG8_LD2(lds + PG8_SA(b, h) + aoff + m * 2048); } \
        else { _Pragma("unroll") for (int m = 0; m < 4; ++m) _Pragma("unroll") for (int k = 0; k < 2; ++k) dst##_bf[m][k] = *(const LAS bf16x8*)(lds + PG8_SA(b, h) + aoff + m * 2048 + k * 1024); } } while (0)
#define PG8_LDB(dst, b, h) do { if (FP8) { _Pragma("unroll") for (int n = 0; n < 2; ++n) dst##_f8[n] = PG8_LD2(lds + PG8_SB(b, h) + boff + n * 2048); } \
        else { _Pragma("unroll") for (int n = 0; n < 2; ++n) _Pragma("unroll") for (int k = 0; k < 2; ++k) dst##_bf[n][k] = *(const LAS bf16x8*)(lds + PG8_SB(b, h) + boff + n * 2048 + k * 1024); } } while (0)
#define PG8_MMA(ai, bj, At, Bt) do { __builtin_amdgcn_s_setprio(1); \
        if (FP8) { _Pragma("unroll") for (int m = 0; m < 4; ++m) _Pragma("unroll") for (int n = 0; n < 2; ++n) \
            asm volatile("v_mfma_scale_f32_16x16x128_f8f6f4 %0, %1, %2, %0, %3, %3 op_sel_hi:[0,0,0]" : "+v"(acc[ai][bj][m][n]) : "v"(Bt##_f8[n]), "v"(At##_f8[m]), "v"(sc1)); } \
        else { _Pragma("unroll") for (int m = 0; m < 4; ++m) _Pragma("unroll") for (int n = 0; n < 2; ++n) _Pragma("unroll") for (int k = 0; k < 2; ++k) \
            acc[ai][bj][m][n] = __builtin_amdgcn_mfma_f32_16x16x32_bf16(Bt##_bf[n][k], At##_bf[m][k], acc[ai][bj][m][n], 0, 0, 0); } \
        __builtin_amdgcn_s_setprio(0); } while (0)
#define PG8_WAIT_V(n) asm volatile("s_waitcnt vmcnt(" #n ")" ::: "memory")
#define PG8_WAIT_L(n) asm volatile("s_waitcnt lgkmcnt(" #n ")" ::: "memory")
#define PG8_BAR __builtin_amdgcn_s_barrier()
#define PG8_SCHED __builtin_amdgcn_sched_barrier(0)
#define PG8_GLOAD(gv, i) do { if (GATHER) { _Pragma("unroll") for (int _h = 0; _h < 2; ++_h) _Pragma("unroll") for (int _i = 0; _i < 2; ++_i) (gv)[_h][_i] = gtab[(i) * 256 + _h * 128 + RA[_i]] + (unsigned)CA2[_i]; } } while (0)
    Unit cur, nxt; int ui = 0;
    if (!S.next(0, cur)) return;
    f32x4 acc[2][2][4][2];
    if constexpr (Epi::INIT) E.init(acc, cur, wr, wc, fr, fq, gtab);
    else {
#pragma unroll
    for (int a = 0; a < 2; ++a)
#pragma unroll
        for (int b = 0; b < 2; ++b)
#pragma unroll
            for (int m = 0; m < 4; ++m)
#pragma unroll
                for (int n = 0; n < 2; ++n) acc[a][b][m][n] = (f32x4){0.f, 0.f, 0.f, 0.f};
    }
    i32x8 At_f8[4], B0_f8[2], B1_f8[2]; bf16x8 At_bf[4][2], B0_bf[2][2], B1_bf[2][2];
    int sc1 = 0x7F7F7F7F; asm volatile("" : "+v"(sc1));
    unsigned gc[2][2] = {{0u, 0u}, {0u, 0u}}, gn[2][2] = {{0u, 0u}, {0u, 0u}};
    PG8_GLOAD(gc, 0);
    const char* cA = S.abase(cur); const char* cB = S.bbase(cur);
    PG8_STAGE(PG8_SB(0, 0), cB, voffB); PG8_STAGE_A(PG8_SA(0, 0), cA, 0, 0, gc); PG8_STAGE(PG8_SB(0, 1), cB + hstep, voffB); PG8_STAGE_A(PG8_SA(0, 1), cA, 0, 1, gc);
    if (wr == 1) PG8_BAR;
    PG8_WAIT_V(4); PG8_BAR;
    PG8_STAGE(PG8_SB(1, 0), cB + kstep, voffB); PG8_STAGE_A(PG8_SA(1, 0), cA, kstep, 0, gc); PG8_STAGE(PG8_SB(1, 1), cB + hstep + kstep, voffB);
    PG8_WAIT_V(6); PG8_BAR;
    for (;;) {
        const bool has_next = S.next(ui + 1, nxt);
        const char* nA = has_next ? S.abase(nxt) : cA; const char* nB = has_next ? S.bbase(nxt) : cB;
        if (GATHER) { if (has_next) { PG8_GLOAD(gn, ui + 1); } else {
#pragma unroll
            for (int _h = 0; _h < 2; ++_h)
#pragma unroll
                for (int _i = 0; _i < 2; ++_i) gn[_h][_i] = gc[_h][_i]; } }
        for (int t = 0; t < nt; t += 2) {
            const bool last = (t == nt - 2);
            const size_t k1 = (size_t)(t + 1) * kstep;
            const char* a2 = last ? nA : cA + (size_t)(t + 2) * kstep; const char* b2 = last ? nB : cB + (size_t)(t + 2) * kstep;
            const char* a3 = a2 + kstep; const char* b3 = b2 + kstep;
            unsigned g2[2][2];
#pragma unroll
            for (int _h = 0; _h < 2; ++_h)
#pragma unroll
                for (int _i = 0; _i < 2; ++_i) g2[_h][_i] = last ? gn[_h][_i] : gc[_h][_i];
            if (HOOK && t == 16) {
                const LAS float* ht = (const LAS float*)gtab;
#pragma unroll
                for (int a = 0; a < 2; ++a)
#pragma unroll
                    for (int m = 0; m < 4; ++m) { const float sc = ht[a * 128 + wr * 64 + m * 16 + fr];
#pragma unroll
                        for (int b = 0; b < 2; ++b)
#pragma unroll
                            for (int n = 0; n < 2; ++n) acc[a][b][m][n] = acc[a][b][m][n] * sc; }
            }
            PG8_LDB(B0, 0, 0); PG8_SCHED; PG8_LDA(At, 0, 0); PG8_STAGE_A(PG8_SA(1, 1), cA, k1, 1, gc);
            PG8_WAIT_L(8); PG8_BAR; PG8_WAIT_L(0); PG8_MMA(0, 0, At, B0); PG8_BAR; PG8_SCHED;
            PG8_LDB(B1, 0, 1); PG8_STAGE(PG8_SB(0, 0), b2, voffB);
            PG8_BAR; PG8_WAIT_L(0); PG8_MMA(0, 1, At, B1); PG8_BAR;
            PG8_LDA(At, 0, 1); PG8_STAGE_A(PG8_SA(0, 0), a2, 0, 0, g2);
            PG8_BAR; PG8_WAIT_L(0); PG8_MMA(1, 0, At, B0); PG8_BAR; PG8_SCHED;
            PG8_STAGE(PG8_SB(0, 1), b2 + hstep, voffB);
            PG8_WAIT_V(6); PG8_BAR; PG8_MMA(1, 1, At, B1); PG8_BAR;
            PG8_LDB(B0, 1, 0); PG8_SCHED; PG8_LDA(At, 1, 0); PG8_STAGE_A(PG8_SA(0, 1), a2, 0, 1, g2);
            PG8_WAIT_L(8); PG8_BAR; PG8_WAIT_L(0); PG8_MMA(0, 0, At, B0); PG8_BAR; PG8_SCHED;
            PG8_LDB(B1, 1, 1); PG8_STAGE(PG8_SB(1, 0), b3, voffB);
            PG8_BAR; PG8_WAIT_L(0); PG8_MMA(0, 1, At, B1); PG8_BAR;
            PG8_LDA(At, 1, 1); PG8_STAGE_A(PG8_SA(1, 0), a3, 0, 0, g2);
            PG8_BAR; PG8_WAIT_L(0); PG8_MMA(1, 0, At, B0); PG8_BAR; PG8_SCHED;
            PG8_STAGE(PG8_SB(1, 1), b3 + hstep, voffB);
            PG8_WAIT_V(6); PG8_BAR; PG8_MMA(1, 1, At, B1); PG8_BAR;
        }
        E(acc, cur, wr, wc, fr, fq, lds);
        if (!has_next) break;
#pragma unroll
        for (int a = 0; a < 2; ++a)
#pragma unroll
            for (int b = 0; b < 2; ++b)
#pragma unroll
                for (int m = 0; m < 4; ++m)
#pragma unroll
                    for (int n = 0; n < 2; ++n) acc[a][b][m][n] = (f32x4){0.f, 0.f, 0.f, 0.f};
        cur = nxt; cA = nA; cB = nB; ++ui;
#pragma unroll
        for (int _h = 0; _h < 2; ++_h)
#pragma unroll
            for (int _i = 0; _i < 2; ++_i) gc[_h][_i] = gn[_h][_i];
    }
    PG8_WAIT_V(0);
    if (wr == 0) PG8_BAR;
    PG8_BAR;
#undef PG8_SA
#undef PG8_SB
#undef PG8_STAGE
#undef PG8_STAGE_A
#undef PG8_LDA
#undef PG8_LDB
#undef PG8_MMA
#undef PG8_LD2
#undef PG8_WAIT_V
#undef PG8_WAIT_L
#undef PG8_BAR
#undef PG8_SCHED
#undef PG8_GLOAD
}

struct OrderMN {
    int nM, nN, nwg, G, c; const char* A; const char* Bt; size_t tstep;
    __device__ __forceinline__ void init(const void* A_, const void* Bt_, int M, int N, int K, int G_, int c_) { nM = M / BM; nN = N / BM; nwg = nM * nN; G = G_; c = c_; A = (const char*)A_; Bt = (const char*)Bt_; tstep = (size_t)BM * K * 2; }
    __device__ __forceinline__ bool next(int i, Unit& u) const {
        if (c >= G) return false;
        const long L = (long)i * G + c; if (L >= nwg) return false;
        int wgid = (int)L; { const int q = nwg / NXCD, r = nwg % NXCD, xcd = wgid % NXCD, off = wgid / NXCD; wgid = (xcd < r ? xcd * (q + 1) : r * (q + 1) + (xcd - r) * q) + off; }
        const int nig = WGM * nN, gid = wgid / nig, fm = gid * WGM, gsz = (nM - fm) < WGM ? (nM - fm) : WGM;
        u.pm = fm + ((wgid % nig) % gsz); u.pn = (wgid % nig) / gsz; u.e = 0; return true;
    }
    __device__ __forceinline__ const char* abase(const Unit& u) const { return A + (size_t)u.pm * tstep; }
    __device__ __forceinline__ const char* bbase(const Unit& u) const { return Bt + (size_t)u.pn * tstep; }
};
struct OrderExpert {
    int nN, ntile, G, c, per; const char* A; const char* Bt; size_t a_estride, b_estride, tstepA, tstepB; bool gather;
    __device__ __forceinline__ void init(const void* A_, const void* Bt_, int N, int K, size_t a_es, size_t b_es, bool gather_, int G_, int c_, int per_) {
        nN = N / BM; ntile = NEXP * nN; G = G_; c = c_; per = per_; A = (const char*)A_; Bt = (const char*)Bt_; a_estride = a_es; b_estride = b_es; tstepA = (size_t)BM * K * 2; tstepB = tstepA; gather = gather_; }
    __device__ __forceinline__ bool next(int i, Unit& u) const {
        int T, pm;
        if ((G & 7) == 0) {
            const int x = c & 7, j = c >> 3; if (j >= per) return false;
            const int q = i * per + j, U = 4 * nN; if (q >= 2 * U) return false;
            const int el = q >= U ? 1 : 0, r = q - el * U, chunk = r >> 5, w = r & 31;
            pm = w & 3; const int pn = chunk * 8 + (w >> 2);
            T = (2 * x + el) * nN + pn;
            if (pn >= nN) return false;
        }
        else { const int q = i * G + c; T = q >> 2; pm = q & 3; }
        if (T >= ntile) return false;
        u.e = T / nN; u.pn = T % nN; u.pm = pm; return true;
    }
    __device__ __forceinline__ const char* abase(const Unit& u) const { return gather ? A : A + (size_t)u.e * a_estride + (size_t)u.pm * tstepA; }
    __device__ __forceinline__ const char* bbase(const Unit& u) const { return Bt + (size_t)u.e * b_estride + (size_t)u.pn * tstepB; }
};
}

struct EpiInProj {
    static constexpr bool INIT = false;
    bf16_t* proj;
    __device__ __forceinline__ void operator()(const f32x4 (&acc)[2][2][4][2], const pg8::Unit& u, int wr, int wc, int fr, int fq, LAS unsigned char* lds) const {
        const int pn = u.pn, grp = pn >> 2;
        const int row0 = u.pm * 256 + wr * 64 + fr;
        if (grp == 5 || grp == 2) {
#pragma unroll
            for (int ai = 0; ai < 2; ++ai)
#pragma unroll
                for (int m = 0; m < 4; ++m) {
                    bf16_t* rowp = proj + (size_t)(row0 + ai * 128 + m * 16) * INC + pn * 256 + wc * 32 + 8 * fq;
#pragma unroll
                    for (int bj = 0; bj < 2; ++bj) { const f32x4 v0 = acc[ai][bj][m][0], v1 = acc[ai][bj][m][1];
                        u32x4 w; w.x = cvtpk(v0[0], v0[1]); w.y = cvtpk(v0[2], v0[3]); w.z = cvtpk(v1[0], v1[1]); w.w = cvtpk(v1[2], v1[3]);
                        *(u32x4*)(rowp + bj * 128) = w; }
                }
            return;
        }
        const int gsel = (grp == 0) ? 0 : (grp == 1) ? 1 : (grp == 3) ? 2 : 3;
        const LAS float* gain = (const LAS float*)(lds + SCR_OFF + 8192) + gsel * 128;
        const float osc = (grp == 0 || grp == 3) ? QSCALE : 1.0f;
        LAS float* Pt = (LAS float*)(lds + SCR_OFF);
#pragma unroll
        for (int ai = 0; ai < 2; ++ai)
#pragma unroll
            for (int m = 0; m < 4; ++m)
#pragma unroll
                for (int bj = 0; bj < 2; ++bj) {
                    const f32x4 v0 = acc[ai][bj][m][0], v1 = acc[ai][bj][m][1];
                    float s = (v0[0] * v0[0] + v0[1] * v0[1]) + (v0[2] * v0[2] + v0[3] * v0[3]) + (v1[0] * v1[0] + v1[1] * v1[1]) + (v1[2] * v1[2] + v1[3] * v1[3]);
                    s += __shfl_xor(s, 16); s += __shfl_xor(s, 32);
                    if (fq == 0) Pt[((ai * 128 + wr * 64 + m * 16 + fr) * 2 + bj) * 4 + wc] = s;
                }
        asm volatile("s_waitcnt lgkmcnt(0)" ::: "memory"); __builtin_amdgcn_s_barrier(); asm volatile("" ::: "memory");
        const f32x4 g0 = *(const LAS f32x4*)(gain + wc * 32 + 8 * fq), g1 = *(const LAS f32x4*)(gain + wc * 32 + 8 * fq + 4);
#pragma unroll
        for (int ai = 0; ai < 2; ++ai)
#pragma unroll
            for (int m = 0; m < 4; ++m) {
                bf16_t* rowp = proj + (size_t)(row0 + ai * 128 + m * 16) * INC + pn * 256 + wc * 32 + 8 * fq;
#pragma unroll
                for (int bj = 0; bj < 2; ++bj) {
                    const f32x4 ps = *(const LAS f32x4*)(Pt + ((ai * 128 + wr * 64 + m * 16 + fr) * 2 + bj) * 4);
                    const float rstd = rsqrtf(((ps[0] + ps[1]) + (ps[2] + ps[3])) * (1.0f / 128.0f) + RMS_EPS) * osc;
                    const f32x4 v0 = acc[ai][bj][m][0] * rstd * g0, v1 = acc[ai][bj][m][1] * rstd * g1;
                    u32x4 w; w.x = cvtpk(v0[0], v0[1]); w.y = cvtpk(v0[2], v0[3]); w.z = cvtpk(v1[0], v1[1]); w.w = cvtpk(v1[2], v1[3]);
                    *(u32x4*)(rowp + bj * 128) = w;
                }
            }
    }
};
struct EpiOutProj {
    static constexpr bool INIT = true;
    const float* x; bf16_t* x1b; float* rowss;
    __device__ __forceinline__ void init(f32x4 (&acc)[2][2][4][2], const pg8::Unit& u, int wr, int wc, int fr, int fq, const LAS unsigned* gtab) const {
        const LAS float* ht = (const LAS float*)gtab;
        const int row0 = u.pm * 256 + wr * 64 + fr, col0 = u.pn * 256 + wc * 32 + 8 * fq;
#pragma unroll
        for (int ai = 0; ai < 2; ++ai)
#pragma unroll
            for (int m = 0; m < 4; ++m) {
                const float isc = __builtin_amdgcn_rcpf(ht[ai * 128 + wr * 64 + m * 16 + fr]);
                const float* xp = x + (size_t)(row0 + ai * 128 + m * 16) * DM + col0;
#pragma unroll
                for (int bj = 0; bj < 2; ++bj)
#pragma unroll
                    for (int n = 0; n < 2; ++n) acc[ai][bj][m][n] = *(const f32x4*)(xp + bj * 128 + 4 * n) * isc;
            }
    }
    __device__ __forceinline__ void operator()(const f32x4 (&acc)[2][2][4][2], const pg8::Unit& u, int wr, int wc, int fr, int fq, LAS unsigned char* lds) const {
        const int row0 = u.pm * 256 + wr * 64 + fr, col0 = u.pn * 256 + wc * 32 + 8 * fq;
#pragma unroll
        for (int ai = 0; ai < 2; ++ai)
#pragma unroll
            for (int m = 0; m < 4; ++m) {
                const int row = row0 + ai * 128 + m * 16;
                bf16_t* op = x1b + (size_t)row * DM + col0;
                float s = 0.f;
#pragma unroll
                for (int bj = 0; bj < 2; ++bj) {
                    const f32x4 v0 = acc[ai][bj][m][0], v1 = acc[ai][bj][m][1];
                    u32x4 w; w.x = cvtpk(v0[0], v0[1]); w.y = cvtpk(v0[2], v0[3]); w.z = cvtpk(v1[0], v1[1]); w.w = cvtpk(v1[2], v1[3]);
                    *(u32x4*)(op + bj * 128) = w;
                    s += (v0[0] * v0[0] + v0[1] * v0[1]) + (v0[2] * v0[2] + v0[3] * v0[3]) + (v1[0] * v1[0] + v1[1] * v1[1]) + (v1[2] * v1[2] + v1[3] * v1[3]);
                }
                s += __shfl_xor(s, 16); s += __shfl_xor(s, 32);
                if (fq == 0) rowss[(size_t)row * 32 + u.pn * 4 + wc] = s;
            }
    }
};
struct EpiGateUp {
    static constexpr bool INIT = false;
    unsigned char* act;
    __device__ __forceinline__ void operator()(const f32x4 (&acc)[2][2][4][2], const pg8::Unit& u, int wr, int wc, int fr, int fq, LAS unsigned char* lds) const {
        const int row0 = u.pm * 256 + wr * 64 + fr;
        unsigned char* base = act + (size_t)u.e * EROWS * FF + u.pn * 128 + wc * 32 + 8 * fq;
        constexpr float DS = 1.0f / (WSC8 * HSC8);
#pragma unroll
        for (int ai = 0; ai < 2; ++ai)
#pragma unroll
            for (int m = 0; m < 4; ++m) {
                float r[8];
#pragma unroll
                for (int n = 0; n < 2; ++n)
#pragma unroll
                    for (int j = 0; j < 4; ++j) { const float g = acc[ai][0][m][n][j] * DS, uu = acc[ai][1][m][n][j] * DS;
                        const float a = g * __builtin_amdgcn_rcpf(1.0f + __builtin_amdgcn_exp2f(-g * LOG2E)) * uu * ASC8;
                        r[n * 4 + j] = fminf(fmaxf(a, -448.0f), 448.0f); }
                u32x2 w; w.x = cvt4_fp8(r[0], r[1], r[2], r[3]); w.y = cvt4_fp8(r[4], r[5], r[6], r[7]);
                *(u32x2*)(base + (size_t)(row0 + ai * 128 + m * 16) * FF) = w;
            }
    }
};
struct EpiDown {
    static constexpr bool INIT = false;
    unsigned char* y; const float* selgate;
    __device__ __forceinline__ void operator()(const f32x4 (&acc)[2][2][4][2], const pg8::Unit& u, int wr, int wc, int fr, int fq, LAS unsigned char* lds) const {
        const int row0 = u.pm * 256 + wr * 64 + fr;
        unsigned char* base = y + (size_t)u.e * EROWS * DM + u.pn * 256 + wc * 32 + 8 * fq;
#pragma unroll
        for (int ai = 0; ai < 2; ++ai)
#pragma unroll
            for (int m = 0; m < 4; ++m) {
                const int row = row0 + ai * 128 + m * 16;
                const float gt = selgate[u.e * EROWS + row] * (YSC8 / (WSC8 * ASC8));
#pragma unroll
                for (int bj = 0; bj < 2; ++bj) { const f32x4 v0 = acc[ai][bj][m][0] * gt, v1 = acc[ai][bj][m][1] * gt;
                    u32x2 w; w.x = cvt4_fp8(fminf(fmaxf(v0[0], -448.f), 448.f), fminf(fmaxf(v0[1], -448.f), 448.f), fminf(fmaxf(v0[2], -448.f), 448.f), fminf(fmaxf(v0[3], -448.f), 448.f));
                    w.y = cvt4_fp8(fminf(fmaxf(v1[0], -448.f), 448.f), fminf(fmaxf(v1[1], -448.f), 448.f), fminf(fmaxf(v1[2], -448.f), 448.f), fminf(fmaxf(v1[3], -448.f), 448.f));
                    *(u32x2*)(base + (size_t)row * DM + bj * 128) = w; }
            }
    }
};

#define KSWZ(row, colB) ((row) * 256 + ((colB) ^ (((row) & 7) << 4)))
#define SBAR() __builtin_amdgcn_sched_barrier(0)
__device__ __forceinline__ int crow(int r, int hi) { return (r & 3) + 8 * (r >> 2) + 4 * hi; }
#define PK4(P, BASE, OUT) do { unsigned a0 = cvtpk(P[BASE + 0], P[BASE + 1]), a1 = cvtpk(P[BASE + 2], P[BASE + 3]);   \
    unsigned b0 = cvtpk(P[BASE + 4], P[BASE + 5]), b1 = cvtpk(P[BASE + 6], P[BASE + 7]);                              \
    auto r0 = __builtin_amdgcn_permlane32_swap(a0, b0, false, false); auto r1 = __builtin_amdgcn_permlane32_swap(a1, b1, false, false); \
    u32x4 w = {r0[0], r1[0], r0[1], r1[1]}; OUT = *reinterpret_cast<bf16x8*>(&w); } while (0)
__device__ __forceinline__ float swap_add(float v) { auto rr = __builtin_amdgcn_permlane32_swap(__float_as_uint(v), __float_as_uint(v), false, false); return __uint_as_float(rr[0]) + __uint_as_float(rr[1]); }

namespace da {
constexpr int D = 128, NW = 8, QBLK = 32, KVBLK = 64;
constexpr int SHM_V = KVBLK * D * 2, SHM_K = KVBLK * D * 2, SHM_ATTN = 2 * SHM_V + 2 * SHM_K + NW * 64 * 4;
constexpr int LDP = INC;

__device__ __forceinline__ void qkt(f32x16& p0, f32x16& p1, const LAS unsigned char* Ks, const bf16x8* qr, int r32, int hi) {
    p0 = f32x16{}; p1 = f32x16{};
#pragma unroll
    for (int d0 = 0; d0 < 8; ++d0) { const int cb = (d0 * 16 + hi * 8) * 2;
        const bf16x8 b0 = *(const LAS bf16x8*)(Ks + KSWZ(r32, cb));
        const bf16x8 b1 = *(const LAS bf16x8*)(Ks + KSWZ(32 + r32, cb));
        p0 = __builtin_amdgcn_mfma_f32_32x32x16_bf16(b0, qr[d0], p0, 0, 0, 0);
        p1 = __builtin_amdgcn_mfma_f32_32x32x16_bf16(b1, qr[d0], p1, 0, 0, 0); }
}
__device__ __forceinline__ int v_st(int k, int c) { const int kk = (k & ~0xC) | ((k & 4) << 1) | ((k & 8) >> 1); return ((kk >> 3) * 4 + (c >> 5)) * 512 + ((kk & 7) * 32 + (c & 31)) * 2; }
__device__ __forceinline__ int v_rd_base(int lane) { return ((lane & 3) << 3) | (((lane >> 2) & 3) << 6) | (((lane >> 4) & 1) << 5) | (((lane >> 5) & 1) << 8); }
constexpr int v_rd_off(int d0, int ks, int half) { return d0 * 512 + ks * 4096 + half * 2048; }
template <int OFF> __device__ __forceinline__ s16x4 tr_read(int vb) {
    s16x4 r; asm volatile("ds_read_b64_tr_b16 %0, %1 offset:%2" : "=&v"(r) : "v"(vb), "i"(OFF) : "memory"); return r;
}
template <int D0> __device__ __forceinline__ void pv_one(f32x16& od, int vb, bf16x8 pa0, bf16x8 pa1, bf16x8 pa2, bf16x8 pa3) {
    const s16x4 l0 = tr_read<v_rd_off(D0, 0, 0)>(vb), h0 = tr_read<v_rd_off(D0, 0, 1)>(vb), l1 = tr_read<v_rd_off(D0, 1, 0)>(vb), h1 = tr_read<v_rd_off(D0, 1, 1)>(vb);
    const s16x4 l2 = tr_read<v_rd_off(D0, 2, 0)>(vb), h2 = tr_read<v_rd_off(D0, 2, 1)>(vb), l3 = tr_read<v_rd_off(D0, 3, 0)>(vb), h3 = tr_read<v_rd_off(D0, 3, 1)>(vb);
    asm volatile("s_waitcnt lgkmcnt(0)" ::: "memory"); SBAR();
#define PKV(L, H) (bf16x8){L[0], L[1], L[2], L[3], H[0], H[1], H[2], H[3]}
    od = __builtin_amdgcn_mfma_f32_32x32x16_bf16(pa0, PKV(l0, h0), od, 0, 0, 0);
    od = __builtin_amdgcn_mfma_f32_32x32x16_bf16(pa1, PKV(l1, h1), od, 0, 0, 0);
    od = __builtin_amdgcn_mfma_f32_32x32x16_bf16(pa2, PKV(l2, h2), od, 0, 0, 0);
    od = __builtin_amdgcn_mfma_f32_32x32x16_bf16(pa3, PKV(l3, h3), od, 0, 0, 0);
#undef PKV
}
__device__ __forceinline__ void pv_d0(f32x16* o, int vb, bf16x8 pa0, bf16x8 pa1, bf16x8 pa2, bf16x8 pa3) {
    pv_one<0>(o[0], vb, pa0, pa1, pa2, pa3); pv_one<1>(o[1], vb, pa0, pa1, pa2, pa3); pv_one<2>(o[2], vb, pa0, pa1, pa2, pa3); pv_one<3>(o[3], vb, pa0, pa1, pa2, pa3);
}
__device__ __forceinline__ void sm_a(f32x16& p0, f32x16& p1, float dq, float slope2) {
#pragma unroll
    for (int r = 0; r < 16; ++r) { const float c = (float)((r & 3) + 8 * (r >> 2)); p0[r] = __builtin_amdgcn_exp2f(p0[r] - slope2 * fabsf(dq - c)); }
#pragma unroll
    for (int r = 0; r < 16; ++r) { const float c = (float)((r & 3) + 8 * (r >> 2) + 32); p1[r] = p1[r] - slope2 * fabsf(dq - c); }
}
__device__ __forceinline__ void sm_b(f32x16& p0, f32x16& p1, float& l_reg, bf16x8& pa0, bf16x8& pa1, bf16x8& pa2, bf16x8& pa3) {
#pragma unroll
    for (int r = 0; r < 16; ++r) p1[r] = __builtin_amdgcn_exp2f(p1[r]);
    float ps = 0;
#pragma unroll
    for (int r = 0; r < 16; ++r) ps += p0[r];
#pragma unroll
    for (int r = 0; r < 16; ++r) ps += p1[r];
    l_reg += swap_add(ps);
    PK4(p0, 0, pa0); PK4(p0, 8, pa1); PK4(p1, 0, pa2); PK4(p1, 8, pa3);
}
__device__ __forceinline__ void attn_body(const bf16_t* __restrict__ Qb, const bf16_t* __restrict__ Kh, const bf16_t* __restrict__ Vh, float* __restrict__ Ob, int q0, float slope2, LAS unsigned char* lds) {
    const int tid = threadIdx.x, wid = tid >> 6, lane = tid & 63, r32 = lane & 31, hi = lane >> 5;
    LAS unsigned char* V_lds = lds; LAS unsigned char* K_lds = lds + 2 * SHM_V;
    LAS float* li_l = (LAS float*)(lds + 2 * SHM_V + 2 * SHM_K) + wid * 64;
    float l_reg = 0; f32x16 o[4] = {}; bf16x8 qr[8];
    const bf16_t* Qw = Qb + (size_t)(wid * QBLK + r32) * LDP + hi * 8;
#pragma unroll
    for (int d0 = 0; d0 < 8; ++d0) qr[d0] = *(const bf16x8*)(Qw + d0 * 16);
    const int sr = tid >> 4, sc = (tid & 15) * 8, vst0 = v_st(sr, sc), vst1 = v_st(32 + sr, sc);
    const int vb0 = (int)(uintptr_t)V_lds + v_rd_base(lane);
    const float dqbase = (float)(q0 + wid * QBLK + r32 - 4 * hi);
    struct { bf16x8 vs0, vs1, ks0, ks1; } sr_[1];
    const unsigned so0 = (unsigned)(sr * LDP + sc) * 2u, so1 = (unsigned)((32 + sr) * LDP + sc) * 2u;
#define SLOAD(i, k0) do { const char* vb_ = (const char*)Vh + (size_t)(k0) * (LDP * 2); const char* kb_ = (const char*)Kh + (size_t)(k0) * (LDP * 2); \
    sr_[i].vs0 = *(const bf16x8*)(vb_ + so0); sr_[i].vs1 = *(const bf16x8*)(vb_ + so1); \
    sr_[i].ks0 = *(const bf16x8*)(kb_ + so0); sr_[i].ks1 = *(const bf16x8*)(kb_ + so1); } while (0)
#define SWRITE(b, i) do { *(LAS bf16x8*)(V_lds + (b) * SHM_V + vst0) = sr_[i].vs0;          \
    *(LAS bf16x8*)(V_lds + (b) * SHM_V + vst1) = sr_[i].vs1; const int kc = sc * 2;               \
    *(LAS bf16x8*)(K_lds + (b) * SHM_K + KSWZ(sr, kc)) = sr_[i].ks0;                       \
    *(LAS bf16x8*)(K_lds + (b) * SHM_K + KSWZ(32 + sr, kc)) = sr_[i].ks1; } while (0)
#define SWAIT() asm volatile("s_waitcnt vmcnt(0)" ::: "memory")
    f32x16 pA0, pA1, pB0, pB1; bf16x8 pa0, pa1, pa2, pa3; constexpr int NT = SEQ / KVBLK;
    SLOAD(0, 0); SWAIT(); SWRITE(0, 0); __syncthreads();
    qkt(pA0, pA1, K_lds, qr, r32, hi); sm_a(pA0, pA1, dqbase, slope2);
    SLOAD(0, KVBLK);
    SWAIT(); SWRITE(1, 0); __syncthreads();
    for (int j = 1; j + 1 < NT; j += 2) {
        SBAR(); qkt(pB0, pB1, K_lds + SHM_K, qr, r32, hi);
        sm_b(pA0, pA1, l_reg, pa0, pa1, pa2, pa3); SBAR();
        SLOAD(0, (j + 1) * KVBLK); SBAR();
        pv_d0(o, vb0, pa0, pa1, pa2, pa3); sm_a(pB0, pB1, dqbase - (float)(j * KVBLK), slope2);
        __syncthreads(); SWAIT(); SWRITE(0, 0);
        __syncthreads();
        SBAR(); qkt(pA0, pA1, K_lds, qr, r32, hi);
        sm_b(pB0, pB1, l_reg, pa0, pa1, pa2, pa3); SBAR();
        SLOAD(0, (j + 2) * KVBLK); SBAR();
        pv_d0(o, vb0 + SHM_V, pa0, pa1, pa2, pa3); sm_a(pA0, pA1, dqbase - (float)((j + 1) * KVBLK), slope2);
        __syncthreads(); SWAIT(); SWRITE(1, 0);
        __syncthreads();
    }
    SBAR(); qkt(pB0, pB1, K_lds + SHM_K, qr, r32, hi);
    sm_b(pA0, pA1, l_reg, pa0, pa1, pa2, pa3); SBAR();
    pv_d0(o, vb0, pa0, pa1, pa2, pa3); sm_a(pB0, pB1, dqbase - (float)((NT - 1) * KVBLK), slope2);
    __syncthreads();
    sm_b(pB0, pB1, l_reg, pa0, pa1, pa2, pa3); SBAR();
    pv_d0(o, vb0 + SHM_V, pa0, pa1, pa2, pa3);
    if (hi == 0) li_l[r32] = l_reg; asm volatile("s_waitcnt lgkmcnt(0)" ::: "memory");
    float rli[16];
#pragma unroll
    for (int r = 0; r < 16; ++r) rli[r] = __builtin_amdgcn_rcpf(li_l[crow(r, hi)]);
    float* Ow = Ob + (size_t)(wid * QBLK) * DM;
#pragma unroll
    for (int r = 0; r < 16; ++r) { const int orow = crow(r, hi);
#pragma unroll
        for (int d0 = 0; d0 < 4; ++d0) Ow[(size_t)orow * DM + d0 * 32 + r32] = o[d0][r] * rli[r]; }
    __syncthreads();
#undef SLOAD
#undef SWRITE
#undef SWAIT
}
}

namespace da2 {
constexpr int BUFB = 65536, KB = 16384;
__device__ __forceinline__ int v_rd_base(int lane) { return ((lane & 3) << 3) | (((lane >> 2) & 3) << 6) | (((lane >> 4) & 1) << 5) | (((lane >> 5) & 1) << 8); }
template <int OFF> __device__ __forceinline__ s16x4 tr_read(int vb) {
    s16x4 r; asm volatile("ds_read_b64_tr_b16 %0, %1 offset:%2" : "=&v"(r) : "v"(vb), "i"(OFF) : "memory"); return r;
}
template <int NCB, int CB> __device__ __forceinline__ void pv_one(f32x16& od, int vb, bf16x8 pa0, bf16x8 pa1, bf16x8 pa2, bf16x8 pa3) {
    constexpr int S = NCB * 512;
    const s16x4 l0 = tr_read<CB * 512 + 0 * S>(vb), h0 = tr_read<CB * 512 + 1 * S>(vb), l1 = tr_read<CB * 512 + 2 * S>(vb), h1 = tr_read<CB * 512 + 3 * S>(vb);
    const s16x4 l2 = tr_read<CB * 512 + 4 * S>(vb), h2 = tr_read<CB * 512 + 5 * S>(vb), l3 = tr_read<CB * 512 + 6 * S>(vb), h3 = tr_read<CB * 512 + 7 * S>(vb);
    asm volatile("s_waitcnt lgkmcnt(0)" ::: "memory"); SBAR();
#define PKV(L, H) (bf16x8){L[0], L[1], L[2], L[3], H[0], H[1], H[2], H[3]}
    od = __builtin_amdgcn_mfma_f32_32x32x16_bf16(pa0, PKV(l0, h0), od, 0, 0, 0);
    od = __builtin_amdgcn_mfma_f32_32x32x16_bf16(pa1, PKV(l1, h1), od, 0, 0, 0);
    od = __builtin_amdgcn_mfma_f32_32x32x16_bf16(pa2, PKV(l2, h2), od, 0, 0, 0);
    od = __builtin_amdgcn_mfma_f32_32x32x16_bf16(pa3, PKV(l3, h3), od, 0, 0, 0);
#undef PKV
}
__device__ __forceinline__ void qkt(f32x16& p0, f32x16& p1, const LAS unsigned char* Ks, const bf16x8* qr, int r32, int hi) {
    p0 = f32x16{}; p1 = f32x16{};
#pragma unroll
    for (int d0 = 0; d0 < 8; ++d0) { const int cb = (d0 * 16 + hi * 8) * 2;
        const bf16x8 b0 = *(const LAS bf16x8*)(Ks + KSWZ(r32, cb));
        const bf16x8 b1 = *(const LAS bf16x8*)(Ks + KSWZ(32 + r32, cb));
        p0 = __builtin_amdgcn_mfma_f32_32x32x16_bf16(b0, qr[d0], p0, 0, 0, 0);
        p1 = __builtin_amdgcn_mfma_f32_32x32x16_bf16(b1, qr[d0], p1, 0, 0, 0); }
}
__device__ __forceinline__ int unswap23(int kk) { return (kk & ~0xC) | ((kk & 4) << 1) | ((kk & 8) >> 1); }

__device__ __forceinline__ void epilogue(const Params& P, LAS unsigned char* lds, f32x16 (&o)[8], float l_reg, int tz, int it) {
    const int wid = __builtin_amdgcn_readfirstlane(tz >> 6), lane = tz & 63, r32 = lane & 31, hi = lane >> 5;
    float lam;
    { float a = P.lam_q1[lane] * P.lam_k1[lane] + P.lam_q1[lane + 64] * P.lam_k1[lane + 64];
      float c = P.lam_q2[lane] * P.lam_k2[lane] + P.lam_q2[lane + 64] * P.lam_k2[lane + 64];
      a = wave_sum(a); c = wave_sum(c); lam = expf(a) - expf(c) + 0.2f; }
    const int br = wid >> 2, w4 = wid & 3;
    const int b = it >> 7, h = (it >> 5) & 3, qt = it & 31;
    const size_t row0 = (size_t)b * SEQ; const int q0 = qt * 128;
    LAS float* li_l = (LAS float*)(lds + SCR_OFF) + wid * 32;
    if (hi == 0) li_l[r32] = l_reg;
    asm volatile("s_waitcnt lgkmcnt(0)" ::: "memory");
    __syncthreads();
    LAS float* X = (LAS float*)lds + w4 * 8192;
    if (br == 1) {
#pragma unroll
        for (int r = 0; r < 16; ++r) { const float rl = __builtin_amdgcn_rcpf(li_l[crow(r, hi)]);
#pragma unroll
            for (int d = 0; d < 8; ++d) X[(r * 8 + d) * 64 + lane] = o[d][r] * rl; }
    }
    __syncthreads();
    if (br == 0) {
        LAS unsigned char* T = (LAS unsigned char*)X;
        float g[8];
#pragma unroll
        for (int d = 0; d < 8; ++d) g[d] = P.subln_b[d * 32 + r32];
#pragma unroll
        for (int r = 0; r < 16; ++r) {
            const float rl = __builtin_amdgcn_rcpf(li_l[crow(r, hi)]);
            float v[8], sq = 0.f;
#pragma unroll
            for (int d = 0; d < 8; ++d) { v[d] = o[d][r] * rl - lam * X[(r * 8 + d) * 64 + lane]; sq += v[d] * v[d]; }
#pragma unroll
            for (int sh = 16; sh >= 1; sh >>= 1) sq += __shfl_xor(sq, sh);
            const float rstd = rsqrtf(sq * (1.0f / 256.0f) + RMS_EPS) * 0.8f;
#pragma unroll
            for (int d = 0; d < 8; ++d) { const unsigned w = cvtpk(v[d] * rstd * g[d], 0.f); *(LAS bf16_t*)(T + (2 * r + hi) * 512 + (d * 32 + r32) * 2) = (bf16_t)(w & 0xffffu); }
        }
        asm volatile("s_waitcnt lgkmcnt(0)" ::: "memory");
        char* mixb = (char*)((bf16_t*)(P.ws + WS_MIX) + (row0 + q0 + w4 * 32) * DM + 1024 + h * 256);
        const unsigned loff = (unsigned)(hi * 4 * DM * 2 + r32 * 16);
#pragma unroll
        for (int i = 0; i < 16; ++i) {
            const u32x4 w = *(const LAS u32x4*)(T + (2 * i + hi) * 512 + r32 * 16);
            *(u32x4*)(mixb + (size_t)((i & 3) + 8 * (i >> 2)) * (DM * 2) + loff) = w;
        }
    }
    __syncthreads();
}
__device__ __forceinline__ void item(const Params& P, int it, LAS unsigned char* lds) {
    int tid = threadIdx.x; asm volatile("" : "+v"(tid));
    const int wid = __builtin_amdgcn_readfirstlane(tid >> 6), lane = tid & 63, r32 = lane & 31, hi = lane >> 5;
    const int br = wid >> 2, w4 = wid & 3;
    const int b = it >> 7, h = (it >> 5) & 3, qt = it & 31;
    const bf16_t* proj = (const bf16_t*)(P.ws + WS_PROJ);
    const size_t row0 = (size_t)b * SEQ; const int q0 = qt * 128;
    bf16x8 qr[8];
    { const bf16_t* Qw = proj + (row0 + q0 + w4 * 32 + r32) * INC + 3072 + br * 512 + h * 128 + hi * 8;
#pragma unroll
      for (int d0 = 0; d0 < 8; ++d0) qr[d0] = *(const bf16x8*)(Qw + d0 * 16); }
    const char* kbase = (const char*)(proj + row0 * INC + 4096 + h * 128);
    const char* vbase = (const char*)(proj + row0 * INC + 5120 + h * 256);
    const int krow = wid * 8 + (lane >> 4);
    const unsigned voffK0 = (unsigned)(krow * INC * 2 + (((lane & 15) ^ (lane >> 4)) << 4));
    const unsigned voffK1 = (unsigned)((krow + 4) * INC * 2 + (((lane & 15) ^ (4 + (lane >> 4))) << 4));
    const unsigned voffV = (unsigned)(unswap23(wid * 8 + ((lane & 31) >> 2)) * INC * 2 + (lane >> 5) * 64 + (lane & 3) * 16);
#define DA2_ISSUE(t, bufi) do { const char* kb_ = kbase + (size_t)(t) * (64 * INC * 2); const char* vb_ = vbase + (size_t)(t) * (64 * INC * 2); \
        LAS unsigned char* lb_ = lds + (bufi) * BUFB; \
        __builtin_amdgcn_global_load_lds((const unsigned*)(kb_ + voffK0), (LAS unsigned*)(lb_ + wid * 2048), 16, 0, 0); \
        __builtin_amdgcn_global_load_lds((const unsigned*)(kb_ + voffK1), (LAS unsigned*)(lb_ + wid * 2048 + 1024), 16, 0, 0); \
        __builtin_amdgcn_global_load_lds((const unsigned*)(kb_ + 1024 + voffK0), (LAS unsigned*)(lb_ + KB + wid * 2048), 16, 0, 0); \
        __builtin_amdgcn_global_load_lds((const unsigned*)(kb_ + 1024 + voffK1), (LAS unsigned*)(lb_ + KB + wid * 2048 + 1024), 16, 0, 0); \
        _Pragma("unroll") for (int i_ = 0; i_ < 4; ++i_) \
            __builtin_amdgcn_global_load_lds((const unsigned*)(vb_ + i_ * 128 + voffV), (LAS unsigned*)(lb_ + 2 * KB + wid * 4096 + i_ * 1024), 16, 0, 0); } while (0)
    const float slope2 = exp2f(-2.0f * (float)(h + 1)) * LOG2E;
    float dq = (float)(q0 + w4 * 32 + r32 - 4 * hi);
    f32x16 o[8];
#pragma unroll
    for (int d = 0; d < 8; ++d) o[d] = f32x16{};
    float l_reg = 0.f;
    const int vb0 = (int)(uintptr_t)(lds + 2 * KB) + v_rd_base(lane);
    DA2_ISSUE(0, 0);
#pragma unroll 1
    for (int j = 0; j < SEQ / 64; ++j) {
        asm volatile("s_waitcnt vmcnt(0)" ::: "memory");
        __builtin_amdgcn_s_barrier();
        asm volatile("" ::: "memory");
        if (j + 1 < SEQ / 64) DA2_ISSUE(j + 1, (j + 1) & 1);
        const LAS unsigned char* Kb = lds + (j & 1) * BUFB + br * KB;
        f32x16 p0, p1;
        qkt(p0, p1, Kb, qr, r32, hi);
        float ps = 0.f;
#pragma unroll
        for (int r = 0; r < 16; ++r) { const float c = (float)((r & 3) + 8 * (r >> 2)); p0[r] = __builtin_amdgcn_exp2f(p0[r] - slope2 * fabsf(dq - c)); ps += p0[r]; }
#pragma unroll
        for (int r = 0; r < 16; ++r) { const float c = (float)((r & 3) + 8 * (r >> 2) + 32); p1[r] = __builtin_amdgcn_exp2f(p1[r] - slope2 * fabsf(dq - c)); ps += p1[r]; }
        l_reg += swap_add(ps);
        bf16x8 pa0, pa1, pa2, pa3;
        PK4(p0, 0, pa0); PK4(p0, 8, pa1); PK4(p1, 0, pa2); PK4(p1, 8, pa3);
        const int vb = vb0 + (j & 1) * BUFB;
        pv_one<8, 0>(o[0], vb, pa0, pa1, pa2, pa3); pv_one<8, 1>(o[1], vb, pa0, pa1, pa2, pa3); pv_one<8, 2>(o[2], vb, pa0, pa1, pa2, pa3); pv_one<8, 3>(o[3], vb, pa0, pa1, pa2, pa3);
        pv_one<8, 4>(o[4], vb, pa0, pa1, pa2, pa3); pv_one<8, 5>(o[5], vb, pa0, pa1, pa2, pa3); pv_one<8, 6>(o[6], vb, pa0, pa1, pa2, pa3); pv_one<8, 7>(o[7], vb, pa0, pa1, pa2, pa3);
        dq -= 64.0f;
    }
#undef DA2_ISSUE
    int tz = threadIdx.x; asm volatile("" : "+v"(tz));
    epilogue(P, lds, o, l_reg, tz, it);
}
}

namespace da3 {
constexpr int BUFB = 65536, KB = 16384;
__device__ __forceinline__ void qk_softmax(const LAS unsigned char* Kb, const bf16x8* qr, int r32, int hi, float dq, float slope2, int rel  ,
                                           float& l_reg, bf16x8& pa0, bf16x8& pa1, bf16x8& pa2, bf16x8& pa3) {
    f32x16 p0, p1;
    if (rel != 0) {
        const float ss = rel < 0 ? slope2 : -slope2, A = -ss * dq;
#pragma unroll
        for (int r = 0; r < 16; ++r) { const float c = (float)((r & 3) + 8 * (r >> 2)); p0[r] = fmaf(ss, c, A); p1[r] = fmaf(ss, c + 32.0f, A); }
    } else {
#pragma unroll
        for (int r = 0; r < 16; ++r) { const float c = (float)((r & 3) + 8 * (r >> 2)); p0[r] = -slope2 * fabsf(dq - c); p1[r] = -slope2 * fabsf(dq - c - 32.0f); }
    }
#pragma unroll
    for (int d0 = 0; d0 < 8; ++d0) { const int cb = (d0 * 16 + hi * 8) * 2;
        const bf16x8 b0 = *(const LAS bf16x8*)(Kb + KSWZ(r32, cb));
        const bf16x8 b1 = *(const LAS bf16x8*)(Kb + KSWZ(32 + r32, cb));
        p0 = __builtin_amdgcn_mfma_f32_32x32x16_bf16(b0, qr[d0], p0, 0, 0, 0);
        p1 = __builtin_amdgcn_mfma_f32_32x32x16_bf16(b1, qr[d0], p1, 0, 0, 0); }
    f32x2 s2 = {0.f, 0.f};
#pragma unroll
    for (int r = 0; r < 16; r += 2) { p0[r] = __builtin_amdgcn_exp2f(p0[r]); p0[r + 1] = __builtin_amdgcn_exp2f(p0[r + 1]); s2 += (f32x2){p0[r], p0[r + 1]}; }
#pragma unroll
    for (int r = 0; r < 16; r += 2) { p1[r] = __builtin_amdgcn_exp2f(p1[r]); p1[r + 1] = __builtin_amdgcn_exp2f(p1[r + 1]); s2 += (f32x2){p1[r], p1[r + 1]}; }
    l_reg += swap_add(s2[0] + s2[1]);
    PK4(p0, 0, pa0); PK4(p0, 8, pa1); PK4(p1, 0, pa2); PK4(p1, 8, pa3);
}
struct VFrag { s16x4 l0, h0, l1, h1, l2, h2, l3, h3; };
template <int CB> __device__ __forceinline__ void vread(VFrag& f, int vb) {
    constexpr int S = 8 * 512;
    f.l0 = da2::tr_read<CB * 512 + 0 * S>(vb); f.h0 = da2::tr_read<CB * 512 + 1 * S>(vb); f.l1 = da2::tr_read<CB * 512 + 2 * S>(vb); f.h1 = da2::tr_read<CB * 512 + 3 * S>(vb);
    f.l2 = da2::tr_read<CB * 512 + 4 * S>(vb); f.h2 = da2::tr_read<CB * 512 + 5 * S>(vb); f.l3 = da2::tr_read<CB * 512 + 6 * S>(vb); f.h3 = da2::tr_read<CB * 512 + 7 * S>(vb);
}
__device__ __forceinline__ void vmma(f32x16& od, const VFrag& f, bf16x8 pa0, bf16x8 pa1, bf16x8 pa2, bf16x8 pa3) {
#define PKV(L, H) (bf16x8){L[0], L[1], L[2], L[3], H[0], H[1], H[2], H[3]}
    od = __builtin_amdgcn_mfma_f32_32x32x16_bf16(pa0, PKV(f.l0, f.h0), od, 0, 0, 0);
    od = __builtin_amdgcn_mfma_f32_32x32x16_bf16(pa1, PKV(f.l1, f.h1), od, 0, 0, 0);
    od = __builtin_amdgcn_mfma_f32_32x32x16_bf16(pa2, PKV(f.l2, f.h2), od, 0, 0, 0);
    od = __builtin_amdgcn_mfma_f32_32x32x16_bf16(pa3, PKV(f.l3, f.h3), od, 0, 0, 0);
#undef PKV
}
#define DA3_LW(n) do { asm volatile("s_waitcnt lgkmcnt(" #n ")" ::: "memory"); SBAR(); } while (0)
__device__ __forceinline__ void pv8(f32x16 (&o)[8], int vb, bf16x8 pa0, bf16x8 pa1, bf16x8 pa2, bf16x8 pa3) {
    VFrag fa, fb;
    vread<0>(fa, vb);
    vread<1>(fb, vb); DA3_LW(8); vmma(o[0], fa, pa0, pa1, pa2, pa3);
    vread<2>(fa, vb); DA3_LW(8); vmma(o[1], fb, pa0, pa1, pa2, pa3);
    vread<3>(fb, vb); DA3_LW(8); vmma(o[2], fa, pa0, pa1, pa2, pa3);
    vread<4>(fa, vb); DA3_LW(8); vmma(o[3], fb, pa0, pa1, pa2, pa3);
    vread<5>(fb, vb); DA3_LW(8); vmma(o[4], fa, pa0, pa1, pa2, pa3);
    vread<6>(fa, vb); DA3_LW(8); vmma(o[5], fb, pa0, pa1, pa2, pa3);
    vread<7>(fb, vb); DA3_LW(8); vmma(o[6], fa, pa0, pa1, pa2, pa3);
    DA3_LW(0); vmma(o[7], fb, pa0, pa1, pa2, pa3);
}
__device__ __forceinline__ void item(const Params& P, int it, LAS unsigned char* lds) {
    int tid = threadIdx.x; asm volatile("" : "+v"(tid));
    const int wid = __builtin_amdgcn_readfirstlane(tid >> 6), lane = tid & 63, r32 = lane & 31, hi = lane >> 5;
    const int br = wid >> 2, w4 = wid & 3;
    const int b = it >> 7, h = (it >> 5) & 3, qt = it & 31;
    const bf16_t* proj = (const bf16_t*)(P.ws + WS_PROJ);
    const size_t row0 = (size_t)b * SEQ; const int q0 = qt * 128;
    bf16x8 qr[8];
    { const bf16_t* Qw = proj + (row0 + q0 + w4 * 32 + r32) * INC + 3072 + br * 512 + h * 128 + hi * 8;
#pragma unroll
      for (int d0 = 0; d0 < 8; ++d0) qr[d0] = *(const bf16x8*)(Qw + d0 * 16); }
    const char* kbase = (const char*)(proj + row0 * INC + 4096 + br * 512 + h * 128);
    const char* vbase = (const char*)(proj + row0 * INC + 5120 + h * 256);
#define DA3_LANE() int lz_ = lane; asm volatile("" : "+v"(lz_)); const int krow_ = w4 * 16 + (lz_ >> 4)
#define DA3_ISSUE_K(t, bufi) do { DA3_LANE(); \
        const unsigned voffK0 = (unsigned)(krow_ * INC * 2 + (((lz_ & 15) ^ (lz_ >> 4)) << 4)); \
        const unsigned voffK1 = (unsigned)((krow_ + 4) * INC * 2 + (((lz_ & 15) ^ (4 + (lz_ >> 4))) << 4)); \
        const char* kb_ = kbase + (size_t)(t) * (64 * INC * 2); LAS unsigned char* lb_ = lds + (bufi) * BUFB + br * KB + w4 * 4096; \
        __builtin_amdgcn_global_load_lds((const unsigned*)(kb_ + voffK0), (LAS unsigned*)(lb_), 16, 0, 0); \
        __builtin_amdgcn_global_load_lds((const unsigned*)(kb_ + voffK1), (LAS unsigned*)(lb_ + 1024), 16, 0, 0); \
        __builtin_amdgcn_global_load_lds((const unsigned*)(kb_ + 8 * INC * 2 + voffK0), (LAS unsigned*)(lb_ + 2048), 16, 0, 0); \
        __builtin_amdgcn_global_load_lds((const unsigned*)(kb_ + 8 * INC * 2 + voffK1), (LAS unsigned*)(lb_ + 3072), 16, 0, 0); } while (0)
#define DA3_ISSUE_V(t, bufi) do { DA3_LANE(); (void)krow_; \
        const unsigned voffV = (unsigned)(da2::unswap23(wid * 8 + ((lz_ & 31) >> 2)) * INC * 2 + (lz_ >> 5) * 64 + (lz_ & 3) * 16); \
        const char* vb_ = vbase + (size_t)(t) * (64 * INC * 2); LAS unsigned char* lb_ = lds + (bufi) * BUFB + 2 * KB + wid * 4096; \
        _Pragma("unroll") for (int i_ = 0; i_ < 4; ++i_) \
            __builtin_amdgcn_global_load_lds((const unsigned*)(vb_ + i_ * 128 + voffV), (LAS unsigned*)(lb_ + i_ * 1024), 16, 0, 0); } while (0)
#define DA3_BAR() do { asm volatile("" ::: "memory"); __builtin_amdgcn_s_barrier(); asm volatile("" ::: "memory"); } while (0)
    const float slope2 = exp2f(-2.0f * (float)(h + 1)) * LOG2E;
    const int qlo = q0 + w4 * 32, jd = qlo >> 6;
    int jlo = 0, jhi = SEQ / 64 - 1;
    { float gq = fmaxf(fabsf(P.qn_b[lane]), fabsf(P.qn_b[lane + 64])), gk = fmaxf(fabsf(P.kn_b[lane]), fabsf(P.kn_b[lane + 64]));
#pragma unroll
      for (int o_ = 32; o_ >= 1; o_ >>= 1) { gq = fmaxf(gq, __shfl_xor(gq, o_)); gk = fmaxf(gk, __shfl_xor(gk, o_)); }
      const float smax = 128.0f * QSCALE * gq * gk, dmax = (160.0f + smax) / slope2;
      const int di = dmax < 8192.0f ? (int)dmax + 1 : 8192;
      const int klo = q0 - di, khi = q0 + 127 + di;
      jlo = __builtin_amdgcn_readfirstlane(klo <= 0 ? 0 : (klo >> 6)); jhi = __builtin_amdgcn_readfirstlane(khi >= SEQ - 1 ? SEQ / 64 - 1 : (khi >> 6)); }
    float dq = (float)(qlo + r32 - 4 * hi - 64 * jlo);
    f32x16 o[8];
#pragma unroll
    for (int d = 0; d < 8; ++d) o[d] = f32x16{};
    float l_reg = 0.f;
    const int vb0 = (int)(uintptr_t)(lds + 2 * KB) + da2::v_rd_base(lane);
    bf16x8 pa0, pa1, pa2, pa3;
    DA3_ISSUE_K(jlo, 0); DA3_ISSUE_V(jlo, 0);
    if (br == 0) {
        asm volatile("s_waitcnt vmcnt(4)" ::: "memory");
#pragma unroll 1
        for (int j = jlo; j <= jhi; ++j) {
            const int jn = (j + 1 <= jhi) ? j + 1 : jhi, bc = (j - jlo) & 1, bn = bc ^ 1;
            DA3_BAR();
            DA3_ISSUE_K(jn, bn);
            qk_softmax(lds + bc * BUFB, qr, r32, hi, dq, slope2, j - jd, l_reg, pa0, pa1, pa2, pa3);
            asm volatile("s_waitcnt vmcnt(4)" ::: "memory");
            DA3_BAR();
            DA3_ISSUE_V(jn, bn);
            pv8(o, vb0 + bc * BUFB, pa0, pa1, pa2, pa3);
            asm volatile("s_waitcnt vmcnt(4)" ::: "memory");
            dq -= 64.0f;
        }
        DA3_BAR();
    } else {
        DA3_BAR();
        asm volatile("s_waitcnt vmcnt(0)" ::: "memory");
#pragma unroll 1
        for (int j = jlo; j <= jhi; ++j) {
            const int jn = (j + 1 <= jhi) ? j + 1 : jhi, bc = (j - jlo) & 1, bn = bc ^ 1;
            DA3_BAR();
            DA3_ISSUE_K(jn, bn); DA3_ISSUE_V(jn, bn);
            qk_softmax(lds + bc * BUFB + KB, qr, r32, hi, dq, slope2, j - jd, l_reg, pa0, pa1, pa2, pa3);
            DA3_BAR();
            pv8(o, vb0 + bc * BUFB, pa0, pa1, pa2, pa3);
            asm volatile("s_waitcnt vmcnt(0)" ::: "memory");
            dq -= 64.0f;
        }
    }
#undef DA3_ISSUE_K
#undef DA3_LANE
#undef DA3_ISSUE_V
#undef DA3_BAR
    asm volatile("s_waitcnt vmcnt(0)" ::: "memory");
    int tz = threadIdx.x; asm volatile("" : "+v"(tz));
    da2::epilogue(P, lds, o, l_reg, tz, it);
}
}

namespace da5 {
constexpr int BUFB = 65536, KB = 16384;
typedef float f32x4v __attribute__((ext_vector_type(4)));
template <int OFF> __device__ __forceinline__ s16x4 trr(int a) { s16x4 r; asm volatile("ds_read_b64_tr_b16 %0, %1 offset:%2" : "=&v"(r) : "v"(a), "i"(OFF) : "memory"); return r; }
#define D5_LW(n) do { asm volatile("s_waitcnt lgkmcnt(" #n ")" ::: "memory"); SBAR(); } while (0)

__device__ __forceinline__ void qk_softmax(const LAS unsigned char* Kb, const bf16x8 (&qr)[4][2], int lane_, float dqb, float slope2, int rel, float (&l)[2], bf16x8 (&pa)[2][2]) {
    asm volatile("" : "+v"(lane_));
    const int l16 = lane_ & 15, g = lane_ >> 4;
    f32x4v S[4][2];
    if (rel != 0) {
        const float ss = rel < 0 ? slope2 : -slope2, A = -ss * dqb;
#pragma unroll
        for (int kg = 0; kg < 4; ++kg)
#pragma unroll
            for (int qg = 0; qg < 2; ++qg)
#pragma unroll
                for (int r = 0; r < 4; ++r) S[kg][qg][r] = fmaf(ss, (float)(16 * kg + r - 16 * qg), A);
    } else {
#pragma unroll
        for (int kg = 0; kg < 4; ++kg)
#pragma unroll
            for (int qg = 0; qg < 2; ++qg)
#pragma unroll
                for (int r = 0; r < 4; ++r) S[kg][qg][r] = -slope2 * fabsf(dqb - (float)(16 * kg + r - 16 * qg));
    }
    const int krow = l16 * 256, kx = (l16 & 7) << 4;
#pragma unroll
    for (int s = 0; s < 4; ++s) {
        const int ka = krow + ((64 * s + 16 * g) ^ kx);
        const bf16x8 k0 = *(const LAS bf16x8*)(Kb + ka), k1 = *(const LAS bf16x8*)(Kb + ka + 4096), k2 = *(const LAS bf16x8*)(Kb + ka + 8192), k3 = *(const LAS bf16x8*)(Kb + ka + 12288);
        __builtin_amdgcn_s_setprio(1);
#pragma unroll
        for (int qg = 0; qg < 2; ++qg) {
            S[0][qg] = __builtin_amdgcn_mfma_f32_16x16x32_bf16(k0, qr[s][qg], S[0][qg], 0, 0, 0);
            S[1][qg] = __builtin_amdgcn_mfma_f32_16x16x32_bf16(k1, qr[s][qg], S[1][qg], 0, 0, 0);
            S[2][qg] = __builtin_amdgcn_mfma_f32_16x16x32_bf16(k2, qr[s][qg], S[2][qg], 0, 0, 0);
            S[3][qg] = __builtin_amdgcn_mfma_f32_16x16x32_bf16(k3, qr[s][qg], S[3][qg], 0, 0, 0);
        }
        __builtin_amdgcn_s_setprio(0);
    }
#pragma unroll
    for (int qg = 0; qg < 2; ++qg) {
        f32x2 s2 = {0.f, 0.f};
#pragma unroll
        for (int kg = 0; kg < 4; ++kg) {
#pragma unroll
            for (int r = 0; r < 4; ++r) S[kg][qg][r] = __builtin_amdgcn_exp2f(S[kg][qg][r]);
            s2 += (f32x2){S[kg][qg][0], S[kg][qg][1]}; s2 += (f32x2){S[kg][qg][2], S[kg][qg][3]};
        }
        float ps = s2[0] + s2[1];
        ps += __shfl_xor(ps, 16); ps += __shfl_xor(ps, 32);
        l[qg] += ps;
#pragma unroll
        for (int ks = 0; ks < 2; ++ks) {
            u32x4 w; w.x = cvtpk(S[2 * ks][qg][0], S[2 * ks][qg][1]); w.y = cvtpk(S[2 * ks][qg][2], S[2 * ks][qg][3]);
            w.z = cvtpk(S[2 * ks + 1][qg][0], S[2 * ks + 1][qg][1]); w.w = cvtpk(S[2 * ks + 1][qg][2], S[2 * ks + 1][qg][3]);
            pa[qg][ks] = *reinterpret_cast<bf16x8*>(&w);
        }
    }
}
struct VF { s16x4 a0, a1, b0, b1; };
template <int HI> __device__ __forceinline__ void vread(VF& f, int a) {
    f.a0 = trr<HI * 256 + 0>(a); f.a1 = trr<HI * 256 + 8192>(a); f.b0 = trr<HI * 256 + 16384>(a); f.b1 = trr<HI * 256 + 24576>(a);
}
__device__ __forceinline__ void vmma(f32x4v& o0, f32x4v& o1, const VF& f, const bf16x8 (&pa)[2][2]) {
#define PKV(L, H) (bf16x8){L[0], L[1], L[2], L[3], H[0], H[1], H[2], H[3]}
    const bf16x8 v0 = PKV(f.a0, f.a1), v1 = PKV(f.b0, f.b1);
    __builtin_amdgcn_s_setprio(1);
    o0 = __builtin_amdgcn_mfma_f32_16x16x32_bf16(pa[0][0], v0, o0, 0, 0, 0);
    o1 = __builtin_amdgcn_mfma_f32_16x16x32_bf16(pa[1][0], v0, o1, 0, 0, 0);
    o0 = __builtin_amdgcn_mfma_f32_16x16x32_bf16(pa[0][1], v1, o0, 0, 0, 0);
    o1 = __builtin_amdgcn_mfma_f32_16x16x32_bf16(pa[1][1], v1, o1, 0, 0, 0);
    __builtin_amdgcn_s_setprio(0);
#undef PKV
}
__device__ __forceinline__ void pv16(f32x4v (&o)[2][16], int vbuf, int lane_, const bf16x8 (&pa)[2][2]) {
    asm volatile("" : "+v"(lane_));
    const int l16 = lane_ & 15, g = lane_ >> 4, q4 = l16 >> 2, p = l16 & 3;
    const int lb = (4 * g + q4) * 512 + ((4 * (g & 1) + q4) << 5) + 8 * p;
    VF fa, fb;
#define VA(vt) (vbuf + (lb ^ (((vt) & 7) << 5)))
    vread<0>(fa, VA(0));
    vread<0>(fb, VA(1)); D5_LW(4); vmma(o[0][0], o[1][0], fa, pa);
    vread<0>(fa, VA(2)); D5_LW(4); vmma(o[0][1], o[1][1], fb, pa);
    vread<0>(fb, VA(3)); D5_LW(4); vmma(o[0][2], o[1][2], fa, pa);
    vread<0>(fa, VA(4)); D5_LW(4); vmma(o[0][3], o[1][3], fb, pa);
    vread<0>(fb, VA(5)); D5_LW(4); vmma(o[0][4], o[1][4], fa, pa);
    vread<0>(fa, VA(6)); D5_LW(4); vmma(o[0][5], o[1][5], fb, pa);
    vread<0>(fb, VA(7)); D5_LW(4); vmma(o[0][6], o[1][6], fa, pa);
    vread<1>(fa, VA(8)); D5_LW(4); vmma(o[0][7], o[1][7], fb, pa);
    vread<1>(fb, VA(9)); D5_LW(4); vmma(o[0][8], o[1][8], fa, pa);
    vread<1>(fa, VA(10)); D5_LW(4); vmma(o[0][9], o[1][9], fb, pa);
    vread<1>(fb, VA(11)); D5_LW(4); vmma(o[0][10], o[1][10], fa, pa);
    vread<1>(fa, VA(12)); D5_LW(4); vmma(o[0][11], o[1][11], fb, pa);
    vread<1>(fb, VA(13)); D5_LW(4); vmma(o[0][12], o[1][12], fa, pa);
    vread<1>(fa, VA(14)); D5_LW(4); vmma(o[0][13], o[1][13], fb, pa);
    vread<1>(fb, VA(15)); D5_LW(4); vmma(o[0][14], o[1][14], fa, pa);
    D5_LW(0); vmma(o[0][15], o[1][15], fb, pa);
#undef VA
}
__device__ __forceinline__ void epilogue(const Params& P, LAS unsigned char* lds, f32x4v (&o)[2][16], const float (&l)[2], int tz, int it) {
    const int wid = __builtin_amdgcn_readfirstlane(tz >> 6), lane = tz & 63, l16 = lane & 15, g = lane >> 4;
    float lam;
    { float a = P.lam_q1[lane] * P.lam_k1[lane] + P.lam_q1[lane + 64] * P.lam_k1[lane + 64];
      float c = P.lam_q2[lane] * P.lam_k2[lane] + P.lam_q2[lane + 64] * P.lam_k2[lane + 64];
      a = wave_sum(a); c = wave_sum(c); lam = expf(a) - expf(c) + 0.2f; }
    const int br = wid >> 2, w4 = wid & 3;
    const int b = it >> 7, h = (it >> 5) & 3, qt = it & 31;
    const size_t row0 = (size_t)b * SEQ; const int q0 = qt * 128;
    LAS float* li_l = (LAS float*)(lds + SCR_OFF) + wid * 32;
    if (g == 0) { li_l[l16] = l[0]; li_l[16 + l16] = l[1]; }
    asm volatile("s_waitcnt lgkmcnt(0)" ::: "memory");
    __syncthreads();
    LAS float* X = (LAS float*)lds + w4 * 8192;
    if (br == 1) {
#pragma unroll
        for (int qg = 0; qg < 2; ++qg)
#pragma unroll
            for (int r = 0; r < 4; ++r) { const float rl = __builtin_amdgcn_rcpf(li_l[16 * qg + 4 * g + r]);
#pragma unroll
                for (int vt = 0; vt < 16; ++vt) X[((qg * 4 + r) * 16 + vt) * 64 + lane] = o[qg][vt][r] * rl; }
    }
    __syncthreads();
    if (br == 0) {
        LAS unsigned char* T = (LAS unsigned char*)X;
        float gw[16];
#pragma unroll
        for (int vt = 0; vt < 16; ++vt) gw[vt] = P.subln_b[16 * vt + l16];
#pragma unroll
        for (int qg = 0; qg < 2; ++qg)
#pragma unroll
            for (int r = 0; r < 4; ++r) {
                const int u = qg * 4 + r;
                const float rl = __builtin_amdgcn_rcpf(li_l[16 * qg + 4 * g + r]);
                float v[16], sq = 0.f;
#pragma unroll
                for (int vt = 0; vt < 16; ++vt) { v[vt] = o[qg][vt][r] * rl - lam * X[(u * 16 + vt) * 64 + lane]; sq += v[vt] * v[vt]; }
                sq += __shfl_xor(sq, 1); sq += __shfl_xor(sq, 2); sq += __shfl_xor(sq, 4); sq += __shfl_xor(sq, 8);
                const float rstd = rsqrtf(sq * (1.0f / 256.0f) + RMS_EPS) * 0.8f;
#pragma unroll
                for (int vt = 0; vt < 16; ++vt) { const unsigned w = cvtpk(v[vt] * rstd * gw[vt], 0.f); *(LAS bf16_t*)(T + (4 * u + g) * 512 + (16 * vt + l16) * 2) = (bf16_t)(w & 0xffffu); }
            }
        asm volatile("s_waitcnt lgkmcnt(0)" ::: "memory");
        char* mixb = (char*)((bf16_t*)(P.ws + WS_MIX) + (row0 + q0 + w4 * 32) * DM + 1024 + h * 256);
#pragma unroll
        for (int i = 0; i < 16; ++i) {
            const int ti = 2 * i + (lane >> 5), u = ti >> 2, gg = ti & 3, q = 16 * (u >> 2) + 4 * gg + (u & 3);
            const u32x4 w = *(const LAS u32x4*)(T + ti * 512 + (lane & 31) * 16);
            *(u32x4*)(mixb + (size_t)q * (DM * 2) + (lane & 31) * 16) = w;
        }
    }
    __syncthreads();
}
__device__ __forceinline__ void item(const Params& P, int it, LAS unsigned char* lds) {
    int tid = threadIdx.x; asm volatile("" : "+v"(tid));
    const int wid = __builtin_amdgcn_readfirstlane(tid >> 6), lane = tid & 63, l16 = lane & 15, g = lane >> 4;
    const int br = wid >> 2, w4 = wid & 3;
    const int b = it >> 7, h = (it >> 5) & 3, qt = it & 31;
    const bf16_t* proj = (const bf16_t*)(P.ws + WS_PROJ);
    const size_t row0 = (size_t)b * SEQ; const int q0 = qt * 128;
    bf16x8 qr[4][2];
    { const bf16_t* Qw = proj + (row0 + q0 + w4 * 32 + l16) * INC + 3072 + br * 512 + h * 128 + 8 * g;
#pragma unroll
      for (int s = 0; s < 4; ++s)
#pragma unroll
          for (int qg = 0; qg < 2; ++qg) qr[s][qg] = *(const bf16x8*)(Qw + (size_t)(16 * qg) * INC + 32 * s); }
    const char* kbase = (const char*)(proj + row0 * INC + 4096 + br * 512 + h * 128);
    const char* vbase = (const char*)(proj + row0 * INC + 5120 + h * 256);
#define D5_LANE() int lz_ = lane; asm volatile("" : "+v"(lz_))
#define D5_ISSUE_K(t, bufi) do { D5_LANE(); const int krow_ = w4 * 16 + (lz_ >> 4); \
        const unsigned voffK0 = (unsigned)(krow_ * INC * 2 + (((lz_ & 15) ^ (lz_ >> 4)) << 4)); \
        const unsigned voffK1 = (unsigned)((krow_ + 4) * INC * 2 + (((lz_ & 15) ^ (4 + (lz_ >> 4))) << 4)); \
        const char* kb_ = kbase + (size_t)(t) * (64 * INC * 2); LAS unsigned char* lb_ = lds + (bufi) * BUFB + br * KB + w4 * 4096; \
        __builtin_amdgcn_global_load_lds((const unsigned*)(kb_ + voffK0), (LAS unsigned*)(lb_), 16, 0, 0); \
        __builtin_amdgcn_global_load_lds((const unsigned*)(kb_ + voffK1), (LAS unsigned*)(lb_ + 1024), 16, 0, 0); \
        __builtin_amdgcn_global_load_lds((const unsigned*)(kb_ + 8 * INC * 2 + voffK0), (LAS unsigned*)(lb_ + 2048), 16, 0, 0); \
        __builtin_amdgcn_global_load_lds((const unsigned*)(kb_ + 8 * INC * 2 + voffK1), (LAS unsigned*)(lb_ + 3072), 16, 0, 0); } while (0)
#define D5_ISSUE_V(t, bufi) do { D5_LANE(); const char* vb_ = vbase + (size_t)(t) * (64 * INC * 2) + (size_t)(wid * 8) * (INC * 2); LAS unsigned char* lb_ = lds + (bufi) * BUFB + 2 * KB + wid * 4096; \
        _Pragma("unroll") for (int i_ = 0; i_ < 4; ++i_) { const int rr_ = 2 * i_ + (lz_ >> 5); \
            const unsigned vo_ = (unsigned)(rr_ * INC * 2 + (((lz_ & 31) ^ (rr_ << 1)) << 4)); \
            __builtin_amdgcn_global_load_lds((const unsigned*)(vb_ + vo_), (LAS unsigned*)(lb_ + i_ * 1024), 16, 0, 0); } } while (0)
#define D5_BAR() do { asm volatile("" ::: "memory"); __builtin_amdgcn_s_barrier(); asm volatile("" ::: "memory"); } while (0)
    const float slope2 = __int_as_float(__builtin_amdgcn_readfirstlane(__float_as_int(exp2f(-2.0f * (float)(h + 1)) * LOG2E)));
    const int qlo = q0 + w4 * 32, jd = qlo >> 6;
    int jlo = 0, jhi = SEQ / 64 - 1;
    { float gq = fmaxf(fabsf(P.qn_b[lane]), fabsf(P.qn_b[lane + 64])), gk = fmaxf(fabsf(P.kn_b[lane]), fabsf(P.kn_b[lane + 64]));
#pragma unroll
      for (int o_ = 32; o_ >= 1; o_ >>= 1) { gq = fmaxf(gq, __shfl_xor(gq, o_)); gk = fmaxf(gk, __shfl_xor(gk, o_)); }
      const float smax = 128.0f * QSCALE * gq * gk, dmax = (160.0f + smax) / slope2;
      const int di = dmax < 8192.0f ? (int)dmax + 1 : 8192;
      const int klo = q0 - di, khi = q0 + 127 + di;
      jlo = __builtin_amdgcn_readfirstlane(klo <= 0 ? 0 : (klo >> 6)); jhi = __builtin_amdgcn_readfirstlane(khi >= SEQ - 1 ? SEQ / 64 - 1 : (khi >> 6)); }
    float dqb = (float)(qlo + l16 - 4 * g - 64 * jlo);
    f32x4v o[2][16];
#pragma unroll
    for (int qg = 0; qg < 2; ++qg)
#pragma unroll
        for (int vt = 0; vt < 16; ++vt) o[qg][vt] = (f32x4v){0.f, 0.f, 0.f, 0.f};
    float l[2] = {0.f, 0.f};
    const int vbuf0 = (int)(uintptr_t)(lds + 2 * KB);
    bf16x8 pa[2][2];
    D5_ISSUE_K(jlo, 0); D5_ISSUE_V(jlo, 0);
    if (br == 0) {
        asm volatile("s_waitcnt vmcnt(4)" ::: "memory");
#pragma unroll 1
        for (int j = jlo; j <= jhi; ++j) {
            const int jn = (j + 1 <= jhi) ? j + 1 : jhi, bc = (j - jlo) & 1, bn = bc ^ 1;
            D5_BAR();
            D5_ISSUE_K(jn, bn);
            qk_softmax(lds + bc * BUFB, qr, lane, dqb, slope2, j - jd, l, pa);
            asm volatile("s_waitcnt vmcnt(4)" ::: "memory");
            D5_BAR();
            D5_ISSUE_V(jn, bn);
            pv16(o, vbuf0 + bc * BUFB, lane, pa);
            asm volatile("s_waitcnt vmcnt(4)" ::: "memory");
            dqb -= 64.0f;
        }
        D5_BAR();
    } else {
        D5_BAR();
        asm volatile("s_waitcnt vmcnt(0)" ::: "memory");
#pragma unroll 1
        for (int j = jlo; j <= jhi; ++j) {
            const int jn = (j + 1 <= jhi) ? j + 1 : jhi, bc = (j - jlo) & 1, bn = bc ^ 1;
            D5_BAR();
            D5_ISSUE_K(jn, bn); D5_ISSUE_V(jn, bn);
            qk_softmax(lds + bc * BUFB + KB, qr, lane, dqb, slope2, j - jd, l, pa);
            D5_BAR();
            pv16(o, vbuf0 + bc * BUFB, lane, pa);
            asm volatile("s_waitcnt vmcnt(0)" ::: "memory");
            dqb -= 64.0f;
        }
    }
#undef D5_ISSUE_K
#undef D5_ISSUE_V
#undef D5_BAR
#undef D5_LANE
    asm volatile("s_waitcnt vmcnt(0)" ::: "memory");
    int tz = threadIdx.x; asm volatile("" : "+v"(tz));
    epilogue(P, lds, o, l, tz, it);
}
#undef D5_LW
}

namespace na2 {
__device__ __forceinline__ void item(const Params& P, int it, LAS unsigned char* lds) {
    int tid = threadIdx.x; asm volatile("" : "+v"(tid));
    const int wid = __builtin_amdgcn_readfirstlane(tid >> 6), lane = tid & 63, r32 = lane & 31, hi = lane >> 5;
    const int b = it >> 7, h = (it >> 4) & 7, r0 = (it & 15) * 4;
    const int r = r0 + (wid >> 1), cq0 = (wid & 1) * 32;
    const bf16_t* proj = (const bf16_t*)(P.ws + WS_PROJ);
    LAS float* tab = (LAS float*)(lds + SCR_OFF);
    LAS float* li_l = (LAS float*)(lds + SCR_OFF + 2048) + wid * 32;
    for (int i = tid; i < 15 * 31; i += NTHR) tab[(i / 31) * 32 + (i % 31)] = P.rpb_a[h * 465 + i] * LOG2E;
    bf16x8 qr[8];
    { const bf16_t* Qw = proj + ((size_t)b * SEQ + r * 64 + cq0 + r32) * INC + h * 128 + hi * 8;
#pragma unroll
      for (int d0 = 0; d0 < 8; ++d0) qr[d0] = *(const bf16x8*)(Qw + d0 * 16); }
    int kr_lo = r0 - 4; kr_lo = kr_lo < 0 ? 0 : (kr_lo > 56 ? 56 : kr_lo);
    int kr_hi = r0 - 1; kr_hi = (kr_hi < 0 ? 0 : (kr_hi > 56 ? 56 : kr_hi)) + 7;
    int rs = r - 4; rs = rs < 0 ? 0 : (rs > 56 ? 56 : rs);
    const int cq = cq0 + r32; int cs = cq - 8; cs = cs < 0 ? 0 : (cs > 48 ? 48 : cs);
    const char* kbase = (const char*)(proj + (size_t)b * SEQ * INC + 1024 + h * 128);
    const char* vbase = (const char*)(proj + (size_t)b * SEQ * INC + 2048 + h * 128);
    const int krow = wid * 8 + (lane >> 4);
    const unsigned voffK0 = (unsigned)(krow * INC * 2 + (((lane & 15) ^ (lane >> 4)) << 4));
    const unsigned voffK1 = (unsigned)((krow + 4) * INC * 2 + (((lane & 15) ^ (4 + (lane >> 4))) << 4));
    const unsigned voffV = (unsigned)(da2::unswap23(wid * 8 + ((lane & 31) >> 2)) * INC * 2 + (lane >> 5) * 64 + (lane & 3) * 16);
#define NA2_ISSUE(kr, bufi) do { const char* kb_ = kbase + (size_t)(kr) * (64 * INC * 2); const char* vb_ = vbase + (size_t)(kr) * (64 * INC * 2); \
        LAS unsigned char* lb_ = lds + (bufi) * 32768; \
        __builtin_amdgcn_global_load_lds((const unsigned*)(kb_ + voffK0), (LAS unsigned*)(lb_ + wid * 2048), 16, 0, 0); \
        __builtin_amdgcn_global_load_lds((const unsigned*)(kb_ + voffK1), (LAS unsigned*)(lb_ + wid * 2048 + 1024), 16, 0, 0); \
        __builtin_amdgcn_global_load_lds((const unsigned*)(vb_ + voffV), (LAS unsigned*)(lb_ + 16384 + wid * 2048), 16, 0, 0); \
        __builtin_amdgcn_global_load_lds((const unsigned*)(vb_ + 128 + voffV), (LAS unsigned*)(lb_ + 16384 + wid * 2048 + 1024), 16, 0, 0); } while (0)
    f32x16 o[4];
#pragma unroll
    for (int d = 0; d < 4; ++d) o[d] = f32x16{};
    float l_reg = 0.f;
    const int vb0 = (int)(uintptr_t)(lds + 16384) + da2::v_rd_base(lane);
    NA2_ISSUE(kr_lo, 0);
#pragma unroll 1
    for (int kr = kr_lo; kr <= kr_hi; ++kr) {
        const int bi = (kr - kr_lo) & 1;
        asm volatile("s_waitcnt vmcnt(0) lgkmcnt(0)" ::: "memory");
        __builtin_amdgcn_s_barrier();
        asm volatile("" ::: "memory");
        if (kr < kr_hi) NA2_ISSUE(kr + 1, bi ^ 1);
        if (kr >= rs && kr < rs + 8) {
            f32x16 p0, p1;
            da2::qkt(p0, p1, lds + bi * 32768, qr, r32, hi);
            const LAS float* trow = tab + (kr - r + 7) * 32;
            float ps = 0.f;
#pragma unroll
            for (int rr = 0; rr < 16; ++rr) {
                const int ck = crow(rr, hi);
                { const int rel = ck - cq + 15; const bool valid = (ck >= cs) && (ck < cs + 16); const int idx = rel < 0 ? 0 : (rel > 30 ? 30 : rel);
                  const float v = valid ? __builtin_amdgcn_exp2f(p0[rr] + trow[idx]) : 0.f; p0[rr] = v; ps += v; }
                { const int ck1 = ck + 32; const int rel = ck1 - cq + 15; const bool valid = (ck1 >= cs) && (ck1 < cs + 16); const int idx = rel < 0 ? 0 : (rel > 30 ? 30 : rel);
                  const float v = valid ? __builtin_amdgcn_exp2f(p1[rr] + trow[idx]) : 0.f; p1[rr] = v; ps += v; }
            }
            l_reg += swap_add(ps);
            bf16x8 pa0, pa1, pa2, pa3;
            PK4(p0, 0, pa0); PK4(p0, 8, pa1); PK4(p1, 0, pa2); PK4(p1, 8, pa3);
            const int vb = vb0 + bi * 32768;
            da2::pv_one<4, 0>(o[0], vb, pa0, pa1, pa2, pa3); da2::pv_one<4, 1>(o[1], vb, pa0, pa1, pa2, pa3);
            da2::pv_one<4, 2>(o[2], vb, pa0, pa1, pa2, pa3); da2::pv_one<4, 3>(o[3], vb, pa0, pa1, pa2, pa3);
        }
    }
#undef NA2_ISSUE
    if (hi == 0) li_l[r32] = l_reg;
    asm volatile("s_waitcnt lgkmcnt(0)" ::: "memory");
    __syncthreads();
    LAS unsigned char* T = lds + wid * 8192;
    float* nassq = (float*)(P.ws + WS_NASSQ);
    const size_t t0 = (size_t)b * SEQ + r * 64 + cq0;
#pragma unroll
    for (int rr = 0; rr < 16; ++rr) {
        const float rl = __builtin_amdgcn_rcpf(li_l[crow(rr, hi)]);
        float sq = 0.f;
#pragma unroll
        for (int d = 0; d < 4; ++d) {
            const unsigned w = cvtpk(o[d][rr] * rl, 0.f); const float vq = __uint_as_float(w << 16);
            sq += vq * vq;
            *(LAS bf16_t*)(T + (2 * rr + hi) * 256 + (d * 32 + r32) * 2) = (bf16_t)(w & 0xffffu);
        }
#pragma unroll
        for (int sh = 16; sh >= 1; sh >>= 1) sq += __shfl_xor(sq, sh);
        if (r32 == 0) nassq[(t0 + crow(rr, hi)) * 8 + h] = sq;
    }
    asm volatile("s_waitcnt lgkmcnt(0)" ::: "memory");
    char* mixb = (char*)((bf16_t*)(P.ws + WS_MIX) + t0 * DM + h * 128);
#pragma unroll
    for (int i = 0; i < 8; ++i) {
        const int tr = i * 4 + (lane >> 4), rr2 = tr >> 1, h2 = tr & 1;
        const u32x4 w = *(const LAS u32x4*)(T + tr * 256 + (lane & 15) * 16);
        *(u32x4*)(mixb + (size_t)crow(rr2, h2) * (DM * 2) + (lane & 15) * 16) = w;
    }
    __syncthreads();
}
}

__device__ __forceinline__ void da_combine(const Params& P) {
    int tid = threadIdx.x; asm volatile("" : "+v"(tid)); const int wid = tid >> 6, lane = tid & 63;
    float a = P.lam_q1[lane] * P.lam_k1[lane] + P.lam_q1[lane + 64] * P.lam_k1[lane + 64];
    float c = P.lam_q2[lane] * P.lam_k2[lane] + P.lam_q2[lane + 64] * P.lam_k2[lane + 64];
    a = wave_sum(a); c = wave_sum(c);
    const float lam = expf(a) - expf(c) + 0.2f;
    const float* op = (const float*)(P.ws + WS_OPART);
    bf16_t* mix = (bf16_t*)(P.ws + WS_MIX);
    const f32x4 g = ((const f32x4*)P.subln_b)[lane];
    for (int it = blockIdx.x * 8 + wid; it < MTOK * 4; it += gridDim.x * 8) {
        const int tok = it >> 2, h = it & 3;
        const float* p = op + (size_t)tok * DM + h * 512;
        const f32x4 o1 = ((const f32x4*)p)[lane], o2 = ((const f32x4*)(p + 256))[lane];
        const f32x4 v = o1 - lam * o2;
        float ss = (v[0] * v[0] + v[1] * v[1]) + (v[2] * v[2] + v[3] * v[3]);
        ss = wave_sum(ss);
        const float rstd = rsqrtf(ss * (1.0f / 256.0f) + RMS_EPS) * 0.8f;
        u32x2 w; w.x = cvtpk(v[0] * rstd * g[0], v[1] * rstd * g[1]); w.y = cvtpk(v[2] * rstd * g[2], v[3] * rstd * g[3]);
        *(u32x2*)(mix + (size_t)tok * DM + 1024 + h * 256 + lane * 4) = w;
    }
}

__device__ __forceinline__ f32x4 ldx1(const bf16_t* p) { const u32x2 w = *(const u32x2*)p; return (f32x4){__uint_as_float(w.x << 16), __uint_as_float(w.x & 0xffff0000u), __uint_as_float(w.y << 16), __uint_as_float(w.y & 0xffff0000u)}; }
__device__ __forceinline__ void router_phase(const Params& P, LAS unsigned char* lds) {
    int tid = threadIdx.x; asm volatile("" : "+v"(tid)); const int wid = tid >> 6, lane = tid & 63;
    { const f32x4* src = (const f32x4*)(P.ws + WS_WRT);
#pragma unroll
      for (int i = 0; i < 16; ++i) *(LAS f32x4*)(lds + (size_t)(i * NTHR + tid) * 16) = src[i * NTHR + tid];
      __syncthreads(); }
    const LAS float* wl = (const LAS float*)lds;
    const bf16_t* x1b = (const bf16_t*)(P.ws + WS_OPART);
    const float* rowss = (const float*)(P.ws + WS_ROWSS);
    unsigned char* H2 = (unsigned char*)(P.ws + WS_H2);
    float* aff = (float*)(P.ws + WS_AFF);
    LAS float* red = (LAS float*)(lds + 131072) + wid * 64;
    for (int g4 = blockIdx.x * 8 + wid; g4 < MTOK / 4; g4 += gridDim.x * 8) {
        const int row0 = g4 * 4;
        f32x4 xa[4], xb[4];
#pragma unroll
        for (int t = 0; t < 4; ++t) { xa[t] = ldx1(x1b + (size_t)(row0 + t) * DM + (0 * 64 + lane) * 4); xb[t] = ldx1(x1b + (size_t)(row0 + t) * DM + (1 * 64 + lane) * 4); }
        float rstd[4];
#pragma unroll
        for (int t = 0; t < 4; ++t) { float s = (lane < 32) ? rowss[(size_t)(row0 + t) * 32 + lane] : 0.f; s = wave_sum(s); rstd[t] = rsqrtf(s * (1.0f / DM) + RMS_EPS); }
        float acc[64];
#pragma unroll
        for (int k = 0; k < 64; ++k) acc[k] = 0.f;
#pragma unroll
        for (int i = 0; i < 8; ++i) {
            const int c0 = (i * 64 + lane) * 4;
            const f32x4 g = *(const f32x4*)(P.ln2_g + c0);
            f32x4 hv[4];
#pragma unroll
            for (int t = 0; t < 4; ++t) {
                const f32x4 xc = (i & 1) ? xb[t] : xa[t];
                if (i + 2 < 8) { const f32x4 nx = ldx1(x1b + (size_t)(row0 + t) * DM + ((i + 2) * 64 + lane) * 4); if (i & 1) xb[t] = nx; else xa[t] = nx; }
                hv[t] = xc * rstd[t] * g;
                *(unsigned*)(H2 + (size_t)(row0 + t) * DM + c0) = cvt4_fp8(hv[t][0] * HSC8, hv[t][1] * HSC8, hv[t][2] * HSC8, hv[t][3] * HSC8);
            }
#pragma unroll
            for (int e = 0; e < 16; ++e) {
                const f32x4 w = *(const LAS f32x4*)(wl + e * DM + c0);
#pragma unroll
                for (int t = 0; t < 4; ++t) acc[t * 16 + e] += (hv[t][0] * w[0] + hv[t][1] * w[1]) + (hv[t][2] * w[2] + hv[t][3] * w[3]);
            }
        }
#pragma unroll
        for (int step = 0; step < 6; ++step) {
            const int m = 32 >> step, half = 32 >> step;
            const bool up = (lane & m) != 0;
#pragma unroll
            for (int k = 0; k < half; ++k) {
                const float keep = up ? acc[k + half] : acc[k], send = up ? acc[k] : acc[k + half];
                acc[k] = keep + __shfl_xor(send, m);
            }
        }
        red[lane] = acc[0];
        asm volatile("s_waitcnt lgkmcnt(0)" ::: "memory");
        if (lane < 4) {
            const int t = lane; float lg[16], mx = -1e30f;
#pragma unroll
            for (int e = 0; e < 16; ++e) { lg[e] = red[t * 16 + e]; mx = fmaxf(mx, lg[e]); }
            float sum = 0.f;
#pragma unroll
            for (int e = 0; e < 16; ++e) { lg[e] = expf(lg[e] - mx); sum += lg[e]; }
            const float inv = 1.0f / sum;
            const int row = row0 + t, bb = row >> 12, sq = row & 4095;
#pragma unroll
            for (int e = 0; e < 16; ++e) aff[((size_t)bb * 16 + e) * SEQ + sq] = lg[e] * inv;
        }
    }
}

__device__ __forceinline__ void topk_phase(const Params& P, LAS unsigned char* lds) {
    int tid = threadIdx.x; asm volatile("" : "+v"(tid)); const int wid = tid >> 6, lane = tid & 63;
    const float* aff = (const float*)(P.ws + WS_AFF);
    int* selidx = (int*)(P.ws + WS_SELIDX); float* selgate = (float*)(P.ws + WS_SELGATE); int* slot = (int*)(P.ws + WS_SLOT);
    LAS unsigned* red = (LAS unsigned*)lds;
    for (int it = blockIdx.x; it < NB * NEXP; it += gridDim.x) {
        const int b = it >> 4, e = it & 15;
        const float* ap = aff + (size_t)it * SEQ + tid * 8;
        const f32x4 a0 = *(const f32x4*)ap, a1 = *(const f32x4*)(ap + 4);
        unsigned v[8];
#pragma unroll
        for (int j = 0; j < 4; ++j) { v[j] = __float_as_uint(a0[j]); v[4 + j] = __float_as_uint(a1[j]); }
        LAS unsigned* hist = red + 64;
        unsigned T = 0u, pmask = 0u, needk = (unsigned)CAP;
#pragma unroll 1
        for (int pass = 0; pass < 4; ++pass) {
            const int shift = 24 - 8 * pass;
            if (tid < 256) hist[tid] = 0u;
            __syncthreads();
#pragma unroll
            for (int j = 0; j < 8; ++j) if ((v[j] & pmask) == T) atomicAdd((unsigned*)(hist + ((v[j] >> shift) & 255u)), 1u);
            __syncthreads();
            unsigned hv = 0, incl = 0;
            if (tid < 256) { hv = hist[255 - tid]; incl = hv;
#pragma unroll
                for (int o = 1; o < 64; o <<= 1) { const unsigned up = __shfl_up(incl, o); if (lane >= o) incl += up; }
                if (lane == 63) hist[260 + wid] = incl; }
            __syncthreads();
            if (tid < 256) {
                for (int w = 0; w < wid; ++w) incl += hist[260 + w];
                const unsigned sfx = incl - hv;
                if (sfx < needk && incl >= needk) { hist[256] = (unsigned)(255 - tid); hist[257] = needk - sfx; }
            }
            __syncthreads();
            T |= hist[256] << shift; pmask |= 255u << shift; needk = hist[257];
            __syncthreads();
        }
        unsigned g[8], q[8], gsum = 0, qsum = 0;
#pragma unroll
        for (int j = 0; j < 8; ++j) { g[j] = v[j] > T ? 1u : 0u; q[j] = v[j] == T ? 1u : 0u; gsum += g[j]; qsum += q[j]; }
        unsigned gi = gsum, qi = qsum;
#pragma unroll
        for (int o = 1; o < 64; o <<= 1) { const unsigned tg = __shfl_up(gi, o), tq = __shfl_up(qi, o); if (lane >= o) { gi += tg; qi += tq; } }
        LAS unsigned* sc = red + 32;
        __syncthreads();
        if (lane == 63) { sc[wid] = gi; sc[8 + wid] = qi; }
        __syncthreads();
        unsigned gbase = 0, qbase = 0, gtot = 0;
#pragma unroll
        for (int w = 0; w < 8; ++w) { const unsigned a = sc[w], c2 = sc[8 + w]; if (w < wid) { gbase += a; qbase += c2; } gtot += a; }
        unsigned G = gbase + gi - gsum, Q = qbase + qi - qsum;
        const unsigned need = (unsigned)CAP - gtot;
#pragma unroll
        for (int j = 0; j < 8; ++j) {
            const int tok = tid * 8 + j;
            const bool sel = g[j] || (q[j] && Q < need);
            const unsigned sl = G + (Q < need ? Q : need);
            if (sel) { selidx[e * EROWS + b * CAP + sl] = b * SEQ + tok; selgate[e * EROWS + b * CAP + sl] = __uint_as_float(v[j]); }
            slot[(size_t)it * SEQ + tok] = sel ? (int)sl : -1;
            G += g[j]; Q += q[j];
        }
        __syncthreads();
    }
}

__device__ __forceinline__ void combine_phase(const Params& P, const float ysc) {
    int tid = threadIdx.x; asm volatile("" : "+v"(tid)); const int wid = tid >> 6, lane = tid & 63;
    const int* slot = (const int*)(P.ws + WS_SLOT);
    const unsigned char* Y = (const unsigned char*)(P.ws + WS_Y);
    for (int row = blockIdx.x * 8 + wid; row < MTOK; row += gridDim.x * 8) {
        const int b = row >> 12, s = row & 4095;
        const int sl = (lane < 16) ? slot[((size_t)b * 16 + lane) * SEQ + s] : -1;
        unsigned long long mask = __ballot(sl >= 0);
        float* op = P.out + (size_t)row * DM;
        const bf16_t* xp = (const bf16_t*)(P.ws + WS_OPART) + (size_t)row * DM;
        f32x4 a[8];
#pragma unroll
        for (int i = 0; i < 4; ++i) { const u32x4 w = *(const u32x4*)(xp + i * 512 + lane * 8);
            a[2 * i] = (f32x4){__uint_as_float(w.x << 16), __uint_as_float(w.x & 0xffff0000u), __uint_as_float(w.y << 16), __uint_as_float(w.y & 0xffff0000u)};
            a[2 * i + 1] = (f32x4){__uint_as_float(w.z << 16), __uint_as_float(w.z & 0xffff0000u), __uint_as_float(w.w << 16), __uint_as_float(w.w & 0xffff0000u)}; }
        while (mask) {
            const int e = __builtin_ctzll(mask); mask &= mask - 1;
            const int se = __shfl(sl, e);
            const unsigned char* yp = Y + ((size_t)e * EROWS + b * CAP + se) * DM + lane * 8;
#pragma unroll
            for (int i = 0; i < 4; ++i) {
                const u32x2 w = *(const u32x2*)(yp + i * 512);
                const f32x2 p0 = __builtin_amdgcn_cvt_pk_f32_fp8((int)w.x, false), p1 = __builtin_amdgcn_cvt_pk_f32_fp8((int)w.x, true);
                const f32x2 p2 = __builtin_amdgcn_cvt_pk_f32_fp8((int)w.y, false), p3 = __builtin_amdgcn_cvt_pk_f32_fp8((int)w.y, true);
                a[2 * i] += (f32x4){p0[0], p0[1], p1[0], p1[1]} * (ysc * (1.0f / YSC8));
                a[2 * i + 1] += (f32x4){p2[0], p2[1], p3[0], p3[1]} * (ysc * (1.0f / YSC8));
            }
        }
#pragma unroll
        for (int i = 0; i < 4; ++i) { *(f32x4*)(op + i * 512 + lane * 8) = a[2 * i]; *(f32x4*)(op + i * 512 + lane * 8 + 4) = a[2 * i + 1]; }
    }
}

#ifndef P1_COMPUTE_WGS
#define P1_COMPUTE_WGS 160
#endif
#ifndef P7_PER_XCD
#define P7_PER_XCD 26
#endif
constexpr int N_PHASES = 10;
__global__ void __launch_bounds__(NTHR, 2) fwd_kernel(Params P) {
    extern __shared__ __attribute__((aligned(16))) unsigned char lds_raw[];
    LAS unsigned char* lds = (LAS unsigned char*)lds_raw;
    const int tid = threadIdx.x;
    volatile LAS unsigned* MISC = (volatile LAS unsigned*)(lds + MISC_OFF);
    if (tid < 16) MISC[tid] = 0u;
    __syncthreads();
    XcdBarrier bar; bar.bar = (unsigned*)(P.ws + WS_CTL); bar.x = 0; bar.st = nullptr;
#if MK_N_LAUNCHES == 1
    bar = xcd_barrier_post((unsigned*)(P.ws + WS_CTL), MISC);
#define GRID_BAR() xcd_barrier(bar)
#else
#define GRID_BAR() do { } while (0)
#endif
    const int lo = P.ph_lo, hi = P.ph_hi;
#ifndef PH_MASK
#define PH_MASK 0x3ff
#endif
#define IN(k) (((PH_MASK >> (k)) & 1) && lo <= (k) && (k) < hi)
#define BOTH(k) (IN(k) && IN((k) + 1))

#ifndef PROBE_DUP
#define PROBE_DUP -1
#endif
#define DUP(k) for (int rep_ = 0; rep_ < ((PROBE_DUP) == (k) ? 2 : 1); ++rep_)
    if (IN(0)) { DUP(0) { p0_prologue(P, lds); __syncthreads(); } if (BOTH(0)) GRID_BAR(); }

    if (IN(1)) {
        { LAS float* gl = (LAS float*)(lds + SCR_OFF + 8192);
          if (tid < 128) { gl[tid] = P.qn_a[tid]; gl[128 + tid] = P.kn_a[tid]; gl[256 + tid] = P.qn_b[tid]; gl[384 + tid] = P.kn_b[tid]; }
          __syncthreads(); }
        DUP(1) {
        pg8::OrderMN S; S.init(P.ws + WS_H, P.ws + WS_WIN, MTOK, INC, DM, P1_COMPUTE_WGS, blockIdx.x);
        EpiInProj E{(bf16_t*)(P.ws + WS_PROJ)};
        pg8::gemm_phase<false, false, false>(lds, DM, S, E, nullptr);
        }
        cvt_queue<2>(P, lds, (unsigned*)(P.ws + WS_CTL) + CW_QG); cvt_queue<3>(P, lds, (unsigned*)(P.ws + WS_CTL) + CW_QU);
        if (BOTH(1)) GRID_BAR();
    }

    if (IN(2)) {
        const bf16_t* proj = (const bf16_t*)(P.ws + WS_PROJ);
        float* opart = (float*)(P.ws + WS_OPART);
        const int da_it = (blockIdx.x & 7) * 32 + (blockIdx.x >> 3);
        DUP(2) {
        if (blockIdx.x < 256) da5::item(P, da_it, lds);
        }
        DUP(12) {
        if (blockIdx.x < 256 && ((da_it >> 5) & 3) == 0) {
            const int r64 = (da_it >> 7) * 32 + (da_it & 31);
#pragma unroll 1
            for (int k = 0; k < 4; ++k) na2::item(P, r64 * 4 + k, lds);
        }
        }
        if (BOTH(2)) GRID_BAR();
    }


    if (IN(4)) {
        DUP(4) {
        pg8::OrderMN S; S.init(P.ws + WS_MIX, P.ws + WS_WOUT, MTOK, DM, DM, gridDim.x, blockIdx.x);
        LAS float* ht = (LAS float*)(lds + SCR_OFF);
        { pg8::Unit u; if (S.next(0, u) && tid < 256) { const float* q = (const float*)(P.ws + WS_NASSQ) + (size_t)(u.pm * 256 + tid) * 8;
            const f32x4 a = *(const f32x4*)q, c = *(const f32x4*)(q + 4);
            ht[tid] = rsqrtf(((a[0] + a[1]) + (a[2] + a[3]) + (c[0] + c[1]) + (c[2] + c[3])) * (1.0f / 1024.0f) + RMS_EPS); } }
        __syncthreads();
        EpiOutProj E{P.x, (bf16_t*)(P.ws + WS_OPART), (float*)(P.ws + WS_ROWSS)};
        pg8::gemm_phase<false, true, false>(lds, DM, S, E, (const LAS unsigned*)ht);
        }
        if (BOTH(4)) GRID_BAR();
    }

    if (IN(5)) { DUP(5) { router_phase(P, lds); __syncthreads(); } if (BOTH(5)) GRID_BAR(); }

    if (IN(6)) { DUP(6) { topk_phase(P, lds); } if (BOTH(6)) GRID_BAR(); }

    if (IN(7)) {
        pg8::OrderExpert S; S.init(P.ws + WS_H2, P.ws + WS_WGU, 2 * FF, DM / 2, 0, (size_t)2 * FF * DM, true, gridDim.x, blockIdx.x, P7_PER_XCD);
        LAS unsigned* gtab = (LAS unsigned*)(lds + SCR_OFF);
        const int* selidx = (const int*)(P.ws + WS_SELIDX);
        { pg8::Unit u; for (int i = 0; i < 12 && S.next(i, u); ++i) { if (tid < 256) gtab[i * 256 + tid] = (unsigned)selidx[u.e * EROWS + u.pm * 256 + tid] * (unsigned)DM; } }
        __syncthreads();
        DUP(7) {
        EpiGateUp E{(unsigned char*)(P.ws + WS_ACT)};
        pg8::gemm_phase<true, false, true>(lds, DM / 2, S, E, gtab);
        }
        cvt_queue<4>(P, lds, (unsigned*)(P.ws + WS_CTL) + CW_QD);
        if (BOTH(7)) GRID_BAR();
    }

    if (IN(8)) {
        DUP(8) {
        pg8::OrderExpert S; S.init(P.ws + WS_ACT, P.ws + WS_WD, DM, FF / 2, (size_t)EROWS * FF, (size_t)DM * FF, false, gridDim.x, blockIdx.x, 32);
        EpiDown E{(unsigned char*)(P.ws + WS_Y), (const float*)(P.ws + WS_SELGATE)};
        pg8::gemm_phase<false, false, true>(lds, FF / 2, S, E, nullptr);
        }
        if (BOTH(8)) GRID_BAR();
    }

    if (IN(9)) { if (PROBE_DUP == 9) { combine_phase(P, 0.5f); __syncthreads(); combine_phase(P, 0.5f); } else combine_phase(P, 1.0f); }
#undef IN
#undef BOTH
}

extern "C" void kernel_launch(void* const* d_in, const int* in_sizes, int n_in, void* d_out, int out_size, void* d_ws, size_t ws_size, hipStream_t stream) {
    static int grid = 0;
    if (grid == 0) {
        if (n_in != 20 || out_size != MTOK * DM || ws_size < WS_END) { fprintf(stderr, "kernel_launch: unexpected shapes (n_in %d out %d ws %zu need %zu)\n", n_in, out_size, ws_size, (size_t)WS_END); grid = -1; return; }
        int dev = 0, cus = 0, per_cu = 0;
        if (hipGetDevice(&dev) != hipSuccess || hipDeviceGetAttribute(&cus, hipDeviceAttributeMultiprocessorCount, dev) != hipSuccess) { grid = -1; return; }
        if (hipFuncSetAttribute((const void*)fwd_kernel, hipFuncAttributeMaxDynamicSharedMemorySize, LDS_BYTES) != hipSuccess) { fprintf(stderr, "kernel_launch: hipFuncSetAttribute failed\n"); grid = -1; return; }
        if (hipOccupancyMaxActiveBlocksPerMultiprocessor(&per_cu, (const void*)fwd_kernel, NTHR, LDS_BYTES) != hipSuccess || per_cu < 1) fprintf(stderr, "kernel_launch: occupancy query reports %d\n", per_cu);
        (void)hipGetLastError();
        if (cus != 256) { fprintf(stderr, "kernel_launch: built for a 256-CU device, found %d\n", cus); grid = -1; return; }
        grid = cus;
    }
    if (grid < 0) return;
    hipMemsetAsync((char*)d_ws + WS_CTL, 0, CTL_BYTES, stream);
    Params p{};
    p.x = (const float*)d_in[0]; p.ln1_g = (const float*)d_in[1]; p.w_in = (const float*)d_in[2]; p.qn_a = (const float*)d_in[3]; p.kn_a = (const float*)d_in[4];
    p.rpb_a = (const float*)d_in[5]; p.on_a = (const float*)d_in[6]; p.qn_b = (const float*)d_in[7]; p.kn_b = (const float*)d_in[8];
    p.lam_q1 = (const float*)d_in[9]; p.lam_k1 = (const float*)d_in[10]; p.lam_q2 = (const float*)d_in[11]; p.lam_k2 = (const float*)d_in[12]; p.subln_b = (const float*)d_in[13];
    p.w_out = (const float*)d_in[14]; p.ln2_g = (const float*)d_in[15]; p.w_router = (const float*)d_in[16]; p.w_gate = (const float*)d_in[17]; p.w_up = (const float*)d_in[18]; p.w_down = (const float*)d_in[19];
    p.out = (float*)d_out; p.ws = (unsigned char*)d_ws;
#if MK_N_LAUNCHES == 1
    p.ph_lo = 0; p.ph_hi = N_PHASES;
    hipLaunchKernelGGL(fwd_kernel, dim3(grid), dim3(NTHR), LDS_BYTES, stream, p);
#else
#ifndef PROBE_LDUP
#define PROBE_LDUP -1
#endif
    for (int ph = 0; ph < N_PHASES; ++ph) { p.ph_lo = ph; p.ph_hi = ph + 1;
        for (int rep = 0; rep < ((ph == PROBE_LDUP && ph != 9) ? 2 : 1); ++rep) hipLaunchKernelGGL(fwd_kernel, dim3(grid), dim3(NTHR), LDS_BYTES, stream, p); }
#endif
    const hipError_t le = hipPeekAtLastError();
    if (le != hipSuccess) fprintf(stderr, "kernel_launch: launch failed: %s\n", hipGetErrorName(le));
}
```
